# Optimizing an MI355X kernel written in HIP

```python
import math
import jax, jax.numpy as jnp
from jax import lax
import numpy as np

D_MODEL = 1024
BATCH = 2
SEQ = 8192
DEPTH = 4
DEC_BATCH = 16
DEC_SEQ = 16
PAST_LEN = 4096

CHUNK = 64
EPS = 1e-6
D_FF = 2816
CONV_W = 4
LRU_WIDTH = 1024
LRU_BLOCKS = 16
LRU_BS = LRU_WIDTH // LRU_BLOCKS
LRU_C = 8.0
SSD_HEADS = 16
SSD_HEAD_DIM = 64
SSD_INNER = SSD_HEADS * SSD_HEAD_DIM
SSD_GROUPS = 2
SSD_STATE = 128
SSD_CONV_DIM = SSD_INNER + 2 * SSD_GROUPS * SSD_STATE
N_HEADS = 16
N_KV_HEADS = 4
GQA = N_HEADS // N_KV_HEADS
HEAD_DIM = 64
ATT_WIDTH = N_HEADS * HEAD_DIM
KV_WIDTH = N_KV_HEADS * HEAD_DIM
WINDOW = 128
WIN_CHUNKS = WINDOW // CHUNK
BAND = (WIN_CHUNKS + 1) * CHUNK
NEG = -1e30
N_BRANCH = 3
IN_SIZES = (LRU_WIDTH, LRU_WIDTH, SSD_INNER, SSD_CONV_DIM, SSD_HEADS, ATT_WIDTH, KV_WIDTH, KV_WIDTH, N_BRANCH * D_MODEL)
N_IN = LRU_WIDTH * 2 + SSD_INNER + SSD_CONV_DIM + SSD_HEADS + ATT_WIDTH + 2 * KV_WIDTH + N_BRANCH * D_MODEL
BRANCH_WIDTH = LRU_WIDTH + SSD_INNER + ATT_WIDTH

kernel_name = 'hybrid_streaming_encoder_step'

f32 = jnp.float32


def rms_norm(x, g):
    x32 = x.astype(f32)
    y = x32 * lax.rsqrt(jnp.mean(x32 * x32, axis=-1, keepdims=True) + EPS)
    return (y * g.astype(f32)).astype(x.dtype)


def swiglu(x, wg, wu, wd):
    return (jax.nn.silu(x @ wg) * (x @ wu)) @ wd


def split_cols(h):
    idx = []
    acc = 0
    for s in IN_SIZES[:-1]:
        acc += s
        idx.append(acc)
    return jnp.split(h, idx, axis=-1)


def causal_conv(x, buf, w, b):
    xp = jnp.concatenate([buf, x], axis=1)
    L = x.shape[1]
    y = b + xp[:, 0:L] * w[0]
    for j in range(1, CONV_W):
        y = y + xp[:, j:j + L] * w[j]
    return y, xp[:, -(CONV_W - 1):]


def _lin_combine(e1, e2):
    a1, b1 = e1
    a2, b2 = e2
    return a1 * a2, a2 * b1 + b2


def rglru(x, h0, w_a, b_a, w_x, b_x, lam):
    bsz, L, W = x.shape
    xb = x.reshape(bsz, L, LRU_BLOCKS, LRU_BS)
    r = jax.nn.sigmoid(jnp.einsum('blnk,nkj->blnj', xb, w_a).reshape(bsz, L, W) + b_a)
    i = jax.nn.sigmoid(jnp.einsum('blnk,nkj->blnj', xb, w_x).reshape(bsz, L, W) + b_x)
    log_a = -LRU_C * r.astype(f32) * jax.nn.softplus(-lam.astype(f32))
    a = jnp.exp(log_a)
    u = jnp.sqrt(-jnp.expm1(2.0 * log_a)) * (i * x).astype(f32)
    a_cum, u_cum = lax.associative_scan(_lin_combine, (a, u), axis=1)
    h = a_cum * h0.astype(f32)[:, None] + u_cum
    return h.astype(x.dtype), h[:, -1].astype(x.dtype)


def ssd_scan(x, dt, A, B, C, h0, q):
    b, l, H, P = x.shape
    G, N = B.shape[2], B.shape[3]
    R = H // G
    nc = l // q
    x = x.reshape(b, nc, q, G, R, P)
    dt = dt.reshape(b, nc, q, G, R)
    B = B.reshape(b, nc, q, G, N)
    C = C.reshape(b, nc, q, G, N)
    cum = jnp.cumsum(dt * A.reshape(G, R), axis=2)
    seg = cum[:, :, :, None] - cum[:, :, None, :]
    causal = jnp.tril(jnp.ones((q, q), bool))[:, :, None, None]
    Lmat = jnp.where(causal, jnp.exp(jnp.where(causal, seg, 0.0)), 0.0)
    CB = jnp.einsum('bcign,bcjgn->bcijg', C, B)
    Wm = CB[..., None] * Lmat * dt[:, :, None]
    y_diag = jnp.einsum('bcijgr,bcjgrp->bcigrp', Wm, x)
    decay_end = jnp.exp(cum[:, :, -1:] - cum) * dt
    states = jnp.einsum('bcjgn,bcjgr,bcjgrp->bcgrpn', B, decay_end, x)
    chunk_decay = jnp.exp(cum[:, :, -1])

    def step(h, inp):
        dec, st = inp
        return dec[..., None, None] * h + st, h

    h_fin, h_in = lax.scan(step, h0.reshape(b, G, R, P, N),
                           (jnp.moveaxis(chunk_decay, 1, 0), jnp.moveaxis(states, 1, 0)))
    h_in = jnp.moveaxis(h_in, 0, 1)
    y_off = jnp.einsum('bcign,bcigr,bcgrpn->bcigrp', C, jnp.exp(cum), h_in)
    return (y_diag + y_off).reshape(b, l, H, P), h_fin.reshape(b, H, P, N)


def ssd_branch(z, xbc, dt_raw, conv_buf, h0, conv_w, conv_b, dt_bias, a_log, d_skip, norm_g, q):
    bsz, L = z.shape[:2]
    xbc, new_buf = causal_conv(xbc, conv_buf, conv_w, conv_b)
    xbc = jax.nn.silu(xbc)
    xs, Bm, Cm = jnp.split(xbc, [SSD_INNER, SSD_INNER + SSD_GROUPS * SSD_STATE], axis=-1)
    xs = xs.reshape(bsz, L, SSD_HEADS, SSD_HEAD_DIM).astype(f32)
    Bm = Bm.reshape(bsz, L, SSD_GROUPS, SSD_STATE).astype(f32)
    Cm = Cm.reshape(bsz, L, SSD_GROUPS, SSD_STATE).astype(f32)
    dt = jax.nn.softplus(dt_raw.astype(f32) + dt_bias.astype(f32))
    A = -jnp.exp(a_log.astype(f32))
    y, h = ssd_scan(xs, dt, A, Bm, Cm, h0.astype(f32), q)
    y = y + d_skip.astype(f32)[:, None] * xs
    y = (y.reshape(bsz, L, SSD_INNER) * jax.nn.silu(z.astype(f32))).astype(z.dtype)
    gs = SSD_INNER // SSD_GROUPS
    y = rms_norm(y.reshape(bsz, L, SSD_GROUPS, gs), norm_g.reshape(SSD_GROUPS, gs)).reshape(bsz, L, SSD_INNER)
    return y, new_buf, h.astype(z.dtype)


def alibi_slopes():
    return jnp.exp2(-8.0 * (jnp.arange(N_HEADS, dtype=f32) + 1.0) / N_HEADS)


def attend(q, k, v, q_pos, k_pos, sink):
    s = jnp.einsum('bnqkgd,bnskd->bnkgqs', q.astype(f32), k.astype(f32)) * (HEAD_DIM ** -0.5)
    dist = jnp.abs(q_pos[:, :, None] - k_pos[:, None, :]).astype(f32)
    slopes = alibi_slopes().reshape(N_KV_HEADS, GQA)
    s = s - slopes[None, None, :, :, None, None] * dist[None, :, None, None]
    qc = q_pos[:, :, None] // CHUNK
    kc = k_pos[:, None, :] // CHUNK
    visible = (k_pos[:, None, :] >= 0) & (kc >= qc - WIN_CHUNKS) & (kc <= qc)
    s = jnp.where(visible[None, :, None, None], s, NEG)
    sk = sink.astype(f32).reshape(N_KV_HEADS, GQA)[None, None, :, :, None, None]
    m = jnp.maximum(jnp.max(s, axis=-1, keepdims=True), sk)
    p = jnp.exp(s - m)
    den = jnp.sum(p, axis=-1, keepdims=True) + jnp.exp(sk - m)
    return jnp.einsum('bnkgqs,bnskd->bnqkgd', p / den, v.astype(f32))


def swa_prompt(q, k, v, sink):
    bsz, L = q.shape[:2]
    nc = L // CHUNK
    pad = WIN_CHUNKS * CHUNK
    qg = q.reshape(bsz, nc, CHUNK, N_KV_HEADS, GQA, HEAD_DIM)

    def band(t):
        tp = jnp.pad(t, ((0, 0), (pad, 0), (0, 0), (0, 0))).reshape(bsz, nc + WIN_CHUNKS, CHUNK, N_KV_HEADS, HEAD_DIM)
        return jnp.concatenate([tp[:, j:j + nc] for j in range(WIN_CHUNKS + 1)], axis=2)

    q_pos = jnp.arange(nc)[:, None] * CHUNK + jnp.arange(CHUNK)[None]
    k_pos = (jnp.arange(nc)[:, None] - WIN_CHUNKS) * CHUNK + jnp.arange(BAND)[None]
    o = attend(qg, band(k), band(v), q_pos, k_pos, sink)
    return o.reshape(bsz, L, ATT_WIDTH).astype(q.dtype), k[:, -WINDOW:], v[:, -WINDOW:]


def swa_sample(q, k, v, cache_k, cache_v, sink):
    bsz, L = q.shape[:2]
    n_cache = cache_k.shape[1]
    kk = jnp.concatenate([cache_k, k], axis=1)
    vv = jnp.concatenate([cache_v, v], axis=1)
    qg = q.reshape(bsz, 1, L, N_KV_HEADS, GQA, HEAD_DIM)
    q_pos = (PAST_LEN + jnp.arange(L))[None]
    k_pos = (PAST_LEN - n_cache + jnp.arange(n_cache + L))[None]
    o = attend(qg, kk[:, None], vv[:, None], q_pos, k_pos, sink)
    return o.reshape(bsz, L, ATT_WIDTH).astype(q.dtype), kk[:, -n_cache:], vv[:, -n_cache:]


def token_mixer(n, p, l, st, prompt):
    bsz, L = n.shape[:2]
    cache_k, cache_v, lru_conv, lru_h, ssd_conv, ssd_h = st
    x_lru, g_lru, z, xbc, dt_raw, q, k, v, g_pre = split_cols(n @ p['w_in'][l])
    xa, new_lru_conv = causal_conv(x_lru, lru_conv, p['lru_conv_w'][l], p['lru_conv_b'][l])
    ha, new_lru_h = rglru(xa, lru_h, p['lru_w_a'][l], p['lru_b_a'][l], p['lru_w_x'][l], p['lru_b_x'][l], p['lru_lambda'][l])
    y_a = ha * jax.nn.gelu(g_lru)
    y_b, new_ssd_conv, new_ssd_h = ssd_branch(z, xbc, dt_raw, ssd_conv, ssd_h, p['ssd_conv_w'][l], p['ssd_conv_b'][l],
                                              p['ssd_dt_bias'][l], p['ssd_a_log'][l], p['ssd_d'][l], p['ssd_norm'][l],
                                              CHUNK if prompt else L)
    q = q.reshape(bsz, L, N_HEADS, HEAD_DIM)
    k = k.reshape(bsz, L, N_KV_HEADS, HEAD_DIM)
    v = v.reshape(bsz, L, N_KV_HEADS, HEAD_DIM)
    if prompt:
        y_c, new_k, new_v = swa_prompt(q, k, v, p['attn_sink'][l])
    else:
        y_c, new_k, new_v = swa_sample(q, k, v, cache_k, cache_v, p['attn_sink'][l])
    gates = jax.nn.sigmoid(g_pre).reshape(bsz, L, N_BRANCH, D_MODEL)
    wb = p['w_branch'][l]
    merged = (gates[:, :, 0] * (y_a @ wb[:LRU_WIDTH])
              + gates[:, :, 1] * (y_b @ wb[LRU_WIDTH:LRU_WIDTH + SSD_INNER])
              + gates[:, :, 2] * (y_c @ wb[LRU_WIDTH + SSD_INNER:]))
    return merged @ p['w_out'][l], (new_k, new_v, new_lru_conv, new_lru_h, new_ssd_conv, new_ssd_h)


def run_layer(x, p, l, st, prompt):
    x = x + 0.5 * swiglu(rms_norm(x, p['ffn_norm'][l, 0]), p['ffn_w_gate'][l, 0], p['ffn_w_up'][l, 0], p['ffn_w_down'][l, 0])
    mix, new_st = token_mixer(rms_norm(x, p['mix_norm'][l]), p, l, st, prompt)
    x = x + mix
    x = x + 0.5 * swiglu(rms_norm(x, p['ffn_norm'][l, 1]), p['ffn_w_gate'][l, 1], p['ffn_w_up'][l, 1], p['ffn_w_down'][l, 1])
    return x, new_st


def setup_inputs(seed: int = 0) -> dict:
    key = jax.random.key(seed)
    ks = iter(jax.random.split(key, 40))

    def nrm(shape, scale):
        return scale * jax.random.normal(next(ks), shape, f32)

    L = DEPTH
    att_rows = min(WINDOW, PAST_LEN)
    u = jax.random.uniform(next(ks), (L, LRU_WIDTH), f32, 0.9, 0.999)
    s = u ** (1.0 / LRU_C)
    lru_lambda = jnp.log(s) - jnp.log1p(-s)
    dt = jnp.exp(jax.random.uniform(next(ks), (L, SSD_HEADS), f32, math.log(1e-3), math.log(1e-1)))
    ssd_dt_bias = dt + jnp.log(-jnp.expm1(-dt))
    ssd_a_log = jnp.log(jax.random.uniform(next(ks), (L, SSD_HEADS), f32, 1.0, 16.0))
    return {
        'x_prompt': nrm((BATCH, SEQ, D_MODEL), 1.0),
        'x_sample': nrm((DEC_BATCH, DEC_SEQ, D_MODEL), 1.0),
        'cache_attn_k': nrm((L, DEC_BATCH, att_rows, N_KV_HEADS, HEAD_DIM), 1.0),
        'cache_attn_v': nrm((L, DEC_BATCH, att_rows, N_KV_HEADS, HEAD_DIM), 1.0),
        'state_lru_conv': nrm((L, DEC_BATCH, CONV_W - 1, LRU_WIDTH), 1.0),
        'state_lru_h': nrm((L, DEC_BATCH, LRU_WIDTH), 0.5),
        'state_ssd_conv': nrm((L, DEC_BATCH, CONV_W - 1, SSD_CONV_DIM), 1.0),
        'state_ssd_h': nrm((L, DEC_BATCH, SSD_HEADS, SSD_HEAD_DIM, SSD_STATE), 0.1),
        'ffn_norm': 1.0 + nrm((L, 2, D_MODEL), 0.01),
        'ffn_w_gate': nrm((L, 2, D_MODEL, D_FF), D_MODEL ** -0.5),
        'ffn_w_up': nrm((L, 2, D_MODEL, D_FF), D_MODEL ** -0.5),
        'ffn_w_down': nrm((L, 2, D_FF, D_MODEL), D_FF ** -0.5),
        'mix_norm': 1.0 + nrm((L, D_MODEL), 0.01),
        'w_in': nrm((L, D_MODEL, N_IN), D_MODEL ** -0.5),
        'lru_conv_w': nrm((L, CONV_W, LRU_WIDTH), CONV_W ** -0.5),
        'lru_conv_b': nrm((L, LRU_WIDTH), 0.01),
        'lru_w_a': nrm((L, LRU_BLOCKS, LRU_BS, LRU_BS), LRU_BS ** -0.5),
        'lru_b_a': nrm((L, LRU_WIDTH), 0.01),
        'lru_w_x': nrm((L, LRU_BLOCKS, LRU_BS, LRU_BS), LRU_BS ** -0.5),
        'lru_b_x': nrm((L, LRU_WIDTH), 0.01),
        'lru_lambda': lru_lambda,
        'ssd_conv_w': nrm((L, CONV_W, SSD_CONV_DIM), CONV_W ** -0.5),
        'ssd_conv_b': nrm((L, SSD_CONV_DIM), 0.01),
        'ssd_dt_bias': ssd_dt_bias,
        'ssd_a_log': ssd_a_log,
        'ssd_d': 1.0 + nrm((L, SSD_HEADS), 0.01),
        'ssd_norm': 1.0 + nrm((L, SSD_INNER), 0.01),
        'attn_sink': nrm((L, N_HEADS), 0.5),
        'w_branch': nrm((L, BRANCH_WIDTH, D_MODEL), 1024 ** -0.5),
        'w_out': nrm((L, D_MODEL, D_MODEL), D_MODEL ** -0.5),
        'final_norm': 1.0 + nrm((D_MODEL,), 0.01),
    }


def reference(x_prompt, x_sample, cache_attn_k, cache_attn_v, state_lru_conv, state_lru_h, state_ssd_conv, state_ssd_h,
              ffn_norm, ffn_w_gate, ffn_w_up, ffn_w_down, mix_norm, w_in, lru_conv_w, lru_conv_b, lru_w_a, lru_b_a,
              lru_w_x, lru_b_x, lru_lambda, ssd_conv_w, ssd_conv_b, ssd_dt_bias, ssd_a_log, ssd_d, ssd_norm, attn_sink,
              w_branch, w_out, final_norm):
    p = {'ffn_norm': ffn_norm, 'ffn_w_gate': ffn_w_gate, 'ffn_w_up': ffn_w_up, 'ffn_w_down': ffn_w_down,
         'mix_norm': mix_norm, 'w_in': w_in, 'lru_conv_w': lru_conv_w, 'lru_conv_b': lru_conv_b,
         'lru_w_a': lru_w_a, 'lru_b_a': lru_b_a, 'lru_w_x': lru_w_x, 'lru_b_x': lru_b_x, 'lru_lambda': lru_lambda,
         'ssd_conv_w': ssd_conv_w, 'ssd_conv_b': ssd_conv_b, 'ssd_dt_bias': ssd_dt_bias, 'ssd_a_log': ssd_a_log,
         'ssd_d': ssd_d, 'ssd_norm': ssd_norm, 'attn_sink': attn_sink, 'w_branch': w_branch, 'w_out': w_out}
    dt_ = x_prompt.dtype
    bp = x_prompt.shape[0]
    xp, xs = x_prompt, x_sample
    p_new = [[] for _ in range(6)]
    s_new = [[] for _ in range(6)]
    for l in range(DEPTH):
        st_p = (None, None,
                jnp.zeros((bp, CONV_W - 1, LRU_WIDTH), dt_), jnp.zeros((bp, LRU_WIDTH), dt_),
                jnp.zeros((bp, CONV_W - 1, SSD_CONV_DIM), dt_),
                jnp.zeros((bp, SSD_HEADS, SSD_HEAD_DIM, SSD_STATE), dt_))
        xp, np_st = run_layer(xp, p, l, st_p, True)
        st_s = (cache_attn_k[l], cache_attn_v[l], state_lru_conv[l], state_lru_h[l], state_ssd_conv[l], state_ssd_h[l])
        xs, ns_st = run_layer(xs, p, l, st_s, False)
        for j in range(6):
            p_new[j].append(np_st[j])
            s_new[j].append(ns_st[j])
    y_prompt = rms_norm(xp, final_norm)
    y_sample = rms_norm(xs, final_norm)
    pk, pv, plc, plh, psc, psh = [jnp.stack(t, axis=0) for t in p_new]
    sk, sv, slc, slh, ssc, ssh = [jnp.stack(t, axis=0) for t in s_new]
    return (y_prompt, y_sample, pk, pv, plc, plh, psc, psh, sk, sv, slc, slh, ssc, ssh)
```

```cpp
#include <hip/hip_runtime.h>
#include <hip/hip_cooperative_groups.h>
#include <cstdio>
namespace cg = cooperative_groups;
#define DBG_SANITIZE 0
#define DBG_MIX 1
#define DBG_MERGE 1
#define DBG_ATTN 1
#define DBG_LRU4 1
#define DBG_SSD4 1
#define DBG_P5S 1
#define DBG_P5W 1
#define DBG_P5 1
#define DBG_LRU6 1
#define DBG_SSD6 1

#define LAS __attribute__((address_space(3)))
typedef unsigned short bf16_t;
typedef short bf16x8 __attribute__((ext_vector_type(8)));
typedef float f32x4 __attribute__((ext_vector_type(4)));
typedef unsigned u32x4 __attribute__((ext_vector_type(4)));
typedef unsigned u32x2 __attribute__((ext_vector_type(2)));

constexpr int MP = 16384, MS = 256, MT = 16640;
constexpr int DM = 1024, DFF = 2816, NIN = 9232, NINP = 9472, HP = 9232;
constexpr int HX = 0, HG = 1024, HZ = 2048, HXBC = 3072, HQ = 4608, HK = 5632, HV = 5888, HGATE = 6144, HDT = 9216;
constexpr float EPS = 1e-6f;
constexpr int NITEM = 272;

enum { I_XP = 0, I_XS, I_CK, I_CV, I_SLC, I_SLH, I_SSC, I_SSH, I_FNORM, I_WG, I_WU, I_WD, I_MNORM, I_WIN, I_LCW, I_LCB, I_LWA, I_LBA, I_LWX, I_LBX,
       I_LLAM, I_SCW, I_SCB, I_SDTB, I_SALOG, I_SD, I_SNORM, I_SINK, I_WBR, I_WOUT, I_FINAL, N_INPUTS };

constexpr size_t O_YP = 0, O_YS = O_YP + (size_t)MP * DM, O_PK = O_YS + (size_t)MS * DM, O_PV = O_PK + 4 * 2 * 128 * 256, O_PLC = O_PV + 4 * 2 * 128 * 256,
                 O_PLH = O_PLC + 4 * 2 * 3 * 1024, O_PSC = O_PLH + 4 * 2 * 1024, O_PSH = O_PSC + 4 * 2 * 3 * 1536, O_SK = O_PSH + (size_t)4 * 2 * 16 * 64 * 128,
                 O_SV = O_SK + (size_t)4 * 16 * 128 * 256, O_SLC = O_SV + (size_t)4 * 16 * 128 * 256, O_SLH = O_SLC + 4 * 16 * 3 * 1024, O_SSC = O_SLH + 4 * 16 * 1024,
                 O_SSH = O_SSC + 4 * 16 * 3 * 1536, O_END = O_SSH + (size_t)4 * 16 * 16 * 64 * 128;

constexpr size_t WS_XB = 0;
constexpr size_t WS_H = WS_XB + (size_t)MT * DM * 2;
constexpr size_t WS_ST = WS_H + (size_t)MT * HP * 2;
constexpr size_t WS_Y = WS_ST + (size_t)2 * 128 * 16 * 64 * 128 * 2;
constexpr size_t WS_W = WS_Y + (size_t)MT * 3072 * 2;
constexpr size_t W_GU0 = WS_W, W_GU1 = W_GU0 + (size_t)5632 * 1024 * 2, W_DN0 = W_GU1 + (size_t)5632 * 1024 * 2, W_DN1 = W_DN0 + (size_t)1024 * 2816 * 2,
                 W_IN = W_DN1 + (size_t)1024 * 2816 * 2, W_BR = W_IN + (size_t)NINP * 1024 * 2, W_OUT = W_BR + (size_t)1024 * 3072 * 2,
                 W_LA = W_OUT + (size_t)1024 * 1024 * 2, W_LX = W_LA + 65536 * 2, WS_SSQ = W_LX + 65536 * 2;
constexpr size_t WS_DT = WS_SSQ + (size_t)MT * 16 * 4, WS_LRUA = WS_DT + (size_t)MT * 16 * 4, WS_LRUU = WS_LRUA + 256 * 1024 * 4, WS_CDEC = WS_LRUU + 256 * 1024 * 4,
                 WS_END = WS_CDEC + 256 * 16 * 4;

constexpr int LDS_BYTES = 147456;

struct Params { const float* in[N_INPUTS]; float* out; unsigned char* ws; };
typedef const Params __attribute__((address_space(4))) * KP;
__device__ __forceinline__ KP kparams() { KP p = (KP)__builtin_amdgcn_kernarg_segment_ptr(); asm volatile("" : "+s"(p)); return p; }
__device__ __forceinline__ int tidx(int wv) { int t; asm volatile("v_mbcnt_lo_u32_b32 %0, -1, 0\n\tv_mbcnt_hi_u32_b32 %0, -1, %0" : "=v"(t)); return (wv << 6) | t; }
__device__ __forceinline__ int bidx() { int t = blockIdx.x; asm volatile("" : "+s"(t)); return t; }
__device__ __forceinline__ int gdim() { int t = gridDim.x; asm volatile("" : "+s"(t)); return t; }

typedef __bf16 bf16x2_t __attribute__((ext_vector_type(2)));
typedef float f32x2_t __attribute__((ext_vector_type(2)));
__device__ __forceinline__ unsigned pk2(float lo, float hi) { f32x2_t v = {lo, hi}; bf16x2_t b = __builtin_convertvector(v, bf16x2_t); unsigned r; __builtin_memcpy(&r, &b, 4); return r; }
__device__ __forceinline__ bf16_t f2bf(float f) { return (bf16_t)(pk2(f, 0.f) & 0xffffu); }
__device__ __forceinline__ float bf2f(bf16_t b) { return __uint_as_float(((unsigned)b) << 16); }
__device__ __forceinline__ float bflo(unsigned w) { return __uint_as_float(w << 16); }
__device__ __forceinline__ float bfhi(unsigned w) { return __uint_as_float(w & 0xffff0000u); }
__device__ __forceinline__ float sigmoidf_(float x) { return 1.0f / (1.0f + __expf(-x)); }
__device__ __forceinline__ float siluf_(float x) { return x / (1.0f + __expf(-x)); }
__device__ __forceinline__ float softplusf_(float x) { return x > 20.f ? x : log1pf(__expf(x)); }
__device__ __forceinline__ float gelu_tanh(float x) { const float u = 0.7978845608028654f * (x + 0.044715f * x * x * x); return 0.5f * x * (1.0f + tanhf(u)); }
__device__ __forceinline__ float rstd_row(const float* ssq, int r) {
    const f32x4* p = (const f32x4*)(ssq + (size_t)r * 16); f32x4 a = p[0], b = p[1], c = p[2], d = p[3];
    const float s = (a[0] + a[1] + a[2] + a[3]) + (b[0] + b[1] + b[2] + b[3]) + (c[0] + c[1] + c[2] + c[3]) + (d[0] + d[1] + d[2] + d[3]);
    return rsqrtf(s * (1.0f / 1024.0f) + EPS);
}
#define MFMA16(a, b, c) __builtin_amdgcn_mfma_f32_16x16x32_bf16((a), (b), (c), 0, 0, 0)

namespace pg8 {
constexpr int BM = 256, BK = 64, HALF = 128, HTB = HALF * BK * 2, STAGE_BYTES = 8 * HTB, NXCD = 8, WGM = 8;
__device__ __forceinline__ int lds_byte(int r, int c) { const int st = (r >> 4) * 2 + (c >> 5), rr = r & 15, cc = c & 31, ob = rr * 64 + cc * 2; return st * 1024 + (ob ^ (((ob >> 9) & 1) << 5)); }
__device__ __forceinline__ void stage_rc(int b, int& R, int& C) { const int st = b / 1024, sb = b % 1024, swz = sb ^ (((sb >> 9) & 1) << 5); R = (st >> 1) * 16 + swz / 64; C = (st & 1) * 32 + (swz % 64) / 2; }
struct Unit { int pm, pn; };
struct Gemm { const bf16_t* A; const bf16_t* Bt; int M, N, K; };
struct StaticOrder {
    int nM, nN, nwg, G, c;
    __device__ void init(int M, int N, int G_, int c_) { nM = M / BM; nN = N / BM; nwg = nM * nN; G = G_; c = c_; }
    __device__ bool next(int i, Unit& u) const {
        const long L = (long)i * G + c; if (L >= nwg) return false;
        int wgid = (int)L; { const int q = nwg / NXCD, r = nwg % NXCD, xcd = wgid % NXCD, off = wgid / NXCD; wgid = (xcd < r ? xcd * (q + 1) : r * (q + 1) + (xcd - r) * q) + off; }
        const int nig = WGM * nN, gid = wgid / nig, fm = gid * WGM, gsz = (nM - fm) < WGM ? (nM - fm) : WGM;
        u.pm = fm + ((wgid % nig) % gsz); u.pn = (wgid % nig) / gsz; return true;
    }
};

template <class Epi>
__device__ __forceinline__ void gemm_phase(int wv, LAS unsigned char* lds, const Gemm g, const StaticOrder& S, const Epi& E) {
    const int tid = tidx(wv), wid = wv, lane = tid & 63, wr = wid >> 2, wc = wid & 3, fr = lane & 15, fq = lane >> 4;
    const int K = g.K, nt = K / BK;
    unsigned voffA[2];
#pragma unroll
    for (int i = 0; i < 2; ++i) { int R, C; stage_rc(tid * 16 + i * 8192, R, C); voffA[i] = (unsigned)(R * K + C) * 2u; }
    const size_t kstep = (size_t)(BK * 2);
    const size_t hstep = (size_t)HALF * K * 2;
    const size_t tstep = 2 * hstep;
    const unsigned ldsw = (unsigned)wid * 1024u;
    const int aoff = lds_byte(wr * 64 + fr, fq * 8), boff = lds_byte(wc * 32 + fr, fq * 8);
#define PG8_SA(b, h) (((b) * 2 + (h)) * HTB)
#define PG8_SB(b, h) ((4 + (b) * 2 + (h)) * HTB)
#define PG8_STAGE(bufoff, gbase, voff) do { _Pragma("unroll") for (int _i = 0; _i < 2; ++_i) \
        __builtin_amdgcn_global_load_lds((const unsigned*)((const char*)(gbase) + (voff)[_i]), (LAS unsigned*)(lds + (bufoff) + ldsw + _i * 8192), 16, 0, 0); } while (0)
#define PG8_LDA(dst, b, h) do { _Pragma("unroll") for (int m = 0; m < 4; ++m) _Pragma("unroll") for (int k = 0; k < 2; ++k) dst[m][k] = *(const LAS bf16x8*)(lds + PG8_SA(b, h) + aoff + m * 2048 + k * 1024); } while (0)
#define PG8_LDB(dst, b, h) do { _Pragma("unroll") for (int n = 0; n < 2; ++n) _Pragma("unroll") for (int k = 0; k < 2; ++k) dst[n][k] = *(const LAS bf16x8*)(lds + PG8_SB(b, h) + boff + n * 2048 + k * 1024); } while (0)
#define PG8_MMA(ai, bj, At, Bt) do { __builtin_amdgcn_s_setprio(1); _Pragma("unroll") for (int m = 0; m < 4; ++m) _Pragma("unroll") for (int n = 0; n < 2; ++n) _Pragma("unroll") for (int k = 0; k < 2; ++k) \
        acc[ai][bj][m][n] = __builtin_amdgcn_mfma_f32_16x16x32_bf16(Bt[n][k], At[m][k], acc[ai][bj][m][n], 0, 0, 0); __builtin_amdgcn_s_setprio(0); } while (0)
#define PG8_WAIT_V(n) asm volatile("s_waitcnt vmcnt(" #n ")" ::: "memory")
#define PG8_WAIT_L(n) asm volatile("s_waitcnt lgkmcnt(" #n ")" ::: "memory")
#define PG8_BAR __builtin_amdgcn_s_barrier()
#define PG8_SCHED __builtin_amdgcn_sched_barrier(0)
    Unit cur, nxt; int ui = 0;
    if (!S.next(0, cur)) return;
    f32x4 acc[2][2][4][2];
#pragma unroll
    for (int a = 0; a < 2; ++a)
#pragma unroll
        for (int b = 0; b < 2; ++b)
#pragma unroll
            for (int m = 0; m < 4; ++m)
#pragma unroll
                for (int n = 0; n < 2; ++n) acc[a][b][m][n] = (f32x4){0.f, 0.f, 0.f, 0.f};
    bf16x8 At[4][2], B0[2][2], B1[2][2];
    const char* cA = (const char*)g.A + (size_t)cur.pm * tstep; const char* cB = (const char*)g.Bt + (size_t)cur.pn * tstep;
    PG8_STAGE(PG8_SB(0, 0), cB, voffA); PG8_STAGE(PG8_SA(0, 0), cA, voffA); PG8_STAGE(PG8_SB(0, 1), cB + hstep, voffA); PG8_STAGE(PG8_SA(0, 1), cA + hstep, voffA);
    if (wr == 1) PG8_BAR;
    PG8_WAIT_V(4); PG8_BAR;
    PG8_STAGE(PG8_SB(1, 0), cB + kstep, voffA); PG8_STAGE(PG8_SA(1, 0), cA + kstep, voffA); PG8_STAGE(PG8_SB(1, 1), cB + hstep + kstep, voffA);
    PG8_WAIT_V(6); PG8_BAR;
    for (;;) {
        const bool has_next = S.next(ui + 1, nxt);
        const char* nA = has_next ? (const char*)g.A + (size_t)nxt.pm * tstep : cA; const char* nB = has_next ? (const char*)g.Bt + (size_t)nxt.pn * tstep : cB;
        for (int t = 0; t < nt; t += 2) {
            const bool last = (t == nt - 2);
            const char* a1 = cA + (size_t)(t + 1) * kstep;
            const char* a2 = last ? nA : cA + (size_t)(t + 2) * kstep; const char* b2 = last ? nB : cB + (size_t)(t + 2) * kstep;
            const char* a3 = a2 + kstep; const char* b3 = b2 + kstep;
            PG8_LDB(B0, 0, 0); PG8_SCHED; PG8_LDA(At, 0, 0); PG8_STAGE(PG8_SA(1, 1), a1 + hstep, voffA);
            PG8_WAIT_L(8); PG8_BAR; PG8_WAIT_L(0); PG8_MMA(0, 0, At, B0); PG8_BAR; PG8_SCHED;
            PG8_LDB(B1, 0, 1); PG8_STAGE(PG8_SB(0, 0), b2, voffA);
            PG8_BAR; PG8_WAIT_L(0); PG8_MMA(0, 1, At, B1); PG8_BAR;
            PG8_LDA(At, 0, 1); PG8_STAGE(PG8_SA(0, 0), a2, voffA);
            PG8_BAR; PG8_WAIT_L(0); PG8_MMA(1, 0, At, B0); PG8_BAR; PG8_SCHED;
            PG8_STAGE(PG8_SB(0, 1), b2 + hstep, voffA);
            PG8_WAIT_V(6); PG8_BAR; PG8_MMA(1, 1, At, B1); PG8_BAR;
            PG8_LDB(B0, 1, 0); PG8_SCHED; PG8_LDA(At, 1, 0); PG8_STAGE(PG8_SA(0, 1), a2 + hstep, voffA);
            PG8_WAIT_L(8); PG8_BAR; PG8_WAIT_L(0); PG8_MMA(0, 0, At, B0); PG8_BAR; PG8_SCHED;
            PG8_LDB(B1, 1, 1); PG8_STAGE(PG8_SB(1, 0), b3, voffA);
            PG8_BAR; PG8_WAIT_L(0); PG8_MMA(0, 1, At, B1); PG8_BAR;
            PG8_LDA(At, 1, 1); PG8_STAGE(PG8_SA(1, 0), a3, voffA);
            PG8_BAR; PG8_WAIT_L(0); PG8_MMA(1, 0, At, B0); PG8_BAR; PG8_SCHED;
            PG8_STAGE(PG8_SB(1, 1), b3 + hstep, voffA);
            PG8_WAIT_V(6); PG8_BAR; PG8_MMA(1, 1, At, B1); PG8_BAR;
            if constexpr (Epi::HAS_MID) { if (!last && ((t + 2) & 15) == 0) E.mid(acc, cur, (t + 2) >> 4, wr, wc, fr, fq); }
        }
        E(acc, cur, wr, wc, fr, fq);
        if (!has_next) break;
#pragma unroll
        for (int a = 0; a < 2; ++a)
#pragma unroll
            for (int b = 0; b < 2; ++b)
#pragma unroll
                for (int m = 0; m < 4; ++m)
#pragma unroll
                    for (int n = 0; n < 2; ++n) acc[a][b][m][n] = (f32x4){0.f, 0.f, 0.f, 0.f};
        cur = nxt; cA = nA; cB = nB; ++ui;
    }
    PG8_WAIT_V(0);
    if (wr == 0) PG8_BAR;
    PG8_BAR;
#undef PG8_SA
#undef PG8_SB
#undef PG8_STAGE
#undef PG8_LDA
#undef PG8_LDB
#undef PG8_MMA
#undef PG8_WAIT_V
#undef PG8_WAIT_L
#undef PG8_BAR
#undef PG8_SCHED
}
}
using pg8::Unit;
typedef f32x4 AccT[2][2][4][2];

struct EpiGU {
    static constexpr bool HAS_MID = false;
    const float* ssq; bf16_t* hff;
    __device__ __forceinline__ void mid(AccT&, const Unit&, int, int, int, int, int) const {}
    __device__ __forceinline__ void operator()(const AccT& acc, const Unit& u, int wr, int wc, int fr_, int fq_) const {
        int fr = fr_, fq = fq_; asm volatile("" : "+v"(fr), "+v"(fq));
        const int row0 = u.pm * 256 + wr * 64 + fr, hc0 = u.pn * 128 + wc * 16 + fq * 4;
#pragma unroll
        for (int ai = 0; ai < 2; ++ai)
#pragma unroll
            for (int m = 0; m < 4; ++m) {
                const int r = row0 + ai * 128 + m * 16; const float rs = rstd_row(ssq, r);
#pragma unroll
                for (int bj = 0; bj < 2; ++bj) {
                    const f32x4 gt = acc[ai][bj][m][0] * rs, up = acc[ai][bj][m][1] * rs;
                    u32x2 w; w.x = pk2(siluf_(gt[0]) * up[0], siluf_(gt[1]) * up[1]); w.y = pk2(siluf_(gt[2]) * up[2], siluf_(gt[3]) * up[3]);
                    *(u32x2*)(hff + (size_t)r * DFF + hc0 + bj * 64) = w;
                }
            }
    }
};
struct EpiRes {
    static constexpr bool HAS_MID = false;
    float* x; bf16_t* xb; float* ssq; float scale;
    __device__ __forceinline__ void mid(AccT&, const Unit&, int, int, int, int, int) const {}
    __device__ __forceinline__ void operator()(const AccT& acc, const Unit& u, int wr, int wc, int fr_, int fq_) const {
        int fr = fr_, fq = fq_; asm volatile("" : "+v"(fr), "+v"(fq));
        const int row0 = u.pm * 256 + wr * 64 + fr, col0 = u.pn * 256 + wc * 32 + 4 * fq;
#pragma unroll
        for (int ai = 0; ai < 2; ++ai)
#pragma unroll
            for (int m = 0; m < 4; ++m) {
                const int r = row0 + ai * 128 + m * 16; float ss = 0.f;
#pragma unroll
                for (int bj = 0; bj < 2; ++bj)
#pragma unroll
                    for (int n = 0; n < 2; ++n) {
                        const int c = col0 + bj * 128 + n * 16;
                        f32x4* xp = (f32x4*)(x + (size_t)r * DM + c);
                        f32x4 v = *xp + acc[ai][bj][m][n] * scale;
                        *xp = v;
                        u32x2 w; w.x = pk2(v[0], v[1]); w.y = pk2(v[2], v[3]);
                        *(u32x2*)(xb + (size_t)r * DM + c) = w;
                        ss += v[0] * v[0] + v[1] * v[1] + v[2] * v[2] + v[3] * v[3];
                    }
                ss += __shfl_xor(ss, 16); ss += __shfl_xor(ss, 32);
                if (fq == 0) ssq[(size_t)r * 16 + u.pn * 4 + wc] = ss;
            }
    }
};
struct EpiIn {
    static constexpr bool HAS_MID = false;
    const float* ssq; bf16_t* h; float* dtraw;
    __device__ __forceinline__ void mid(AccT&, const Unit&, int, int, int, int, int) const {}
    __device__ __forceinline__ void operator()(const AccT& acc, const Unit& u, int wr, int wc, int fr_, int fq_) const {
        int fr = fr_, fq = fq_; asm volatile("" : "+v"(fr), "+v"(fq));
        const int row0 = u.pm * 256 + wr * 64 + fr, col0 = u.pn * 256 + wc * 32 + 4 * fq;
#pragma unroll
        for (int ai = 0; ai < 2; ++ai)
#pragma unroll
            for (int m = 0; m < 4; ++m) {
                const int r = row0 + ai * 128 + m * 16; const float rs = rstd_row(ssq, r);
                if (u.pn < 36) {
#pragma unroll
                    for (int bj = 0; bj < 2; ++bj)
#pragma unroll
                        for (int n = 0; n < 2; ++n) {
                            const int c = col0 + bj * 128 + n * 16; const f32x4 v = acc[ai][bj][m][n] * rs;
                            u32x2 w; w.x = pk2(v[0], v[1]); w.y = pk2(v[2], v[3]);
                            *(u32x2*)(h + (size_t)r * HP + c) = w;
                        }
                } else if (wc == 0) {
                    const f32x4 v = acc[ai][0][m][0] * rs;
                    *(f32x4*)(dtraw + (size_t)r * 16 + 4 * fq) = v;
                }
            }
    }
};
struct EpiMerge {
    static constexpr bool HAS_MID = true;
    const bf16_t* h; bf16_t* merged;
    __device__ __forceinline__ void mid(AccT& acc, const Unit& u, int seg, int wr, int wc, int fr_, int fq_) const {
        int fr = fr_, fq = fq_; asm volatile("" : "+v"(fr), "+v"(fq));
        const int row0 = u.pm * 256 + wr * 64 + fr, col0 = u.pn * 256 + wc * 32 + 4 * fq;
#pragma unroll
        for (int ai = 0; ai < 2; ++ai)
#pragma unroll
            for (int m = 0; m < 4; ++m) {
                const int r = row0 + ai * 128 + m * 16;
#pragma unroll
                for (int bj = 0; bj < 2; ++bj)
#pragma unroll
                    for (int n = 0; n < 2; ++n) {
                        const int c = col0 + bj * 128 + n * 16;
                        const bf16_t* gp = h + (size_t)r * HP + HGATE + (seg - 1) * 1024 + c;
                        const u32x2 ga = *(const u32x2*)gp, gb = *(const u32x2*)(gp + 1024);
                        const float a0 = bflo(ga.x), a1 = bfhi(ga.x), a2 = bflo(ga.y), a3 = bfhi(ga.y);
                        const float b0 = bflo(gb.x), b1 = bfhi(gb.x), b2 = bflo(gb.y), b3 = bfhi(gb.y);
                        f32x4 f;
                        f[0] = (1.f + __expf(-fmaxf(b0, -30.f))) / (1.f + __expf(-fmaxf(a0, -30.f)));
                        f[1] = (1.f + __expf(-fmaxf(b1, -30.f))) / (1.f + __expf(-fmaxf(a1, -30.f)));
                        f[2] = (1.f + __expf(-fmaxf(b2, -30.f))) / (1.f + __expf(-fmaxf(a2, -30.f)));
                        f[3] = (1.f + __expf(-fmaxf(b3, -30.f))) / (1.f + __expf(-fmaxf(a3, -30.f)));
                        acc[ai][bj][m][n] *= f;
                    }
            }
    }
    __device__ __forceinline__ void operator()(const AccT& acc, const Unit& u, int wr, int wc, int fr_, int fq_) const {
        int fr = fr_, fq = fq_; asm volatile("" : "+v"(fr), "+v"(fq));
        const int row0 = u.pm * 256 + wr * 64 + fr, col0 = u.pn * 256 + wc * 32 + 4 * fq;
#pragma unroll
        for (int ai = 0; ai < 2; ++ai)
#pragma unroll
            for (int m = 0; m < 4; ++m) {
                const int r = row0 + ai * 128 + m * 16;
#pragma unroll
                for (int bj = 0; bj < 2; ++bj)
#pragma unroll
                    for (int n = 0; n < 2; ++n) {
                        const int c = col0 + bj * 128 + n * 16;
                        const u32x2 ga = *(const u32x2*)(h + (size_t)r * HP + HGATE + 2048 + c);
                        const f32x4 v = acc[ai][bj][m][n];
                        u32x2 w;
                        w.x = pk2(v[0] / (1.f + __expf(-fmaxf(bflo(ga.x), -30.f))), v[1] / (1.f + __expf(-fmaxf(bfhi(ga.x), -30.f))));
                        w.y = pk2(v[2] / (1.f + __expf(-fmaxf(bflo(ga.y), -30.f))), v[3] / (1.f + __expf(-fmaxf(bfhi(ga.y), -30.f))));
                        *(u32x2*)(merged + (size_t)r * DM + c) = w;
                    }
            }
    }
};

template <class Epi> __device__ __forceinline__ void run_gemm(int wv, LAS unsigned char* lds, const bf16_t* A, const bf16_t* Bt, int N, int K, const Epi& E) {
    pg8::Gemm g; g.A = A; g.Bt = Bt; g.M = MT; g.N = N; g.K = K;
    pg8::StaticOrder S; S.init(MT, N, (int)gdim(), (int)bidx());
    pg8::gemm_phase<Epi>(wv, lds, g, S, E);
}

template <class RM>
__device__ __forceinline__ void cvt_tile(int wv, const float* src, int src_ld, int k0, int nsrc0, int nvalid, const float* gk, bf16_t* dst, int dst_ld, RM rowmap, LAS float* tile) {
    const int tid = tidx(wv);
    __syncthreads();
#pragma unroll
    for (int i = 0; i < 2; ++i) {
        const int kk = (tid >> 4) + 32 * i, n4 = (tid & 15) * 4;
        f32x4 v = (f32x4){0.f, 0.f, 0.f, 0.f};
        if (n4 < nvalid) v = *(const f32x4*)(src + (size_t)(k0 + kk) * src_ld + nsrc0 + n4);
        const float gsc = gk ? gk[k0 + kk] : 1.0f;
        tile[kk * 65 + n4 + 0] = v[0] * gsc; tile[kk * 65 + n4 + 1] = v[1] * gsc; tile[kk * 65 + n4 + 2] = v[2] * gsc; tile[kk * 65 + n4 + 3] = v[3] * gsc;
    }
    __syncthreads();
    const int nl = tid >> 3, k8 = (tid & 7) * 8;
    if (nl < nvalid) {
        u32x4 w;
        w.x = pk2(tile[(k8 + 0) * 65 + nl], tile[(k8 + 1) * 65 + nl]); w.y = pk2(tile[(k8 + 2) * 65 + nl], tile[(k8 + 3) * 65 + nl]);
        w.z = pk2(tile[(k8 + 4) * 65 + nl], tile[(k8 + 5) * 65 + nl]); w.w = pk2(tile[(k8 + 6) * 65 + nl], tile[(k8 + 7) * 65 + nl]);
        *(u32x4*)(dst + (size_t)rowmap(nl) * dst_ld + k0 + k8) = w;
    }
}

__device__ __forceinline__ void convert_layer(int wv, KP P, int l, LAS unsigned char* lds) {
    LAS float* tile = (LAS float*)lds;
    constexpr int J_GU = 2 * 2 * 16 * 44, J_DN = 2 * 44 * 16, J_IN = 16 * 145, J_BR = 48 * 16, J_OUT = 16 * 16, J_LRU = 32;
    constexpr int J_TOT = J_GU + J_DN + J_IN + J_BR + J_OUT + J_LRU;
    for (int job = bidx(); job < J_TOT; job += gdim()) {
        int j = job;
        if (j < J_GU) {
            const int nt = j % 44; j /= 44; const int kt = j % 16; j /= 16; const int which = j & 1, j2 = j >> 1;
            const float* src = P->in[which ? I_WU : I_WG] + (size_t)(l * 2 + j2) * 1024 * 2816;
            bf16_t* dst = (bf16_t*)(P->ws + (j2 ? W_GU1 : W_GU0));
            const int hc0 = nt * 64;
            cvt_tile(wv, src, 2816, kt * 64, hc0, 64, P->in[I_FNORM] + (l * 2 + j2) * 1024, dst, 1024,
                     [=](int nl) { const int hc = hc0 + nl; return 256 * (hc >> 7) + 128 * ((hc >> 6) & 1) + 32 * ((hc >> 4) & 3) + 16 * which + (hc & 15); }, tile);
            continue;
        }
        j -= J_GU;
        if (j < J_DN) {
            const int nt = j % 16; j /= 16; const int kt = j % 44; const int j2 = j / 44;
            const float* src = P->in[I_WD] + (size_t)(l * 2 + j2) * 2816 * 1024;
            bf16_t* dst = (bf16_t*)(P->ws + (j2 ? W_DN1 : W_DN0));
            const int n0 = nt * 64;
            cvt_tile(wv, src, 1024, kt * 64, n0, 64, nullptr, dst, 2816, [=](int nl) { return n0 + nl; }, tile);
            continue;
        }
        j -= J_DN;
        if (j < J_IN) {
            const int nt = j % 145, kt = j / 145;
            const float* src = P->in[I_WIN] + (size_t)l * 1024 * NIN;
            bf16_t* dst = (bf16_t*)(P->ws + W_IN);
            const int n0 = nt * 64;
            const int nsrc0 = nt < 72 ? n0 : (nt < 144 ? n0 + 16 : 4608);
            cvt_tile(wv, src, NIN, kt * 64, nsrc0, nt < 144 ? 64 : 16, P->in[I_MNORM] + l * 1024, dst, 1024, [=](int nl) { return n0 + nl; }, tile);
            continue;
        }
        j -= J_IN;
        if (j < J_BR) {
            const int nt = j % 16, kt = j / 16;
            const float* src = P->in[I_WBR] + (size_t)l * 3072 * 1024;
            bf16_t* dst = (bf16_t*)(P->ws + W_BR);
            const int n0 = nt * 64;
            cvt_tile(wv, src, 1024, kt * 64, n0, 64, nullptr, dst, 3072, [=](int nl) { return n0 + nl; }, tile);
            continue;
        }
        j -= J_BR;
        if (j < J_OUT) {
            const int nt = j % 16, kt = j / 16;
            const float* src = P->in[I_WOUT] + (size_t)l * 1024 * 1024;
            bf16_t* dst = (bf16_t*)(P->ws + W_OUT);
            const int n0 = nt * 64;
            cvt_tile(wv, src, 1024, kt * 64, n0, 64, nullptr, dst, 1024, [=](int nl) { return n0 + nl; }, tile);
            continue;
        }
        j -= J_OUT;
        {
            const int blk = j & 15, which = j >> 4;
            const float* src = P->in[which ? I_LWX : I_LWA] + (size_t)(l * 16 + blk) * 4096;
            bf16_t* dst = (bf16_t*)(P->ws + (which ? W_LX : W_LA)) + blk * 4096;
            cvt_tile(wv, src, 64, 0, 0, 64, nullptr, dst, 64, [=](int nl) { return nl; }, tile);
        }
    }
    __syncthreads();
}

__device__ __forceinline__ void phase_init(int wv, KP P) {
    const int w = tidx(wv) >> 6, lane = tidx(wv) & 63;
    float* x = P->out; bf16_t* xb = (bf16_t*)(P->ws + WS_XB); float* ssq = (float*)(P->ws + WS_SSQ);
    for (int row = bidx() * 8 + w; row < MT; row += gdim() * 8) {
        const float* src = row < MP ? P->in[I_XP] + (size_t)row * DM : P->in[I_XS] + (size_t)(row - MP) * DM;
        float ss = 0.f;
#pragma unroll
        for (int i = 0; i < 4; ++i) {
            const int c = (i * 64 + lane) * 4;
            const f32x4 v = *(const f32x4*)(src + c);
            *(f32x4*)(x + (size_t)row * DM + c) = v;
            u32x2 pw; pw.x = pk2(v[0], v[1]); pw.y = pk2(v[2], v[3]);
            *(u32x2*)(xb + (size_t)row * DM + c) = pw;
            ss += v[0] * v[0] + v[1] * v[1] + v[2] * v[2] + v[3] * v[3];
        }
#pragma unroll
        for (int d = 32; d >= 1; d >>= 1) ss += __shfl_xor(ss, d);
        if (lane < 16) ssq[(size_t)row * 16 + lane] = lane == 0 ? ss : 0.f;
    }
}
__device__ __forceinline__ void phase_final(int wv, KP P) {
    const int w = tidx(wv) >> 6, lane = tidx(wv) & 63;
    float* x = P->out; const float* ssq = (const float*)(P->ws + WS_SSQ); const float* gf = P->in[I_FINAL];
    for (int row = bidx() * 8 + w; row < MT; row += gdim() * 8) {
        const float rs = rstd_row(ssq, row);
#pragma unroll
        for (int i = 0; i < 4; ++i) {
            const int c = (i * 64 + lane) * 4;
            f32x4 v = *(const f32x4*)(x + (size_t)row * DM + c); const f32x4 g = *(const f32x4*)(gf + c);
            v = v * rs * g;
            *(f32x4*)(x + (size_t)row * DM + c) = v;
        }
    }
}

struct Item { int row0, L, b, c, sb, sample; };
__device__ __forceinline__ Item get_item(int it) {
    Item I;
    if (it < 256) { I.b = it >> 7; I.c = it & 127; I.row0 = I.b * 8192 + I.c * 64; I.L = 64; I.sample = 0; I.sb = 0; }
    else { I.sb = it - 256; I.b = 0; I.c = 0; I.row0 = MP + I.sb * 16; I.L = 16; I.sample = 1; }
    return I;
}

__device__ __forceinline__ void copy_states_item(int wv, KP P, int l, const Item& I) {
    const bf16_t* h = (const bf16_t*)(P->ws + WS_H);
    const int tid = tidx(wv);
    if (!I.sample) {
        if (I.c >= 126) {
            for (int idx = tid; idx < 64 * 512; idx += 512) {
                const int t = idx >> 9, cc = idx & 511, kv = cc >> 8, e = cc & 255;
                const float v = bf2f(h[(size_t)(I.row0 + t) * HP + (kv ? HV : HK) + e]);
                P->out[(kv ? O_PV : O_PK) + ((size_t)(l * 2 + I.b) * 128 + (I.c - 126) * 64 + t) * 256 + e] = v;
            }
        }
        if (I.c == 127) {
            for (int idx = tid; idx < 3 * 1024; idx += 512) { const int j = idx >> 10, ch = idx & 1023;
                P->out[O_PLC + ((size_t)(l * 2 + I.b) * 3 + j) * 1024 + ch] = bf2f(h[(size_t)(I.row0 + 61 + j) * HP + HX + ch]); }
            for (int idx = tid; idx < 3 * 1536; idx += 512) { const int j = idx / 1536, ch = idx % 1536;
                P->out[O_PSC + ((size_t)(l * 2 + I.b) * 3 + j) * 1536 + ch] = bf2f(h[(size_t)(I.row0 + 61 + j) * HP + HXBC + ch]); }
        }
    } else {
        for (int idx = tid; idx < 128 * 512; idx += 512) {
            const int j = idx >> 9, cc = idx & 511, kv = cc >> 8, e = cc & 255;
            float v;
            if (j < 112) v = P->in[kv ? I_CV : I_CK][((size_t)(l * 16 + I.sb) * 128 + j + 16) * 256 + e];
            else v = bf2f(h[(size_t)(I.row0 + j - 112) * HP + (kv ? HV : HK) + e]);
            P->out[(kv ? O_SV : O_SK) + ((size_t)(l * 16 + I.sb) * 128 + j) * 256 + e] = v;
        }
        for (int idx = tid; idx < 3 * 1024; idx += 512) { const int j = idx >> 10, ch = idx & 1023;
            P->out[O_SLC + ((size_t)(l * 16 + I.sb) * 3 + j) * 1024 + ch] = bf2f(h[(size_t)(I.row0 + 13 + j) * HP + HX + ch]); }
        for (int idx = tid; idx < 3 * 1536; idx += 512) { const int j = idx / 1536, ch = idx % 1536;
            P->out[O_SSC + ((size_t)(l * 16 + I.sb) * 3 + j) * 1536 + ch] = bf2f(h[(size_t)(I.row0 + 13 + j) * HP + HXBC + ch]); }
    }
}

template <int L>
__device__ __forceinline__ void attn_item(int wv, KP P, int l, const Item& I, LAS unsigned char* lds) {
    constexpr int NS = (L == 64) ? 192 : 160;
    constexpr int NST = NS / 16, NKS = NS / 32, NQT = L / 16;
    const bf16_t* h = (const bf16_t*)(P->ws + WS_H);
    bf16_t* yabc = (bf16_t*)(P->ws + WS_Y);
    const int tid = tidx(wv), w = tid >> 6, lane = tid & 63, fr = lane & 15, fq = lane >> 4;
    LAS bf16_t* Kl = (LAS bf16_t*)lds;
    LAS bf16_t* Vt = Kl + 2 * 192 * 72;
    for (int pass = 0; pass < 2; ++pass) {
        __syncthreads();
        for (int idx = tid; idx < 2 * NS * 8; idx += 512) {
            const int dp = idx & 7, s = (idx >> 3) % NS, kvl = idx / (8 * NS), kvh = pass * 2 + kvl;
            u32x4 kw = (u32x4){0u, 0u, 0u, 0u}, vw = (u32x4){0u, 0u, 0u, 0u};
            if (L == 64) {
                const int pos = (I.c - 2) * 64 + s;
                if (pos >= 0) {
                    const bf16_t* rp = h + (size_t)(I.b * 8192 + pos) * HP + kvh * 64 + dp * 8;
                    kw = *(const u32x4*)(rp + HK); vw = *(const u32x4*)(rp + HV);
                }
            } else {
                if (s < 128) {
                    const size_t o = ((size_t)(l * 16 + I.sb) * 128 + s) * 256 + kvh * 64 + dp * 8;
                    const f32x4 k0 = *(const f32x4*)(P->in[I_CK] + o), k1 = *(const f32x4*)(P->in[I_CK] + o + 4);
                    const f32x4 v0 = *(const f32x4*)(P->in[I_CV] + o), v1 = *(const f32x4*)(P->in[I_CV] + o + 4);
                    kw.x = pk2(k0[0], k0[1]); kw.y = pk2(k0[2], k0[3]); kw.z = pk2(k1[0], k1[1]); kw.w = pk2(k1[2], k1[3]);
                    vw.x = pk2(v0[0], v0[1]); vw.y = pk2(v0[2], v0[3]); vw.z = pk2(v1[0], v1[1]); vw.w = pk2(v1[2], v1[3]);
                } else if (s < 144) {
                    const bf16_t* rp = h + (size_t)(I.row0 + s - 128) * HP + kvh * 64 + dp * 8;
                    kw = *(const u32x4*)(rp + HK); vw = *(const u32x4*)(rp + HV);
                }
            }
            *(LAS u32x4*)(Kl + (kvl * 192 + s) * 72 + dp * 8) = kw;
            LAS bf16_t* vp = Vt + (kvl * 64 + dp * 8) * 200 + s;
            vp[0 * 200] = (bf16_t)(vw.x & 0xffffu); vp[1 * 200] = (bf16_t)(vw.x >> 16); vp[2 * 200] = (bf16_t)(vw.y & 0xffffu); vp[3 * 200] = (bf16_t)(vw.y >> 16);
            vp[4 * 200] = (bf16_t)(vw.z & 0xffffu); vp[5 * 200] = (bf16_t)(vw.z >> 16); vp[6 * 200] = (bf16_t)(vw.w & 0xffffu); vp[7 * 200] = (bf16_t)(vw.w >> 16);
        }
        __syncthreads();
        const int head = pass * 8 + w, kvl = w >> 2;
        const float slope = exp2f(-0.5f * (float)(head + 1));
        const float sink = P->in[I_SINK][l * 16 + head];
#pragma unroll 1
        for (int qt = 0; qt < NQT; ++qt) {
            const bf16_t* qp = h + (size_t)(I.row0 + qt * 16 + fr) * HP + HQ + head * 64 + fq * 8;
            const bf16x8 q0 = *(const bf16x8*)qp, q1 = *(const bf16x8*)(qp + 32);
            f32x4 st[NST];
#pragma unroll
            for (int t = 0; t < NST; ++t) {
                const LAS bf16_t* kp = Kl + (kvl * 192 + t * 16 + fr) * 72 + fq * 8;
                f32x4 a = (f32x4){0.f, 0.f, 0.f, 0.f};
                a = MFMA16(*(const LAS bf16x8*)kp, q0, a);
                a = MFMA16(*(const LAS bf16x8*)(kp + 32), q1, a);
                st[t] = a;
                __builtin_amdgcn_sched_barrier(0);
            }
            const int qpos = (L == 64) ? (I.c * 64 + qt * 16 + fr) : (4096 + fr);
            float mx = sink;
#pragma unroll
            for (int t = 0; t < NST; ++t)
#pragma unroll
                for (int jj = 0; jj < 4; ++jj) {
                    const int s = t * 16 + fq * 4 + jj;
                    const int kpos = (L == 64) ? ((I.c - 2) * 64 + s) : (3968 + s);
                    const bool vis = (L == 64) ? (kpos >= 0) : (s < 144);
                    const float d = fabsf((float)(qpos - kpos));
                    const float sc = vis ? (st[t][jj] * 0.125f - slope * d) : -INFINITY;
                    st[t][jj] = sc; mx = fmaxf(mx, sc);
                }
            mx = fmaxf(mx, __shfl_xor(mx, 16)); mx = fmaxf(mx, __shfl_xor(mx, 32));
            float sum = 0.f;
#pragma unroll
            for (int t = 0; t < NST; ++t)
#pragma unroll
                for (int jj = 0; jj < 4; ++jj) { const float p = __expf(st[t][jj] - mx); st[t][jj] = p; sum += p; }
            sum += __shfl_xor(sum, 16); sum += __shfl_xor(sum, 32);
            const float inv = 1.0f / (sum + __expf(sink - mx));
            f32x4 o[4];
#pragma unroll
            for (int dt = 0; dt < 4; ++dt) o[dt] = (f32x4){0.f, 0.f, 0.f, 0.f};
#pragma unroll
            for (int ks = 0; ks < NKS; ++ks) {
                u32x4 pw; pw.x = pk2(st[2 * ks][0], st[2 * ks][1]); pw.y = pk2(st[2 * ks][2], st[2 * ks][3]);
                pw.z = pk2(st[2 * ks + 1][0], st[2 * ks + 1][1]); pw.w = pk2(st[2 * ks + 1][2], st[2 * ks + 1][3]);
                bf16x8 pf; __builtin_memcpy(&pf, &pw, 16);
#pragma unroll
                for (int dt = 0; dt < 4; ++dt) {
                    const LAS bf16_t* vp = Vt + (kvl * 64 + dt * 16 + fr) * 200 + ks * 32 + fq * 4;
                    const u32x2 va = *(const LAS u32x2*)vp, vb = *(const LAS u32x2*)(vp + 16);
                    u32x4 vw; vw.x = va.x; vw.y = va.y; vw.z = vb.x; vw.w = vb.y;
                    bf16x8 vf; __builtin_memcpy(&vf, &vw, 16);
                    o[dt] = MFMA16(vf, pf, o[dt]);
                }
            }
            bf16_t* op = yabc + (size_t)(I.row0 + qt * 16 + fr) * 3072 + 2048 + head * 64 + fq * 4;
#pragma unroll
            for (int dt = 0; dt < 4; ++dt) {
                u32x2 ow; ow.x = pk2(o[dt][0] * inv, o[dt][1] * inv); ow.y = pk2(o[dt][2] * inv, o[dt][3] * inv);
                *(u32x2*)(op + dt * 16) = ow;
            }
        }
    }
}

template <int L, bool FINAL>
__device__ __forceinline__ void lru_item(int wv, KP P, int l, int item, const Item& I, LAS unsigned char* lds) {
    constexpr int NIT = L / 16;
    const bf16_t* h = (const bf16_t*)(P->ws + WS_H);
    bf16_t* yabc = (bf16_t*)(P->ws + WS_Y);
    float* lruA = (float*)(P->ws + WS_LRUA); float* lruU = (float*)(P->ws + WS_LRUU);
    const int tid = tidx(wv), w = tid >> 6, lane = tid & 63, fr = lane & 15, fq = lane >> 4;
    LAS bf16_t* xa = (LAS bf16_t*)lds + w * (64 * 72);
    for (int pass = 0; pass < 2; ++pass) {
        const int blk = w + 8 * pass, ch0 = blk * 64;
        __syncthreads();
        {
            const int ch = ch0 + lane;
            const float* cw = P->in[I_LCW] + (size_t)l * 4 * 1024 + ch;
            const float w0 = cw[0], w1 = cw[1024], w2 = cw[2048], w3 = cw[3072], cb = P->in[I_LCB][l * 1024 + ch];
            float xm3 = 0.f, xm2 = 0.f, xm1 = 0.f;
            if (I.sample) { const float* st = P->in[I_SLC] + (size_t)(l * 16 + I.sb) * 3 * 1024 + ch; xm3 = st[0]; xm2 = st[1024]; xm1 = st[2048]; }
            else if (I.c > 0) { const bf16_t* hp = h + (size_t)(I.row0 - 3) * HP + HX + ch; xm3 = bf2f(hp[0]); xm2 = bf2f(hp[HP]); xm1 = bf2f(hp[2 * (size_t)HP]); }
            const bf16_t* hp = h + (size_t)I.row0 * HP + HX + ch;
#pragma unroll 4
            for (int t = 0; t < L; ++t) {
                const float x0 = bf2f(hp[(size_t)t * HP]);
                const float y = cb + w0 * xm3 + w1 * xm2 + w2 * xm1 + w3 * x0;
                xa[t * 72 + lane] = f2bf(y);
                xm3 = xm2; xm2 = xm1; xm1 = x0;
            }
        }
        __syncthreads();
        const bf16_t* waT = (const bf16_t*)(P->ws + W_LA) + blk * 4096;
        const bf16_t* wxT = (const bf16_t*)(P->ws + W_LX) + blk * 4096;
        float carryH[4][4], carryA[4][4];
#pragma unroll
        for (int jt = 0; jt < 4; ++jt)
#pragma unroll
            for (int jj = 0; jj < 4; ++jj) {
                const int ch = ch0 + jt * 16 + fq * 4 + jj;
                carryA[jt][jj] = 1.0f;
                if (FINAL) carryH[jt][jj] = I.sample ? P->in[I_SLH][(l * 16 + I.sb) * 1024 + ch] : lruU[(size_t)item * 1024 + ch];
                else carryH[jt][jj] = 0.f;
            }
#pragma unroll 1
        for (int it = 0; it < NIT; ++it) {
            const LAS bf16_t* xp = xa + (it * 16 + fr) * 72;
            const bf16x8 b0 = *(const LAS bf16x8*)(xp + fq * 8), b1 = *(const LAS bf16x8*)(xp + 32 + fq * 8);
            const int token = it * 16 + fr;
#pragma unroll
            for (int jt = 0; jt < 4; ++jt) {
                const bf16_t* wa = waT + (jt * 16 + fr) * 64 + fq * 8; const bf16_t* wx = wxT + (jt * 16 + fr) * 64 + fq * 8;
                f32x4 ra = (f32x4){0.f, 0.f, 0.f, 0.f}, ia = (f32x4){0.f, 0.f, 0.f, 0.f};
                ra = MFMA16(*(const bf16x8*)wa, b0, ra); ra = MFMA16(*(const bf16x8*)(wa + 32), b1, ra);
                ia = MFMA16(*(const bf16x8*)wx, b0, ia); ia = MFMA16(*(const bf16x8*)(wx + 32), b1, ia);
                const u32x2 xw = *(const LAS u32x2*)(xp + jt * 16 + fq * 4);
                const float xv[4] = {bflo(xw.x), bfhi(xw.x), bflo(xw.y), bfhi(xw.y)};
                float hv[4];
#pragma unroll
                for (int jj = 0; jj < 4; ++jj) {
                    const int ch = ch0 + jt * 16 + fq * 4 + jj;
                    const float r = sigmoidf_(ra[jj] + P->in[I_LBA][l * 1024 + ch]);
                    const float ig = sigmoidf_(ia[jj] + P->in[I_LBX][l * 1024 + ch]);
                    const float c8 = 8.0f * softplusf_(-P->in[I_LLAM][l * 1024 + ch]);
                    const float la = -c8 * r;
                    float a = __expf(la);
                    float u = sqrtf(fmaxf(-expm1f(2.0f * la), 0.f)) * ig * xv[jj];
#pragma unroll
                    for (int d = 1; d < 16; d <<= 1) {
                        const float ap = __shfl_up(a, d, 16), up = __shfl_up(u, d, 16);
                        if (fr >= d) { u = a * up + u; a = a * ap; }
                    }
                    const float hval = a * carryH[jt][jj] + u;
                    hv[jj] = hval;
                    carryH[jt][jj] = __shfl(hval, 15, 16);
                    if (!FINAL) carryA[jt][jj] = carryA[jt][jj] * __shfl(a, 15, 16);
                }
                if (FINAL) {
                    const u32x2 gw = *(const u32x2*)(h + (size_t)(I.row0 + token) * HP + HG + ch0 + jt * 16 + fq * 4);
                    u32x2 ow; ow.x = pk2(hv[0] * gelu_tanh(bflo(gw.x)), hv[1] * gelu_tanh(bfhi(gw.x)));
                    ow.y = pk2(hv[2] * gelu_tanh(bflo(gw.y)), hv[3] * gelu_tanh(bfhi(gw.y)));
                    *(u32x2*)(yabc + (size_t)(I.row0 + token) * 3072 + ch0 + jt * 16 + fq * 4) = ow;
                    if (it == NIT - 1 && fr == 15) {
                        if (I.sample) *(f32x4*)(P->out + O_SLH + (size_t)(l * 16 + I.sb) * 1024 + ch0 + jt * 16 + fq * 4) = (f32x4){hv[0], hv[1], hv[2], hv[3]};
                        else if (I.c == 127) *(f32x4*)(P->out + O_PLH + (size_t)(l * 2 + I.b) * 1024 + ch0 + jt * 16 + fq * 4) = (f32x4){hv[0], hv[1], hv[2], hv[3]};
                    }
                }
            }
        }
        if (!FINAL) {
            if (fr == 0) {
#pragma unroll
                for (int jt = 0; jt < 4; ++jt) {
                    *(f32x4*)(lruA + (size_t)item * 1024 + ch0 + jt * 16 + fq * 4) = (f32x4){carryA[jt][0], carryA[jt][1], carryA[jt][2], carryA[jt][3]};
                    *(f32x4*)(lruU + (size_t)item * 1024 + ch0 + jt * 16 + fq * 4) = (f32x4){carryH[jt][0], carryH[jt][1], carryH[jt][2], carryH[jt][3]};
                }
            }
        }
    }
}

__device__ __forceinline__ float pre_xbc(KP P, const bf16_t* h, int l, const Item& I, int tt, int ch) {
    if (tt >= 0 || (!I.sample && I.c > 0)) return bf2f(h[(size_t)(I.row0 + tt) * HP + HXBC + ch]);
    if (I.sample) return P->in[I_SSC][((size_t)(l * 16 + I.sb) * 3 + (3 + tt)) * 1536 + ch];
    return 0.f;
}
__device__ __forceinline__ float conv_xbc(KP P, const bf16_t* h, int l, const Item& I, int t, int ch) {
    const float* cw = P->in[I_SCW] + (size_t)l * 4 * 1536 + ch;
    float y = P->in[I_SCB][l * 1536 + ch];
    y += cw[0] * pre_xbc(P, h, l, I, t - 3, ch); y += cw[1536] * pre_xbc(P, h, l, I, t - 2, ch);
    y += cw[3072] * pre_xbc(P, h, l, I, t - 1, ch); y += cw[4608] * pre_xbc(P, h, l, I, t, ch);
    return siluf_(y);
}
template <int L>
__device__ __forceinline__ void ssd_dtcum(int wv, KP P, int l, const Item& I, LAS float* dtv, LAS float* cumv) {
    const float* dtraw = (const float*)(P->ws + WS_DT);
    const int tid = tidx(wv);
    __syncthreads();
    for (int idx = tid; idx < L * 16; idx += 512) { const int hd = idx & 15; dtv[idx] = softplusf_(dtraw[(size_t)I.row0 * 16 + idx] + P->in[I_SDTB][l * 16 + hd]); }
    __syncthreads();
    if (tid < 16) { const float A = -__expf(P->in[I_SALOG][l * 16 + tid]); float c = 0.f; for (int t = 0; t < L; ++t) { c += dtv[t * 16 + tid] * A; cumv[t * 16 + tid] = c; } }
    __syncthreads();
}

template <int L>
__device__ __forceinline__ void ssd_states_item(int wv, KP P, int l, int item, const Item& I, LAS unsigned char* lds) {
    constexpr int LP = L < 32 ? 32 : L, KS = LP / 32;
    const bf16_t* h = (const bf16_t*)(P->ws + WS_H);
    bf16_t* states = (bf16_t*)(P->ws + WS_ST);
    float* cdec = (float*)(P->ws + WS_CDEC);
    const int tid = tidx(wv), w = tid >> 6, lane = tid & 63, fr = lane & 15, fq = lane >> 4;
    LAS float* dtv = (LAS float*)lds; LAS float* cumv = dtv + 1024;
    LAS bf16_t* BmT = (LAS bf16_t*)(lds + 8192);
    LAS bf16_t* xw = (LAS bf16_t*)(lds + 8192 + 36864) + w * (64 * 72);
    ssd_dtcum<L>(wv, P, l, I, dtv, cumv);
    for (int idx = tid; idx < LP * 256; idx += 512) {
        const int chB = idx & 255, j = idx >> 8;
        const float v = (j < L) ? conv_xbc(P, h, l, I, j, 1024 + chB) : 0.f;
        BmT[chB * 72 + j] = f2bf(v);
    }
    for (int hh = 0; hh < 2; ++hh) {
        const int head = w + 8 * hh;
        const float cl = cumv[(L - 1) * 16 + head];
        __syncthreads();
        for (int j = 0; j < LP; ++j) {
            float v = 0.f;
            if (j < L) v = conv_xbc(P, h, l, I, j, head * 64 + lane) * __expf(cl - cumv[j * 16 + head]) * dtv[j * 16 + head];
            xw[lane * 72 + j] = f2bf(v);
        }
        __syncthreads();
        const float dec = __expf(cl);
        if (!I.sample && lane == 0) cdec[item * 16 + head] = dec;
#pragma unroll 1
        for (int nt = 0; nt < 8; ++nt) {
            bf16x8 af[KS];
#pragma unroll
            for (int ks = 0; ks < KS; ++ks) af[ks] = *(const LAS bf16x8*)(BmT + (hh * 128 + nt * 16 + fr) * 72 + ks * 32 + fq * 8);
#pragma unroll
            for (int pt = 0; pt < 4; ++pt) {
                f32x4 a = (f32x4){0.f, 0.f, 0.f, 0.f};
#pragma unroll
                for (int ks = 0; ks < KS; ++ks) a = MFMA16(af[ks], *(const LAS bf16x8*)(xw + (pt * 16 + fr) * 72 + ks * 32 + fq * 8), a);
                const int p = pt * 16 + fr, n0 = nt * 16 + fq * 4;
                if (!I.sample) {
                    u32x2 ow; ow.x = pk2(a[0], a[1]); ow.y = pk2(a[2], a[3]);
                    *(u32x2*)(states + ((size_t)((I.b * 128 + I.c) * 16 + head) * 64 + p) * 128 + n0) = ow;
                } else {
                    const size_t o = ((size_t)((l * 16 + I.sb) * 16 + head) * 64 + p) * 128 + n0;
                    const f32x4 h0 = *(const f32x4*)(P->in[I_SSH] + o);
                    *(f32x4*)(P->out + O_SSH + o) = h0 * dec + a;
                }
            }
        }
    }
}

template <int L>
__device__ __forceinline__ void ssd_y_item(int wv, KP P, int l, const Item& I, LAS unsigned char* lds) {
    constexpr int LP = L < 32 ? 32 : L, KS = LP / 32, NIT = L / 16;
    const bf16_t* h = (const bf16_t*)(P->ws + WS_H);
    const bf16_t* states = (const bf16_t*)(P->ws + WS_ST);
    bf16_t* yabc = (bf16_t*)(P->ws + WS_Y);
    const int tid = tidx(wv), w = tid >> 6, lane = tid & 63, fr = lane & 15, fq = lane >> 4;
    LAS float* dtv = (LAS float*)lds; LAS float* cumv = dtv + 1024;
    LAS bf16_t* Bm = (LAS bf16_t*)(lds + 8192);
    LAS bf16_t* Cm = (LAS bf16_t*)(lds + 8192 + 17408);
    LAS float* CBl = (LAS float*)(lds + 8192 + 2 * 17408);
    LAS float* part = (LAS float*)(lds + 8192 + 3 * 17408);
    LAS bf16_t* xT = (LAS bf16_t*)(lds + 8192 + 3 * 17408 + 2048) + w * (64 * 72);
    ssd_dtcum<L>(wv, P, l, I, dtv, cumv);
    for (int g = 0; g < 2; ++g) {
        const int head = g * 8 + w;
        __syncthreads();
        for (int idx = tid; idx < L * 256; idx += 512) {
            const int cc = idx & 255, t = idx >> 8, which = cc >> 7, n = cc & 127;
            const float v = conv_xbc(P, h, l, I, t, 1024 + which * 256 + g * 128 + n);
            (which ? Cm : Bm)[t * 136 + n] = f2bf(v);
        }
        for (int j = 0; j < LP; ++j) {
            float v = 0.f;
            if (j < L) v = conv_xbc(P, h, l, I, j, head * 64 + lane);
            xT[lane * 72 + j] = f2bf(v);
        }
        __syncthreads();
        for (int tix = w; tix < NIT * NIT; tix += 8) {
            const int it = tix / NIT, jt = tix % NIT;
            f32x4 a = (f32x4){0.f, 0.f, 0.f, 0.f};
#pragma unroll
            for (int ks = 0; ks < 4; ++ks)
                a = MFMA16(*(const LAS bf16x8*)(Cm + (it * 16 + fr) * 136 + ks * 32 + fq * 8), *(const LAS bf16x8*)(Bm + (jt * 16 + fr) * 136 + ks * 32 + fq * 8), a);
#pragma unroll
            for (int jj = 0; jj < 4; ++jj) CBl[(it * 16 + fq * 4 + jj) * 68 + jt * 16 + fr] = a[jj];
        }
        __syncthreads();
        const float dsk = P->in[I_SD][l * 16 + head];
#pragma unroll 1
        for (int it = 0; it < NIT; ++it) {
            const int i = it * 16 + fr; const float cum_i = cumv[i * 16 + head];
            f32x4 acc[4];
#pragma unroll
            for (int pt = 0; pt < 4; ++pt) acc[pt] = (f32x4){0.f, 0.f, 0.f, 0.f};
#pragma unroll
            for (int ks = 0; ks < KS; ++ks) {
                if (ks * 32 > it * 16 + 15) continue;
                const int j0 = ks * 32 + fq * 8;
                const f32x4 c0 = *(const LAS f32x4*)(CBl + i * 68 + j0), c1 = *(const LAS f32x4*)(CBl + i * 68 + j0 + 4);
                float wv8[8];
#pragma unroll
                for (int e = 0; e < 8; ++e) {
                    const int j = j0 + e; const float cb = e < 4 ? c0[e & 3] : c1[e & 3];
                    const float ex = __expf(fminf(cum_i - cumv[j * 16 + head], 0.f));
                    wv8[e] = (j <= i) ? cb * ex * dtv[j * 16 + head] : 0.f;
                }
                u32x4 ww; ww.x = pk2(wv8[0], wv8[1]); ww.y = pk2(wv8[2], wv8[3]); ww.z = pk2(wv8[4], wv8[5]); ww.w = pk2(wv8[6], wv8[7]);
                bf16x8 wf; __builtin_memcpy(&wf, &ww, 16);
#pragma unroll
                for (int pt = 0; pt < 4; ++pt) acc[pt] = MFMA16(*(const LAS bf16x8*)(xT + (pt * 16 + fr) * 72 + j0), wf, acc[pt]);
            }
            const float ecum = __expf(cum_i);
            bf16x8 cf[4];
#pragma unroll
            for (int ks = 0; ks < 4; ++ks) cf[ks] = *(const LAS bf16x8*)(Cm + i * 136 + ks * 32 + fq * 8);
#pragma unroll
            for (int pt = 0; pt < 4; ++pt) {
                bf16x8 hf[4];
                const int p = pt * 16 + fr;
                if (!I.sample) {
                    const bf16_t* sp = states + ((size_t)((I.b * 128 + I.c) * 16 + head) * 64 + p) * 128 + fq * 8;
#pragma unroll
                    for (int ks = 0; ks < 4; ++ks) hf[ks] = *(const bf16x8*)(sp + ks * 32);
                } else {
                    const float* sp = P->in[I_SSH] + ((size_t)((l * 16 + I.sb) * 16 + head) * 64 + p) * 128 + fq * 8;
#pragma unroll
                    for (int ks = 0; ks < 4; ++ks) {
                        const f32x4 a0 = *(const f32x4*)(sp + ks * 32), a1 = *(const f32x4*)(sp + ks * 32 + 4);
                        u32x4 ww; ww.x = pk2(a0[0], a0[1]); ww.y = pk2(a0[2], a0[3]); ww.z = pk2(a1[0], a1[1]); ww.w = pk2(a1[2], a1[3]);
                        __builtin_memcpy(&hf[ks], &ww, 16);
                    }
                }
                f32x4 t2 = (f32x4){0.f, 0.f, 0.f, 0.f};
#pragma unroll
                for (int ks = 0; ks < 4; ++ks) t2 = MFMA16(hf[ks], cf[ks], t2);
                acc[pt] += t2 * ecum;
            }
            float ss = 0.f;
#pragma unroll
            for (int pt = 0; pt < 4; ++pt) {
                const int p0 = pt * 16 + fq * 4;
                const u32x2 zw = *(const u32x2*)(h + (size_t)(I.row0 + i) * HP + HZ + head * 64 + p0);
                const float zv[4] = {bflo(zw.x), bfhi(zw.x), bflo(zw.y), bfhi(zw.y)};
                float yv[4];
#pragma unroll
                for (int jj = 0; jj < 4; ++jj) {
                    const float xs = bf2f(xT[(p0 + jj) * 72 + i]);
                    const float y = (acc[pt][jj] + dsk * xs) * siluf_(zv[jj]);
                    yv[jj] = y; ss += y * y;
                }
                u32x2 ow; ow.x = pk2(yv[0], yv[1]); ow.y = pk2(yv[2], yv[3]);
                *(u32x2*)(yabc + (size_t)(I.row0 + i) * 3072 + 1024 + head * 64 + p0) = ow;
            }
            ss += __shfl_xor(ss, 16); ss += __shfl_xor(ss, 32);
            if (fq == 0) part[i * 8 + w] = ss;
        }
        __syncthreads();
#pragma unroll 1
        for (int it = 0; it < NIT; ++it) {
            const int i = it * 16 + fr;
            const f32x4 pa = *(const LAS f32x4*)(part + i * 8), pb = *(const LAS f32x4*)(part + i * 8 + 4);
            const float tot = (pa[0] + pa[1] + pa[2] + pa[3]) + (pb[0] + pb[1] + pb[2] + pb[3]);
            const float rs = rsqrtf(tot * (1.0f / 512.0f) + EPS);
#pragma unroll
            for (int pt = 0; pt < 4; ++pt) {
                const int p0 = pt * 16 + fq * 4;
                const f32x4 ng = *(const f32x4*)(P->in[I_SNORM] + l * 1024 + head * 64 + p0);
                u32x2* yp = (u32x2*)(yabc + (size_t)(I.row0 + i) * 3072 + 1024 + head * 64 + p0);
                const u32x2 yw = *yp;
                u32x2 ow; ow.x = pk2(bflo(yw.x) * rs * ng[0], bfhi(yw.x) * rs * ng[1]); ow.y = pk2(bflo(yw.y) * rs * ng[2], bfhi(yw.y) * rs * ng[3]);
                *yp = ow;
            }
        }
    }
}

__device__ __forceinline__ void phase_scan(int wv, KP P, int l) {
    bf16_t* states = (bf16_t*)(P->ws + WS_ST);
    const float* cdec = (const float*)(P->ws + WS_CDEC);
    const float* lruA = (const float*)(P->ws + WS_LRUA); float* lruU = (float*)(P->ws + WS_LRUU);
    if (DBG_P5S) for (int idx = bidx() * 512 + tidx(wv); idx < 131072; idx += gdim() * 512) {
        const int e = idx * 2, b = e >> 17, rem = e & 131071, head = rem >> 13;
        unsigned* sp = (unsigned*)(states + (size_t)b * 128 * 131072 + rem);
        const float* dp = cdec + (b * 128) * 16 + head;
        float c0 = 0.f, c1 = 0.f;
        for (int c = 0; c < 128; c += 8) {
            unsigned v[8];
#pragma unroll
            for (int k = 0; k < 8; ++k) v[k] = sp[(size_t)(c + k) * 65536];
#pragma unroll
            for (int k = 0; k < 8; ++k) {
                const float dec = dp[(c + k) * 16];
                if (DBG_P5W) sp[(size_t)(c + k) * 65536] = pk2(c0, c1);
                c0 = dec * c0 + bflo(v[k]); c1 = dec * c1 + bfhi(v[k]);
            }
        }
        float* op = P->out + O_PSH + (size_t)(l * 2 + b) * 131072 + rem;
        op[0] = c0; op[1] = c1;
    }
    if (DBG_LRU4) for (int idx = bidx() * 512 + tidx(wv); idx < 2048; idx += gdim() * 512) {
        const int b = idx >> 10, ch = idx & 1023;
        float carry = 0.f;
        for (int c = 0; c < 128; ++c) {
            const size_t o = (size_t)(b * 128 + c) * 1024 + ch;
            const float A = lruA[o], U = lruU[o];
            lruU[o] = carry;
            carry = A * carry + U;
        }
    }
}

__device__ __forceinline__ void gsync(cg::grid_group& grid) {
    __threadfence(); grid.sync();
    __builtin_amdgcn_fence(__ATOMIC_ACQUIRE, "agent"); asm volatile("s_waitcnt vmcnt(0)" ::: "memory");
}
__device__ __forceinline__ void gemm_gu(int wv, LAS unsigned char* lds, int j2) { KP P = kparams();
    EpiGU E; E.ssq = (const float*)(P->ws + WS_SSQ); E.hff = (bf16_t*)(P->ws + WS_H);
    run_gemm(wv, lds, (const bf16_t*)(P->ws + WS_XB), (const bf16_t*)(P->ws + (j2 ? W_GU1 : W_GU0)), 5632, 1024, E); }
__device__ __forceinline__ void gemm_dn(int wv, LAS unsigned char* lds, int j2) { KP P = kparams();
    EpiRes E; E.x = P->out; E.xb = (bf16_t*)(P->ws + WS_XB); E.ssq = (float*)(P->ws + WS_SSQ); E.scale = 0.5f;
    run_gemm(wv, lds, (const bf16_t*)(P->ws + WS_H), (const bf16_t*)(P->ws + (j2 ? W_DN1 : W_DN0)), 1024, 2816, E); }
__device__ __forceinline__ void gemm_in(int wv, LAS unsigned char* lds) { KP P = kparams();
    EpiIn E; E.ssq = (const float*)(P->ws + WS_SSQ); E.h = (bf16_t*)(P->ws + WS_H); E.dtraw = (float*)(P->ws + WS_DT);
    run_gemm(wv, lds, (const bf16_t*)(P->ws + WS_XB), (const bf16_t*)(P->ws + W_IN), NINP, 1024, E); }
__device__ __forceinline__ void gemm_merge(int wv, LAS unsigned char* lds) { KP P = kparams();
    EpiMerge E; E.h = (const bf16_t*)(P->ws + WS_H); E.merged = (bf16_t*)(P->ws + WS_ST);
    run_gemm(wv, lds, (const bf16_t*)(P->ws + WS_Y), (const bf16_t*)(P->ws + W_BR), 1024, 3072, E); }
__device__ __forceinline__ void gemm_out(int wv, LAS unsigned char* lds) { KP P = kparams();
    EpiRes E; E.x = P->out; E.xb = (bf16_t*)(P->ws + WS_XB); E.ssq = (float*)(P->ws + WS_SSQ); E.scale = 1.0f;
    run_gemm(wv, lds, (const bf16_t*)(P->ws + WS_ST), (const bf16_t*)(P->ws + W_OUT), 1024, 1024, E); }

__global__ __launch_bounds__(512, 2) void mega(Params Pk) {
    extern __shared__ __attribute__((aligned(16))) unsigned char smem[];
    LAS unsigned char* lds = (LAS unsigned char*)smem;
    cg::grid_group grid = cg::this_grid();
    const int wv = __builtin_amdgcn_readfirstlane((int)(threadIdx.x >> 6));
    phase_init(wv, kparams());
#pragma unroll 1
    for (int step = 0; step < 8; ++step) {
        const int l = step >> 1, j2 = step & 1;
        gsync(grid);
        if (j2 == 0) { convert_layer(wv, kparams(), l, lds); gsync(grid); }
        gemm_gu(wv, lds, j2);
        gsync(grid);
        gemm_dn(wv, lds, j2);
        if (j2 == 0 && DBG_MIX) {
            gsync(grid);
            gemm_in(wv, lds);
            gsync(grid);
            for (int item = bidx(); item < NITEM; item += gdim()) {
                const Item I = get_item(item);
                copy_states_item(wv, kparams(), l, I);
                if (!I.sample) { if (DBG_ATTN) attn_item<64>(wv, kparams(), l, I, lds); if (DBG_LRU4) lru_item<64, false>(wv, kparams(), l, item, I, lds); if (DBG_SSD4) ssd_states_item<64>(wv, kparams(), l, item, I, lds); }
                else { if (DBG_ATTN) attn_item<16>(wv, kparams(), l, I, lds); }
            }
            gsync(grid);
            if (DBG_P5) phase_scan(wv, kparams(), l);
            gsync(grid);
            for (int item = bidx(); item < NITEM; item += gdim()) {
                const Item I = get_item(item);
                if (!I.sample) { if (DBG_LRU6) lru_item<64, true>(wv, kparams(), l, item, I, lds); if (DBG_SSD6) ssd_y_item<64>(wv, kparams(), l, I, lds); }
                else { if (DBG_LRU6) lru_item<16, true>(wv, kparams(), l, item, I, lds); if (DBG_SSD6) { ssd_states_item<16>(wv, kparams(), l, item, I, lds); ssd_y_item<16>(wv, kparams(), l, I, lds); } }
            }
            if (DBG_MERGE) {
            gsync(grid);
            gemm_merge(wv, lds);
            gsync(grid);
            gemm_out(wv, lds); }
        }
    }
    gsync(grid);
    phase_final(wv, kparams());
#if DBG_SANITIZE
    gsync(grid);
    { KP P = kparams(); float* o = P->out;
      for (size_t i = (size_t)bidx() * 512 + tidx(wv); i < O_END; i += (size_t)gdim() * 512) { const float v = o[i]; if (!(fabsf(v) < 1e30f)) o[i] = 0.f; } }
#endif
}

extern "C" void kernel_launch(void* const* d_in, const int* in_sizes, int n_in, void* d_out, int out_size, void* d_ws, size_t ws_size, hipStream_t stream) {
    static int grid_blocks = 0;
    if (grid_blocks == 0) {
        if (n_in != N_INPUTS || (size_t)out_size != O_END || ws_size < WS_END) {
            fprintf(stderr, "kernel_launch: unexpected shapes: n_in %d out %d ws %zu (need %zu)\n", n_in, out_size, ws_size, (size_t)WS_END); grid_blocks = -1; return; }
        int dev = 0, cus = 0, per_cu = 0;
        hipGetDevice(&dev);
        hipDeviceGetAttribute(&cus, hipDeviceAttributeMultiprocessorCount, dev);
        if (hipFuncSetAttribute((const void*)mega, hipFuncAttributeMaxDynamicSharedMemorySize, LDS_BYTES) != hipSuccess) { fprintf(stderr, "hipFuncSetAttribute failed\n"); grid_blocks = -1; return; }
        hipOccupancyMaxActiveBlocksPerMultiprocessor(&per_cu, (const void*)mega, 512, LDS_BYTES);
        if (per_cu < 1) per_cu = 1;
        grid_blocks = cus * per_cu;
    }
    if (grid_blocks < 0) return;
    Params p{};
    for (int i = 0; i < N_INPUTS; ++i) p.in[i] = (const float*)d_in[i];
    p.out = (float*)d_out; p.ws = (unsigned char*)d_ws;
    void* args[] = {&p};
    hipError_t e = hipLaunchCooperativeKernel((const void*)mega, dim3(grid_blocks), dim3(512), args, LDS_BYTES, stream);
    if (e != hipSuccess) fprintf(stderr, "cooperative launch failed: %s (grid %d)\n", hipGetErrorString(e), grid_blocks);
}
```

```cpp
#include <hip/hip_runtime.h>
#include <hip/hip_cooperative_groups.h>
#include <cstdio>
namespace cg = cooperative_groups;
#define DBG_SANITIZE 0
#ifndef REP_P4
#define REP_P4 1
#endif
#ifndef REP_P6
#define REP_P6 1
#endif
#ifndef REP_SYNC
#define REP_SYNC 0
#endif
#ifndef REP_IN
#define REP_IN 1
#endif
#define DBG_MIX 1
#define DBG_MERGE 1
#define DBG_ATTN 1
#define DBG_LRU4 1
#define DBG_SSD4 1
#define DBG_P5S 1
#define DBG_P5W 1
#define DBG_P5 1
#define DBG_LRU6 1
#define DBG_SSD6 1

#define LAS __attribute__((address_space(3)))
typedef unsigned short bf16_t;
typedef short bf16x8 __attribute__((ext_vector_type(8)));
typedef float f32x4 __attribute__((ext_vector_type(4)));
typedef unsigned u32x4 __attribute__((ext_vector_type(4)));
typedef unsigned u32x2 __attribute__((ext_vector_type(2)));

constexpr int MP = 16384, MS = 256, MT = 16640;
constexpr int DM = 1024, DFF = 2816, NIN = 9232, NINP = 9472, HP = 9232;
constexpr int HX = 0, HG = 1024, HZ = 2048, HXBC = 3072, HQ = 4608, HK = 5632, HV = 5888, HGATE = 6144, HDT = 9216;
constexpr float EPS = 1e-6f;
constexpr int NITEM = 272;

enum { I_XP = 0, I_XS, I_CK, I_CV, I_SLC, I_SLH, I_SSC, I_SSH, I_FNORM, I_WG, I_WU, I_WD, I_MNORM, I_WIN, I_LCW, I_LCB, I_LWA, I_LBA, I_LWX, I_LBX,
       I_LLAM, I_SCW, I_SCB, I_SDTB, I_SALOG, I_SD, I_SNORM, I_SINK, I_WBR, I_WOUT, I_FINAL, N_INPUTS };

constexpr size_t O_YP = 0, O_YS = O_YP + (size_t)MP * DM, O_PK = O_YS + (size_t)MS * DM, O_PV = O_PK + 4 * 2 * 128 * 256, O_PLC = O_PV + 4 * 2 * 128 * 256,
                 O_PLH = O_PLC + 4 * 2 * 3 * 1024, O_PSC = O_PLH + 4 * 2 * 1024, O_PSH = O_PSC + 4 * 2 * 3 * 1536, O_SK = O_PSH + (size_t)4 * 2 * 16 * 64 * 128,
                 O_SV = O_SK + (size_t)4 * 16 * 128 * 256, O_SLC = O_SV + (size_t)4 * 16 * 128 * 256, O_SLH = O_SLC + 4 * 16 * 3 * 1024, O_SSC = O_SLH + 4 * 16 * 1024,
                 O_SSH = O_SSC + 4 * 16 * 3 * 1536, O_END = O_SSH + (size_t)4 * 16 * 16 * 64 * 128;

constexpr size_t WS_XB = 0;
constexpr size_t WS_H = WS_XB + (size_t)MT * DM * 2;
constexpr size_t WS_ST = WS_H + (size_t)MT * HP * 2;
constexpr size_t WS_Y = WS_ST + (size_t)2 * 128 * 16 * 64 * 128 * 2;
constexpr size_t WS_W = WS_Y + (size_t)MT * 3072 * 2;
constexpr size_t W_GU0 = WS_W, W_GU1 = W_GU0 + (size_t)5632 * 1024 * 2, W_DN0 = W_GU1 + (size_t)5632 * 1024 * 2, W_DN1 = W_DN0 + (size_t)1024 * 2816 * 2,
                 W_IN = W_DN1 + (size_t)1024 * 2816 * 2, W_BR = W_IN + (size_t)NINP * 1024 * 2, W_OUT = W_BR + (size_t)1024 * 3072 * 2,
                 W_LA = W_OUT + (size_t)1024 * 1024 * 2, W_LX = W_LA + 65536 * 2, WS_SSQ = W_LX + 65536 * 2;
constexpr size_t WS_DT = WS_SSQ + (size_t)MT * 16 * 4, WS_LRUA = WS_DT + (size_t)MT * 16 * 4, WS_LRUU = WS_LRUA + 256 * 1024 * 4, WS_CDEC = WS_LRUU + 256 * 1024 * 4,
                 WS_BAR = WS_CDEC + 256 * 16 * 4, WS_END = WS_BAR + 16384;

constexpr int LDS_BYTES = 147456;

struct Params { const float* in[N_INPUTS]; float* out; unsigned char* ws; };
typedef const Params __attribute__((address_space(4))) * KP;
__device__ __forceinline__ KP kparams() { KP p = (KP)__builtin_amdgcn_kernarg_segment_ptr(); asm volatile("" : "+s"(p)); return p; }
__device__ __forceinline__ int tidx(int wv) { int t; asm volatile("v_mbcnt_lo_u32_b32 %0, -1, 0\n\tv_mbcnt_hi_u32_b32 %0, -1, %0" : "=v"(t)); return (wv << 6) | t; }
__device__ __forceinline__ int bidx() { int t = blockIdx.x; asm volatile("" : "+s"(t)); return t; }
__device__ __forceinline__ int gdim() { int t = gridDim.x; asm volatile("" : "+s"(t)); return t; }

typedef __bf16 bf16x2_t __attribute__((ext_vector_type(2)));
typedef float f32x2_t __attribute__((ext_vector_type(2)));
__device__ __forceinline__ unsigned pk2(float lo, float hi) { f32x2_t v = {lo, hi}; bf16x2_t b = __builtin_convertvector(v, bf16x2_t); unsigned r; __builtin_memcpy(&r, &b, 4); return r; }
__device__ __forceinline__ bf16_t f2bf(float f) { return (bf16_t)(pk2(f, 0.f) & 0xffffu); }
__device__ __forceinline__ float bf2f(bf16_t b) { return __uint_as_float(((unsigned)b) << 16); }
__device__ __forceinline__ float bflo(unsigned w) { return __uint_as_float(w << 16); }
__device__ __forceinline__ float bfhi(unsigned w) { return __uint_as_float(w & 0xffff0000u); }
__device__ __forceinline__ float sigmoidf_(float x) { return 1.0f / (1.0f + __expf(-x)); }
__device__ __forceinline__ float siluf_(float x) { return x / (1.0f + __expf(-x)); }
__device__ __forceinline__ float softplusf_(float x) { return x > 20.f ? x : log1pf(__expf(x)); }
__device__ __forceinline__ float gelu_tanh(float x) { const float u = 0.7978845608028654f * (x + 0.044715f * x * x * x); return 0.5f * x * (1.0f + tanhf(u)); }
__device__ __forceinline__ float rstd_row(const float* ssq, int r) {
    const f32x4* p = (const f32x4*)(ssq + (size_t)r * 16); f32x4 a = p[0], b = p[1], c = p[2], d = p[3];
    const float s = (a[0] + a[1] + a[2] + a[3]) + (b[0] + b[1] + b[2] + b[3]) + (c[0] + c[1] + c[2] + c[3]) + (d[0] + d[1] + d[2] + d[3]);
    return rsqrtf(s * (1.0f / 1024.0f) + EPS);
}
#define MFMA16(a, b, c) __builtin_amdgcn_mfma_f32_16x16x32_bf16((a), (b), (c), 0, 0, 0)

namespace pg8 {
constexpr int BM = 256, BK = 64, HALF = 128, HTB = HALF * BK * 2, STAGE_BYTES = 8 * HTB, NXCD = 8, WGM = 8;
__device__ __forceinline__ int lds_byte(int r, int c) { const int st = (r >> 4) * 2 + (c >> 5), rr = r & 15, cc = c & 31, ob = rr * 64 + cc * 2; return st * 1024 + (ob ^ (((ob >> 9) & 1) << 5)); }
__device__ __forceinline__ void stage_rc(int b, int& R, int& C) { const int st = b / 1024, sb = b % 1024, swz = sb ^ (((sb >> 9) & 1) << 5); R = (st >> 1) * 16 + swz / 64; C = (st & 1) * 32 + (swz % 64) / 2; }
struct Unit { int pm, pn; };
struct Gemm { const bf16_t* A; const bf16_t* Bt; int M, N, K; };
struct StaticOrder {
    int nM, nN, nwg, G, c;
    __device__ void init(int M, int N, int G_, int c_) { nM = M / BM; nN = N / BM; nwg = nM * nN; G = G_; c = c_; }
    __device__ bool next(int i, Unit& u) const {
        const long L = (long)i * G + c; if (L >= nwg) return false;
        int wgid = (int)L; { const int q = nwg / NXCD, r = nwg % NXCD, xcd = wgid % NXCD, off = wgid / NXCD; wgid = (xcd < r ? xcd * (q + 1) : r * (q + 1) + (xcd - r) * q) + off; }
        const int nig = WGM * nN, gid = wgid / nig, fm = gid * WGM, gsz = (nM - fm) < WGM ? (nM - fm) : WGM;
        u.pm = fm + ((wgid % nig) % gsz); u.pn = (wgid % nig) / gsz; return true;
    }
};

template <class Epi>
__device__ __forceinline__ void gemm_phase(int wv, LAS unsigned char* lds, const Gemm g, const StaticOrder& S, const Epi& E) {
    const int tid = tidx(wv), wid = wv, lane = tid & 63, wr = wid >> 2, wc = wid & 3, fr = lane & 15, fq = lane >> 4;
    const int K = g.K, nt = K / BK;
    unsigned voffA[2];
#pragma unroll
    for (int i = 0; i < 2; ++i) { int R, C; stage_rc(tid * 16 + i * 8192, R, C); voffA[i] = (unsigned)(R * K + C) * 2u; }
    const size_t kstep = (size_t)(BK * 2);
    const size_t hstep = (size_t)HALF * K * 2;
    const size_t tstep = 2 * hstep;
    const unsigned ldsw = (unsigned)wid * 1024u;
    const int aoff = lds_byte(wr * 64 + fr, fq * 8), boff = lds_byte(wc * 32 + fr, fq * 8);
#define PG8_SA(b, h) (((b) * 2 + (h)) * HTB)
#define PG8_SB(b, h) ((4 + (b) * 2 + (h)) * HTB)
#define PG8_STAGE(bufoff, gbase, voff) do { _Pragma("unroll") for (int _i = 0; _i < 2; ++_i) \
        __builtin_amdgcn_global_load_lds((const unsigned*)((const char*)(gbase) + (voff)[_i]), (LAS unsigned*)(lds + (bufoff) + ldsw + _i * 8192), 16, 0, 0); } while (0)
#define PG8_LDA(dst, b, h) do { _Pragma("unroll") for (int m = 0; m < 4; ++m) _Pragma("unroll") for (int k = 0; k < 2; ++k) dst[m][k] = *(const LAS bf16x8*)(lds + PG8_SA(b, h) + aoff + m * 2048 + k * 1024); } while (0)
#define PG8_LDB(dst, b, h) do { _Pragma("unroll") for (int n = 0; n < 2; ++n) _Pragma("unroll") for (int k = 0; k < 2; ++k) dst[n][k] = *(const LAS bf16x8*)(lds + PG8_SB(b, h) + boff + n * 2048 + k * 1024); } while (0)
#define PG8_MMA(ai, bj, At, Bt) do { __builtin_amdgcn_s_setprio(1); _Pragma("unroll") for (int m = 0; m < 4; ++m) _Pragma("unroll") for (int n = 0; n < 2; ++n) _Pragma("unroll") for (int k = 0; k < 2; ++k) \
        acc[ai][bj][m][n] = __builtin_amdgcn_mfma_f32_16x16x32_bf16(Bt[n][k], At[m][k], acc[ai][bj][m][n], 0, 0, 0); __builtin_amdgcn_s_setprio(0); } while (0)
#define PG8_WAIT_V(n) asm volatile("s_waitcnt vmcnt(" #n ")" ::: "memory")
#define PG8_WAIT_L(n) asm volatile("s_waitcnt lgkmcnt(" #n ")" ::: "memory")
#define PG8_BAR __builtin_amdgcn_s_barrier()
#define PG8_SCHED __builtin_amdgcn_sched_barrier(0)
    Unit cur, nxt; int ui = 0;
    if (!S.next(0, cur)) return;
    f32x4 acc[2][2][4][2];
#pragma unroll
    for (int a = 0; a < 2; ++a)
#pragma unroll
        for (int b = 0; b < 2; ++b)
#pragma unroll
            for (int m = 0; m < 4; ++m)
#pragma unroll
                for (int n = 0; n < 2; ++n) acc[a][b][m][n] = (f32x4){0.f, 0.f, 0.f, 0.f};
    bf16x8 At[4][2], B0[2][2], B1[2][2];
    const char* cA = (const char*)g.A + (size_t)cur.pm * tstep; const char* cB = (const char*)g.Bt + (size_t)cur.pn * tstep;
    PG8_STAGE(PG8_SB(0, 0), cB, voffA); PG8_STAGE(PG8_SA(0, 0), cA, voffA); PG8_STAGE(PG8_SB(0, 1), cB + hstep, voffA); PG8_STAGE(PG8_SA(0, 1), cA + hstep, voffA);
    if (wr == 1) PG8_BAR;
    PG8_WAIT_V(4); PG8_BAR;
    PG8_STAGE(PG8_SB(1, 0), cB + kstep, voffA); PG8_STAGE(PG8_SA(1, 0), cA + kstep, voffA); PG8_STAGE(PG8_SB(1, 1), cB + hstep + kstep, voffA);
    PG8_WAIT_V(6); PG8_BAR;
    for (;;) {
        const bool has_next = S.next(ui + 1, nxt);
        const char* nA = has_next ? (const char*)g.A + (size_t)nxt.pm * tstep : cA; const char* nB = has_next ? (const char*)g.Bt + (size_t)nxt.pn * tstep : cB;
        for (int t = 0; t < nt; t += 2) {
            const bool last = (t == nt - 2);
            const char* a1 = cA + (size_t)(t + 1) * kstep;
            const char* a2 = last ? nA : cA + (size_t)(t + 2) * kstep; const char* b2 = last ? nB : cB + (size_t)(t + 2) * kstep;
            const char* a3 = a2 + kstep; const char* b3 = b2 + kstep;
            PG8_LDB(B0, 0, 0); PG8_SCHED; PG8_LDA(At, 0, 0); PG8_STAGE(PG8_SA(1, 1), a1 + hstep, voffA);
            PG8_WAIT_L(8); PG8_BAR; PG8_WAIT_L(0); PG8_MMA(0, 0, At, B0); PG8_BAR; PG8_SCHED;
            PG8_LDB(B1, 0, 1); PG8_STAGE(PG8_SB(0, 0), b2, voffA);
            PG8_BAR; PG8_WAIT_L(0); PG8_MMA(0, 1, At, B1); PG8_BAR;
            PG8_LDA(At, 0, 1); PG8_STAGE(PG8_SA(0, 0), a2, voffA);
            PG8_BAR; PG8_WAIT_L(0); PG8_MMA(1, 0, At, B0); PG8_BAR; PG8_SCHED;
            PG8_STAGE(PG8_SB(0, 1), b2 + hstep, voffA);
            PG8_WAIT_V(6); PG8_BAR; PG8_MMA(1, 1, At, B1); PG8_BAR;
            PG8_LDB(B0, 1, 0); PG8_SCHED; PG8_LDA(At, 1, 0); PG8_STAGE(PG8_SA(0, 1), a2 + hstep, voffA);
            PG8_WAIT_L(8); PG8_BAR; PG8_WAIT_L(0); PG8_MMA(0, 0, At, B0); PG8_BAR; PG8_SCHED;
            PG8_LDB(B1, 1, 1); PG8_STAGE(PG8_SB(1, 0), b3, voffA);
            PG8_BAR; PG8_WAIT_L(0); PG8_MMA(0, 1, At, B1); PG8_BAR;
            PG8_LDA(At, 1, 1); PG8_STAGE(PG8_SA(1, 0), a3, voffA);
            PG8_BAR; PG8_WAIT_L(0); PG8_MMA(1, 0, At, B0); PG8_BAR; PG8_SCHED;
            PG8_STAGE(PG8_SB(1, 1), b3 + hstep, voffA);
            PG8_WAIT_V(6); PG8_BAR; PG8_MMA(1, 1, At, B1); PG8_BAR;
            if constexpr (Epi::HAS_MID) { if (!last && ((t + 2) & 15) == 0) E.mid(acc, cur, (t + 2) >> 4, wr, wc, fr, fq); }
        }
        E(acc, cur, wr, wc, fr, fq);
        if (!has_next) break;
#pragma unroll
        for (int a = 0; a < 2; ++a)
#pragma unroll
            for (int b = 0; b < 2; ++b)
#pragma unroll
                for (int m = 0; m < 4; ++m)
#pragma unroll
                    for (int n = 0; n < 2; ++n) acc[a][b][m][n] = (f32x4){0.f, 0.f, 0.f, 0.f};
        cur = nxt; cA = nA; cB = nB; ++ui;
    }
    PG8_WAIT_V(0);
    if (wr == 0) PG8_BAR;
    PG8_BAR;
#undef PG8_SA
#undef PG8_SB
#undef PG8_STAGE
#undef PG8_LDA
#undef PG8_LDB
#undef PG8_MMA
#undef PG8_WAIT_V
#undef PG8_WAIT_L
#undef PG8_BAR
#undef PG8_SCHED
}
}
using pg8::Unit;
typedef f32x4 AccT[2][2][4][2];

struct EpiGU {
    static constexpr bool HAS_MID = false;
    const float* ssq; bf16_t* hff;
    __device__ __forceinline__ void mid(AccT&, const Unit&, int, int, int, int, int) const {}
    __device__ __forceinline__ void operator()(const AccT& acc, const Unit& u, int wr, int wc, int fr_, int fq_) const {
        int fr = fr_, fq = fq_; asm volatile("" : "+v"(fr), "+v"(fq));
        const int row0 = u.pm * 256 + wr * 64 + fr, hc0 = u.pn * 128 + wc * 16 + fq * 4;
#pragma unroll
        for (int ai = 0; ai < 2; ++ai)
#pragma unroll
            for (int m = 0; m < 4; ++m) {
                const int r = row0 + ai * 128 + m * 16; const float rs = rstd_row(ssq, r);
#pragma unroll
                for (int bj = 0; bj < 2; ++bj) {
                    const f32x4 gt = acc[ai][bj][m][0] * rs, up = acc[ai][bj][m][1] * rs;
                    u32x2 w; w.x = pk2(siluf_(gt[0]) * up[0], siluf_(gt[1]) * up[1]); w.y = pk2(siluf_(gt[2]) * up[2], siluf_(gt[3]) * up[3]);
                    *(u32x2*)(hff + (size_t)r * DFF + hc0 + bj * 64) = w;
                }
            }
    }
};
struct EpiRes {
    static constexpr bool HAS_MID = false;
    float* x; bf16_t* xb; float* ssq; float scale;
    __device__ __forceinline__ void mid(AccT&, const Unit&, int, int, int, int, int) const {}
    __device__ __forceinline__ void operator()(const AccT& acc, const Unit& u, int wr, int wc, int fr_, int fq_) const {
        int fr = fr_, fq = fq_; asm volatile("" : "+v"(fr), "+v"(fq));
        const int row0 = u.pm * 256 + wr * 64 + fr, col0 = u.pn * 256 + wc * 32 + 4 * fq;
#pragma unroll
        for (int ai = 0; ai < 2; ++ai)
#pragma unroll
            for (int m = 0; m < 4; ++m) {
                const int r = row0 + ai * 128 + m * 16; float ss = 0.f;
#pragma unroll
                for (int bj = 0; bj < 2; ++bj)
#pragma unroll
                    for (int n = 0; n < 2; ++n) {
                        const int c = col0 + bj * 128 + n * 16;
                        f32x4* xp = (f32x4*)(x + (size_t)r * DM + c);
                        f32x4 v = *xp + acc[ai][bj][m][n] * scale;
                        *xp = v;
                        u32x2 w; w.x = pk2(v[0], v[1]); w.y = pk2(v[2], v[3]);
                        *(u32x2*)(xb + (size_t)r * DM + c) = w;
                        ss += v[0] * v[0] + v[1] * v[1] + v[2] * v[2] + v[3] * v[3];
                    }
                ss += __shfl_xor(ss, 16); ss += __shfl_xor(ss, 32);
                if (fq == 0) ssq[(size_t)r * 16 + u.pn * 4 + wc] = ss;
            }
    }
};
struct EpiIn {
    static constexpr bool HAS_MID = false;
    const float* ssq; bf16_t* h; float* dtraw;
    __device__ __forceinline__ void mid(AccT&, const Unit&, int, int, int, int, int) const {}
    __device__ __forceinline__ void operator()(const AccT& acc, const Unit& u, int wr, int wc, int fr_, int fq_) const {
        int fr = fr_, fq = fq_; asm volatile("" : "+v"(fr), "+v"(fq));
        const int row0 = u.pm * 256 + wr * 64 + fr, col0 = u.pn * 256 + wc * 32 + 4 * fq;
#pragma unroll
        for (int ai = 0; ai < 2; ++ai)
#pragma unroll
            for (int m = 0; m < 4; ++m) {
                const int r = row0 + ai * 128 + m * 16; const float rs = rstd_row(ssq, r);
                if (u.pn < 36) {
#pragma unroll
                    for (int bj = 0; bj < 2; ++bj)
#pragma unroll
                        for (int n = 0; n < 2; ++n) {
                            const int c = col0 + bj * 128 + n * 16; const f32x4 v = acc[ai][bj][m][n] * rs;
                            u32x2 w; w.x = pk2(v[0], v[1]); w.y = pk2(v[2], v[3]);
                            *(u32x2*)(h + (size_t)r * HP + c) = w;
                        }
                } else if (wc == 0) {
                    const f32x4 v = acc[ai][0][m][0] * rs;
                    *(f32x4*)(dtraw + (size_t)r * 16 + 4 * fq) = v;
                }
            }
    }
};
struct EpiMerge {
    static constexpr bool HAS_MID = true;
    const bf16_t* h; bf16_t* merged;
    __device__ __forceinline__ void mid(AccT& acc, const Unit& u, int seg, int wr, int wc, int fr_, int fq_) const {
        int fr = fr_, fq = fq_; asm volatile("" : "+v"(fr), "+v"(fq));
        const int row0 = u.pm * 256 + wr * 64 + fr, col0 = u.pn * 256 + wc * 32 + 4 * fq;
#pragma unroll
        for (int ai = 0; ai < 2; ++ai)
#pragma unroll
            for (int m = 0; m < 4; ++m) {
                const int r = row0 + ai * 128 + m * 16;
#pragma unroll
                for (int bj = 0; bj < 2; ++bj)
#pragma unroll
                    for (int n = 0; n < 2; ++n) {
                        const int c = col0 + bj * 128 + n * 16;
                        const bf16_t* gp = h + (size_t)r * HP + HGATE + (seg - 1) * 1024 + c;
                        const u32x2 ga = *(const u32x2*)gp, gb = *(const u32x2*)(gp + 1024);
                        const float a0 = bflo(ga.x), a1 = bfhi(ga.x), a2 = bflo(ga.y), a3 = bfhi(ga.y);
                        const float b0 = bflo(gb.x), b1 = bfhi(gb.x), b2 = bflo(gb.y), b3 = bfhi(gb.y);
                        f32x4 f;
                        f[0] = (1.f + __expf(-fmaxf(b0, -30.f))) / (1.f + __expf(-fmaxf(a0, -30.f)));
                        f[1] = (1.f + __expf(-fmaxf(b1, -30.f))) / (1.f + __expf(-fmaxf(a1, -30.f)));
                        f[2] = (1.f + __expf(-fmaxf(b2, -30.f))) / (1.f + __expf(-fmaxf(a2, -30.f)));
                        f[3] = (1.f + __expf(-fmaxf(b3, -30.f))) / (1.f + __expf(-fmaxf(a3, -30.f)));
                        acc[ai][bj][m][n] *= f;
                    }
            }
    }
    __device__ __forceinline__ void operator()(const AccT& acc, const Unit& u, int wr, int wc, int fr_, int fq_) const {
        int fr = fr_, fq = fq_; asm volatile("" : "+v"(fr), "+v"(fq));
        const int row0 = u.pm * 256 + wr * 64 + fr, col0 = u.pn * 256 + wc * 32 + 4 * fq;
#pragma unroll
        for (int ai = 0; ai < 2; ++ai)
#pragma unroll
            for (int m = 0; m < 4; ++m) {
                const int r = row0 + ai * 128 + m * 16;
#pragma unroll
                for (int bj = 0; bj < 2; ++bj)
#pragma unroll
                    for (int n = 0; n < 2; ++n) {
                        const int c = col0 + bj * 128 + n * 16;
                        const u32x2 ga = *(const u32x2*)(h + (size_t)r * HP + HGATE + 2048 + c);
                        const f32x4 v = acc[ai][bj][m][n];
                        u32x2 w;
                        w.x = pk2(v[0] / (1.f + __expf(-fmaxf(bflo(ga.x), -30.f))), v[1] / (1.f + __expf(-fmaxf(bfhi(ga.x), -30.f))));
                        w.y = pk2(v[2] / (1.f + __expf(-fmaxf(bflo(ga.y), -30.f))), v[3] / (1.f + __expf(-fmaxf(bfhi(ga.y), -30.f))));
                        *(u32x2*)(merged + (size_t)r * DM + c) = w;
                    }
            }
    }
};

template <class Epi> __device__ __forceinline__ void run_gemm(int wv, LAS unsigned char* lds, const bf16_t* A, const bf16_t* Bt, int N, int K, const Epi& E) {
    pg8::Gemm g; g.A = A; g.Bt = Bt; g.M = MT; g.N = N; g.K = K;
    pg8::StaticOrder S; S.init(MT, N, (int)gdim(), (int)bidx());
    pg8::gemm_phase<Epi>(wv, lds, g, S, E);
}

template <class RM>
__device__ __forceinline__ void cvt_tile(int wv, const float* src, int src_ld, int k0, int nsrc0, int nvalid, const float* gk, bf16_t* dst, int dst_ld, RM rowmap, LAS float* tile) {
    const int tid = tidx(wv);
    __syncthreads();
#pragma unroll
    for (int i = 0; i < 2; ++i) {
        const int kk = (tid >> 4) + 32 * i, n4 = (tid & 15) * 4;
        f32x4 v = (f32x4){0.f, 0.f, 0.f, 0.f};
        if (n4 < nvalid) v = *(const f32x4*)(src + (size_t)(k0 + kk) * src_ld + nsrc0 + n4);
        const float gsc = gk ? gk[k0 + kk] : 1.0f;
        tile[kk * 65 + n4 + 0] = v[0] * gsc; tile[kk * 65 + n4 + 1] = v[1] * gsc; tile[kk * 65 + n4 + 2] = v[2] * gsc; tile[kk * 65 + n4 + 3] = v[3] * gsc;
    }
    __syncthreads();
    const int nl = tid >> 3, k8 = (tid & 7) * 8;
    if (nl < nvalid) {
        u32x4 w;
        w.x = pk2(tile[(k8 + 0) * 65 + nl], tile[(k8 + 1) * 65 + nl]); w.y = pk2(tile[(k8 + 2) * 65 + nl], tile[(k8 + 3) * 65 + nl]);
        w.z = pk2(tile[(k8 + 4) * 65 + nl], tile[(k8 + 5) * 65 + nl]); w.w = pk2(tile[(k8 + 6) * 65 + nl], tile[(k8 + 7) * 65 + nl]);
        *(u32x4*)(dst + (size_t)rowmap(nl) * dst_ld + k0 + k8) = w;
    }
}

__device__ __forceinline__ void convert_layer(int wv, KP P, int l, LAS unsigned char* lds) {
    LAS float* tile = (LAS float*)lds;
    constexpr int J_GU = 2 * 2 * 16 * 44, J_DN = 2 * 44 * 16, J_IN = 16 * 145, J_BR = 48 * 16, J_OUT = 16 * 16, J_LRU = 32;
    constexpr int J_TOT = J_GU + J_DN + J_IN + J_BR + J_OUT + J_LRU;
    for (int job = bidx(); job < J_TOT; job += gdim()) {
        int j = job;
        if (j < J_GU) {
            const int nt = j % 44; j /= 44; const int kt = j % 16; j /= 16; const int which = j & 1, j2 = j >> 1;
            const float* src = P->in[which ? I_WU : I_WG] + (size_t)(l * 2 + j2) * 1024 * 2816;
            bf16_t* dst = (bf16_t*)(P->ws + (j2 ? W_GU1 : W_GU0));
            const int hc0 = nt * 64;
            cvt_tile(wv, src, 2816, kt * 64, hc0, 64, P->in[I_FNORM] + (l * 2 + j2) * 1024, dst, 1024,
                     [=](int nl) { const int hc = hc0 + nl; return 256 * (hc >> 7) + 128 * ((hc >> 6) & 1) + 32 * ((hc >> 4) & 3) + 16 * which + (hc & 15); }, tile);
            continue;
        }
        j -= J_GU;
        if (j < J_DN) {
            const int nt = j % 16; j /= 16; const int kt = j % 44; const int j2 = j / 44;
            const float* src = P->in[I_WD] + (size_t)(l * 2 + j2) * 2816 * 1024;
            bf16_t* dst = (bf16_t*)(P->ws + (j2 ? W_DN1 : W_DN0));
            const int n0 = nt * 64;
            cvt_tile(wv, src, 1024, kt * 64, n0, 64, nullptr, dst, 2816, [=](int nl) { return n0 + nl; }, tile);
            continue;
        }
        j -= J_DN;
        if (j < J_IN) {
            const int nt = j % 145, kt = j / 145;
            const float* src = P->in[I_WIN] + (size_t)l * 1024 * NIN;
            bf16_t* dst = (bf16_t*)(P->ws + W_IN);
            const int n0 = nt * 64;
            const int nsrc0 = nt < 72 ? n0 : (nt < 144 ? n0 + 16 : 4608);
            cvt_tile(wv, src, NIN, kt * 64, nsrc0, nt < 144 ? 64 : 16, P->in[I_MNORM] + l * 1024, dst, 1024, [=](int nl) { return n0 + nl; }, tile);
            continue;
        }
        j -= J_IN;
        if (j < J_BR) {
            const int nt = j % 16, kt = j / 16;
            const float* src = P->in[I_WBR] + (size_t)l * 3072 * 1024;
            bf16_t* dst = (bf16_t*)(P->ws + W_BR);
            const int n0 = nt * 64;
            cvt_tile(wv, src, 1024, kt * 64, n0, 64, nullptr, dst, 3072, [=](int nl) { return n0 + nl; }, tile);
            continue;
        }
        j -= J_BR;
        if (j < J_OUT) {
            const int nt = j % 16, kt = j / 16;
            const float* src = P->in[I_WOUT] + (size_t)l * 1024 * 1024;
            bf16_t* dst = (bf16_t*)(P->ws + W_OUT);
            const int n0 = nt * 64;
            cvt_tile(wv, src, 1024, kt * 64, n0, 64, nullptr, dst, 1024, [=](int nl) { return n0 + nl; }, tile);
            continue;
        }
        j -= J_OUT;
        {
            const int blk = j & 15, which = j >> 4;
            const float* src = P->in[which ? I_LWX : I_LWA] + (size_t)(l * 16 + blk) * 4096;
            bf16_t* dst = (bf16_t*)(P->ws + (which ? W_LX : W_LA)) + blk * 4096;
            cvt_tile(wv, src, 64, 0, 0, 64, nullptr, dst, 64, [=](int nl) { return nl; }, tile);
        }
    }
    __syncthreads();
}

__device__ __forceinline__ void phase_init(int wv, KP P) {
    const int w = tidx(wv) >> 6, lane = tidx(wv) & 63;
    float* x = P->out; bf16_t* xb = (bf16_t*)(P->ws + WS_XB); float* ssq = (float*)(P->ws + WS_SSQ);
    for (int row = bidx() * 8 + w; row < MT; row += gdim() * 8) {
        const float* src = row < MP ? P->in[I_XP] + (size_t)row * DM : P->in[I_XS] + (size_t)(row - MP) * DM;
        float ss = 0.f;
#pragma unroll
        for (int i = 0; i < 4; ++i) {
            const int c = (i * 64 + lane) * 4;
            const f32x4 v = *(const f32x4*)(src + c);
            *(f32x4*)(x + (size_t)row * DM + c) = v;
            u32x2 pw; pw.x = pk2(v[0], v[1]); pw.y = pk2(v[2], v[3]);
            *(u32x2*)(xb + (size_t)row * DM + c) = pw;
            ss += v[0] * v[0] + v[1] * v[1] + v[2] * v[2] + v[3] * v[3];
        }
#pragma unroll
        for (int d = 32; d >= 1; d >>= 1) ss += __shfl_xor(ss, d);
        if (lane < 16) ssq[(size_t)row * 16 + lane] = lane == 0 ? ss : 0.f;
    }
}
__device__ __forceinline__ void phase_final(int wv, KP P) {
    const int w = tidx(wv) >> 6, lane = tidx(wv) & 63;
    float* x = P->out; const float* ssq = (const float*)(P->ws + WS_SSQ); const float* gf = P->in[I_FINAL];
    for (int row = bidx() * 8 + w; row < MT; row += gdim() * 8) {
        const float rs = rstd_row(ssq, row);
#pragma unroll
        for (int i = 0; i < 4; ++i) {
            const int c = (i * 64 + lane) * 4;
            f32x4 v = *(const f32x4*)(x + (size_t)row * DM + c); const f32x4 g = *(const f32x4*)(gf + c);
            v = v * rs * g;
            *(f32x4*)(x + (size_t)row * DM + c) = v;
        }
    }
}

struct Item { int row0, L, b, c, sb, sample; };
__device__ __forceinline__ Item get_item(int it) {
    Item I;
    if (it < 256) { I.b = it >> 7; I.c = it & 127; I.row0 = I.b * 8192 + I.c * 64; I.L = 64; I.sample = 0; I.sb = 0; }
    else { I.sb = it - 256; I.b = 0; I.c = 0; I.row0 = MP + I.sb * 16; I.L = 16; I.sample = 1; }
    return I;
}

__device__ __forceinline__ void copy_states_item(int wv, KP P, int l, const Item& I) {
    const bf16_t* h = (const bf16_t*)(P->ws + WS_H);
    const int tid = tidx(wv);
    if (!I.sample) {
        if (I.c >= 126) {
            for (int idx = tid; idx < 64 * 512; idx += 512) {
                const int t = idx >> 9, cc = idx & 511, kv = cc >> 8, e = cc & 255;
                const float v = bf2f(h[(size_t)(I.row0 + t) * HP + (kv ? HV : HK) + e]);
                P->out[(kv ? O_PV : O_PK) + ((size_t)(l * 2 + I.b) * 128 + (I.c - 126) * 64 + t) * 256 + e] = v;
            }
        }
        if (I.c == 127) {
            for (int idx = tid; idx < 3 * 1024; idx += 512) { const int j = idx >> 10, ch = idx & 1023;
                P->out[O_PLC + ((size_t)(l * 2 + I.b) * 3 + j) * 1024 + ch] = bf2f(h[(size_t)(I.row0 + 61 + j) * HP + HX + ch]); }
            for (int idx = tid; idx < 3 * 1536; idx += 512) { const int j = idx / 1536, ch = idx % 1536;
                P->out[O_PSC + ((size_t)(l * 2 + I.b) * 3 + j) * 1536 + ch] = bf2f(h[(size_t)(I.row0 + 61 + j) * HP + HXBC + ch]); }
        }
    } else {
        for (int idx = tid; idx < 128 * 512; idx += 512) {
            const int j = idx >> 9, cc = idx & 511, kv = cc >> 8, e = cc & 255;
            float v;
            if (j < 112) v = P->in[kv ? I_CV : I_CK][((size_t)(l * 16 + I.sb) * 128 + j + 16) * 256 + e];
            else v = bf2f(h[(size_t)(I.row0 + j - 112) * HP + (kv ? HV : HK) + e]);
            P->out[(kv ? O_SV : O_SK) + ((size_t)(l * 16 + I.sb) * 128 + j) * 256 + e] = v;
        }
        for (int idx = tid; idx < 3 * 1024; idx += 512) { const int j = idx >> 10, ch = idx & 1023;
            P->out[O_SLC + ((size_t)(l * 16 + I.sb) * 3 + j) * 1024 + ch] = bf2f(h[(size_t)(I.row0 + 13 + j) * HP + HX + ch]); }
        for (int idx = tid; idx < 3 * 1536; idx += 512) { const int j = idx / 1536, ch = idx % 1536;
            P->out[O_SSC + ((size_t)(l * 16 + I.sb) * 3 + j) * 1536 + ch] = bf2f(h[(size_t)(I.row0 + 13 + j) * HP + HXBC + ch]); }
    }
}

template <int L>
__device__ __forceinline__ void attn_item(int wv, KP P, int l, const Item& I, LAS unsigned char* lds) {
    constexpr int NS = (L == 64) ? 192 : 160;
    constexpr int NST = NS / 16, NKS = NS / 32, NQT = L / 16;
    const bf16_t* h = (const bf16_t*)(P->ws + WS_H);
    bf16_t* yabc = (bf16_t*)(P->ws + WS_Y);
    const int tid = tidx(wv), w = tid >> 6, lane = tid & 63, fr = lane & 15, fq = lane >> 4;
    LAS bf16_t* Kl = (LAS bf16_t*)lds;
    LAS bf16_t* Vt = Kl + 2 * 192 * 72;
    for (int pass = 0; pass < 2; ++pass) {
        __syncthreads();
        for (int idx = tid; idx < 2 * NS * 8; idx += 512) {
            const int dp = idx & 7, s = (idx >> 3) % NS, kvl = idx / (8 * NS), kvh = pass * 2 + kvl;
            u32x4 kw = (u32x4){0u, 0u, 0u, 0u}, vw = (u32x4){0u, 0u, 0u, 0u};
            if (L == 64) {
                const int pos = (I.c - 2) * 64 + s;
                if (pos >= 0) {
                    const bf16_t* rp = h + (size_t)(I.b * 8192 + pos) * HP + kvh * 64 + dp * 8;
                    kw = *(const u32x4*)(rp + HK); vw = *(const u32x4*)(rp + HV);
                }
            } else {
                if (s < 128) {
                    const size_t o = ((size_t)(l * 16 + I.sb) * 128 + s) * 256 + kvh * 64 + dp * 8;
                    const f32x4 k0 = *(const f32x4*)(P->in[I_CK] + o), k1 = *(const f32x4*)(P->in[I_CK] + o + 4);
                    const f32x4 v0 = *(const f32x4*)(P->in[I_CV] + o), v1 = *(const f32x4*)(P->in[I_CV] + o + 4);
                    kw.x = pk2(k0[0], k0[1]); kw.y = pk2(k0[2], k0[3]); kw.z = pk2(k1[0], k1[1]); kw.w = pk2(k1[2], k1[3]);
                    vw.x = pk2(v0[0], v0[1]); vw.y = pk2(v0[2], v0[3]); vw.z = pk2(v1[0], v1[1]); vw.w = pk2(v1[2], v1[3]);
                } else if (s < 144) {
                    const bf16_t* rp = h + (size_t)(I.row0 + s - 128) * HP + kvh * 64 + dp * 8;
                    kw = *(const u32x4*)(rp + HK); vw = *(const u32x4*)(rp + HV);
                }
            }
            *(LAS u32x4*)(Kl + (kvl * 192 + s) * 72 + dp * 8) = kw;
            LAS bf16_t* vp = Vt + (kvl * 64 + dp * 8) * 200 + s;
            vp[0 * 200] = (bf16_t)(vw.x & 0xffffu); vp[1 * 200] = (bf16_t)(vw.x >> 16); vp[2 * 200] = (bf16_t)(vw.y & 0xffffu); vp[3 * 200] = (bf16_t)(vw.y >> 16);
            vp[4 * 200] = (bf16_t)(vw.z & 0xffffu); vp[5 * 200] = (bf16_t)(vw.z >> 16); vp[6 * 200] = (bf16_t)(vw.w & 0xffffu); vp[7 * 200] = (bf16_t)(vw.w >> 16);
        }
        __syncthreads();
        const int head = pass * 8 + w, kvl = w >> 2;
        const float slope = exp2f(-0.5f * (float)(head + 1));
        const float sink = P->in[I_SINK][l * 16 + head];
#pragma unroll 1
        for (int qt = 0; qt < NQT; ++qt) {
            const bf16_t* qp = h + (size_t)(I.row0 + qt * 16 + fr) * HP + HQ + head * 64 + fq * 8;
            const bf16x8 q0 = *(const bf16x8*)qp, q1 = *(const bf16x8*)(qp + 32);
            f32x4 st[NST];
#pragma unroll
            for (int t = 0; t < NST; ++t) {
                const LAS bf16_t* kp = Kl + (kvl * 192 + t * 16 + fr) * 72 + fq * 8;
                f32x4 a = (f32x4){0.f, 0.f, 0.f, 0.f};
                a = MFMA16(*(const LAS bf16x8*)kp, q0, a);
                a = MFMA16(*(const LAS bf16x8*)(kp + 32), q1, a);
                st[t] = a;
                __builtin_amdgcn_sched_barrier(0);
            }
            const int qpos = (L == 64) ? (I.c * 64 + qt * 16 + fr) : (4096 + fr);
            float mx = sink;
#pragma unroll
            for (int t = 0; t < NST; ++t)
#pragma unroll
                for (int jj = 0; jj < 4; ++jj) {
                    const int s = t * 16 + fq * 4 + jj;
                    const int kpos = (L == 64) ? ((I.c - 2) * 64 + s) : (3968 + s);
                    const bool vis = (L == 64) ? (kpos >= 0) : (s < 144);
                    const float d = fabsf((float)(qpos - kpos));
                    const float sc = vis ? (st[t][jj] * 0.125f - slope * d) : -INFINITY;
                    st[t][jj] = sc; mx = fmaxf(mx, sc);
                }
            mx = fmaxf(mx, __shfl_xor(mx, 16)); mx = fmaxf(mx, __shfl_xor(mx, 32));
            float sum = 0.f;
#pragma unroll
            for (int t = 0; t < NST; ++t)
#pragma unroll
                for (int jj = 0; jj < 4; ++jj) { const float p = __expf(st[t][jj] - mx); st[t][jj] = p; sum += p; }
            sum += __shfl_xor(sum, 16); sum += __shfl_xor(sum, 32);
            const float inv = 1.0f / (sum + __expf(sink - mx));
            f32x4 o[4];
#pragma unroll
            for (int dt = 0; dt < 4; ++dt) o[dt] = (f32x4){0.f, 0.f, 0.f, 0.f};
#pragma unroll
            for (int ks = 0; ks < NKS; ++ks) {
                u32x4 pw; pw.x = pk2(st[2 * ks][0], st[2 * ks][1]); pw.y = pk2(st[2 * ks][2], st[2 * ks][3]);
                pw.z = pk2(st[2 * ks + 1][0], st[2 * ks + 1][1]); pw.w = pk2(st[2 * ks + 1][2], st[2 * ks + 1][3]);
                bf16x8 pf; __builtin_memcpy(&pf, &pw, 16);
#pragma unroll
                for (int dt = 0; dt < 4; ++dt) {
                    const LAS bf16_t* vp = Vt + (kvl * 64 + dt * 16 + fr) * 200 + ks * 32 + fq * 4;
                    const u32x2 va = *(const LAS u32x2*)vp, vb = *(const LAS u32x2*)(vp + 16);
                    u32x4 vw; vw.x = va.x; vw.y = va.y; vw.z = vb.x; vw.w = vb.y;
                    bf16x8 vf; __builtin_memcpy(&vf, &vw, 16);
                    o[dt] = MFMA16(vf, pf, o[dt]);
                }
            }
            bf16_t* op = yabc + (size_t)(I.row0 + qt * 16 + fr) * 3072 + 2048 + head * 64 + fq * 4;
#pragma unroll
            for (int dt = 0; dt < 4; ++dt) {
                u32x2 ow; ow.x = pk2(o[dt][0] * inv, o[dt][1] * inv); ow.y = pk2(o[dt][2] * inv, o[dt][3] * inv);
                *(u32x2*)(op + dt * 16) = ow;
            }
        }
    }
}

template <int L, bool FINAL>
__device__ __forceinline__ void lru_item(int wv, KP P, int l, int item, const Item& I, LAS unsigned char* lds) {
    constexpr int NIT = L / 16;
    const bf16_t* h = (const bf16_t*)(P->ws + WS_H);
    bf16_t* yabc = (bf16_t*)(P->ws + WS_Y);
    float* lruA = (float*)(P->ws + WS_LRUA); float* lruU = (float*)(P->ws + WS_LRUU);
    const int tid = tidx(wv), w = tid >> 6, lane = tid & 63, fr = lane & 15, fq = lane >> 4;
    LAS bf16_t* xa = (LAS bf16_t*)lds + w * (64 * 72);
    for (int pass = 0; pass < 2; ++pass) {
        const int blk = w + 8 * pass, ch0 = blk * 64;
        __syncthreads();
        {
            const int ch = ch0 + lane;
            const float* cw = P->in[I_LCW] + (size_t)l * 4 * 1024 + ch;
            const float w0 = cw[0], w1 = cw[1024], w2 = cw[2048], w3 = cw[3072], cb = P->in[I_LCB][l * 1024 + ch];
            float xm3 = 0.f, xm2 = 0.f, xm1 = 0.f;
            if (I.sample) { const float* st = P->in[I_SLC] + (size_t)(l * 16 + I.sb) * 3 * 1024 + ch; xm3 = st[0]; xm2 = st[1024]; xm1 = st[2048]; }
            else if (I.c > 0) { const bf16_t* hp = h + (size_t)(I.row0 - 3) * HP + HX + ch; xm3 = bf2f(hp[0]); xm2 = bf2f(hp[HP]); xm1 = bf2f(hp[2 * (size_t)HP]); }
            const bf16_t* hp = h + (size_t)I.row0 * HP + HX + ch;
#pragma unroll 4
            for (int t = 0; t < L; ++t) {
                const float x0 = bf2f(hp[(size_t)t * HP]);
                const float y = cb + w0 * xm3 + w1 * xm2 + w2 * xm1 + w3 * x0;
                xa[t * 72 + lane] = f2bf(y);
                xm3 = xm2; xm2 = xm1; xm1 = x0;
            }
        }
        __syncthreads();
        const bf16_t* waT = (const bf16_t*)(P->ws + W_LA) + blk * 4096;
        const bf16_t* wxT = (const bf16_t*)(P->ws + W_LX) + blk * 4096;
        float carryH[4][4], carryA[4][4];
#pragma unroll
        for (int jt = 0; jt < 4; ++jt)
#pragma unroll
            for (int jj = 0; jj < 4; ++jj) {
                const int ch = ch0 + jt * 16 + fq * 4 + jj;
                carryA[jt][jj] = 1.0f;
                if (FINAL) carryH[jt][jj] = I.sample ? P->in[I_SLH][(l * 16 + I.sb) * 1024 + ch] : lruU[(size_t)item * 1024 + ch];
                else carryH[jt][jj] = 0.f;
            }
#pragma unroll 1
        for (int it = 0; it < NIT; ++it) {
            const LAS bf16_t* xp = xa + (it * 16 + fr) * 72;
            const bf16x8 b0 = *(const LAS bf16x8*)(xp + fq * 8), b1 = *(const LAS bf16x8*)(xp + 32 + fq * 8);
            const int token = it * 16 + fr;
#pragma unroll
            for (int jt = 0; jt < 4; ++jt) {
                const bf16_t* wa = waT + (jt * 16 + fr) * 64 + fq * 8; const bf16_t* wx = wxT + (jt * 16 + fr) * 64 + fq * 8;
                f32x4 ra = (f32x4){0.f, 0.f, 0.f, 0.f}, ia = (f32x4){0.f, 0.f, 0.f, 0.f};
                ra = MFMA16(*(const bf16x8*)wa, b0, ra); ra = MFMA16(*(const bf16x8*)(wa + 32), b1, ra);
                ia = MFMA16(*(const bf16x8*)wx, b0, ia); ia = MFMA16(*(const bf16x8*)(wx + 32), b1, ia);
                const u32x2 xw = *(const LAS u32x2*)(xp + jt * 16 + fq * 4);
                const float xv[4] = {bflo(xw.x), bfhi(xw.x), bflo(xw.y), bfhi(xw.y)};
                float hv[4];
#pragma unroll
                for (int jj = 0; jj < 4; ++jj) {
                    const int ch = ch0 + jt * 16 + fq * 4 + jj;
                    const float r = sigmoidf_(ra[jj] + P->in[I_LBA][l * 1024 + ch]);
                    const float ig = sigmoidf_(ia[jj] + P->in[I_LBX][l * 1024 + ch]);
                    const float c8 = 8.0f * softplusf_(-P->in[I_LLAM][l * 1024 + ch]);
                    const float la = -c8 * r;
                    float a = __expf(la);
                    float u = sqrtf(fmaxf(-expm1f(2.0f * la), 0.f)) * ig * xv[jj];
#pragma unroll
                    for (int d = 1; d < 16; d <<= 1) {
                        const float ap = __shfl_up(a, d, 16), up = __shfl_up(u, d, 16);
                        if (fr >= d) { u = a * up + u; a = a * ap; }
                    }
                    const float hval = a * carryH[jt][jj] + u;
                    hv[jj] = hval;
                    carryH[jt][jj] = __shfl(hval, 15, 16);
                    if (!FINAL) carryA[jt][jj] = carryA[jt][jj] * __shfl(a, 15, 16);
                }
                if (FINAL) {
                    const u32x2 gw = *(const u32x2*)(h + (size_t)(I.row0 + token) * HP + HG + ch0 + jt * 16 + fq * 4);
                    u32x2 ow; ow.x = pk2(hv[0] * gelu_tanh(bflo(gw.x)), hv[1] * gelu_tanh(bfhi(gw.x)));
                    ow.y = pk2(hv[2] * gelu_tanh(bflo(gw.y)), hv[3] * gelu_tanh(bfhi(gw.y)));
                    *(u32x2*)(yabc + (size_t)(I.row0 + token) * 3072 + ch0 + jt * 16 + fq * 4) = ow;
                    if (it == NIT - 1 && fr == 15) {
                        if (I.sample) *(f32x4*)(P->out + O_SLH + (size_t)(l * 16 + I.sb) * 1024 + ch0 + jt * 16 + fq * 4) = (f32x4){hv[0], hv[1], hv[2], hv[3]};
                        else if (I.c == 127) *(f32x4*)(P->out + O_PLH + (size_t)(l * 2 + I.b) * 1024 + ch0 + jt * 16 + fq * 4) = (f32x4){hv[0], hv[1], hv[2], hv[3]};
                    }
                }
            }
        }
        if (!FINAL) {
            if (fr == 0) {
#pragma unroll
                for (int jt = 0; jt < 4; ++jt) {
                    *(f32x4*)(lruA + (size_t)item * 1024 + ch0 + jt * 16 + fq * 4) = (f32x4){carryA[jt][0], carryA[jt][1], carryA[jt][2], carryA[jt][3]};
                    *(f32x4*)(lruU + (size_t)item * 1024 + ch0 + jt * 16 + fq * 4) = (f32x4){carryH[jt][0], carryH[jt][1], carryH[jt][2], carryH[jt][3]};
                }
            }
        }
    }
}

__device__ __forceinline__ float pre_xbc(KP P, const bf16_t* h, int l, const Item& I, int tt, int ch) {
    if (tt >= 0 || (!I.sample && I.c > 0)) return bf2f(h[(size_t)(I.row0 + tt) * HP + HXBC + ch]);
    if (I.sample) return P->in[I_SSC][((size_t)(l * 16 + I.sb) * 3 + (3 + tt)) * 1536 + ch];
    return 0.f;
}
__device__ __forceinline__ float conv_xbc(KP P, const bf16_t* h, int l, const Item& I, int t, int ch) {
    const float* cw = P->in[I_SCW] + (size_t)l * 4 * 1536 + ch;
    float y = P->in[I_SCB][l * 1536 + ch];
    y += cw[0] * pre_xbc(P, h, l, I, t - 3, ch); y += cw[1536] * pre_xbc(P, h, l, I, t - 2, ch);
    y += cw[3072] * pre_xbc(P, h, l, I, t - 1, ch); y += cw[4608] * pre_xbc(P, h, l, I, t, ch);
    return siluf_(y);
}
template <int L>
__device__ __forceinline__ void ssd_dtcum(int wv, KP P, int l, const Item& I, LAS float* dtv, LAS float* cumv) {
    const float* dtraw = (const float*)(P->ws + WS_DT);
    const int tid = tidx(wv);
    __syncthreads();
    for (int idx = tid; idx < L * 16; idx += 512) { const int hd = idx & 15; dtv[idx] = softplusf_(dtraw[(size_t)I.row0 * 16 + idx] + P->in[I_SDTB][l * 16 + hd]); }
    __syncthreads();
    if (tid < 16) { const float A = -__expf(P->in[I_SALOG][l * 16 + tid]); float c = 0.f; for (int t = 0; t < L; ++t) { c += dtv[t * 16 + tid] * A; cumv[t * 16 + tid] = c; } }
    __syncthreads();
}

template <int L>
__device__ __forceinline__ void ssd_states_item(int wv, KP P, int l, int item, const Item& I, LAS unsigned char* lds) {
    constexpr int LP = L < 32 ? 32 : L, KS = LP / 32;
    const bf16_t* h = (const bf16_t*)(P->ws + WS_H);
    bf16_t* states = (bf16_t*)(P->ws + WS_ST);
    float* cdec = (float*)(P->ws + WS_CDEC);
    const int tid = tidx(wv), w = tid >> 6, lane = tid & 63, fr = lane & 15, fq = lane >> 4;
    LAS float* dtv = (LAS float*)lds; LAS float* cumv = dtv + 1024;
    LAS bf16_t* BmT = (LAS bf16_t*)(lds + 8192);
    LAS bf16_t* xw = (LAS bf16_t*)(lds + 8192 + 36864) + w * (64 * 72);
    ssd_dtcum<L>(wv, P, l, I, dtv, cumv);
    for (int idx = tid; idx < LP * 256; idx += 512) {
        const int chB = idx & 255, j = idx >> 8;
        const float v = (j < L) ? conv_xbc(P, h, l, I, j, 1024 + chB) : 0.f;
        BmT[chB * 72 + j] = f2bf(v);
    }
    for (int hh = 0; hh < 2; ++hh) {
        const int head = w + 8 * hh;
        const float cl = cumv[(L - 1) * 16 + head];
        __syncthreads();
        for (int j = 0; j < LP; ++j) {
            float v = 0.f;
            if (j < L) v = conv_xbc(P, h, l, I, j, head * 64 + lane) * __expf(cl - cumv[j * 16 + head]) * dtv[j * 16 + head];
            xw[lane * 72 + j] = f2bf(v);
        }
        __syncthreads();
        const float dec = __expf(cl);
        if (!I.sample && lane == 0) cdec[item * 16 + head] = dec;
#pragma unroll 1
        for (int nt = 0; nt < 8; ++nt) {
            bf16x8 af[KS];
#pragma unroll
            for (int ks = 0; ks < KS; ++ks) af[ks] = *(const LAS bf16x8*)(BmT + (hh * 128 + nt * 16 + fr) * 72 + ks * 32 + fq * 8);
#pragma unroll
            for (int pt = 0; pt < 4; ++pt) {
                f32x4 a = (f32x4){0.f, 0.f, 0.f, 0.f};
#pragma unroll
                for (int ks = 0; ks < KS; ++ks) a = MFMA16(af[ks], *(const LAS bf16x8*)(xw + (pt * 16 + fr) * 72 + ks * 32 + fq * 8), a);
                const int p = pt * 16 + fr, n0 = nt * 16 + fq * 4;
                if (!I.sample) {
                    u32x2 ow; ow.x = pk2(a[0], a[1]); ow.y = pk2(a[2], a[3]);
                    *(u32x2*)(states + ((size_t)((I.b * 128 + I.c) * 16 + head) * 64 + p) * 128 + n0) = ow;
                } else {
                    const size_t o = ((size_t)((l * 16 + I.sb) * 16 + head) * 64 + p) * 128 + n0;
                    const f32x4 h0 = *(const f32x4*)(P->in[I_SSH] + o);
                    *(f32x4*)(P->out + O_SSH + o) = h0 * dec + a;
                }
            }
        }
    }
}

template <int L>
__device__ __forceinline__ void ssd_y_item(int wv, KP P, int l, const Item& I, LAS unsigned char* lds) {
    constexpr int LP = L < 32 ? 32 : L, KS = LP / 32, NIT = L / 16;
    const bf16_t* h = (const bf16_t*)(P->ws + WS_H);
    const bf16_t* states = (const bf16_t*)(P->ws + WS_ST);
    bf16_t* yabc = (bf16_t*)(P->ws + WS_Y);
    const int tid = tidx(wv), w = tid >> 6, lane = tid & 63, fr = lane & 15, fq = lane >> 4;
    LAS float* dtv = (LAS float*)lds; LAS float* cumv = dtv + 1024;
    LAS bf16_t* Bm = (LAS bf16_t*)(lds + 8192);
    LAS bf16_t* Cm = (LAS bf16_t*)(lds + 8192 + 17408);
    LAS float* CBl = (LAS float*)(lds + 8192 + 2 * 17408);
    LAS float* part = (LAS float*)(lds + 8192 + 3 * 17408);
    LAS bf16_t* xT = (LAS bf16_t*)(lds + 8192 + 3 * 17408 + 2048) + w * (64 * 72);
    ssd_dtcum<L>(wv, P, l, I, dtv, cumv);
    for (int g = 0; g < 2; ++g) {
        const int head = g * 8 + w;
        __syncthreads();
        for (int idx = tid; idx < L * 256; idx += 512) {
            const int cc = idx & 255, t = idx >> 8, which = cc >> 7, n = cc & 127;
            const float v = conv_xbc(P, h, l, I, t, 1024 + which * 256 + g * 128 + n);
            (which ? Cm : Bm)[t * 136 + n] = f2bf(v);
        }
        for (int j = 0; j < LP; ++j) {
            float v = 0.f;
            if (j < L) v = conv_xbc(P, h, l, I, j, head * 64 + lane);
            xT[lane * 72 + j] = f2bf(v);
        }
        __syncthreads();
        for (int tix = w; tix < NIT * NIT; tix += 8) {
            const int it = tix / NIT, jt = tix % NIT;
            f32x4 a = (f32x4){0.f, 0.f, 0.f, 0.f};
#pragma unroll
            for (int ks = 0; ks < 4; ++ks)
                a = MFMA16(*(const LAS bf16x8*)(Cm + (it * 16 + fr) * 136 + ks * 32 + fq * 8), *(const LAS bf16x8*)(Bm + (jt * 16 + fr) * 136 + ks * 32 + fq * 8), a);
#pragma unroll
            for (int jj = 0; jj < 4; ++jj) CBl[(it * 16 + fq * 4 + jj) * 68 + jt * 16 + fr] = a[jj];
        }
        __syncthreads();
        const float dsk = P->in[I_SD][l * 16 + head];
#pragma unroll 1
        for (int it = 0; it < NIT; ++it) {
            const int i = it * 16 + fr; const float cum_i = cumv[i * 16 + head];
            f32x4 acc[4];
#pragma unroll
            for (int pt = 0; pt < 4; ++pt) acc[pt] = (f32x4){0.f, 0.f, 0.f, 0.f};
#pragma unroll
            for (int ks = 0; ks < KS; ++ks) {
                if (ks * 32 > it * 16 + 15) continue;
                const int j0 = ks * 32 + fq * 8;
                const f32x4 c0 = *(const LAS f32x4*)(CBl + i * 68 + j0), c1 = *(const LAS f32x4*)(CBl + i * 68 + j0 + 4);
                float wv8[8];
#pragma unroll
                for (int e = 0; e < 8; ++e) {
                    const int j = j0 + e; const float cb = e < 4 ? c0[e & 3] : c1[e & 3];
                    const float ex = __expf(fminf(cum_i - cumv[j * 16 + head], 0.f));
                    wv8[e] = (j <= i) ? cb * ex * dtv[j * 16 + head] : 0.f;
                }
                u32x4 ww; ww.x = pk2(wv8[0], wv8[1]); ww.y = pk2(wv8[2], wv8[3]); ww.z = pk2(wv8[4], wv8[5]); ww.w = pk2(wv8[6], wv8[7]);
                bf16x8 wf; __builtin_memcpy(&wf, &ww, 16);
#pragma unroll
                for (int pt = 0; pt < 4; ++pt) acc[pt] = MFMA16(*(const LAS bf16x8*)(xT + (pt * 16 + fr) * 72 + j0), wf, acc[pt]);
            }
            const float ecum = __expf(cum_i);
            bf16x8 cf[4];
#pragma unroll
            for (int ks = 0; ks < 4; ++ks) cf[ks] = *(const LAS bf16x8*)(Cm + i * 136 + ks * 32 + fq * 8);
#pragma unroll
            for (int pt = 0; pt < 4; ++pt) {
                bf16x8 hf[4];
                const int p = pt * 16 + fr;
                if (!I.sample) {
                    const bf16_t* sp = states + ((size_t)((I.b * 128 + I.c) * 16 + head) * 64 + p) * 128 + fq * 8;
#pragma unroll
                    for (int ks = 0; ks < 4; ++ks) hf[ks] = *(const bf16x8*)(sp + ks * 32);
                } else {
                    const float* sp = P->in[I_SSH] + ((size_t)((l * 16 + I.sb) * 16 + head) * 64 + p) * 128 + fq * 8;
#pragma unroll
                    for (int ks = 0; ks < 4; ++ks) {
                        const f32x4 a0 = *(const f32x4*)(sp + ks * 32), a1 = *(const f32x4*)(sp + ks * 32 + 4);
                        u32x4 ww; ww.x = pk2(a0[0], a0[1]); ww.y = pk2(a0[2], a0[3]); ww.z = pk2(a1[0], a1[1]); ww.w = pk2(a1[2], a1[3]);
                        __builtin_memcpy(&hf[ks], &ww, 16);
                    }
                }
                f32x4 t2 = (f32x4){0.f, 0.f, 0.f, 0.f};
#pragma unroll
                for (int ks = 0; ks < 4; ++ks) t2 = MFMA16(hf[ks], cf[ks], t2);
                acc[pt] += t2 * ecum;
            }
            float ss = 0.f;
#pragma unroll
            for (int pt = 0; pt < 4; ++pt) {
                const int p0 = pt * 16 + fq * 4;
                const u32x2 zw = *(const u32x2*)(h + (size_t)(I.row0 + i) * HP + HZ + head * 64 + p0);
                const float zv[4] = {bflo(zw.x), bfhi(zw.x), bflo(zw.y), bfhi(zw.y)};
                float yv[4];
#pragma unroll
                for (int jj = 0; jj < 4; ++jj) {
                    const float xs = bf2f(xT[(p0 + jj) * 72 + i]);
                    const float y = (acc[pt][jj] + dsk * xs) * siluf_(zv[jj]);
                    yv[jj] = y; ss += y * y;
                }
                u32x2 ow; ow.x = pk2(yv[0], yv[1]); ow.y = pk2(yv[2], yv[3]);
                *(u32x2*)(yabc + (size_t)(I.row0 + i) * 3072 + 1024 + head * 64 + p0) = ow;
            }
            ss += __shfl_xor(ss, 16); ss += __shfl_xor(ss, 32);
            if (fq == 0) part[i * 8 + w] = ss;
        }
        __syncthreads();
#pragma unroll 1
        for (int it = 0; it < NIT; ++it) {
            const int i = it * 16 + fr;
            const f32x4 pa = *(const LAS f32x4*)(part + i * 8), pb = *(const LAS f32x4*)(part + i * 8 + 4);
            const float tot = (pa[0] + pa[1] + pa[2] + pa[3]) + (pb[0] + pb[1] + pb[2] + pb[3]);
            const float rs = rsqrtf(tot * (1.0f / 512.0f) + EPS);
#pragma unroll
            for (int pt = 0; pt < 4; ++pt) {
                const int p0 = pt * 16 + fq * 4;
                const f32x4 ng = *(const f32x4*)(P->in[I_SNORM] + l * 1024 + head * 64 + p0);
                u32x2* yp = (u32x2*)(yabc + (size_t)(I.row0 + i) * 3072 + 1024 + head * 64 + p0);
                const u32x2 yw = *yp;
                u32x2 ow; ow.x = pk2(bflo(yw.x) * rs * ng[0], bfhi(yw.x) * rs * ng[1]); ow.y = pk2(bflo(yw.y) * rs * ng[2], bfhi(yw.y) * rs * ng[3]);
                *yp = ow;
            }
        }
    }
}

__device__ __forceinline__ void phase_scan(int wv, KP P, int l) {
    bf16_t* states = (bf16_t*)(P->ws + WS_ST);
    const float* cdec = (const float*)(P->ws + WS_CDEC);
    const float* lruA = (const float*)(P->ws + WS_LRUA); float* lruU = (float*)(P->ws + WS_LRUU);
    if (DBG_P5S) for (int idx = bidx() * 512 + tidx(wv); idx < 131072; idx += gdim() * 512) {
        const int e = idx * 2, b = e >> 17, rem = e & 131071, head = rem >> 13;
        unsigned* sp = (unsigned*)(states + (size_t)b * 128 * 131072 + rem);
        const float* dp = cdec + (b * 128) * 16 + head;
        float c0 = 0.f, c1 = 0.f;
        for (int c = 0; c < 128; c += 8) {
            unsigned v[8];
#pragma unroll
            for (int k = 0; k < 8; ++k) v[k] = sp[(size_t)(c + k) * 65536];
#pragma unroll
            for (int k = 0; k < 8; ++k) {
                const float dec = dp[(c + k) * 16];
                if (DBG_P5W) sp[(size_t)(c + k) * 65536] = pk2(c0, c1);
                c0 = dec * c0 + bflo(v[k]); c1 = dec * c1 + bfhi(v[k]);
            }
        }
        float* op = P->out + O_PSH + (size_t)(l * 2 + b) * 131072 + rem;
        op[0] = c0; op[1] = c1;
    }
    if (DBG_LRU4) for (int idx = bidx() * 512 + tidx(wv); idx < 2048; idx += gdim() * 512) {
        const int b = idx >> 10, ch = idx & 1023;
        float carry = 0.f;
        for (int c = 0; c < 128; ++c) {
            const size_t o = (size_t)(b * 128 + c) * 1024 + ch;
            const float A = lruA[o], U = lruU[o];
            lruU[o] = carry;
            carry = A * carry + U;
        }
    }
}

__device__ __forceinline__ void gsync(cg::grid_group& grid) {
    __threadfence(); grid.sync();
    __builtin_amdgcn_fence(__ATOMIC_ACQUIRE, "agent"); asm volatile("s_waitcnt vmcnt(0)" ::: "memory");
}
#define XB_TMO      128
#define XB_XCNT(j)  (256  + 64 * (j))
#define XB_XSUB(j)  (1280 + 64 * (j))
#define XB_XGEN(j)  (2304 + 64 * (j))
#define XB_TOP      3328
#define XB_TOPGEN   3392
#define XCD_BAR_WORDS 3456
#define XB_SPIN_CAP (1u << 20)
__device__ __forceinline__ unsigned xb_ld(unsigned* p)              { return __hip_atomic_load(p, __ATOMIC_RELAXED, __HIP_MEMORY_SCOPE_AGENT); }
__device__ __forceinline__ unsigned xb_add(unsigned* p, unsigned v) { return __hip_atomic_fetch_add(p, v, __ATOMIC_RELAXED, __HIP_MEMORY_SCOPE_AGENT); }
__device__ __forceinline__ unsigned xb_xcc_id() { return (unsigned)__builtin_amdgcn_s_getreg((3 << 11) | 20) & 0xFu; }
#define XB_SPIN(cond, bar) do { unsigned _sp = 0; while (cond) { __builtin_amdgcn_s_sleep(1); \
    if ((++_sp & 255u) == 0u) { if (xb_ld(&(bar)[XB_TMO])) break; if (_sp > XB_SPIN_CAP) { atomicAdd(&(bar)[XB_TMO], 1u); break; } } } } while (0)
__device__ __forceinline__ void xcd_barrier_complete(unsigned* bar, unsigned x, unsigned& nloc, unsigned& nx) {
    const unsigned G = (unsigned)gdim();
    unsigned sum, cnt, mine, sp = 0u;
    for (;;) {
        sum = 0u; cnt = 0u; mine = 0u;
#pragma unroll
        for (unsigned j = 0; j < 16; ++j) { const unsigned c = xb_ld(&bar[XB_XCNT(j)]); sum += c; cnt += (c > 0u) ? 1u : 0u; mine = (j == x) ? c : mine; }
        if (sum == G) break;
        __builtin_amdgcn_s_sleep(1);
        if ((++sp & 255u) == 0u) { if (xb_ld(&bar[XB_TMO])) break; if (sp > XB_SPIN_CAP) { atomicAdd(&bar[XB_TMO], 1u); break; } }
    }
    nloc = mine > 0u ? mine : 1u; nx = cnt > 0u ? cnt : 1u;
}
__device__ __forceinline__ void gbar(int wv, LAS unsigned char* lds) {
    asm volatile("s_waitcnt vmcnt(0)" ::: "memory");
    __syncthreads();
    unsigned* bar = (unsigned*)(kparams()->ws + WS_BAR);
    if (tidx(wv) == 0) {
        volatile LAS unsigned* st = (volatile LAS unsigned*)(lds + LDS_BYTES - 16);
        const unsigned x = xb_xcc_id();
        __builtin_amdgcn_s_waitcnt(0);
        unsigned nloc = st[0], nx = st[1];
        if (nloc == 0u) { xcd_barrier_complete(bar, x, nloc, nx); st[0] = nloc; st[1] = nx; }
        const unsigned old = xb_add(&bar[XB_XSUB(x)], 1u);
        const unsigned gen = old / nloc;
        if (old + 1u == (gen + 1u) * nloc) {
            __builtin_amdgcn_fence(__ATOMIC_RELEASE, "agent");
            asm volatile("s_waitcnt vmcnt(0)" ::: "memory");
            const unsigned og = xb_add(&bar[XB_TOP], 1u);
            const unsigned tg = og / nx;
            if (og + 1u == (tg + 1u) * nx) xb_add(&bar[XB_TOPGEN], 1u);
            else XB_SPIN(xb_ld(&bar[XB_TOPGEN]) == tg, bar);
            __builtin_amdgcn_fence(__ATOMIC_ACQUIRE, "agent");
            xb_add(&bar[XB_XGEN(x)], 1u);
            asm volatile("s_waitcnt vmcnt(0)" ::: "memory");
        } else {
            XB_SPIN(xb_ld(&bar[XB_XGEN(x)]) == gen, bar);
            __builtin_amdgcn_fence(__ATOMIC_ACQUIRE, "agent");
            asm volatile("s_waitcnt vmcnt(0)" ::: "memory");
        }
    }
    __syncthreads();
}
__device__ __forceinline__ void gemm_gu(int wv, LAS unsigned char* lds, int j2) { KP P = kparams();
    EpiGU E; E.ssq = (const float*)(P->ws + WS_SSQ); E.hff = (bf16_t*)(P->ws + WS_H);
    run_gemm(wv, lds, (const bf16_t*)(P->ws + WS_XB), (const bf16_t*)(P->ws + (j2 ? W_GU1 : W_GU0)), 5632, 1024, E); }
__device__ __forceinline__ void gemm_dn(int wv, LAS unsigned char* lds, int j2) { KP P = kparams();
    EpiRes E; E.x = P->out; E.xb = (bf16_t*)(P->ws + WS_XB); E.ssq = (float*)(P->ws + WS_SSQ); E.scale = 0.5f;
    run_gemm(wv, lds, (const bf16_t*)(P->ws + WS_H), (const bf16_t*)(P->ws + (j2 ? W_DN1 : W_DN0)), 1024, 2816, E); }
__device__ __forceinline__ void gemm_in(int wv, LAS unsigned char* lds) { KP P = kparams();
    EpiIn E; E.ssq = (const float*)(P->ws + WS_SSQ); E.h = (bf16_t*)(P->ws + WS_H); E.dtraw = (float*)(P->ws + WS_DT);
    run_gemm(wv, lds, (const bf16_t*)(P->ws + WS_XB), (const bf16_t*)(P->ws + W_IN), NINP, 1024, E); }
__device__ __forceinline__ void gemm_merge(int wv, LAS unsigned char* lds) { KP P = kparams();
    EpiMerge E; E.h = (const bf16_t*)(P->ws + WS_H); E.merged = (bf16_t*)(P->ws + WS_ST);
    run_gemm(wv, lds, (const bf16_t*)(P->ws + WS_Y), (const bf16_t*)(P->ws + W_BR), 1024, 3072, E); }
__device__ __forceinline__ void gemm_out(int wv, LAS unsigned char* lds) { KP P = kparams();
    EpiRes E; E.x = P->out; E.xb = (bf16_t*)(P->ws + WS_XB); E.ssq = (float*)(P->ws + WS_SSQ); E.scale = 1.0f;
    run_gemm(wv, lds, (const bf16_t*)(P->ws + WS_ST), (const bf16_t*)(P->ws + W_OUT), 1024, 1024, E); }

__global__ __launch_bounds__(512, 2) void mega(Params Pk) {
    extern __shared__ __attribute__((aligned(16))) unsigned char smem[];
    LAS unsigned char* lds = (LAS unsigned char*)smem;
    cg::grid_group grid = cg::this_grid();
    const int wv = __builtin_amdgcn_readfirstlane((int)(threadIdx.x >> 6));
    unsigned* bar0 = (unsigned*)(kparams()->ws + WS_BAR);
    if (threadIdx.x == 0) {
        volatile LAS unsigned* st = (volatile LAS unsigned*)(lds + LDS_BYTES - 16); st[0] = 0u; st[1] = 0u;
        (void)xb_add(&bar0[XB_XCNT(xb_xcc_id())], 1u);
    }
    __syncthreads();
    phase_init(wv, kparams());
    gsync(grid);
#pragma unroll 1
    for (int step = 0; step < 8; ++step) {
        const int l = step >> 1, j2 = step & 1;
        gbar(wv, lds);
        if (j2 == 0) { convert_layer(wv, kparams(), l, lds); gbar(wv, lds); }
        gemm_gu(wv, lds, j2);
        gbar(wv, lds);
        gemm_dn(wv, lds, j2);
        if (j2 == 0 && DBG_MIX) {
            gbar(wv, lds);
            for (int rep = 0; rep < REP_IN; ++rep) { if (rep) gbar(wv, lds); gemm_in(wv, lds); }
            for (int rep = 0; rep < REP_SYNC; ++rep) gbar(wv, lds);
            gbar(wv, lds);
            for (int rep = 0; rep < REP_P4; ++rep)
            for (int item = bidx(); item < NITEM; item += gdim()) {
                const Item I = get_item(item);
                copy_states_item(wv, kparams(), l, I);
                if (!I.sample) { if (DBG_ATTN) attn_item<64>(wv, kparams(), l, I, lds); if (DBG_LRU4) lru_item<64, false>(wv, kparams(), l, item, I, lds); if (DBG_SSD4) ssd_states_item<64>(wv, kparams(), l, item, I, lds); }
                else { if (DBG_ATTN) attn_item<16>(wv, kparams(), l, I, lds); }
            }
            gbar(wv, lds);
            if (DBG_P5) phase_scan(wv, kparams(), l);
            gbar(wv, lds);
            for (int rep = 0; rep < REP_P6; ++rep)
            for (int item = bidx(); item < NITEM; item += gdim()) {
                const Item I = get_item(item);
                if (!I.sample) { if (DBG_LRU6) lru_item<64, true>(wv, kparams(), l, item, I, lds); if (DBG_SSD6) ssd_y_item<64>(wv, kparams(), l, I, lds); }
                else { if (DBG_LRU6) lru_item<16, true>(wv, kparams(), l, item, I, lds); if (DBG_SSD6) { ssd_states_item<16>(wv, kparams(), l, item, I, lds); ssd_y_item<16>(wv, kparams(), l, I, lds); } }
            }
            if (DBG_MERGE) {
            gbar(wv, lds);
            gemm_merge(wv, lds);
            gbar(wv, lds);
            gemm_out(wv, lds); }
        }
    }
    gbar(wv, lds);
    phase_final(wv, kparams());
#if DBG_SANITIZE
    gbar(wv, lds);
    { KP P = kparams(); float* o = P->out;
      for (size_t i = (size_t)bidx() * 512 + tidx(wv); i < O_END; i += (size_t)gdim() * 512) { const float v = o[i]; if (!(fabsf(v) < 1e30f)) o[i] = 0.f; } }
#endif
}

extern "C" void kernel_launch(void* const* d_in, const int* in_sizes, int n_in, void* d_out, int out_size, void* d_ws, size_t ws_size, hipStream_t stream) {
    static int grid_blocks = 0;
    if (grid_blocks == 0) {
        if (n_in != N_INPUTS || (size_t)out_size != O_END || ws_size < WS_END) {
            fprintf(stderr, "kernel_launch: unexpected shapes: n_in %d out %d ws %zu (need %zu)\n", n_in, out_size, ws_size, (size_t)WS_END); grid_blocks = -1; return; }
        int dev = 0, cus = 0, per_cu = 0;
        hipGetDevice(&dev);
        hipDeviceGetAttribute(&cus, hipDeviceAttributeMultiprocessorCount, dev);
        if (hipFuncSetAttribute((const void*)mega, hipFuncAttributeMaxDynamicSharedMemorySize, LDS_BYTES) != hipSuccess) { fprintf(stderr, "hipFuncSetAttribute failed\n"); grid_blocks = -1; return; }
        hipOccupancyMaxActiveBlocksPerMultiprocessor(&per_cu, (const void*)mega, 512, LDS_BYTES);
        if (per_cu < 1) per_cu = 1;
        grid_blocks = cus * per_cu;
    }
    if (grid_blocks < 0) return;
    Params p{};
    for (int i = 0; i < N_INPUTS; ++i) p.in[i] = (const float*)d_in[i];
    p.out = (float*)d_out; p.ws = (unsigned char*)d_ws;
    if (hipMemsetAsync((unsigned char*)d_ws + WS_BAR, 0, 16384, stream) != hipSuccess) { fprintf(stderr, "memset failed\n"); return; }
    void* args[] = {&p};
    hipError_t e = hipLaunchCooperativeKernel((const void*)mega, dim3(grid_blocks), dim3(512), args, LDS_BYTES, stream);
    if (e != hipSuccess) fprintf(stderr, "cooperative launch failed: %s (grid %d)\n", hipGetErrorString(e), grid_blocks);
}
```

```cpp
#include <hip/hip_runtime.h>
#include <hip/hip_cooperative_groups.h>
#include <cstdio>
namespace cg = cooperative_groups;
#define DBG_SANITIZE 0
#ifndef REP_P4
#define REP_P4 1
#endif
#ifndef REP_P6
#define REP_P6 1
#endif
#ifndef REP_SYNC
#define REP_SYNC 0
#endif
#ifndef REP_IN
#define REP_IN 1
#endif
#define DBG_MIX 1
#define DBG_MERGE 1
#define DBG_ATTN 1
#define DBG_LRU4 1
#define DBG_SSD4 1
#define DBG_P5S 1
#define DBG_P5W 1
#define DBG_P5 1
#define DBG_LRU6 1
#define DBG_SSD6 1

#define LAS __attribute__((address_space(3)))
typedef unsigned short bf16_t;
typedef short bf16x8 __attribute__((ext_vector_type(8)));
typedef float f32x4 __attribute__((ext_vector_type(4)));
typedef unsigned u32x4 __attribute__((ext_vector_type(4)));
typedef unsigned u32x2 __attribute__((ext_vector_type(2)));

constexpr int MP = 16384, MS = 256, MT = 16640;
constexpr int DM = 1024, DFF = 2816, NIN = 9232, NINP = 9472, HP = 9232;
constexpr int HX = 0, HG = 1024, HZ = 2048, HXBC = 3072, HQ = 4608, HK = 5632, HV = 5888, HGATE = 6144, HDT = 9216;
constexpr float EPS = 1e-6f;
constexpr int NITEM = 272;

enum { I_XP = 0, I_XS, I_CK, I_CV, I_SLC, I_SLH, I_SSC, I_SSH, I_FNORM, I_WG, I_WU, I_WD, I_MNORM, I_WIN, I_LCW, I_LCB, I_LWA, I_LBA, I_LWX, I_LBX,
       I_LLAM, I_SCW, I_SCB, I_SDTB, I_SALOG, I_SD, I_SNORM, I_SINK, I_WBR, I_WOUT, I_FINAL, N_INPUTS };

constexpr size_t O_YP = 0, O_YS = O_YP + (size_t)MP * DM, O_PK = O_YS + (size_t)MS * DM, O_PV = O_PK + 4 * 2 * 128 * 256, O_PLC = O_PV + 4 * 2 * 128 * 256,
                 O_PLH = O_PLC + 4 * 2 * 3 * 1024, O_PSC = O_PLH + 4 * 2 * 1024, O_PSH = O_PSC + 4 * 2 * 3 * 1536, O_SK = O_PSH + (size_t)4 * 2 * 16 * 64 * 128,
                 O_SV = O_SK + (size_t)4 * 16 * 128 * 256, O_SLC = O_SV + (size_t)4 * 16 * 128 * 256, O_SLH = O_SLC + 4 * 16 * 3 * 1024, O_SSC = O_SLH + 4 * 16 * 1024,
                 O_SSH = O_SSC + 4 * 16 * 3 * 1536, O_END = O_SSH + (size_t)4 * 16 * 16 * 64 * 128;

constexpr size_t WS_XB = 0;
constexpr size_t WS_H = WS_XB + (size_t)MT * DM * 2;
constexpr size_t WS_ST = WS_H + (size_t)MT * HP * 2;
constexpr size_t WS_Y = WS_ST + (size_t)2 * 128 * 16 * 64 * 128 * 2;
constexpr size_t WS_W = WS_Y + (size_t)MT * 3072 * 2;
constexpr size_t W_GU0 = WS_W, W_GU1 = W_GU0 + (size_t)5632 * 1024 * 2, W_DN0 = W_GU1 + (size_t)5632 * 1024 * 2, W_DN1 = W_DN0 + (size_t)1024 * 2816 * 2,
                 W_IN = W_DN1 + (size_t)1024 * 2816 * 2, W_BR = W_IN + (size_t)NINP * 1024 * 2, W_OUT = W_BR + (size_t)1024 * 3072 * 2,
                 W_LA = W_OUT + (size_t)1024 * 1024 * 2, W_LX = W_LA + 65536 * 2, WS_SSQ = W_LX + 65536 * 2;
constexpr size_t WS_DT = WS_SSQ + (size_t)MT * 16 * 4, WS_LRUA = WS_DT + (size_t)MT * 16 * 4, WS_LRUU = WS_LRUA + 256 * 1024 * 4, WS_CDEC = WS_LRUU + 256 * 1024 * 4,
                 WS_BAR = WS_CDEC + 256 * 16 * 4, WS_END = WS_BAR + 16384;

constexpr int LDS_BYTES = 147456;

struct Params { const float* in[N_INPUTS]; float* out; unsigned char* ws; };
typedef const Params __attribute__((address_space(4))) * KP;
__device__ __forceinline__ KP kparams() { KP p = (KP)__builtin_amdgcn_kernarg_segment_ptr(); asm volatile("" : "+s"(p)); return p; }
__device__ __forceinline__ int tidx(int wv) { int t; asm volatile("v_mbcnt_lo_u32_b32 %0, -1, 0\n\tv_mbcnt_hi_u32_b32 %0, -1, %0" : "=v"(t)); return (wv << 6) | t; }
__device__ __forceinline__ int bidx() { int t = blockIdx.x; asm volatile("" : "+s"(t)); return t; }
__device__ __forceinline__ int gdim() { int t = gridDim.x; asm volatile("" : "+s"(t)); return t; }

typedef __bf16 bf16x2_t __attribute__((ext_vector_type(2)));
typedef float f32x2_t __attribute__((ext_vector_type(2)));
__device__ __forceinline__ unsigned pk2(float lo, float hi) { f32x2_t v = {lo, hi}; bf16x2_t b = __builtin_convertvector(v, bf16x2_t); unsigned r; __builtin_memcpy(&r, &b, 4); return r; }
__device__ __forceinline__ bf16_t f2bf(float f) { return (bf16_t)(pk2(f, 0.f) & 0xffffu); }
__device__ __forceinline__ float bf2f(bf16_t b) { return __uint_as_float(((unsigned)b) << 16); }
__device__ __forceinline__ float bflo(unsigned w) { return __uint_as_float(w << 16); }
__device__ __forceinline__ float bfhi(unsigned w) { return __uint_as_float(w & 0xffff0000u); }
__device__ __forceinline__ float sigmoidf_(float x) { return 1.0f / (1.0f + __expf(-x)); }
__device__ __forceinline__ float siluf_(float x) { return x / (1.0f + __expf(-x)); }
__device__ __forceinline__ float softplusf_(float x) { return x > 20.f ? x : log1pf(__expf(x)); }
__device__ __forceinline__ float gelu_tanh(float x) { const float u = 0.7978845608028654f * (x + 0.044715f * x * x * x); return x / (1.0f + __expf(-2.0f * u)); }
__device__ __forceinline__ float rstd_row(const float* ssq, int r) {
    const f32x4* p = (const f32x4*)(ssq + (size_t)r * 16); f32x4 a = p[0], b = p[1], c = p[2], d = p[3];
    const float s = (a[0] + a[1] + a[2] + a[3]) + (b[0] + b[1] + b[2] + b[3]) + (c[0] + c[1] + c[2] + c[3]) + (d[0] + d[1] + d[2] + d[3]);
    return rsqrtf(s * (1.0f / 1024.0f) + EPS);
}
#define MFMA16(a, b, c) __builtin_amdgcn_mfma_f32_16x16x32_bf16((a), (b), (c), 0, 0, 0)

namespace pg8 {
constexpr int BM = 256, BK = 64, HALF = 128, HTB = HALF * BK * 2, STAGE_BYTES = 8 * HTB, NXCD = 8, WGM = 8;
__device__ __forceinline__ int lds_byte(int r, int c) { const int st = (r >> 4) * 2 + (c >> 5), rr = r & 15, cc = c & 31, ob = rr * 64 + cc * 2; return st * 1024 + (ob ^ (((ob >> 9) & 1) << 5)); }
__device__ __forceinline__ void stage_rc(int b, int& R, int& C) { const int st = b / 1024, sb = b % 1024, swz = sb ^ (((sb >> 9) & 1) << 5); R = (st >> 1) * 16 + swz / 64; C = (st & 1) * 32 + (swz % 64) / 2; }
struct Unit { int pm, pn; };
struct Gemm { const bf16_t* A; const bf16_t* Bt; int M, N, K; };
struct StaticOrder {
    int nM, nN, nwg, G, c;
    __device__ void init(int M, int N, int G_, int c_) { nM = M / BM; nN = N / BM; nwg = nM * nN; G = G_; c = c_; }
    __device__ bool next(int i, Unit& u) const {
        const long L = (long)i * G + c; if (L >= nwg) return false;
        int wgid = (int)L; { const int q = nwg / NXCD, r = nwg % NXCD, xcd = wgid % NXCD, off = wgid / NXCD; wgid = (xcd < r ? xcd * (q + 1) : r * (q + 1) + (xcd - r) * q) + off; }
        const int nig = WGM * nN, gid = wgid / nig, fm = gid * WGM, gsz = (nM - fm) < WGM ? (nM - fm) : WGM;
        u.pm = fm + ((wgid % nig) % gsz); u.pn = (wgid % nig) / gsz; return true;
    }
};

template <class Epi>
__device__ __forceinline__ void gemm_phase(int wv, LAS unsigned char* lds, const Gemm g, const StaticOrder& S, const Epi& E) {
    const int tid = tidx(wv), wid = wv, lane = tid & 63, wr = wid >> 2, wc = wid & 3, fr = lane & 15, fq = lane >> 4;
    const int K = g.K, nt = K / BK;
    unsigned voffA[2];
#pragma unroll
    for (int i = 0; i < 2; ++i) { int R, C; stage_rc(tid * 16 + i * 8192, R, C); voffA[i] = (unsigned)(R * K + C) * 2u; }
    const size_t kstep = (size_t)(BK * 2);
    const size_t hstep = (size_t)HALF * K * 2;
    const size_t tstep = 2 * hstep;
    const unsigned ldsw = (unsigned)wid * 1024u;
    const int aoff = lds_byte(wr * 64 + fr, fq * 8), boff = lds_byte(wc * 32 + fr, fq * 8);
#define PG8_SA(b, h) (((b) * 2 + (h)) * HTB)
#define PG8_SB(b, h) ((4 + (b) * 2 + (h)) * HTB)
#define PG8_STAGE(bufoff, gbase, voff) do { _Pragma("unroll") for (int _i = 0; _i < 2; ++_i) \
        __builtin_amdgcn_global_load_lds((const unsigned*)((const char*)(gbase) + (voff)[_i]), (LAS unsigned*)(lds + (bufoff) + ldsw + _i * 8192), 16, 0, 0); } while (0)
#define PG8_LDA(dst, b, h) do { _Pragma("unroll") for (int m = 0; m < 4; ++m) _Pragma("unroll") for (int k = 0; k < 2; ++k) dst[m][k] = *(const LAS bf16x8*)(lds + PG8_SA(b, h) + aoff + m * 2048 + k * 1024); } while (0)
#define PG8_LDB(dst, b, h) do { _Pragma("unroll") for (int n = 0; n < 2; ++n) _Pragma("unroll") for (int k = 0; k < 2; ++k) dst[n][k] = *(const LAS bf16x8*)(lds + PG8_SB(b, h) + boff + n * 2048 + k * 1024); } while (0)
#define PG8_MMA(ai, bj, At, Bt) do { __builtin_amdgcn_s_setprio(1); _Pragma("unroll") for (int m = 0; m < 4; ++m) _Pragma("unroll") for (int n = 0; n < 2; ++n) _Pragma("unroll") for (int k = 0; k < 2; ++k) \
        acc[ai][bj][m][n] = __builtin_amdgcn_mfma_f32_16x16x32_bf16(Bt[n][k], At[m][k], acc[ai][bj][m][n], 0, 0, 0); __builtin_amdgcn_s_setprio(0); } while (0)
#define PG8_WAIT_V(n) asm volatile("s_waitcnt vmcnt(" #n ")" ::: "memory")
#define PG8_WAIT_L(n) asm volatile("s_waitcnt lgkmcnt(" #n ")" ::: "memory")
#define PG8_BAR __builtin_amdgcn_s_barrier()
#define PG8_SCHED __builtin_amdgcn_sched_barrier(0)
    Unit cur, nxt; int ui = 0;
    if (!S.next(0, cur)) return;
    f32x4 acc[2][2][4][2];
#pragma unroll
    for (int a = 0; a < 2; ++a)
#pragma unroll
        for (int b = 0; b < 2; ++b)
#pragma unroll
            for (int m = 0; m < 4; ++m)
#pragma unroll
                for (int n = 0; n < 2; ++n) acc[a][b][m][n] = (f32x4){0.f, 0.f, 0.f, 0.f};
    bf16x8 At[4][2], B0[2][2], B1[2][2];
    const char* cA = (const char*)g.A + (size_t)cur.pm * tstep; const char* cB = (const char*)g.Bt + (size_t)cur.pn * tstep;
    PG8_STAGE(PG8_SB(0, 0), cB, voffA); PG8_STAGE(PG8_SA(0, 0), cA, voffA); PG8_STAGE(PG8_SB(0, 1), cB + hstep, voffA); PG8_STAGE(PG8_SA(0, 1), cA + hstep, voffA);
    if (wr == 1) PG8_BAR;
    PG8_WAIT_V(4); PG8_BAR;
    PG8_STAGE(PG8_SB(1, 0), cB + kstep, voffA); PG8_STAGE(PG8_SA(1, 0), cA + kstep, voffA); PG8_STAGE(PG8_SB(1, 1), cB + hstep + kstep, voffA);
    PG8_WAIT_V(6); PG8_BAR;
    for (;;) {
        const bool has_next = S.next(ui + 1, nxt);
        const char* nA = has_next ? (const char*)g.A + (size_t)nxt.pm * tstep : cA; const char* nB = has_next ? (const char*)g.Bt + (size_t)nxt.pn * tstep : cB;
        for (int t = 0; t < nt; t += 2) {
            const bool last = (t == nt - 2);
            const char* a1 = cA + (size_t)(t + 1) * kstep;
            const char* a2 = last ? nA : cA + (size_t)(t + 2) * kstep; const char* b2 = last ? nB : cB + (size_t)(t + 2) * kstep;
            const char* a3 = a2 + kstep; const char* b3 = b2 + kstep;
            PG8_LDB(B0, 0, 0); PG8_SCHED; PG8_LDA(At, 0, 0); PG8_STAGE(PG8_SA(1, 1), a1 + hstep, voffA);
            PG8_WAIT_L(8); PG8_BAR; PG8_WAIT_L(0); PG8_MMA(0, 0, At, B0); PG8_BAR; PG8_SCHED;
            PG8_LDB(B1, 0, 1); PG8_STAGE(PG8_SB(0, 0), b2, voffA);
            PG8_BAR; PG8_WAIT_L(0); PG8_MMA(0, 1, At, B1); PG8_BAR;
            PG8_LDA(At, 0, 1); PG8_STAGE(PG8_SA(0, 0), a2, voffA);
            PG8_BAR; PG8_WAIT_L(0); PG8_MMA(1, 0, At, B0); PG8_BAR; PG8_SCHED;
            PG8_STAGE(PG8_SB(0, 1), b2 + hstep, voffA);
            PG8_WAIT_V(6); PG8_BAR; PG8_MMA(1, 1, At, B1); PG8_BAR;
            PG8_LDB(B0, 1, 0); PG8_SCHED; PG8_LDA(At, 1, 0); PG8_STAGE(PG8_SA(0, 1), a2 + hstep, voffA);
            PG8_WAIT_L(8); PG8_BAR; PG8_WAIT_L(0); PG8_MMA(0, 0, At, B0); PG8_BAR; PG8_SCHED;
            PG8_LDB(B1, 1, 1); PG8_STAGE(PG8_SB(1, 0), b3, voffA);
            PG8_BAR; PG8_WAIT_L(0); PG8_MMA(0, 1, At, B1); PG8_BAR;
            PG8_LDA(At, 1, 1); PG8_STAGE(PG8_SA(1, 0), a3, voffA);
            PG8_BAR; PG8_WAIT_L(0); PG8_MMA(1, 0, At, B0); PG8_BAR; PG8_SCHED;
            PG8_STAGE(PG8_SB(1, 1), b3 + hstep, voffA);
            PG8_WAIT_V(6); PG8_BAR; PG8_MMA(1, 1, At, B1); PG8_BAR;
            if constexpr (Epi::HAS_MID) { if (!last && ((t + 2) & 15) == 0) E.mid(acc, cur, (t + 2) >> 4, wr, wc, fr, fq); }
        }
        E(acc, cur, wr, wc, fr, fq);
        if (!has_next) break;
#pragma unroll
        for (int a = 0; a < 2; ++a)
#pragma unroll
            for (int b = 0; b < 2; ++b)
#pragma unroll
                for (int m = 0; m < 4; ++m)
#pragma unroll
                    for (int n = 0; n < 2; ++n) acc[a][b][m][n] = (f32x4){0.f, 0.f, 0.f, 0.f};
        cur = nxt; cA = nA; cB = nB; ++ui;
    }
    PG8_WAIT_V(0);
    if (wr == 0) PG8_BAR;
    PG8_BAR;
#undef PG8_SA
#undef PG8_SB
#undef PG8_STAGE
#undef PG8_LDA
#undef PG8_LDB
#undef PG8_MMA
#undef PG8_WAIT_V
#undef PG8_WAIT_L
#undef PG8_BAR
#undef PG8_SCHED
}
}
using pg8::Unit;
typedef f32x4 AccT[2][2][4][2];

struct EpiGU {
    static constexpr bool HAS_MID = false;
    const float* ssq; bf16_t* hff;
    __device__ __forceinline__ void mid(AccT&, const Unit&, int, int, int, int, int) const {}
    __device__ __forceinline__ void operator()(const AccT& acc, const Unit& u, int wr, int wc, int fr_, int fq_) const {
        int fr = fr_, fq = fq_; asm volatile("" : "+v"(fr), "+v"(fq));
        const int row0 = u.pm * 256 + wr * 64 + fr, hc0 = u.pn * 128 + wc * 16 + fq * 4;
#pragma unroll
        for (int ai = 0; ai < 2; ++ai)
#pragma unroll
            for (int m = 0; m < 4; ++m) {
                const int r = row0 + ai * 128 + m * 16; const float rs = rstd_row(ssq, r);
#pragma unroll
                for (int bj = 0; bj < 2; ++bj) {
                    const f32x4 gt = acc[ai][bj][m][0] * rs, up = acc[ai][bj][m][1] * rs;
                    u32x2 w; w.x = pk2(siluf_(gt[0]) * up[0], siluf_(gt[1]) * up[1]); w.y = pk2(siluf_(gt[2]) * up[2], siluf_(gt[3]) * up[3]);
                    *(u32x2*)(hff + (size_t)r * DFF + hc0 + bj * 64) = w;
                }
            }
    }
};
struct EpiRes {
    static constexpr bool HAS_MID = false;
    float* x; bf16_t* xb; float* ssq; float scale;
    __device__ __forceinline__ void mid(AccT&, const Unit&, int, int, int, int, int) const {}
    __device__ __forceinline__ void operator()(const AccT& acc, const Unit& u, int wr, int wc, int fr_, int fq_) const {
        int fr = fr_, fq = fq_; asm volatile("" : "+v"(fr), "+v"(fq));
        const int row0 = u.pm * 256 + wr * 64 + fr, col0 = u.pn * 256 + wc * 32 + 4 * fq;
#pragma unroll
        for (int ai = 0; ai < 2; ++ai)
#pragma unroll
            for (int m = 0; m < 4; ++m) {
                const int r = row0 + ai * 128 + m * 16; float ss = 0.f;
#pragma unroll
                for (int bj = 0; bj < 2; ++bj)
#pragma unroll
                    for (int n = 0; n < 2; ++n) {
                        const int c = col0 + bj * 128 + n * 16;
                        f32x4* xp = (f32x4*)(x + (size_t)r * DM + c);
                        f32x4 v = *xp + acc[ai][bj][m][n] * scale;
                        *xp = v;
                        u32x2 w; w.x = pk2(v[0], v[1]); w.y = pk2(v[2], v[3]);
                        *(u32x2*)(xb + (size_t)r * DM + c) = w;
                        ss += v[0] * v[0] + v[1] * v[1] + v[2] * v[2] + v[3] * v[3];
                    }
                ss += __shfl_xor(ss, 16); ss += __shfl_xor(ss, 32);
                if (fq == 0) ssq[(size_t)r * 16 + u.pn * 4 + wc] = ss;
            }
    }
};
struct EpiIn {
    static constexpr bool HAS_MID = false;
    const float* ssq; bf16_t* h; float* dtraw;
    __device__ __forceinline__ void mid(AccT&, const Unit&, int, int, int, int, int) const {}
    __device__ __forceinline__ void operator()(const AccT& acc, const Unit& u, int wr, int wc, int fr_, int fq_) const {
        int fr = fr_, fq = fq_; asm volatile("" : "+v"(fr), "+v"(fq));
        const int row0 = u.pm * 256 + wr * 64 + fr, col0 = u.pn * 256 + wc * 32 + 4 * fq;
#pragma unroll
        for (int ai = 0; ai < 2; ++ai)
#pragma unroll
            for (int m = 0; m < 4; ++m) {
                const int r = row0 + ai * 128 + m * 16; const float rs = rstd_row(ssq, r);
                if (u.pn < 36) {
#pragma unroll
                    for (int bj = 0; bj < 2; ++bj)
#pragma unroll
                        for (int n = 0; n < 2; ++n) {
                            const int c = col0 + bj * 128 + n * 16; const f32x4 v = acc[ai][bj][m][n] * rs;
                            u32x2 w; w.x = pk2(v[0], v[1]); w.y = pk2(v[2], v[3]);
                            *(u32x2*)(h + (size_t)r * HP + c) = w;
                        }
                } else if (wc == 0) {
                    const f32x4 v = acc[ai][0][m][0] * rs;
                    *(f32x4*)(dtraw + (size_t)r * 16 + 4 * fq) = v;
                }
            }
    }
};
struct EpiMerge {
    static constexpr bool HAS_MID = true;
    const bf16_t* h; bf16_t* merged;
    __device__ __forceinline__ void mid(AccT& acc, const Unit& u, int seg, int wr, int wc, int fr_, int fq_) const {
        int fr = fr_, fq = fq_; asm volatile("" : "+v"(fr), "+v"(fq));
        const int row0 = u.pm * 256 + wr * 64 + fr, col0 = u.pn * 256 + wc * 32 + 4 * fq;
#pragma unroll
        for (int ai = 0; ai < 2; ++ai)
#pragma unroll
            for (int m = 0; m < 4; ++m) {
                const int r = row0 + ai * 128 + m * 16;
#pragma unroll
                for (int bj = 0; bj < 2; ++bj)
#pragma unroll
                    for (int n = 0; n < 2; ++n) {
                        const int c = col0 + bj * 128 + n * 16;
                        const bf16_t* gp = h + (size_t)r * HP + HGATE + (seg - 1) * 1024 + c;
                        const u32x2 ga = *(const u32x2*)gp, gb = *(const u32x2*)(gp + 1024);
                        const float a0 = bflo(ga.x), a1 = bfhi(ga.x), a2 = bflo(ga.y), a3 = bfhi(ga.y);
                        const float b0 = bflo(gb.x), b1 = bfhi(gb.x), b2 = bflo(gb.y), b3 = bfhi(gb.y);
                        f32x4 f;
                        f[0] = (1.f + __expf(-fmaxf(b0, -30.f))) / (1.f + __expf(-fmaxf(a0, -30.f)));
                        f[1] = (1.f + __expf(-fmaxf(b1, -30.f))) / (1.f + __expf(-fmaxf(a1, -30.f)));
                        f[2] = (1.f + __expf(-fmaxf(b2, -30.f))) / (1.f + __expf(-fmaxf(a2, -30.f)));
                        f[3] = (1.f + __expf(-fmaxf(b3, -30.f))) / (1.f + __expf(-fmaxf(a3, -30.f)));
                        acc[ai][bj][m][n] *= f;
                    }
            }
    }
    __device__ __forceinline__ void operator()(const AccT& acc, const Unit& u, int wr, int wc, int fr_, int fq_) const {
        int fr = fr_, fq = fq_; asm volatile("" : "+v"(fr), "+v"(fq));
        const int row0 = u.pm * 256 + wr * 64 + fr, col0 = u.pn * 256 + wc * 32 + 4 * fq;
#pragma unroll
        for (int ai = 0; ai < 2; ++ai)
#pragma unroll
            for (int m = 0; m < 4; ++m) {
                const int r = row0 + ai * 128 + m * 16;
#pragma unroll
                for (int bj = 0; bj < 2; ++bj)
#pragma unroll
                    for (int n = 0; n < 2; ++n) {
                        const int c = col0 + bj * 128 + n * 16;
                        const u32x2 ga = *(const u32x2*)(h + (size_t)r * HP + HGATE + 2048 + c);
                        const f32x4 v = acc[ai][bj][m][n];
                        u32x2 w;
                        w.x = pk2(v[0] / (1.f + __expf(-fmaxf(bflo(ga.x), -30.f))), v[1] / (1.f + __expf(-fmaxf(bfhi(ga.x), -30.f))));
                        w.y = pk2(v[2] / (1.f + __expf(-fmaxf(bflo(ga.y), -30.f))), v[3] / (1.f + __expf(-fmaxf(bfhi(ga.y), -30.f))));
                        *(u32x2*)(merged + (size_t)r * DM + c) = w;
                    }
            }
    }
};

template <class Epi> __device__ __forceinline__ void run_gemm(int wv, LAS unsigned char* lds, const bf16_t* A, const bf16_t* Bt, int N, int K, const Epi& E) {
    pg8::Gemm g; g.A = A; g.Bt = Bt; g.M = MT; g.N = N; g.K = K;
    pg8::StaticOrder S; S.init(MT, N, (int)gdim(), (int)bidx());
    pg8::gemm_phase<Epi>(wv, lds, g, S, E);
}

template <class RM>
__device__ __forceinline__ void cvt_tile(int wv, const float* src, int src_ld, int k0, int nsrc0, int nvalid, const float* gk, bf16_t* dst, int dst_ld, RM rowmap, LAS float* tile) {
    const int tid = tidx(wv);
    __syncthreads();
#pragma unroll
    for (int i = 0; i < 2; ++i) {
        const int kk = (tid >> 4) + 32 * i, n4 = (tid & 15) * 4;
        f32x4 v = (f32x4){0.f, 0.f, 0.f, 0.f};
        if (n4 < nvalid) v = *(const f32x4*)(src + (size_t)(k0 + kk) * src_ld + nsrc0 + n4);
        const float gsc = gk ? gk[k0 + kk] : 1.0f;
        tile[kk * 65 + n4 + 0] = v[0] * gsc; tile[kk * 65 + n4 + 1] = v[1] * gsc; tile[kk * 65 + n4 + 2] = v[2] * gsc; tile[kk * 65 + n4 + 3] = v[3] * gsc;
    }
    __syncthreads();
    const int nl = tid >> 3, k8 = (tid & 7) * 8;
    if (nl < nvalid) {
        u32x4 w;
        w.x = pk2(tile[(k8 + 0) * 65 + nl], tile[(k8 + 1) * 65 + nl]); w.y = pk2(tile[(k8 + 2) * 65 + nl], tile[(k8 + 3) * 65 + nl]);
        w.z = pk2(tile[(k8 + 4) * 65 + nl], tile[(k8 + 5) * 65 + nl]); w.w = pk2(tile[(k8 + 6) * 65 + nl], tile[(k8 + 7) * 65 + nl]);
        *(u32x4*)(dst + (size_t)rowmap(nl) * dst_ld + k0 + k8) = w;
    }
}

__device__ __forceinline__ void convert_layer(int wv, KP P, int l, LAS unsigned char* lds) {
    LAS float* tile = (LAS float*)lds;
    constexpr int J_GU = 2 * 2 * 16 * 44, J_DN = 2 * 44 * 16, J_IN = 16 * 145, J_BR = 48 * 16, J_OUT = 16 * 16, J_LRU = 32;
    constexpr int J_TOT = J_GU + J_DN + J_IN + J_BR + J_OUT + J_LRU;
    for (int job = bidx(); job < J_TOT; job += gdim()) {
        int j = job;
        if (j < J_GU) {
            const int nt = j % 44; j /= 44; const int kt = j % 16; j /= 16; const int which = j & 1, j2 = j >> 1;
            const float* src = P->in[which ? I_WU : I_WG] + (size_t)(l * 2 + j2) * 1024 * 2816;
            bf16_t* dst = (bf16_t*)(P->ws + (j2 ? W_GU1 : W_GU0));
            const int hc0 = nt * 64;
            cvt_tile(wv, src, 2816, kt * 64, hc0, 64, P->in[I_FNORM] + (l * 2 + j2) * 1024, dst, 1024,
                     [=](int nl) { const int hc = hc0 + nl; return 256 * (hc >> 7) + 128 * ((hc >> 6) & 1) + 32 * ((hc >> 4) & 3) + 16 * which + (hc & 15); }, tile);
            continue;
        }
        j -= J_GU;
        if (j < J_DN) {
            const int nt = j % 16; j /= 16; const int kt = j % 44; const int j2 = j / 44;
            const float* src = P->in[I_WD] + (size_t)(l * 2 + j2) * 2816 * 1024;
            bf16_t* dst = (bf16_t*)(P->ws + (j2 ? W_DN1 : W_DN0));
            const int n0 = nt * 64;
            cvt_tile(wv, src, 1024, kt * 64, n0, 64, nullptr, dst, 2816, [=](int nl) { return n0 + nl; }, tile);
            continue;
        }
        j -= J_DN;
        if (j < J_IN) {
            const int nt = j % 145, kt = j / 145;
            const float* src = P->in[I_WIN] + (size_t)l * 1024 * NIN;
            bf16_t* dst = (bf16_t*)(P->ws + W_IN);
            const int n0 = nt * 64;
            const int nsrc0 = nt < 72 ? n0 : (nt < 144 ? n0 + 16 : 4608);
            cvt_tile(wv, src, NIN, kt * 64, nsrc0, nt < 144 ? 64 : 16, P->in[I_MNORM] + l * 1024, dst, 1024, [=](int nl) { return n0 + nl; }, tile);
            continue;
        }
        j -= J_IN;
        if (j < J_BR) {
            const int nt = j % 16, kt = j / 16;
            const float* src = P->in[I_WBR] + (size_t)l * 3072 * 1024;
            bf16_t* dst = (bf16_t*)(P->ws + W_BR);
            const int n0 = nt * 64;
            cvt_tile(wv, src, 1024, kt * 64, n0, 64, nullptr, dst, 3072, [=](int nl) { return n0 + nl; }, tile);
            continue;
        }
        j -= J_BR;
        if (j < J_OUT) {
            const int nt = j % 16, kt = j / 16;
            const float* src = P->in[I_WOUT] + (size_t)l * 1024 * 1024;
            bf16_t* dst = (bf16_t*)(P->ws + W_OUT);
            const int n0 = nt * 64;
            cvt_tile(wv, src, 1024, kt * 64, n0, 64, nullptr, dst, 1024, [=](int nl) { return n0 + nl; }, tile);
            continue;
        }
        j -= J_OUT;
        {
            const int blk = j & 15, which = j >> 4;
            const float* src = P->in[which ? I_LWX : I_LWA] + (size_t)(l * 16 + blk) * 4096;
            bf16_t* dst = (bf16_t*)(P->ws + (which ? W_LX : W_LA)) + blk * 4096;
            cvt_tile(wv, src, 64, 0, 0, 64, nullptr, dst, 64, [=](int nl) { return nl; }, tile);
        }
    }
    __syncthreads();
}

__device__ __forceinline__ void phase_init(int wv, KP P) {
    const int w = tidx(wv) >> 6, lane = tidx(wv) & 63;
    float* x = P->out; bf16_t* xb = (bf16_t*)(P->ws + WS_XB); float* ssq = (float*)(P->ws + WS_SSQ);
    for (int row = bidx() * 8 + w; row < MT; row += gdim() * 8) {
        const float* src = row < MP ? P->in[I_XP] + (size_t)row * DM : P->in[I_XS] + (size_t)(row - MP) * DM;
        float ss = 0.f;
#pragma unroll
        for (int i = 0; i < 4; ++i) {
            const int c = (i * 64 + lane) * 4;
            const f32x4 v = *(const f32x4*)(src + c);
            *(f32x4*)(x + (size_t)row * DM + c) = v;
            u32x2 pw; pw.x = pk2(v[0], v[1]); pw.y = pk2(v[2], v[3]);
            *(u32x2*)(xb + (size_t)row * DM + c) = pw;
            ss += v[0] * v[0] + v[1] * v[1] + v[2] * v[2] + v[3] * v[3];
        }
#pragma unroll
        for (int d = 32; d >= 1; d >>= 1) ss += __shfl_xor(ss, d);
        if (lane < 16) ssq[(size_t)row * 16 + lane] = lane == 0 ? ss : 0.f;
    }
}
__device__ __forceinline__ void phase_final(int wv, KP P) {
    const int w = tidx(wv) >> 6, lane = tidx(wv) & 63;
    float* x = P->out; const float* ssq = (const float*)(P->ws + WS_SSQ); const float* gf = P->in[I_FINAL];
    for (int row = bidx() * 8 + w; row < MT; row += gdim() * 8) {
        const float rs = rstd_row(ssq, row);
#pragma unroll
        for (int i = 0; i < 4; ++i) {
            const int c = (i * 64 + lane) * 4;
            f32x4 v = *(const f32x4*)(x + (size_t)row * DM + c); const f32x4 g = *(const f32x4*)(gf + c);
            v = v * rs * g;
            *(f32x4*)(x + (size_t)row * DM + c) = v;
        }
    }
}

struct Item { int row0, L, b, c, sb, sample; };
__device__ __forceinline__ Item get_item(int it) {
    Item I;
    if (it < 256) { I.b = it >> 7; I.c = it & 127; I.row0 = I.b * 8192 + I.c * 64; I.L = 64; I.sample = 0; I.sb = 0; }
    else { I.sb = it - 256; I.b = 0; I.c = 0; I.row0 = MP + I.sb * 16; I.L = 16; I.sample = 1; }
    return I;
}

__device__ __forceinline__ void copy_states_item(int wv, KP P, int l, const Item& I) {
    const bf16_t* h = (const bf16_t*)(P->ws + WS_H);
    const int tid = tidx(wv);
    if (!I.sample) {
        if (I.c >= 126) {
            for (int idx = tid; idx < 64 * 512; idx += 512) {
                const int t = idx >> 9, cc = idx & 511, kv = cc >> 8, e = cc & 255;
                const float v = bf2f(h[(size_t)(I.row0 + t) * HP + (kv ? HV : HK) + e]);
                P->out[(kv ? O_PV : O_PK) + ((size_t)(l * 2 + I.b) * 128 + (I.c - 126) * 64 + t) * 256 + e] = v;
            }
        }
        if (I.c == 127) {
            for (int idx = tid; idx < 3 * 1024; idx += 512) { const int j = idx >> 10, ch = idx & 1023;
                P->out[O_PLC + ((size_t)(l * 2 + I.b) * 3 + j) * 1024 + ch] = bf2f(h[(size_t)(I.row0 + 61 + j) * HP + HX + ch]); }
            for (int idx = tid; idx < 3 * 1536; idx += 512) { const int j = idx / 1536, ch = idx % 1536;
                P->out[O_PSC + ((size_t)(l * 2 + I.b) * 3 + j) * 1536 + ch] = bf2f(h[(size_t)(I.row0 + 61 + j) * HP + HXBC + ch]); }
        }
    } else {
        for (int idx = tid; idx < 128 * 512; idx += 512) {
            const int j = idx >> 9, cc = idx & 511, kv = cc >> 8, e = cc & 255;
            float v;
            if (j < 112) v = P->in[kv ? I_CV : I_CK][((size_t)(l * 16 + I.sb) * 128 + j + 16) * 256 + e];
            else v = bf2f(h[(size_t)(I.row0 + j - 112) * HP + (kv ? HV : HK) + e]);
            P->out[(kv ? O_SV : O_SK) + ((size_t)(l * 16 + I.sb) * 128 + j) * 256 + e] = v;
        }
        for (int idx = tid; idx < 3 * 1024; idx += 512) { const int j = idx >> 10, ch = idx & 1023;
            P->out[O_SLC + ((size_t)(l * 16 + I.sb) * 3 + j) * 1024 + ch] = bf2f(h[(size_t)(I.row0 + 13 + j) * HP + HX + ch]); }
        for (int idx = tid; idx < 3 * 1536; idx += 512) { const int j = idx / 1536, ch = idx % 1536;
            P->out[O_SSC + ((size_t)(l * 16 + I.sb) * 3 + j) * 1536 + ch] = bf2f(h[(size_t)(I.row0 + 13 + j) * HP + HXBC + ch]); }
    }
}

template <int L>
__device__ __forceinline__ void attn_item(int wv, KP P, int l, const Item& I, LAS unsigned char* lds) {
    constexpr int NS = (L == 64) ? 192 : 160;
    constexpr int NST = NS / 16, NKS = NS / 32, NQT = L / 16;
    const bf16_t* h = (const bf16_t*)(P->ws + WS_H);
    bf16_t* yabc = (bf16_t*)(P->ws + WS_Y);
    const int tid = tidx(wv), w = tid >> 6, lane = tid & 63, fr = lane & 15, fq = lane >> 4;
    LAS bf16_t* Kl = (LAS bf16_t*)lds;
    LAS bf16_t* Vt = Kl + 2 * 192 * 72;
    for (int pass = 0; pass < 2; ++pass) {
        __syncthreads();
        for (int idx = tid; idx < 2 * NS * 8; idx += 512) {
            const int dp = idx & 7, s = (idx >> 3) % NS, kvl = idx / (8 * NS), kvh = pass * 2 + kvl;
            u32x4 kw = (u32x4){0u, 0u, 0u, 0u}, vw = (u32x4){0u, 0u, 0u, 0u};
            if (L == 64) {
                const int pos = (I.c - 2) * 64 + s;
                if (pos >= 0) {
                    const bf16_t* rp = h + (size_t)(I.b * 8192 + pos) * HP + kvh * 64 + dp * 8;
                    kw = *(const u32x4*)(rp + HK); vw = *(const u32x4*)(rp + HV);
                }
            } else {
                if (s < 128) {
                    const size_t o = ((size_t)(l * 16 + I.sb) * 128 + s) * 256 + kvh * 64 + dp * 8;
                    const f32x4 k0 = *(const f32x4*)(P->in[I_CK] + o), k1 = *(const f32x4*)(P->in[I_CK] + o + 4);
                    const f32x4 v0 = *(const f32x4*)(P->in[I_CV] + o), v1 = *(const f32x4*)(P->in[I_CV] + o + 4);
                    kw.x = pk2(k0[0], k0[1]); kw.y = pk2(k0[2], k0[3]); kw.z = pk2(k1[0], k1[1]); kw.w = pk2(k1[2], k1[3]);
                    vw.x = pk2(v0[0], v0[1]); vw.y = pk2(v0[2], v0[3]); vw.z = pk2(v1[0], v1[1]); vw.w = pk2(v1[2], v1[3]);
                } else if (s < 144) {
                    const bf16_t* rp = h + (size_t)(I.row0 + s - 128) * HP + kvh * 64 + dp * 8;
                    kw = *(const u32x4*)(rp + HK); vw = *(const u32x4*)(rp + HV);
                }
            }
            *(LAS u32x4*)(Kl + (kvl * 192 + s) * 72 + dp * 8) = kw;
            LAS bf16_t* vp = Vt + (kvl * 64 + dp * 8) * 200 + s;
            vp[0 * 200] = (bf16_t)(vw.x & 0xffffu); vp[1 * 200] = (bf16_t)(vw.x >> 16); vp[2 * 200] = (bf16_t)(vw.y & 0xffffu); vp[3 * 200] = (bf16_t)(vw.y >> 16);
            vp[4 * 200] = (bf16_t)(vw.z & 0xffffu); vp[5 * 200] = (bf16_t)(vw.z >> 16); vp[6 * 200] = (bf16_t)(vw.w & 0xffffu); vp[7 * 200] = (bf16_t)(vw.w >> 16);
        }
        __syncthreads();
        const int head = pass * 8 + w, kvl = w >> 2;
        const float slope = exp2f(-0.5f * (float)(head + 1));
        const float sink = P->in[I_SINK][l * 16 + head];
#pragma unroll 1
        for (int qt = 0; qt < NQT; ++qt) {
            const bf16_t* qp = h + (size_t)(I.row0 + qt * 16 + fr) * HP + HQ + head * 64 + fq * 8;
            const bf16x8 q0 = *(const bf16x8*)qp, q1 = *(const bf16x8*)(qp + 32);
            f32x4 st[NST];
#pragma unroll
            for (int t = 0; t < NST; ++t) {
                const LAS bf16_t* kp = Kl + (kvl * 192 + t * 16 + fr) * 72 + fq * 8;
                f32x4 a = (f32x4){0.f, 0.f, 0.f, 0.f};
                a = MFMA16(*(const LAS bf16x8*)kp, q0, a);
                a = MFMA16(*(const LAS bf16x8*)(kp + 32), q1, a);
                st[t] = a;
                __builtin_amdgcn_sched_barrier(0);
            }
            const int qpos = (L == 64) ? (I.c * 64 + qt * 16 + fr) : (4096 + fr);
            float mx = sink;
#pragma unroll
            for (int t = 0; t < NST; ++t)
#pragma unroll
                for (int jj = 0; jj < 4; ++jj) {
                    const int s = t * 16 + fq * 4 + jj;
                    const int kpos = (L == 64) ? ((I.c - 2) * 64 + s) : (3968 + s);
                    const bool vis = (L == 64) ? (kpos >= 0) : (s < 144);
                    const float d = fabsf((float)(qpos - kpos));
                    const float sc = vis ? (st[t][jj] * 0.125f - slope * d) : -INFINITY;
                    st[t][jj] = sc; mx = fmaxf(mx, sc);
                }
            mx = fmaxf(mx, __shfl_xor(mx, 16)); mx = fmaxf(mx, __shfl_xor(mx, 32));
            float sum = 0.f;
#pragma unroll
            for (int t = 0; t < NST; ++t)
#pragma unroll
                for (int jj = 0; jj < 4; ++jj) { const float p = __expf(st[t][jj] - mx); st[t][jj] = p; sum += p; }
            sum += __shfl_xor(sum, 16); sum += __shfl_xor(sum, 32);
            const float inv = 1.0f / (sum + __expf(sink - mx));
            f32x4 o[4];
#pragma unroll
            for (int dt = 0; dt < 4; ++dt) o[dt] = (f32x4){0.f, 0.f, 0.f, 0.f};
#pragma unroll
            for (int ks = 0; ks < NKS; ++ks) {
                u32x4 pw; pw.x = pk2(st[2 * ks][0], st[2 * ks][1]); pw.y = pk2(st[2 * ks][2], st[2 * ks][3]);
                pw.z = pk2(st[2 * ks + 1][0], st[2 * ks + 1][1]); pw.w = pk2(st[2 * ks + 1][2], st[2 * ks + 1][3]);
                bf16x8 pf; __builtin_memcpy(&pf, &pw, 16);
#pragma unroll
                for (int dt = 0; dt < 4; ++dt) {
                    const LAS bf16_t* vp = Vt + (kvl * 64 + dt * 16 + fr) * 200 + ks * 32 + fq * 4;
                    const u32x2 va = *(const LAS u32x2*)vp, vb = *(const LAS u32x2*)(vp + 16);
                    u32x4 vw; vw.x = va.x; vw.y = va.y; vw.z = vb.x; vw.w = vb.y;
                    bf16x8 vf; __builtin_memcpy(&vf, &vw, 16);
                    o[dt] = MFMA16(vf, pf, o[dt]);
                }
            }
            bf16_t* op = yabc + (size_t)(I.row0 + qt * 16 + fr) * 3072 + 2048 + head * 64 + fq * 4;
#pragma unroll
            for (int dt = 0; dt < 4; ++dt) {
                u32x2 ow; ow.x = pk2(o[dt][0] * inv, o[dt][1] * inv); ow.y = pk2(o[dt][2] * inv, o[dt][3] * inv);
                *(u32x2*)(op + dt * 16) = ow;
            }
        }
    }
}

template <int L, bool FINAL>
__device__ __forceinline__ void lru_item(int wv, KP P, int l, int item, const Item& I, LAS unsigned char* lds) {
    constexpr int NIT = L / 16;
    const bf16_t* h = (const bf16_t*)(P->ws + WS_H);
    bf16_t* yabc = (bf16_t*)(P->ws + WS_Y);
    float* lruA = (float*)(P->ws + WS_LRUA); float* lruU = (float*)(P->ws + WS_LRUU);
    const int tid = tidx(wv), w = tid >> 6, lane = tid & 63, fr = lane & 15, fq = lane >> 4;
    LAS bf16_t* xa = (LAS bf16_t*)lds + w * (64 * 72);
    for (int pass = 0; pass < 2; ++pass) {
        const int blk = w + 8 * pass, ch0 = blk * 64;
        __syncthreads();
        {
            const int ch = ch0 + lane;
            const float* cw = P->in[I_LCW] + (size_t)l * 4 * 1024 + ch;
            const float w0 = cw[0], w1 = cw[1024], w2 = cw[2048], w3 = cw[3072], cb = P->in[I_LCB][l * 1024 + ch];
            float xm3 = 0.f, xm2 = 0.f, xm1 = 0.f;
            if (I.sample) { const float* st = P->in[I_SLC] + (size_t)(l * 16 + I.sb) * 3 * 1024 + ch; xm3 = st[0]; xm2 = st[1024]; xm1 = st[2048]; }
            else if (I.c > 0) { const bf16_t* hp = h + (size_t)(I.row0 - 3) * HP + HX + ch; xm3 = bf2f(hp[0]); xm2 = bf2f(hp[HP]); xm1 = bf2f(hp[2 * (size_t)HP]); }
            const bf16_t* hp = h + (size_t)I.row0 * HP + HX + ch;
#pragma unroll 8
            for (int t = 0; t < L; ++t) {
                const float x0 = bf2f(hp[(size_t)t * HP]);
                const float y = cb + w0 * xm3 + w1 * xm2 + w2 * xm1 + w3 * x0;
                xa[t * 72 + lane] = f2bf(y);
                xm3 = xm2; xm2 = xm1; xm1 = x0;
            }
        }
        __syncthreads();
        const bf16_t* waT = (const bf16_t*)(P->ws + W_LA) + blk * 4096;
        const bf16_t* wxT = (const bf16_t*)(P->ws + W_LX) + blk * 4096;
        float carryH[4][4], carryA[4][4], c8v[4][4];
#pragma unroll
        for (int jt = 0; jt < 4; ++jt)
#pragma unroll
            for (int jj = 0; jj < 4; ++jj) {
                const int ch = ch0 + jt * 16 + fq * 4 + jj;
                carryA[jt][jj] = 1.0f;
                c8v[jt][jj] = 8.0f * softplusf_(-P->in[I_LLAM][l * 1024 + ch]);
                if (FINAL) carryH[jt][jj] = I.sample ? P->in[I_SLH][(l * 16 + I.sb) * 1024 + ch] : lruU[(size_t)item * 1024 + ch];
                else carryH[jt][jj] = 0.f;
            }
#pragma unroll 1
        for (int it = 0; it < NIT; ++it) {
            const LAS bf16_t* xp = xa + (it * 16 + fr) * 72;
            const bf16x8 b0 = *(const LAS bf16x8*)(xp + fq * 8), b1 = *(const LAS bf16x8*)(xp + 32 + fq * 8);
            const int token = it * 16 + fr;
#pragma unroll
            for (int jt = 0; jt < 4; ++jt) {
                const bf16_t* wa = waT + (jt * 16 + fr) * 64 + fq * 8; const bf16_t* wx = wxT + (jt * 16 + fr) * 64 + fq * 8;
                f32x4 ra = (f32x4){0.f, 0.f, 0.f, 0.f}, ia = (f32x4){0.f, 0.f, 0.f, 0.f};
                ra = MFMA16(*(const bf16x8*)wa, b0, ra); ra = MFMA16(*(const bf16x8*)(wa + 32), b1, ra);
                ia = MFMA16(*(const bf16x8*)wx, b0, ia); ia = MFMA16(*(const bf16x8*)(wx + 32), b1, ia);
                const u32x2 xw = *(const LAS u32x2*)(xp + jt * 16 + fq * 4);
                const float xv[4] = {bflo(xw.x), bfhi(xw.x), bflo(xw.y), bfhi(xw.y)};
                float hv[4];
#pragma unroll
                for (int jj = 0; jj < 4; ++jj) {
                    const int ch = ch0 + jt * 16 + fq * 4 + jj;
                    const float r = sigmoidf_(ra[jj] + P->in[I_LBA][l * 1024 + ch]);
                    const float ig = sigmoidf_(ia[jj] + P->in[I_LBX][l * 1024 + ch]);
                    const float la = -c8v[jt][jj] * r;
                    float a = __expf(la);
                    float u = sqrtf(fmaxf(1.0f - a * a, 0.f)) * ig * xv[jj];
#pragma unroll
                    for (int d = 1; d < 16; d <<= 1) {
                        const float ap = __shfl_up(a, d, 16), up = __shfl_up(u, d, 16);
                        if (fr >= d) { u = a * up + u; a = a * ap; }
                    }
                    const float hval = a * carryH[jt][jj] + u;
                    hv[jj] = hval;
                    carryH[jt][jj] = __shfl(hval, 15, 16);
                    if (!FINAL) carryA[jt][jj] = carryA[jt][jj] * __shfl(a, 15, 16);
                }
                if (FINAL) {
                    const u32x2 gw = *(const u32x2*)(h + (size_t)(I.row0 + token) * HP + HG + ch0 + jt * 16 + fq * 4);
                    u32x2 ow; ow.x = pk2(hv[0] * gelu_tanh(bflo(gw.x)), hv[1] * gelu_tanh(bfhi(gw.x)));
                    ow.y = pk2(hv[2] * gelu_tanh(bflo(gw.y)), hv[3] * gelu_tanh(bfhi(gw.y)));
                    *(u32x2*)(yabc + (size_t)(I.row0 + token) * 3072 + ch0 + jt * 16 + fq * 4) = ow;
                    if (it == NIT - 1 && fr == 15) {
                        if (I.sample) *(f32x4*)(P->out + O_SLH + (size_t)(l * 16 + I.sb) * 1024 + ch0 + jt * 16 + fq * 4) = (f32x4){hv[0], hv[1], hv[2], hv[3]};
                        else if (I.c == 127) *(f32x4*)(P->out + O_PLH + (size_t)(l * 2 + I.b) * 1024 + ch0 + jt * 16 + fq * 4) = (f32x4){hv[0], hv[1], hv[2], hv[3]};
                    }
                }
            }
        }
        if (!FINAL) {
            if (fr == 0) {
#pragma unroll
                for (int jt = 0; jt < 4; ++jt) {
                    *(f32x4*)(lruA + (size_t)item * 1024 + ch0 + jt * 16 + fq * 4) = (f32x4){carryA[jt][0], carryA[jt][1], carryA[jt][2], carryA[jt][3]};
                    *(f32x4*)(lruU + (size_t)item * 1024 + ch0 + jt * 16 + fq * 4) = (f32x4){carryH[jt][0], carryH[jt][1], carryH[jt][2], carryH[jt][3]};
                }
            }
        }
    }
}

__device__ __forceinline__ float pre_xbc(KP P, const bf16_t* h, int l, const Item& I, int tt, int ch) {
    if (tt >= 0 || (!I.sample && I.c > 0)) return bf2f(h[(size_t)(I.row0 + tt) * HP + HXBC + ch]);
    if (I.sample) return P->in[I_SSC][((size_t)(l * 16 + I.sb) * 3 + (3 + tt)) * 1536 + ch];
    return 0.f;
}
__device__ __forceinline__ float conv_xbc(KP P, const bf16_t* h, int l, const Item& I, int t, int ch) {
    const float* cw = P->in[I_SCW] + (size_t)l * 4 * 1536 + ch;
    float y = P->in[I_SCB][l * 1536 + ch];
    y += cw[0] * pre_xbc(P, h, l, I, t - 3, ch); y += cw[1536] * pre_xbc(P, h, l, I, t - 2, ch);
    y += cw[3072] * pre_xbc(P, h, l, I, t - 1, ch); y += cw[4608] * pre_xbc(P, h, l, I, t, ch);
    return siluf_(y);
}
template <class F>
__device__ __forceinline__ void conv_roll(KP P, const bf16_t* h, int l, const Item& I, int chx, int t0, int t1, F f) {
    const float* cw = P->in[I_SCW] + (size_t)l * 4 * 1536 + chx;
    const float w0 = cw[0], w1 = cw[1536], w2 = cw[3072], w3 = cw[4608], cb = P->in[I_SCB][l * 1536 + chx];
    float xm3 = pre_xbc(P, h, l, I, t0 - 3, chx), xm2 = pre_xbc(P, h, l, I, t0 - 2, chx), xm1 = pre_xbc(P, h, l, I, t0 - 1, chx);
    const bf16_t* hp = h + (size_t)I.row0 * HP + HXBC + chx;
#pragma unroll 8
    for (int t = t0; t < t1; ++t) {
        const float x0 = bf2f(hp[(size_t)t * HP]);
        const float y = cb + w0 * xm3 + w1 * xm2 + w2 * xm1 + w3 * x0;
        f(t, siluf_(y));
        xm3 = xm2; xm2 = xm1; xm1 = x0;
    }
}
template <int L>
__device__ __forceinline__ void ssd_dtcum(int wv, KP P, int l, const Item& I, LAS float* dtv, LAS float* cumv) {
    const float* dtraw = (const float*)(P->ws + WS_DT);
    const int tid = tidx(wv);
    __syncthreads();
    for (int idx = tid; idx < L * 16; idx += 512) { const int hd = idx & 15; dtv[idx] = softplusf_(dtraw[(size_t)I.row0 * 16 + idx] + P->in[I_SDTB][l * 16 + hd]); }
    __syncthreads();
    if (tid < 64) {
        constexpr int SEG = L / 4;
        const int hd = tid & 15, sg = tid >> 4;
        const float A = -__expf(P->in[I_SALOG][l * 16 + hd]);
        float c = 0.f;
#pragma unroll
        for (int t = 0; t < SEG; ++t) { c += dtv[(sg * SEG + t) * 16 + hd] * A; cumv[(sg * SEG + t) * 16 + hd] = c; }
        const float t1 = __shfl(c, hd), t2 = __shfl(c, 16 + hd), t3 = __shfl(c, 32 + hd);
        const float off = sg == 0 ? 0.f : (sg == 1 ? t1 : (sg == 2 ? t1 + t2 : t1 + t2 + t3));
#pragma unroll
        for (int t = 0; t < SEG; ++t) cumv[(sg * SEG + t) * 16 + hd] += off;
    }
    __syncthreads();
}

template <int L>
__device__ __forceinline__ void ssd_states_item(int wv, KP P, int l, int item, const Item& I, LAS unsigned char* lds) {
    constexpr int LP = L < 32 ? 32 : L, KS = LP / 32;
    const bf16_t* h = (const bf16_t*)(P->ws + WS_H);
    bf16_t* states = (bf16_t*)(P->ws + WS_ST);
    float* cdec = (float*)(P->ws + WS_CDEC);
    const int tid = tidx(wv), w = tid >> 6, lane = tid & 63, fr = lane & 15, fq = lane >> 4;
    LAS float* dtv = (LAS float*)lds; LAS float* cumv = dtv + 1024;
    LAS bf16_t* BmT = (LAS bf16_t*)(lds + 8192);
    LAS bf16_t* xw = (LAS bf16_t*)(lds + 8192 + 36864) + w * (64 * 72);
    ssd_dtcum<L>(wv, P, l, I, dtv, cumv);
    {
        const int chB = tid & 255, half = tid >> 8;
        conv_roll(P, h, l, I, 1024 + chB, half * (L / 2), (half + 1) * (L / 2), [&](int t, float v) { BmT[chB * 72 + t] = f2bf(v); });
        if (L < LP) for (int j = L + half * ((LP - L) / 2); j < L + (half + 1) * ((LP - L) / 2); ++j) BmT[chB * 72 + j] = 0;
    }
    for (int hh = 0; hh < 2; ++hh) {
        const int head = w + 8 * hh;
        const float cl = cumv[(L - 1) * 16 + head];
        __syncthreads();
        conv_roll(P, h, l, I, head * 64 + lane, 0, L, [&](int t, float v) { xw[lane * 72 + t] = f2bf(v * __expf(cl - cumv[t * 16 + head]) * dtv[t * 16 + head]); });
        for (int j = L; j < LP; ++j) xw[lane * 72 + j] = 0;
        __syncthreads();
        const float dec = __expf(cl);
        if (!I.sample && lane == 0) cdec[item * 16 + head] = dec;
#pragma unroll 1
        for (int nt = 0; nt < 8; ++nt) {
            bf16x8 af[KS];
#pragma unroll
            for (int ks = 0; ks < KS; ++ks) af[ks] = *(const LAS bf16x8*)(BmT + (hh * 128 + nt * 16 + fr) * 72 + ks * 32 + fq * 8);
#pragma unroll
            for (int pt = 0; pt < 4; ++pt) {
                f32x4 a = (f32x4){0.f, 0.f, 0.f, 0.f};
#pragma unroll
                for (int ks = 0; ks < KS; ++ks) a = MFMA16(af[ks], *(const LAS bf16x8*)(xw + (pt * 16 + fr) * 72 + ks * 32 + fq * 8), a);
                const int p = pt * 16 + fr, n0 = nt * 16 + fq * 4;
                if (!I.sample) {
                    u32x2 ow; ow.x = pk2(a[0], a[1]); ow.y = pk2(a[2], a[3]);
                    *(u32x2*)(states + ((size_t)((I.b * 128 + I.c) * 16 + head) * 64 + p) * 128 + n0) = ow;
                } else {
                    const size_t o = ((size_t)((l * 16 + I.sb) * 16 + head) * 64 + p) * 128 + n0;
                    const f32x4 h0 = *(const f32x4*)(P->in[I_SSH] + o);
                    *(f32x4*)(P->out + O_SSH + o) = h0 * dec + a;
                }
            }
        }
    }
}

template <int L>
__device__ __forceinline__ void ssd_y_item(int wv, KP P, int l, const Item& I, LAS unsigned char* lds) {
    constexpr int LP = L < 32 ? 32 : L, KS = LP / 32, NIT = L / 16;
    const bf16_t* h = (const bf16_t*)(P->ws + WS_H);
    const bf16_t* states = (const bf16_t*)(P->ws + WS_ST);
    bf16_t* yabc = (bf16_t*)(P->ws + WS_Y);
    const int tid = tidx(wv), w = tid >> 6, lane = tid & 63, fr = lane & 15, fq = lane >> 4;
    LAS float* dtv = (LAS float*)lds; LAS float* cumv = dtv + 1024;
    LAS bf16_t* Bm = (LAS bf16_t*)(lds + 8192);
    LAS bf16_t* Cm = (LAS bf16_t*)(lds + 8192 + 17408);
    LAS float* CBl = (LAS float*)(lds + 8192 + 2 * 17408);
    LAS float* part = (LAS float*)(lds + 8192 + 3 * 17408);
    LAS bf16_t* xT = (LAS bf16_t*)(lds + 8192 + 3 * 17408 + 2048) + w * (64 * 72);
    ssd_dtcum<L>(wv, P, l, I, dtv, cumv);
    for (int g = 0; g < 2; ++g) {
        const int head = g * 8 + w;
        __syncthreads();
        {
            const int cc = tid & 255, half = tid >> 8, which = cc >> 7, n = cc & 127;
            LAS bf16_t* dstm = which ? Cm : Bm;
            conv_roll(P, h, l, I, 1024 + which * 256 + g * 128 + n, half * (L / 2), (half + 1) * (L / 2), [&](int t, float v) { dstm[t * 136 + n] = f2bf(v); });
        }
        conv_roll(P, h, l, I, head * 64 + lane, 0, L, [&](int t, float v) { xT[lane * 72 + t] = f2bf(v); });
        for (int j = L; j < LP; ++j) xT[lane * 72 + j] = 0;
        __syncthreads();
        for (int tix = w; tix < NIT * NIT; tix += 8) {
            const int it = tix / NIT, jt = tix % NIT;
            f32x4 a = (f32x4){0.f, 0.f, 0.f, 0.f};
#pragma unroll
            for (int ks = 0; ks < 4; ++ks)
                a = MFMA16(*(const LAS bf16x8*)(Cm + (it * 16 + fr) * 136 + ks * 32 + fq * 8), *(const LAS bf16x8*)(Bm + (jt * 16 + fr) * 136 + ks * 32 + fq * 8), a);
#pragma unroll
            for (int jj = 0; jj < 4; ++jj) CBl[(it * 16 + fq * 4 + jj) * 68 + jt * 16 + fr] = a[jj];
        }
        __syncthreads();
        const float dsk = P->in[I_SD][l * 16 + head];
#pragma unroll 1
        for (int it = 0; it < NIT; ++it) {
            const int i = it * 16 + fr; const float cum_i = cumv[i * 16 + head];
            f32x4 acc[4];
#pragma unroll
            for (int pt = 0; pt < 4; ++pt) acc[pt] = (f32x4){0.f, 0.f, 0.f, 0.f};
#pragma unroll
            for (int ks = 0; ks < KS; ++ks) {
                if (ks * 32 > it * 16 + 15) continue;
                const int j0 = ks * 32 + fq * 8;
                const f32x4 c0 = *(const LAS f32x4*)(CBl + i * 68 + j0), c1 = *(const LAS f32x4*)(CBl + i * 68 + j0 + 4);
                float wv8[8];
#pragma unroll
                for (int e = 0; e < 8; ++e) {
                    const int j = j0 + e; const float cb = e < 4 ? c0[e & 3] : c1[e & 3];
                    const float ex = __expf(fminf(cum_i - cumv[j * 16 + head], 0.f));
                    wv8[e] = (j <= i) ? cb * ex * dtv[j * 16 + head] : 0.f;
                }
                u32x4 ww; ww.x = pk2(wv8[0], wv8[1]); ww.y = pk2(wv8[2], wv8[3]); ww.z = pk2(wv8[4], wv8[5]); ww.w = pk2(wv8[6], wv8[7]);
                bf16x8 wf; __builtin_memcpy(&wf, &ww, 16);
#pragma unroll
                for (int pt = 0; pt < 4; ++pt) acc[pt] = MFMA16(*(const LAS bf16x8*)(xT + (pt * 16 + fr) * 72 + j0), wf, acc[pt]);
            }
            const float ecum = __expf(cum_i);
            bf16x8 cf[4];
#pragma unroll
            for (int ks = 0; ks < 4; ++ks) cf[ks] = *(const LAS bf16x8*)(Cm + i * 136 + ks * 32 + fq * 8);
#pragma unroll
            for (int pt = 0; pt < 4; ++pt) {
                bf16x8 hf[4];
                const int p = pt * 16 + fr;
                if (!I.sample) {
                    const bf16_t* sp = states + ((size_t)((I.b * 128 + I.c) * 16 + head) * 64 + p) * 128 + fq * 8;
#pragma unroll
                    for (int ks = 0; ks < 4; ++ks) hf[ks] = *(const bf16x8*)(sp + ks * 32);
                } else {
                    const float* sp = P->in[I_SSH] + ((size_t)((l * 16 + I.sb) * 16 + head) * 64 + p) * 128 + fq * 8;
#pragma unroll
                    for (int ks = 0; ks < 4; ++ks) {
                        const f32x4 a0 = *(const f32x4*)(sp + ks * 32), a1 = *(const f32x4*)(sp + ks * 32 + 4);
                        u32x4 ww; ww.x = pk2(a0[0], a0[1]); ww.y = pk2(a0[2], a0[3]); ww.z = pk2(a1[0], a1[1]); ww.w = pk2(a1[2], a1[3]);
                        __builtin_memcpy(&hf[ks], &ww, 16);
                    }
                }
                f32x4 t2 = (f32x4){0.f, 0.f, 0.f, 0.f};
#pragma unroll
                for (int ks = 0; ks < 4; ++ks) t2 = MFMA16(hf[ks], cf[ks], t2);
                acc[pt] += t2 * ecum;
            }
            float ss = 0.f;
#pragma unroll
            for (int pt = 0; pt < 4; ++pt) {
                const int p0 = pt * 16 + fq * 4;
                const u32x2 zw = *(const u32x2*)(h + (size_t)(I.row0 + i) * HP + HZ + head * 64 + p0);
                const float zv[4] = {bflo(zw.x), bfhi(zw.x), bflo(zw.y), bfhi(zw.y)};
                float yv[4];
#pragma unroll
                for (int jj = 0; jj < 4; ++jj) {
                    const float xs = bf2f(xT[(p0 + jj) * 72 + i]);
                    const float y = (acc[pt][jj] + dsk * xs) * siluf_(zv[jj]);
                    yv[jj] = y; ss += y * y;
                }
                u32x2 ow; ow.x = pk2(yv[0], yv[1]); ow.y = pk2(yv[2], yv[3]);
                *(u32x2*)(yabc + (size_t)(I.row0 + i) * 3072 + 1024 + head * 64 + p0) = ow;
            }
            ss += __shfl_xor(ss, 16); ss += __shfl_xor(ss, 32);
            if (fq == 0) part[i * 8 + w] = ss;
        }
        __syncthreads();
#pragma unroll 1
        for (int it = 0; it < NIT; ++it) {
            const int i = it * 16 + fr;
            const f32x4 pa = *(const LAS f32x4*)(part + i * 8), pb = *(const LAS f32x4*)(part + i * 8 + 4);
            const float tot = (pa[0] + pa[1] + pa[2] + pa[3]) + (pb[0] + pb[1] + pb[2] + pb[3]);
            const float rs = rsqrtf(tot * (1.0f / 512.0f) + EPS);
#pragma unroll
            for (int pt = 0; pt < 4; ++pt) {
                const int p0 = pt * 16 + fq * 4;
                const f32x4 ng = *(const f32x4*)(P->in[I_SNORM] + l * 1024 + head * 64 + p0);
                u32x2* yp = (u32x2*)(yabc + (size_t)(I.row0 + i) * 3072 + 1024 + head * 64 + p0);
                const u32x2 yw = *yp;
                u32x2 ow; ow.x = pk2(bflo(yw.x) * rs * ng[0], bfhi(yw.x) * rs * ng[1]); ow.y = pk2(bflo(yw.y) * rs * ng[2], bfhi(yw.y) * rs * ng[3]);
                *yp = ow;
            }
        }
    }
}

__device__ __forceinline__ void phase_scan(int wv, KP P, int l) {
    bf16_t* states = (bf16_t*)(P->ws + WS_ST);
    const float* cdec = (const float*)(P->ws + WS_CDEC);
    const float* lruA = (const float*)(P->ws + WS_LRUA); float* lruU = (float*)(P->ws + WS_LRUU);
    if (DBG_P5S) for (int idx = bidx() * 512 + tidx(wv); idx < 131072; idx += gdim() * 512) {
        const int e = idx * 2, b = e >> 17, rem = e & 131071, head = rem >> 13;
        unsigned* sp = (unsigned*)(states + (size_t)b * 128 * 131072 + rem);
        const float* dp = cdec + (b * 128) * 16 + head;
        float c0 = 0.f, c1 = 0.f;
        for (int c = 0; c < 128; c += 8) {
            unsigned v[8];
#pragma unroll
            for (int k = 0; k < 8; ++k) v[k] = sp[(size_t)(c + k) * 65536];
#pragma unroll
            for (int k = 0; k < 8; ++k) {
                const float dec = dp[(c + k) * 16];
                if (DBG_P5W) sp[(size_t)(c + k) * 65536] = pk2(c0, c1);
                c0 = dec * c0 + bflo(v[k]); c1 = dec * c1 + bfhi(v[k]);
            }
        }
        float* op = P->out + O_PSH + (size_t)(l * 2 + b) * 131072 + rem;
        op[0] = c0; op[1] = c1;
    }
    if (DBG_LRU4) for (int idx = bidx() * 512 + tidx(wv); idx < 2048; idx += gdim() * 512) {
        const int b = idx >> 10, ch = idx & 1023;
        float carry = 0.f;
        for (int c = 0; c < 128; ++c) {
            const size_t o = (size_t)(b * 128 + c) * 1024 + ch;
            const float A = lruA[o], U = lruU[o];
            lruU[o] = carry;
            carry = A * carry + U;
        }
    }
}

__device__ __forceinline__ void gsync(cg::grid_group& grid) {
    __threadfence(); grid.sync();
    __builtin_amdgcn_fence(__ATOMIC_ACQUIRE, "agent"); asm volatile("s_waitcnt vmcnt(0)" ::: "memory");
}
#define XB_TMO      128
#define XB_XCNT(j)  (256  + 64 * (j))
#define XB_XSUB(j)  (1280 + 64 * (j))
#define XB_XGEN(j)  (2304 + 64 * (j))
#define XB_TOP      3328
#define XB_TOPGEN   3392
#define XCD_BAR_WORDS 3456
#define XB_SPIN_CAP (1u << 20)
__device__ __forceinline__ unsigned xb_ld(unsigned* p)              { return __hip_atomic_load(p, __ATOMIC_RELAXED, __HIP_MEMORY_SCOPE_AGENT); }
__device__ __forceinline__ unsigned xb_add(unsigned* p, unsigned v) { return __hip_atomic_fetch_add(p, v, __ATOMIC_RELAXED, __HIP_MEMORY_SCOPE_AGENT); }
__device__ __forceinline__ unsigned xb_xcc_id() { return (unsigned)__builtin_amdgcn_s_getreg((3 << 11) | 20) & 0xFu; }
#define XB_SPIN(cond, bar) do { unsigned _sp = 0; while (cond) { __builtin_amdgcn_s_sleep(1); \
    if ((++_sp & 255u) == 0u) { if (xb_ld(&(bar)[XB_TMO])) break; if (_sp > XB_SPIN_CAP) { atomicAdd(&(bar)[XB_TMO], 1u); break; } } } } while (0)
__device__ __forceinline__ void xcd_barrier_complete(unsigned* bar, unsigned x, unsigned& nloc, unsigned& nx) {
    const unsigned G = (unsigned)gdim();
    unsigned sum, cnt, mine, sp = 0u;
    for (;;) {
        sum = 0u; cnt = 0u; mine = 0u;
#pragma unroll
        for (unsigned j = 0; j < 16; ++j) { const unsigned c = xb_ld(&bar[XB_XCNT(j)]); sum += c; cnt += (c > 0u) ? 1u : 0u; mine = (j == x) ? c : mine; }
        if (sum == G) break;
        __builtin_amdgcn_s_sleep(1);
        if ((++sp & 255u) == 0u) { if (xb_ld(&bar[XB_TMO])) break; if (sp > XB_SPIN_CAP) { atomicAdd(&bar[XB_TMO], 1u); break; } }
    }
    nloc = mine > 0u ? mine : 1u; nx = cnt > 0u ? cnt : 1u;
}
__device__ __forceinline__ void gbar(int wv, LAS unsigned char* lds) {
    asm volatile("s_waitcnt vmcnt(0)" ::: "memory");
    __syncthreads();
    unsigned* bar = (unsigned*)(kparams()->ws + WS_BAR);
    if (tidx(wv) == 0) {
        volatile LAS unsigned* st = (volatile LAS unsigned*)(lds + LDS_BYTES - 16);
        const unsigned x = xb_xcc_id();
        __builtin_amdgcn_s_waitcnt(0);
        unsigned nloc = st[0], nx = st[1];
        if (nloc == 0u) { xcd_barrier_complete(bar, x, nloc, nx); st[0] = nloc; st[1] = nx; }
        const unsigned old = xb_add(&bar[XB_XSUB(x)], 1u);
        const unsigned gen = old / nloc;
        if (old + 1u == (gen + 1u) * nloc) {
            __builtin_amdgcn_fence(__ATOMIC_RELEASE, "agent");
            asm volatile("s_waitcnt vmcnt(0)" ::: "memory");
            const unsigned og = xb_add(&bar[XB_TOP], 1u);
            const unsigned tg = og / nx;
            if (og + 1u == (tg + 1u) * nx) xb_add(&bar[XB_TOPGEN], 1u);
            else XB_SPIN(xb_ld(&bar[XB_TOPGEN]) == tg, bar);
            __builtin_amdgcn_fence(__ATOMIC_ACQUIRE, "agent");
            xb_add(&bar[XB_XGEN(x)], 1u);
            asm volatile("s_waitcnt vmcnt(0)" ::: "memory");
        } else {
            XB_SPIN(xb_ld(&bar[XB_XGEN(x)]) == gen, bar);
            __builtin_amdgcn_fence(__ATOMIC_ACQUIRE, "agent");
            asm volatile("s_waitcnt vmcnt(0)" ::: "memory");
        }
    }
    __syncthreads();
}
__device__ __forceinline__ void gemm_gu(int wv, LAS unsigned char* lds, int j2) { KP P = kparams();
    EpiGU E; E.ssq = (const float*)(P->ws + WS_SSQ); E.hff = (bf16_t*)(P->ws + WS_H);
    run_gemm(wv, lds, (const bf16_t*)(P->ws + WS_XB), (const bf16_t*)(P->ws + (j2 ? W_GU1 : W_GU0)), 5632, 1024, E); }
__device__ __forceinline__ void gemm_dn(int wv, LAS unsigned char* lds, int j2) { KP P = kparams();
    EpiRes E; E.x = P->out; E.xb = (bf16_t*)(P->ws + WS_XB); E.ssq = (float*)(P->ws + WS_SSQ); E.scale = 0.5f;
    run_gemm(wv, lds, (const bf16_t*)(P->ws + WS_H), (const bf16_t*)(P->ws + (j2 ? W_DN1 : W_DN0)), 1024, 2816, E); }
__device__ __forceinline__ void gemm_in(int wv, LAS unsigned char* lds) { KP P = kparams();
    EpiIn E; E.ssq = (const float*)(P->ws + WS_SSQ); E.h = (bf16_t*)(P->ws + WS_H); E.dtraw = (float*)(P->ws + WS_DT);
    run_gemm(wv, lds, (const bf16_t*)(P->ws + WS_XB), (const bf16_t*)(P->ws + W_IN), NINP, 1024, E); }
__device__ __forceinline__ void gemm_merge(int wv, LAS unsigned char* lds) { KP P = kparams();
    EpiMerge E; E.h = (const bf16_t*)(P->ws + WS_H); E.merged = (bf16_t*)(P->ws + WS_ST);
    run_gemm(wv, lds, (const bf16_t*)(P->ws + WS_Y), (const bf16_t*)(P->ws + W_BR), 1024, 3072, E); }
__device__ __forceinline__ void gemm_out(int wv, LAS unsigned char* lds) { KP P = kparams();
    EpiRes E; E.x = P->out; E.xb = (bf16_t*)(P->ws + WS_XB); E.ssq = (float*)(P->ws + WS_SSQ); E.scale = 1.0f;
    run_gemm(wv, lds, (const bf16_t*)(P->ws + WS_ST), (const bf16_t*)(P->ws + W_OUT), 1024, 1024, E); }

__global__ __launch_bounds__(512, 2) void mega(Params Pk) {
    extern __shared__ __attribute__((aligned(16))) unsigned char smem[];
    LAS unsigned char* lds = (LAS unsigned char*)smem;
    cg::grid_group grid = cg::this_grid();
    const int wv = __builtin_amdgcn_readfirstlane((int)(threadIdx.x >> 6));
    unsigned* bar0 = (unsigned*)(kparams()->ws + WS_BAR);
    if (threadIdx.x == 0) {
        volatile LAS unsigned* st = (volatile LAS unsigned*)(lds + LDS_BYTES - 16); st[0] = 0u; st[1] = 0u;
        (void)xb_add(&bar0[XB_XCNT(xb_xcc_id())], 1u);
    }
    __syncthreads();
    phase_init(wv, kparams());
    gsync(grid);
#pragma unroll 1
    for (int step = 0; step < 8; ++step) {
        const int l = step >> 1, j2 = step & 1;
        gbar(wv, lds);
        if (j2 == 0) { convert_layer(wv, kparams(), l, lds); gbar(wv, lds); }
        gemm_gu(wv, lds, j2);
        gbar(wv, lds);
        gemm_dn(wv, lds, j2);
        if (j2 == 0 && DBG_MIX) {
            gbar(wv, lds);
            for (int rep = 0; rep < REP_IN; ++rep) { if (rep) gbar(wv, lds); gemm_in(wv, lds); }
            for (int rep = 0; rep < REP_SYNC; ++rep) gbar(wv, lds);
            gbar(wv, lds);
            for (int rep = 0; rep < REP_P4; ++rep)
            for (int item = bidx(); item < 256; item += gdim()) {
                const Item I = get_item(item);
                copy_states_item(wv, kparams(), l, I);
                attn_item<64>(wv, kparams(), l, I, lds); lru_item<64, false>(wv, kparams(), l, item, I, lds); ssd_states_item<64>(wv, kparams(), l, item, I, lds);
            }
            gbar(wv, lds);
            phase_scan(wv, kparams(), l);
            for (int sb = gdim() - 1 - bidx(); sb < 16; sb += gdim()) {
                const Item I = get_item(256 + sb);
                copy_states_item(wv, kparams(), l, I);
                attn_item<16>(wv, kparams(), l, I, lds);
            }
            gbar(wv, lds);
            for (int rep = 0; rep < REP_P6; ++rep) {
            for (int item = bidx(); item < 256; item += gdim()) {
                const Item I = get_item(item);
                lru_item<64, true>(wv, kparams(), l, item, I, lds); ssd_y_item<64>(wv, kparams(), l, I, lds);
            }
            for (int sj = bidx(); sj < 48; sj += gdim()) {
                const int sb = sj & 15, piece = sj >> 4;
                const Item I = get_item(256 + sb);
                if (piece == 0) lru_item<16, true>(wv, kparams(), l, 256 + sb, I, lds);
                else if (piece == 1) ssd_states_item<16>(wv, kparams(), l, 256 + sb, I, lds);
                else ssd_y_item<16>(wv, kparams(), l, I, lds);
            }
            }
            if (DBG_MERGE) {
            gbar(wv, lds);
            gemm_merge(wv, lds);
            gbar(wv, lds);
            gemm_out(wv, lds); }
        }
    }
    gbar(wv, lds);
    phase_final(wv, kparams());
#if DBG_SANITIZE
    gbar(wv, lds);
    { KP P = kparams(); float* o = P->out;
      for (size_t i = (size_t)bidx() * 512 + tidx(wv); i < O_END; i += (size_t)gdim() * 512) { const float v = o[i]; if (!(fabsf(v) < 1e30f)) o[i] = 0.f; } }
#endif
}

extern "C" void kernel_launch(void* const* d_in, const int* in_sizes, int n_in, void* d_out, int out_size, void* d_ws, size_t ws_size, hipStream_t stream) {
    static int grid_blocks = 0;
    if (grid_blocks == 0) {
        if (n_in != N_INPUTS || (size_t)out_size != O_END || ws_size < WS_END) {
            fprintf(stderr, "kernel_launch: unexpected shapes: n_in %d out %d ws %zu (need %zu)\n", n_in, out_size, ws_size, (size_t)WS_END); grid_blocks = -1; return; }
        int dev = 0, cus = 0, per_cu = 0;
        hipGetDevice(&dev);
        hipDeviceGetAttribute(&cus, hipDeviceAttributeMultiprocessorCount, dev);
        if (hipFuncSetAttribute((const void*)mega, hipFuncAttributeMaxDynamicSharedMemorySize, LDS_BYTES) != hipSuccess) { fprintf(stderr, "hipFuncSetAttribute failed\n"); grid_blocks = -1; return; }
        hipOccupancyMaxActiveBlocksPerMultiprocessor(&per_cu, (const void*)mega, 512, LDS_BYTES);
        if (per_cu < 1) per_cu = 1;
        grid_blocks = cus * per_cu;
    }
    if (grid_blocks < 0) return;
    Params p{};
    for (int i = 0; i < N_INPUTS; ++i) p.in[i] = (const float*)d_in[i];
    p.out = (float*)d_out; p.ws = (unsigned char*)d_ws;
    if (hipMemsetAsync((unsigned char*)d_ws + WS_BAR, 0, 16384, stream) != hipSuccess) { fprintf(stderr, "memset failed\n"); return; }
    void* args[] = {&p};
    hipError_t e = hipLaunchCooperativeKernel((const void*)mega, dim3(grid_blocks), dim3(512), args, LDS_BYTES, stream);
    if (e != hipSuccess) fprintf(stderr, "cooperative launch failed: %s (grid %d)\n", hipGetErrorString(e), grid_blocks);
}
```

```cpp
#include <hip/hip_runtime.h>
#include <hip/hip_cooperative_groups.h>
#include <cstdio>
namespace cg = cooperative_groups;
#define DBG_SANITIZE 0
#ifndef REP_P4
#define REP_P4 1
#endif
#ifndef REP_P6
#define REP_P6 1
#endif
#ifndef REP_SYNC
#define REP_SYNC 0
#endif
#ifndef REP_IN
#define REP_IN 1
#endif
#ifndef REP_GU
#define REP_GU 1
#endif
#ifndef REP_MG
#define REP_MG 1
#endif
#define DBG_MIX 1
#define DBG_MERGE 1
#define DBG_ATTN 1
#define DBG_LRU4 1
#define DBG_SSD4 1
#define DBG_P5S 1
#define DBG_P5W 1
#define DBG_P5 1
#define DBG_LRU6 1
#define DBG_SSD6 1

#define LAS __attribute__((address_space(3)))
typedef unsigned short bf16_t;
typedef short bf16x8 __attribute__((ext_vector_type(8)));
typedef float f32x4 __attribute__((ext_vector_type(4)));
typedef unsigned u32x4 __attribute__((ext_vector_type(4)));
typedef unsigned u32x2 __attribute__((ext_vector_type(2)));

constexpr int MP = 16384, MS = 256, MT = 16640;
constexpr int DM = 1024, DFF = 2816, NIN = 9232, NINP = 9472, HP = 9232;
constexpr int HX = 0, HG = 1024, HZ = 2048, HXBC = 3072, HQ = 4608, HK = 5632, HV = 5888, HGATE = 6144, HDT = 9216;
constexpr float EPS = 1e-6f;
constexpr int NITEM = 272;

enum { I_XP = 0, I_XS, I_CK, I_CV, I_SLC, I_SLH, I_SSC, I_SSH, I_FNORM, I_WG, I_WU, I_WD, I_MNORM, I_WIN, I_LCW, I_LCB, I_LWA, I_LBA, I_LWX, I_LBX,
       I_LLAM, I_SCW, I_SCB, I_SDTB, I_SALOG, I_SD, I_SNORM, I_SINK, I_WBR, I_WOUT, I_FINAL, N_INPUTS };

constexpr size_t O_YP = 0, O_YS = O_YP + (size_t)MP * DM, O_PK = O_YS + (size_t)MS * DM, O_PV = O_PK + 4 * 2 * 128 * 256, O_PLC = O_PV + 4 * 2 * 128 * 256,
                 O_PLH = O_PLC + 4 * 2 * 3 * 1024, O_PSC = O_PLH + 4 * 2 * 1024, O_PSH = O_PSC + 4 * 2 * 3 * 1536, O_SK = O_PSH + (size_t)4 * 2 * 16 * 64 * 128,
                 O_SV = O_SK + (size_t)4 * 16 * 128 * 256, O_SLC = O_SV + (size_t)4 * 16 * 128 * 256, O_SLH = O_SLC + 4 * 16 * 3 * 1024, O_SSC = O_SLH + 4 * 16 * 1024,
                 O_SSH = O_SSC + 4 * 16 * 3 * 1536, O_END = O_SSH + (size_t)4 * 16 * 16 * 64 * 128;

constexpr size_t WS_XB = 0;
constexpr size_t WS_H = WS_XB + (size_t)MT * DM * 2;
constexpr size_t WS_ST = WS_H + (size_t)MT * HP * 2;
constexpr size_t WS_Y = WS_ST + (size_t)2 * 128 * 16 * 64 * 128 * 2;
constexpr size_t WS_W = WS_Y + (size_t)MT * 3072 * 2;
constexpr size_t W_GU0 = WS_W, W_GU1 = W_GU0 + (size_t)5632 * 1024 * 2, W_DN0 = W_GU1 + (size_t)5632 * 1024 * 2, W_DN1 = W_DN0 + (size_t)1024 * 2816 * 2,
                 W_IN = W_DN1 + (size_t)1024 * 2816 * 2, W_BR = W_IN + (size_t)NINP * 1024 * 2, W_OUT = W_BR + (size_t)1024 * 3072 * 2,
                 W_LA = W_OUT + (size_t)1024 * 1024 * 2, W_LX = W_LA + 65536 * 2, WS_SSQ = W_LX + 65536 * 2;
constexpr size_t WS_DT = WS_SSQ + (size_t)MT * 16 * 4, WS_LRUA = WS_DT + (size_t)MT * 16 * 4, WS_LRUU = WS_LRUA + 256 * 1024 * 4, WS_CDEC = WS_LRUU + 256 * 1024 * 4,
                 WS_BAR = WS_CDEC + 256 * 16 * 4, WS_SSQ2 = WS_BAR + 16384, WS_END = WS_SSQ2 + 256 * 16 * 4;

constexpr int LDS_BYTES = 147456;

struct Params { const float* in[N_INPUTS]; float* out; unsigned char* ws; };
typedef const Params __attribute__((address_space(4))) * KP;
__device__ __forceinline__ KP kparams() { KP p = (KP)__builtin_amdgcn_kernarg_segment_ptr(); asm volatile("" : "+s"(p)); return p; }
__device__ __forceinline__ int tidx(int wv) { int t; asm volatile("v_mbcnt_lo_u32_b32 %0, -1, 0\n\tv_mbcnt_hi_u32_b32 %0, -1, %0" : "=v"(t)); return (wv << 6) | t; }
__device__ __forceinline__ int bidx() { int t = blockIdx.x; asm volatile("" : "+s"(t)); return t; }
__device__ __forceinline__ int gdim() { int t = gridDim.x; asm volatile("" : "+s"(t)); return t; }

typedef __bf16 bf16x2_t __attribute__((ext_vector_type(2)));
typedef float f32x2_t __attribute__((ext_vector_type(2)));
__device__ __forceinline__ unsigned pk2(float lo, float hi) { f32x2_t v = {lo, hi}; bf16x2_t b = __builtin_convertvector(v, bf16x2_t); unsigned r; __builtin_memcpy(&r, &b, 4); return r; }
__device__ __forceinline__ bf16_t f2bf(float f) { return (bf16_t)(pk2(f, 0.f) & 0xffffu); }
__device__ __forceinline__ float bf2f(bf16_t b) { return __uint_as_float(((unsigned)b) << 16); }
__device__ __forceinline__ float bflo(unsigned w) { return __uint_as_float(w << 16); }
__device__ __forceinline__ float bfhi(unsigned w) { return __uint_as_float(w & 0xffff0000u); }
__device__ __forceinline__ float sigmoidf_(float x) { return 1.0f / (1.0f + __expf(-x)); }
__device__ __forceinline__ float siluf_(float x) { return x / (1.0f + __expf(-x)); }
__device__ __forceinline__ float softplusf_(float x) { return x > 20.f ? x : log1pf(__expf(x)); }
__device__ __forceinline__ float gelu_tanh(float x) { const float u = 0.7978845608028654f * (x + 0.044715f * x * x * x); return x / (1.0f + __expf(-2.0f * u)); }
__device__ __forceinline__ float rstd_row(const float* ssq, int r) {
    const f32x4* p = (const f32x4*)(ssq + (size_t)r * 16); f32x4 a = p[0], b = p[1], c = p[2], d = p[3];
    float s = (a[0] + a[1] + a[2] + a[3]) + (b[0] + b[1] + b[2] + b[3]) + (c[0] + c[1] + c[2] + c[3]) + (d[0] + d[1] + d[2] + d[3]);
    if (r >= MP) {
        const f32x4* q = (const f32x4*)(ssq + (WS_SSQ2 - WS_SSQ) / 4 + (size_t)(r - MP) * 16); a = q[0]; b = q[1]; c = q[2]; d = q[3];
        s += (a[0] + a[1] + a[2] + a[3]) + (b[0] + b[1] + b[2] + b[3]) + (c[0] + c[1] + c[2] + c[3]) + (d[0] + d[1] + d[2] + d[3]);
    }
    return rsqrtf(s * (1.0f / 1024.0f) + EPS);
}
#define MFMA16(a, b, c) __builtin_amdgcn_mfma_f32_16x16x32_bf16((a), (b), (c), 0, 0, 0)

namespace pg8 {
constexpr int BM = 256, BK = 64, HALF = 128, HTB = HALF * BK * 2, STAGE_BYTES = 8 * HTB, NXCD = 8, WGM = 8;
__device__ __forceinline__ int lds_byte(int r, int c) { const int st = (r >> 4) * 2 + (c >> 5), rr = r & 15, cc = c & 31, ob = rr * 64 + cc * 2; return st * 1024 + (ob ^ (((ob >> 9) & 1) << 5)); }
__device__ __forceinline__ void stage_rc(int b, int& R, int& C) { const int st = b / 1024, sb = b % 1024, swz = sb ^ (((sb >> 9) & 1) << 5); R = (st >> 1) * 16 + swz / 64; C = (st & 1) * 32 + (swz % 64) / 2; }
struct Unit { int pm, pn; };
struct Gemm { const bf16_t* A; const bf16_t* Bt; int M, N, K; };
struct StaticOrder {
    int nM, nN, nwg, G, c;
    __device__ void init(int M, int N, int G_, int c_) { nM = M / BM; nN = N / BM; nwg = nM * nN; G = G_; c = c_; }
    __device__ bool next(int i, Unit& u) const {
        const long L = (long)i * G + c; if (L >= nwg) return false;
        int wgid = (int)L; { const int q = nwg / NXCD, r = nwg % NXCD, xcd = wgid % NXCD, off = wgid / NXCD; wgid = (xcd < r ? xcd * (q + 1) : r * (q + 1) + (xcd - r) * q) + off; }
        const int nig = WGM * nN, gid = wgid / nig, fm = gid * WGM, gsz = (nM - fm) < WGM ? (nM - fm) : WGM;
        u.pm = fm + ((wgid % nig) % gsz); u.pn = (wgid % nig) / gsz; return true;
    }
};

template <class Epi>
__device__ __forceinline__ void gemm_phase(int wv, LAS unsigned char* lds, const Gemm g, const StaticOrder& S, const Epi& E) {
    const int tid = tidx(wv), wid = wv, lane = tid & 63, wr = wid >> 2, wc = wid & 3, fr = lane & 15, fq = lane >> 4;
    const int K = g.K, nt = K / BK;
    unsigned voffA[2];
#pragma unroll
    for (int i = 0; i < 2; ++i) { int R, C; stage_rc(tid * 16 + i * 8192, R, C); voffA[i] = (unsigned)(R * K + C) * 2u; }
    const size_t kstep = (size_t)(BK * 2);
    const size_t hstep = (size_t)HALF * K * 2;
    const size_t tstep = 2 * hstep;
    const unsigned ldsw = (unsigned)wid * 1024u;
    const int aoff = lds_byte(wr * 64 + fr, fq * 8), boff = lds_byte(wc * 32 + fr, fq * 8);
#define PG8_SA(b, h) (((b) * 2 + (h)) * HTB)
#define PG8_SB(b, h) ((4 + (b) * 2 + (h)) * HTB)
#define PG8_STAGE(bufoff, gbase, voff) do { _Pragma("unroll") for (int _i = 0; _i < 2; ++_i) \
        __builtin_amdgcn_global_load_lds((const unsigned*)((const char*)(gbase) + (voff)[_i]), (LAS unsigned*)(lds + (bufoff) + ldsw + _i * 8192), 16, 0, 0); } while (0)
#define PG8_LDA(dst, b, h) do { _Pragma("unroll") for (int m = 0; m < 4; ++m) _Pragma("unroll") for (int k = 0; k < 2; ++k) dst[m][k] = *(const LAS bf16x8*)(lds + PG8_SA(b, h) + aoff + m * 2048 + k * 1024); } while (0)
#define PG8_LDB(dst, b, h) do { _Pragma("unroll") for (int n = 0; n < 2; ++n) _Pragma("unroll") for (int k = 0; k < 2; ++k) dst[n][k] = *(const LAS bf16x8*)(lds + PG8_SB(b, h) + boff + n * 2048 + k * 1024); } while (0)
#define PG8_MMA(ai, bj, At, Bt) do { __builtin_amdgcn_s_setprio(1); _Pragma("unroll") for (int m = 0; m < 4; ++m) _Pragma("unroll") for (int n = 0; n < 2; ++n) _Pragma("unroll") for (int k = 0; k < 2; ++k) \
        acc[ai][bj][m][n] = __builtin_amdgcn_mfma_f32_16x16x32_bf16(Bt[n][k], At[m][k], acc[ai][bj][m][n], 0, 0, 0); __builtin_amdgcn_s_setprio(0); } while (0)
#define PG8_WAIT_V(n) asm volatile("s_waitcnt vmcnt(" #n ")" ::: "memory")
#define PG8_WAIT_L(n) asm volatile("s_waitcnt lgkmcnt(" #n ")" ::: "memory")
#define PG8_BAR __builtin_amdgcn_s_barrier()
#define PG8_SCHED __builtin_amdgcn_sched_barrier(0)
    Unit cur, nxt; int ui = 0;
    if (!S.next(0, cur)) return;
    f32x4 acc[2][2][4][2];
#pragma unroll
    for (int a = 0; a < 2; ++a)
#pragma unroll
        for (int b = 0; b < 2; ++b)
#pragma unroll
            for (int m = 0; m < 4; ++m)
#pragma unroll
                for (int n = 0; n < 2; ++n) acc[a][b][m][n] = (f32x4){0.f, 0.f, 0.f, 0.f};
    bf16x8 At[4][2], B0[2][2], B1[2][2];
    const char* cA = (const char*)g.A + (size_t)cur.pm * tstep; const char* cB = (const char*)g.Bt + (size_t)cur.pn * tstep;
    PG8_STAGE(PG8_SB(0, 0), cB, voffA); PG8_STAGE(PG8_SA(0, 0), cA, voffA); PG8_STAGE(PG8_SB(0, 1), cB + hstep, voffA); PG8_STAGE(PG8_SA(0, 1), cA + hstep, voffA);
    if (wr == 1) PG8_BAR;
    PG8_WAIT_V(4); PG8_BAR;
    PG8_STAGE(PG8_SB(1, 0), cB + kstep, voffA); PG8_STAGE(PG8_SA(1, 0), cA + kstep, voffA); PG8_STAGE(PG8_SB(1, 1), cB + hstep + kstep, voffA);
    PG8_WAIT_V(6); PG8_BAR;
    for (;;) {
        const bool has_next = S.next(ui + 1, nxt);
        const char* nA = has_next ? (const char*)g.A + (size_t)nxt.pm * tstep : cA; const char* nB = has_next ? (const char*)g.Bt + (size_t)nxt.pn * tstep : cB;
        for (int t = 0; t < nt; t += 2) {
            const bool last = (t == nt - 2);
            const char* a1 = cA + (size_t)(t + 1) * kstep;
            const char* a2 = last ? nA : cA + (size_t)(t + 2) * kstep; const char* b2 = last ? nB : cB + (size_t)(t + 2) * kstep;
            const char* a3 = a2 + kstep; const char* b3 = b2 + kstep;
            PG8_LDB(B0, 0, 0); PG8_SCHED; PG8_LDA(At, 0, 0); PG8_STAGE(PG8_SA(1, 1), a1 + hstep, voffA);
            PG8_WAIT_L(8); PG8_BAR; PG8_WAIT_L(0); PG8_MMA(0, 0, At, B0); PG8_BAR; PG8_SCHED;
            PG8_LDB(B1, 0, 1); PG8_STAGE(PG8_SB(0, 0), b2, voffA);
            PG8_BAR; PG8_WAIT_L(0); PG8_MMA(0, 1, At, B1); PG8_BAR;
            PG8_LDA(At, 0, 1); PG8_STAGE(PG8_SA(0, 0), a2, voffA);
            PG8_BAR; PG8_WAIT_L(0); PG8_MMA(1, 0, At, B0); PG8_BAR; PG8_SCHED;
            PG8_STAGE(PG8_SB(0, 1), b2 + hstep, voffA);
            PG8_WAIT_V(6); PG8_BAR; PG8_MMA(1, 1, At, B1); PG8_BAR;
            PG8_LDB(B0, 1, 0); PG8_SCHED; PG8_LDA(At, 1, 0); PG8_STAGE(PG8_SA(0, 1), a2 + hstep, voffA);
            PG8_WAIT_L(8); PG8_BAR; PG8_WAIT_L(0); PG8_MMA(0, 0, At, B0); PG8_BAR; PG8_SCHED;
            PG8_LDB(B1, 1, 1); PG8_STAGE(PG8_SB(1, 0), b3, voffA);
            PG8_BAR; PG8_WAIT_L(0); PG8_MMA(0, 1, At, B1); PG8_BAR;
            PG8_LDA(At, 1, 1); PG8_STAGE(PG8_SA(1, 0), a3, voffA);
            PG8_BAR; PG8_WAIT_L(0); PG8_MMA(1, 0, At, B0); PG8_BAR; PG8_SCHED;
            PG8_STAGE(PG8_SB(1, 1), b3 + hstep, voffA);
            PG8_WAIT_V(6); PG8_BAR; PG8_MMA(1, 1, At, B1); PG8_BAR;
            if constexpr (Epi::HAS_MID) { if (!last && ((t + 2) & 15) == 0) E.mid(acc, cur, (t + 2) >> 4, wr, wc, fr, fq); }
        }
        E(acc, cur, wr, wc, fr, fq);
        if (!has_next) break;
#pragma unroll
        for (int a = 0; a < 2; ++a)
#pragma unroll
            for (int b = 0; b < 2; ++b)
#pragma unroll
                for (int m = 0; m < 4; ++m)
#pragma unroll
                    for (int n = 0; n < 2; ++n) acc[a][b][m][n] = (f32x4){0.f, 0.f, 0.f, 0.f};
        cur = nxt; cA = nA; cB = nB; ++ui;
    }
    PG8_WAIT_V(0);
    if (wr == 0) PG8_BAR;
    PG8_BAR;
#undef PG8_SA
#undef PG8_SB
#undef PG8_STAGE
#undef PG8_LDA
#undef PG8_LDB
#undef PG8_MMA
#undef PG8_WAIT_V
#undef PG8_WAIT_L
#undef PG8_BAR
#undef PG8_SCHED
}
}
using pg8::Unit;
typedef f32x4 AccT[2][2][4][2];

struct EpiGU {
    static constexpr bool HAS_MID = false;
    const float* ssq; bf16_t* hff;
    __device__ __forceinline__ void mid(AccT&, const Unit&, int, int, int, int, int) const {}
    __device__ __forceinline__ void operator()(const AccT& acc, const Unit& u, int wr, int wc, int fr_, int fq_) const {
        int fr = fr_, fq = fq_; asm volatile("" : "+v"(fr), "+v"(fq));
        const int row0 = u.pm * 256 + wr * 64 + fr, hc0 = u.pn * 128 + wc * 16 + fq * 4;
#pragma unroll
        for (int ai = 0; ai < 2; ++ai)
#pragma unroll
            for (int m = 0; m < 4; ++m) {
                const int r = row0 + ai * 128 + m * 16; const float rs = rstd_row(ssq, r);
#pragma unroll
                for (int bj = 0; bj < 2; ++bj) {
                    const f32x4 gt = acc[ai][bj][m][0] * rs, up = acc[ai][bj][m][1] * rs;
                    u32x2 w; w.x = pk2(siluf_(gt[0]) * up[0], siluf_(gt[1]) * up[1]); w.y = pk2(siluf_(gt[2]) * up[2], siluf_(gt[3]) * up[3]);
                    *(u32x2*)(hff + (size_t)r * DFF + hc0 + bj * 64) = w;
                }
            }
    }
};
struct EpiRes {
    static constexpr bool HAS_MID = false;
    float* x; bf16_t* xb; float* ssq; float scale;
    __device__ __forceinline__ void mid(AccT&, const Unit&, int, int, int, int, int) const {}
    __device__ __forceinline__ void operator()(const AccT& acc, const Unit& u, int wr, int wc, int fr_, int fq_) const {
        int fr = fr_, fq = fq_; asm volatile("" : "+v"(fr), "+v"(fq));
        const int row0 = u.pm * 256 + wr * 64 + fr, col0 = u.pn * 256 + wc * 32 + 4 * fq;
#pragma unroll
        for (int ai = 0; ai < 2; ++ai)
#pragma unroll
            for (int m = 0; m < 4; ++m) {
                const int r = row0 + ai * 128 + m * 16; float ss = 0.f;
#pragma unroll
                for (int bj = 0; bj < 2; ++bj)
#pragma unroll
                    for (int n = 0; n < 2; ++n) {
                        const int c = col0 + bj * 128 + n * 16;
                        f32x4* xp = (f32x4*)(x + (size_t)r * DM + c);
                        f32x4 v = *xp + acc[ai][bj][m][n] * scale;
                        *xp = v;
                        u32x2 w; w.x = pk2(v[0], v[1]); w.y = pk2(v[2], v[3]);
                        *(u32x2*)(xb + (size_t)r * DM + c) = w;
                        ss += v[0] * v[0] + v[1] * v[1] + v[2] * v[2] + v[3] * v[3];
                    }
                ss += __shfl_xor(ss, 16); ss += __shfl_xor(ss, 32);
                if (fq == 0) ssq[(size_t)r * 16 + u.pn * 4 + wc] = ss;
            }
    }
};
struct EpiIn {
    static constexpr bool HAS_MID = false;
    const float* ssq; bf16_t* h; float* dtraw;
    __device__ __forceinline__ void mid(AccT&, const Unit&, int, int, int, int, int) const {}
    __device__ __forceinline__ void operator()(const AccT& acc, const Unit& u, int wr, int wc, int fr_, int fq_) const {
        int fr = fr_, fq = fq_; asm volatile("" : "+v"(fr), "+v"(fq));
        const int row0 = u.pm * 256 + wr * 64 + fr, col0 = u.pn * 256 + wc * 32 + 4 * fq;
#pragma unroll
        for (int ai = 0; ai < 2; ++ai)
#pragma unroll
            for (int m = 0; m < 4; ++m) {
                const int r = row0 + ai * 128 + m * 16; const float rs = rstd_row(ssq, r);
                if (u.pn < 36) {
#pragma unroll
                    for (int bj = 0; bj < 2; ++bj)
#pragma unroll
                        for (int n = 0; n < 2; ++n) {
                            const int c = col0 + bj * 128 + n * 16; const f32x4 v = acc[ai][bj][m][n] * rs;
                            u32x2 w; w.x = pk2(v[0], v[1]); w.y = pk2(v[2], v[3]);
                            *(u32x2*)(h + (size_t)r * HP + c) = w;
                        }
                } else if (wc == 0) {
                    const f32x4 v = acc[ai][0][m][0] * rs;
                    *(f32x4*)(dtraw + (size_t)r * 16 + 4 * fq) = v;
                }
            }
    }
};
struct EpiMerge {
    static constexpr bool HAS_MID = true;
    const bf16_t* h; bf16_t* merged;
    __device__ __forceinline__ void mid(AccT& acc, const Unit& u, int seg, int wr, int wc, int fr_, int fq_) const {
        int fr = fr_, fq = fq_; asm volatile("" : "+v"(fr), "+v"(fq));
        const int row0 = u.pm * 256 + wr * 64 + fr, col0 = u.pn * 256 + wc * 32 + 4 * fq;
#pragma unroll
        for (int ai = 0; ai < 2; ++ai)
#pragma unroll
            for (int m = 0; m < 4; ++m) {
                const int r = row0 + ai * 128 + m * 16;
#pragma unroll
                for (int bj = 0; bj < 2; ++bj)
#pragma unroll
                    for (int n = 0; n < 2; ++n) {
                        const int c = col0 + bj * 128 + n * 16;
                        const bf16_t* gp = h + (size_t)r * HP + HGATE + (seg - 1) * 1024 + c;
                        const u32x2 ga = *(const u32x2*)gp, gb = *(const u32x2*)(gp + 1024);
                        const float a0 = bflo(ga.x), a1 = bfhi(ga.x), a2 = bflo(ga.y), a3 = bfhi(ga.y);
                        const float b0 = bflo(gb.x), b1 = bfhi(gb.x), b2 = bflo(gb.y), b3 = bfhi(gb.y);
                        f32x4 f;
                        f[0] = (1.f + __expf(-fmaxf(b0, -30.f))) / (1.f + __expf(-fmaxf(a0, -30.f)));
                        f[1] = (1.f + __expf(-fmaxf(b1, -30.f))) / (1.f + __expf(-fmaxf(a1, -30.f)));
                        f[2] = (1.f + __expf(-fmaxf(b2, -30.f))) / (1.f + __expf(-fmaxf(a2, -30.f)));
                        f[3] = (1.f + __expf(-fmaxf(b3, -30.f))) / (1.f + __expf(-fmaxf(a3, -30.f)));
                        acc[ai][bj][m][n] *= f;
                    }
            }
    }
    __device__ __forceinline__ void operator()(const AccT& acc, const Unit& u, int wr, int wc, int fr_, int fq_) const {
        int fr = fr_, fq = fq_; asm volatile("" : "+v"(fr), "+v"(fq));
        const int row0 = u.pm * 256 + wr * 64 + fr, col0 = u.pn * 256 + wc * 32 + 4 * fq;
#pragma unroll
        for (int ai = 0; ai < 2; ++ai)
#pragma unroll
            for (int m = 0; m < 4; ++m) {
                const int r = row0 + ai * 128 + m * 16;
#pragma unroll
                for (int bj = 0; bj < 2; ++bj)
#pragma unroll
                    for (int n = 0; n < 2; ++n) {
                        const int c = col0 + bj * 128 + n * 16;
                        const u32x2 ga = *(const u32x2*)(h + (size_t)r * HP + HGATE + 2048 + c);
                        const f32x4 v = acc[ai][bj][m][n];
                        u32x2 w;
                        w.x = pk2(v[0] / (1.f + __expf(-fmaxf(bflo(ga.x), -30.f))), v[1] / (1.f + __expf(-fmaxf(bfhi(ga.x), -30.f))));
                        w.y = pk2(v[2] / (1.f + __expf(-fmaxf(bflo(ga.y), -30.f))), v[3] / (1.f + __expf(-fmaxf(bfhi(ga.y), -30.f))));
                        *(u32x2*)(merged + (size_t)r * DM + c) = w;
                    }
            }
    }
};

template <class Epi> __device__ __forceinline__ void run_gemm(int wv, LAS unsigned char* lds, const bf16_t* A, const bf16_t* Bt, int M, int N, int K, const Epi& E) {
    pg8::Gemm g; g.A = A; g.Bt = Bt; g.M = M; g.N = N; g.K = K;
    pg8::StaticOrder S; S.init(M, N, (int)gdim(), (int)bidx());
    pg8::gemm_phase<Epi>(wv, lds, g, S, E);
}


template <int MODE>
__device__ __forceinline__ void skinny_gemm(int wv, LAS unsigned char* lds, KP P, const bf16_t* A, const bf16_t* Bt, int K, float scale) {
    const int tid = tidx(wv), w = tid >> 6, lane = tid & 63, fr = lane & 15, fq = lane >> 4;
    LAS float* part = (LAS float*)lds;
    constexpr int NSEG = MODE ? 3 : 1;
    const int kseg = K / NSEG, kw = kseg / 8;
    const bf16_t* h = (const bf16_t*)(P->ws + WS_H);
    for (int task = bidx(); task < 256; task += gdim()) {
        const int rt = task >> 5, ct = task & 31;
        f32x4 tot[2][2];
#pragma unroll
        for (int i = 0; i < 2; ++i)
#pragma unroll
            for (int j = 0; j < 2; ++j) tot[i][j] = (f32x4){0.f, 0.f, 0.f, 0.f};
#pragma unroll 1
        for (int seg = 0; seg < NSEG; ++seg) {
            f32x4 acc[2][2];
#pragma unroll
            for (int i = 0; i < 2; ++i)
#pragma unroll
                for (int j = 0; j < 2; ++j) acc[i][j] = (f32x4){0.f, 0.f, 0.f, 0.f};
            const bf16_t* ap = A + (size_t)(rt * 32 + fr) * K + seg * kseg + w * kw + fq * 8;
            const bf16_t* bp = Bt + (size_t)(ct * 32 + fr) * K + seg * kseg + w * kw + fq * 8;
#pragma unroll 2
            for (int k = 0; k < kw; k += 32) {
                const bf16x8 a0 = *(const bf16x8*)(ap + k), a1 = *(const bf16x8*)(ap + (size_t)16 * K + k);
                const bf16x8 b0 = *(const bf16x8*)(bp + k), b1 = *(const bf16x8*)(bp + (size_t)16 * K + k);
                acc[0][0] = MFMA16(b0, a0, acc[0][0]); acc[0][1] = MFMA16(b1, a0, acc[0][1]);
                acc[1][0] = MFMA16(b0, a1, acc[1][0]); acc[1][1] = MFMA16(b1, a1, acc[1][1]);
            }
#pragma unroll
            for (int i = 0; i < 2; ++i)
#pragma unroll
                for (int j = 0; j < 2; ++j) {
                    if (MODE) {
                        const u32x2 gw = *(const u32x2*)(h + (size_t)(MP + rt * 32 + i * 16 + fr) * HP + HGATE + seg * 1024 + ct * 32 + j * 16 + 4 * fq);
                        f32x4 sg; sg[0] = sigmoidf_(bflo(gw.x)); sg[1] = sigmoidf_(bfhi(gw.x)); sg[2] = sigmoidf_(bflo(gw.y)); sg[3] = sigmoidf_(bfhi(gw.y));
                        tot[i][j] += acc[i][j] * sg;
                    } else tot[i][j] = acc[i][j];
                }
        }
        __syncthreads();
#pragma unroll
        for (int i = 0; i < 2; ++i)
#pragma unroll
            for (int j = 0; j < 2; ++j) *(LAS f32x4*)(part + (w * 32 + i * 16 + fr) * 36 + j * 16 + 4 * fq) = tot[i][j];
        __syncthreads();
        const int row = tid >> 4, c2 = (tid & 15) * 2;
        float v0 = 0.f, v1 = 0.f;
#pragma unroll
        for (int ww = 0; ww < 8; ++ww) { v0 += part[(ww * 32 + row) * 36 + c2]; v1 += part[(ww * 32 + row) * 36 + c2 + 1]; }
        const int r = MP + rt * 32 + row, c = ct * 32 + c2;
        if (MODE) {
            *(unsigned*)((bf16_t*)(P->ws + WS_ST) + (size_t)r * DM + c) = pk2(v0, v1);
        } else {
            float* xp = P->out + (size_t)r * DM + c;
            const float x0 = xp[0] + scale * v0, x1 = xp[1] + scale * v1;
            xp[0] = x0; xp[1] = x1;
            *(unsigned*)((bf16_t*)(P->ws + WS_XB) + (size_t)r * DM + c) = pk2(x0, x1);
            float ss = x0 * x0 + x1 * x1;
            ss += __shfl_xor(ss, 1); ss += __shfl_xor(ss, 2); ss += __shfl_xor(ss, 4); ss += __shfl_xor(ss, 8);
            if ((tid & 15) == 0) {
                float* ssq = (float*)(P->ws + WS_SSQ);
                if (ct < 16) ssq[(size_t)r * 16 + ct] = ss; else ssq[(WS_SSQ2 - WS_SSQ) / 4 + (size_t)(r - MP) * 16 + (ct - 16)] = ss;
            }
        }
    }
}

template <class RM>
__device__ __forceinline__ void cvt_tile(int wv, const float* src, int src_ld, int k0, int nsrc0, int nvalid, const float* gk, bf16_t* dst, int dst_ld, RM rowmap, LAS float* tile) {
    const int tid = tidx(wv);
    __syncthreads();
#pragma unroll
    for (int i = 0; i < 2; ++i) {
        const int kk = (tid >> 4) + 32 * i, n4 = (tid & 15) * 4;
        f32x4 v = (f32x4){0.f, 0.f, 0.f, 0.f};
        if (n4 < nvalid) v = *(const f32x4*)(src + (size_t)(k0 + kk) * src_ld + nsrc0 + n4);
        const float gsc = gk ? gk[k0 + kk] : 1.0f;
        tile[kk * 65 + n4 + 0] = v[0] * gsc; tile[kk * 65 + n4 + 1] = v[1] * gsc; tile[kk * 65 + n4 + 2] = v[2] * gsc; tile[kk * 65 + n4 + 3] = v[3] * gsc;
    }
    __syncthreads();
    const int nl = tid >> 3, k8 = (tid & 7) * 8;
    if (nl < nvalid) {
        u32x4 w;
        w.x = pk2(tile[(k8 + 0) * 65 + nl], tile[(k8 + 1) * 65 + nl]); w.y = pk2(tile[(k8 + 2) * 65 + nl], tile[(k8 + 3) * 65 + nl]);
        w.z = pk2(tile[(k8 + 4) * 65 + nl], tile[(k8 + 5) * 65 + nl]); w.w = pk2(tile[(k8 + 6) * 65 + nl], tile[(k8 + 7) * 65 + nl]);
        *(u32x4*)(dst + (size_t)rowmap(nl) * dst_ld + k0 + k8) = w;
    }
}

__device__ __forceinline__ void convert_layer(int wv, KP P, int l, LAS unsigned char* lds) {
    LAS float* tile = (LAS float*)lds;
    constexpr int J_GU = 2 * 2 * 16 * 44, J_DN = 2 * 44 * 16, J_IN = 16 * 145, J_BR = 48 * 16, J_OUT = 16 * 16, J_LRU = 32;
    constexpr int J_TOT = J_GU + J_DN + J_IN + J_BR + J_OUT + J_LRU;
    for (int job = bidx(); job < J_TOT; job += gdim()) {
        int j = job;
        if (j < J_GU) {
            const int nt = j % 44; j /= 44; const int kt = j % 16; j /= 16; const int which = j & 1, j2 = j >> 1;
            const float* src = P->in[which ? I_WU : I_WG] + (size_t)(l * 2 + j2) * 1024 * 2816;
            bf16_t* dst = (bf16_t*)(P->ws + (j2 ? W_GU1 : W_GU0));
            const int hc0 = nt * 64;
            cvt_tile(wv, src, 2816, kt * 64, hc0, 64, P->in[I_FNORM] + (l * 2 + j2) * 1024, dst, 1024,
                     [=](int nl) { const int hc = hc0 + nl; return 256 * (hc >> 7) + 128 * ((hc >> 6) & 1) + 32 * ((hc >> 4) & 3) + 16 * which + (hc & 15); }, tile);
            continue;
        }
        j -= J_GU;
        if (j < J_DN) {
            const int nt = j % 16; j /= 16; const int kt = j % 44; const int j2 = j / 44;
            const float* src = P->in[I_WD] + (size_t)(l * 2 + j2) * 2816 * 1024;
            bf16_t* dst = (bf16_t*)(P->ws + (j2 ? W_DN1 : W_DN0));
            const int n0 = nt * 64;
            cvt_tile(wv, src, 1024, kt * 64, n0, 64, nullptr, dst, 2816, [=](int nl) { return n0 + nl; }, tile);
            continue;
        }
        j -= J_DN;
        if (j < J_IN) {
            const int nt = j % 145, kt = j / 145;
            const float* src = P->in[I_WIN] + (size_t)l * 1024 * NIN;
            bf16_t* dst = (bf16_t*)(P->ws + W_IN);
            const int n0 = nt * 64;
            const int nsrc0 = nt < 72 ? n0 : (nt < 144 ? n0 + 16 : 4608);
            cvt_tile(wv, src, NIN, kt * 64, nsrc0, nt < 144 ? 64 : 16, P->in[I_MNORM] + l * 1024, dst, 1024, [=](int nl) { return n0 + nl; }, tile);
            continue;
        }
        j -= J_IN;
        if (j < J_BR) {
            const int nt = j % 16, kt = j / 16;
            const float* src = P->in[I_WBR] + (size_t)l * 3072 * 1024;
            bf16_t* dst = (bf16_t*)(P->ws + W_BR);
            const int n0 = nt * 64;
            cvt_tile(wv, src, 1024, kt * 64, n0, 64, nullptr, dst, 3072, [=](int nl) { return n0 + nl; }, tile);
            continue;
        }
        j -= J_BR;
        if (j < J_OUT) {
            const int nt = j % 16, kt = j / 16;
            const float* src = P->in[I_WOUT] + (size_t)l * 1024 * 1024;
            bf16_t* dst = (bf16_t*)(P->ws + W_OUT);
            const int n0 = nt * 64;
            cvt_tile(wv, src, 1024, kt * 64, n0, 64, nullptr, dst, 1024, [=](int nl) { return n0 + nl; }, tile);
            continue;
        }
        j -= J_OUT;
        {
            const int blk = j & 15, which = j >> 4;
            const float* src = P->in[which ? I_LWX : I_LWA] + (size_t)(l * 16 + blk) * 4096;
            bf16_t* dst = (bf16_t*)(P->ws + (which ? W_LX : W_LA)) + blk * 4096;
            cvt_tile(wv, src, 64, 0, 0, 64, nullptr, dst, 64, [=](int nl) { return nl; }, tile);
        }
    }
    __syncthreads();
}

__device__ __forceinline__ void phase_init(int wv, KP P) {
    const int w = tidx(wv) >> 6, lane = tidx(wv) & 63;
    float* x = P->out; bf16_t* xb = (bf16_t*)(P->ws + WS_XB); float* ssq = (float*)(P->ws + WS_SSQ);
    for (int row = bidx() * 8 + w; row < MT; row += gdim() * 8) {
        const float* src = row < MP ? P->in[I_XP] + (size_t)row * DM : P->in[I_XS] + (size_t)(row - MP) * DM;
        float ss = 0.f;
#pragma unroll
        for (int i = 0; i < 4; ++i) {
            const int c = (i * 64 + lane) * 4;
            const f32x4 v = *(const f32x4*)(src + c);
            *(f32x4*)(x + (size_t)row * DM + c) = v;
            u32x2 pw; pw.x = pk2(v[0], v[1]); pw.y = pk2(v[2], v[3]);
            *(u32x2*)(xb + (size_t)row * DM + c) = pw;
            ss += v[0] * v[0] + v[1] * v[1] + v[2] * v[2] + v[3] * v[3];
        }
#pragma unroll
        for (int d = 32; d >= 1; d >>= 1) ss += __shfl_xor(ss, d);
        if (lane < 16) ssq[(size_t)row * 16 + lane] = lane == 0 ? ss : 0.f;
        if (row >= MP && lane < 16) ssq[(WS_SSQ2 - WS_SSQ) / 4 + (size_t)(row - MP) * 16 + lane] = 0.f;
    }
}
__device__ __forceinline__ void phase_final(int wv, KP P) {
    const int w = tidx(wv) >> 6, lane = tidx(wv) & 63;
    float* x = P->out; const float* ssq = (const float*)(P->ws + WS_SSQ); const float* gf = P->in[I_FINAL];
    for (int row = bidx() * 8 + w; row < MT; row += gdim() * 8) {
        const float rs = rstd_row(ssq, row);
#pragma unroll
        for (int i = 0; i < 4; ++i) {
            const int c = (i * 64 + lane) * 4;
            f32x4 v = *(const f32x4*)(x + (size_t)row * DM + c); const f32x4 g = *(const f32x4*)(gf + c);
            v = v * rs * g;
            *(f32x4*)(x + (size_t)row * DM + c) = v;
        }
    }
}

struct Item { int row0, L, b, c, sb, sample; };
__device__ __forceinline__ Item get_item(int it) {
    Item I;
    if (it < 256) { I.b = it >> 7; I.c = it & 127; I.row0 = I.b * 8192 + I.c * 64; I.L = 64; I.sample = 0; I.sb = 0; }
    else { I.sb = it - 256; I.b = 0; I.c = 0; I.row0 = MP + I.sb * 16; I.L = 16; I.sample = 1; }
    return I;
}

__device__ __forceinline__ void copy_states_item(int wv, KP P, int l, const Item& I) {
    const bf16_t* h = (const bf16_t*)(P->ws + WS_H);
    const int tid = tidx(wv);
    if (!I.sample) {
        if (I.c >= 126) {
            for (int idx = tid; idx < 64 * 512; idx += 512) {
                const int t = idx >> 9, cc = idx & 511, kv = cc >> 8, e = cc & 255;
                const float v = bf2f(h[(size_t)(I.row0 + t) * HP + (kv ? HV : HK) + e]);
                P->out[(kv ? O_PV : O_PK) + ((size_t)(l * 2 + I.b) * 128 + (I.c - 126) * 64 + t) * 256 + e] = v;
            }
        }
        if (I.c == 127) {
            for (int idx = tid; idx < 3 * 1024; idx += 512) { const int j = idx >> 10, ch = idx & 1023;
                P->out[O_PLC + ((size_t)(l * 2 + I.b) * 3 + j) * 1024 + ch] = bf2f(h[(size_t)(I.row0 + 61 + j) * HP + HX + ch]); }
            for (int idx = tid; idx < 3 * 1536; idx += 512) { const int j = idx / 1536, ch = idx % 1536;
                P->out[O_PSC + ((size_t)(l * 2 + I.b) * 3 + j) * 1536 + ch] = bf2f(h[(size_t)(I.row0 + 61 + j) * HP + HXBC + ch]); }
        }
    } else {
        for (int idx = tid; idx < 128 * 512; idx += 512) {
            const int j = idx >> 9, cc = idx & 511, kv = cc >> 8, e = cc & 255;
            float v;
            if (j < 112) v = P->in[kv ? I_CV : I_CK][((size_t)(l * 16 + I.sb) * 128 + j + 16) * 256 + e];
            else v = bf2f(h[(size_t)(I.row0 + j - 112) * HP + (kv ? HV : HK) + e]);
            P->out[(kv ? O_SV : O_SK) + ((size_t)(l * 16 + I.sb) * 128 + j) * 256 + e] = v;
        }
        for (int idx = tid; idx < 3 * 1024; idx += 512) { const int j = idx >> 10, ch = idx & 1023;
            P->out[O_SLC + ((size_t)(l * 16 + I.sb) * 3 + j) * 1024 + ch] = bf2f(h[(size_t)(I.row0 + 13 + j) * HP + HX + ch]); }
        for (int idx = tid; idx < 3 * 1536; idx += 512) { const int j = idx / 1536, ch = idx % 1536;
            P->out[O_SSC + ((size_t)(l * 16 + I.sb) * 3 + j) * 1536 + ch] = bf2f(h[(size_t)(I.row0 + 13 + j) * HP + HXBC + ch]); }
    }
}

template <int L>
__device__ __forceinline__ void attn_item(int wv, KP P, int l, const Item& I, LAS unsigned char* lds) {
    constexpr int NS = (L == 64) ? 192 : 160;
    constexpr int NST = NS / 16, NKS = NS / 32, NQT = L / 16;
    const bf16_t* h = (const bf16_t*)(P->ws + WS_H);
    bf16_t* yabc = (bf16_t*)(P->ws + WS_Y);
    const int tid = tidx(wv), w = tid >> 6, lane = tid & 63, fr = lane & 15, fq = lane >> 4;
    LAS bf16_t* Kl = (LAS bf16_t*)lds;
    LAS bf16_t* Vt = Kl + 2 * 192 * 72;
    for (int pass = 0; pass < 2; ++pass) {
        __syncthreads();
        for (int idx = tid; idx < 2 * NS * 8; idx += 512) {
            const int dp = idx & 7, s = (idx >> 3) % NS, kvl = idx / (8 * NS), kvh = pass * 2 + kvl;
            u32x4 kw = (u32x4){0u, 0u, 0u, 0u}, vw = (u32x4){0u, 0u, 0u, 0u};
            if (L == 64) {
                const int pos = (I.c - 2) * 64 + s;
                if (pos >= 0) {
                    const bf16_t* rp = h + (size_t)(I.b * 8192 + pos) * HP + kvh * 64 + dp * 8;
                    kw = *(const u32x4*)(rp + HK); vw = *(const u32x4*)(rp + HV);
                }
            } else {
                if (s < 128) {
                    const size_t o = ((size_t)(l * 16 + I.sb) * 128 + s) * 256 + kvh * 64 + dp * 8;
                    const f32x4 k0 = *(const f32x4*)(P->in[I_CK] + o), k1 = *(const f32x4*)(P->in[I_CK] + o + 4);
                    const f32x4 v0 = *(const f32x4*)(P->in[I_CV] + o), v1 = *(const f32x4*)(P->in[I_CV] + o + 4);
                    kw.x = pk2(k0[0], k0[1]); kw.y = pk2(k0[2], k0[3]); kw.z = pk2(k1[0], k1[1]); kw.w = pk2(k1[2], k1[3]);
                    vw.x = pk2(v0[0], v0[1]); vw.y = pk2(v0[2], v0[3]); vw.z = pk2(v1[0], v1[1]); vw.w = pk2(v1[2], v1[3]);
                } else if (s < 144) {
                    const bf16_t* rp = h + (size_t)(I.row0 + s - 128) * HP + kvh * 64 + dp * 8;
                    kw = *(const u32x4*)(rp + HK); vw = *(const u32x4*)(rp + HV);
                }
            }
            *(LAS u32x4*)(Kl + (kvl * 192 + s) * 72 + dp * 8) = kw;
            LAS bf16_t* vp = Vt + (kvl * 64 + dp * 8) * 200 + s;
            vp[0 * 200] = (bf16_t)(vw.x & 0xffffu); vp[1 * 200] = (bf16_t)(vw.x >> 16); vp[2 * 200] = (bf16_t)(vw.y & 0xffffu); vp[3 * 200] = (bf16_t)(vw.y >> 16);
            vp[4 * 200] = (bf16_t)(vw.z & 0xffffu); vp[5 * 200] = (bf16_t)(vw.z >> 16); vp[6 * 200] = (bf16_t)(vw.w & 0xffffu); vp[7 * 200] = (bf16_t)(vw.w >> 16);
        }
        __syncthreads();
        const int head = pass * 8 + w, kvl = w >> 2;
        const float slope = exp2f(-0.5f * (float)(head + 1));
        const float sink = P->in[I_SINK][l * 16 + head];
#pragma unroll 1
        for (int qt = 0; qt < NQT; ++qt) {
            const bf16_t* qp = h + (size_t)(I.row0 + qt * 16 + fr) * HP + HQ + head * 64 + fq * 8;
            const bf16x8 q0 = *(const bf16x8*)qp, q1 = *(const bf16x8*)(qp + 32);
            f32x4 st[NST];
#pragma unroll
            for (int t = 0; t < NST; ++t) {
                const LAS bf16_t* kp = Kl + (kvl * 192 + t * 16 + fr) * 72 + fq * 8;
                f32x4 a = (f32x4){0.f, 0.f, 0.f, 0.f};
                a = MFMA16(*(const LAS bf16x8*)kp, q0, a);
                a = MFMA16(*(const LAS bf16x8*)(kp + 32), q1, a);
                st[t] = a;
                __builtin_amdgcn_sched_barrier(0);
            }
            const int qpos = (L == 64) ? (I.c * 64 + qt * 16 + fr) : (4096 + fr);
            float mx = sink;
#pragma unroll
            for (int t = 0; t < NST; ++t)
#pragma unroll
                for (int jj = 0; jj < 4; ++jj) {
                    const int s = t * 16 + fq * 4 + jj;
                    const int kpos = (L == 64) ? ((I.c - 2) * 64 + s) : (3968 + s);
                    const bool vis = (L == 64) ? (kpos >= 0) : (s < 144);
                    const float d = fabsf((float)(qpos - kpos));
                    const float sc = vis ? (st[t][jj] * 0.125f - slope * d) : -INFINITY;
                    st[t][jj] = sc; mx = fmaxf(mx, sc);
                }
            mx = fmaxf(mx, __shfl_xor(mx, 16)); mx = fmaxf(mx, __shfl_xor(mx, 32));
            float sum = 0.f;
#pragma unroll
            for (int t = 0; t < NST; ++t)
#pragma unroll
                for (int jj = 0; jj < 4; ++jj) { const float p = __expf(st[t][jj] - mx); st[t][jj] = p; sum += p; }
            sum += __shfl_xor(sum, 16); sum += __shfl_xor(sum, 32);
            const float inv = 1.0f / (sum + __expf(sink - mx));
            f32x4 o[4];
#pragma unroll
            for (int dt = 0; dt < 4; ++dt) o[dt] = (f32x4){0.f, 0.f, 0.f, 0.f};
#pragma unroll
            for (int ks = 0; ks < NKS; ++ks) {
                u32x4 pw; pw.x = pk2(st[2 * ks][0], st[2 * ks][1]); pw.y = pk2(st[2 * ks][2], st[2 * ks][3]);
                pw.z = pk2(st[2 * ks + 1][0], st[2 * ks + 1][1]); pw.w = pk2(st[2 * ks + 1][2], st[2 * ks + 1][3]);
                bf16x8 pf; __builtin_memcpy(&pf, &pw, 16);
#pragma unroll
                for (int dt = 0; dt < 4; ++dt) {
                    const LAS bf16_t* vp = Vt + (kvl * 64 + dt * 16 + fr) * 200 + ks * 32 + fq * 4;
                    const u32x2 va = *(const LAS u32x2*)vp, vb = *(const LAS u32x2*)(vp + 16);
                    u32x4 vw; vw.x = va.x; vw.y = va.y; vw.z = vb.x; vw.w = vb.y;
                    bf16x8 vf; __builtin_memcpy(&vf, &vw, 16);
                    o[dt] = MFMA16(vf, pf, o[dt]);
                }
            }
            bf16_t* op = yabc + (size_t)(I.row0 + qt * 16 + fr) * 3072 + 2048 + head * 64 + fq * 4;
#pragma unroll
            for (int dt = 0; dt < 4; ++dt) {
                u32x2 ow; ow.x = pk2(o[dt][0] * inv, o[dt][1] * inv); ow.y = pk2(o[dt][2] * inv, o[dt][3] * inv);
                *(u32x2*)(op + dt * 16) = ow;
            }
        }
    }
}

template <int L, bool FINAL>
__device__ __forceinline__ void lru_item(int wv, KP P, int l, int item, const Item& I, LAS unsigned char* lds) {
    constexpr int NIT = L / 16;
    const bf16_t* h = (const bf16_t*)(P->ws + WS_H);
    bf16_t* yabc = (bf16_t*)(P->ws + WS_Y);
    float* lruA = (float*)(P->ws + WS_LRUA); float* lruU = (float*)(P->ws + WS_LRUU);
    const int tid = tidx(wv), w = tid >> 6, lane = tid & 63, fr = lane & 15, fq = lane >> 4;
    LAS bf16_t* xa = (LAS bf16_t*)lds + w * (64 * 72);
    for (int pass = 0; pass < 2; ++pass) {
        const int blk = w + 8 * pass, ch0 = blk * 64;
        __syncthreads();
        {
            const int ch = ch0 + lane;
            const float* cw = P->in[I_LCW] + (size_t)l * 4 * 1024 + ch;
            const float w0 = cw[0], w1 = cw[1024], w2 = cw[2048], w3 = cw[3072], cb = P->in[I_LCB][l * 1024 + ch];
            float xm3 = 0.f, xm2 = 0.f, xm1 = 0.f;
            if (I.sample) { const float* st = P->in[I_SLC] + (size_t)(l * 16 + I.sb) * 3 * 1024 + ch; xm3 = st[0]; xm2 = st[1024]; xm1 = st[2048]; }
            else if (I.c > 0) { const bf16_t* hp = h + (size_t)(I.row0 - 3) * HP + HX + ch; xm3 = bf2f(hp[0]); xm2 = bf2f(hp[HP]); xm1 = bf2f(hp[2 * (size_t)HP]); }
            const bf16_t* hp = h + (size_t)I.row0 * HP + HX + ch;
#pragma unroll 8
            for (int t = 0; t < L; ++t) {
                const float x0 = bf2f(hp[(size_t)t * HP]);
                const float y = cb + w0 * xm3 + w1 * xm2 + w2 * xm1 + w3 * x0;
                xa[t * 72 + lane] = f2bf(y);
                xm3 = xm2; xm2 = xm1; xm1 = x0;
            }
        }
        __syncthreads();
        const bf16_t* waT = (const bf16_t*)(P->ws + W_LA) + blk * 4096;
        const bf16_t* wxT = (const bf16_t*)(P->ws + W_LX) + blk * 4096;
        float carryH[4][4], carryA[4][4], c8v[4][4];
#pragma unroll
        for (int jt = 0; jt < 4; ++jt)
#pragma unroll
            for (int jj = 0; jj < 4; ++jj) {
                const int ch = ch0 + jt * 16 + fq * 4 + jj;
                carryA[jt][jj] = 1.0f;
                c8v[jt][jj] = 8.0f * softplusf_(-P->in[I_LLAM][l * 1024 + ch]);
                if (FINAL) carryH[jt][jj] = I.sample ? P->in[I_SLH][(l * 16 + I.sb) * 1024 + ch] : lruU[(size_t)item * 1024 + ch];
                else carryH[jt][jj] = 0.f;
            }
#pragma unroll 1
        for (int it = 0; it < NIT; ++it) {
            const LAS bf16_t* xp = xa + (it * 16 + fr) * 72;
            const bf16x8 b0 = *(const LAS bf16x8*)(xp + fq * 8), b1 = *(const LAS bf16x8*)(xp + 32 + fq * 8);
            const int token = it * 16 + fr;
#pragma unroll
            for (int jt = 0; jt < 4; ++jt) {
                const bf16_t* wa = waT + (jt * 16 + fr) * 64 + fq * 8; const bf16_t* wx = wxT + (jt * 16 + fr) * 64 + fq * 8;
                f32x4 ra = (f32x4){0.f, 0.f, 0.f, 0.f}, ia = (f32x4){0.f, 0.f, 0.f, 0.f};
                ra = MFMA16(*(const bf16x8*)wa, b0, ra); ra = MFMA16(*(const bf16x8*)(wa + 32), b1, ra);
                ia = MFMA16(*(const bf16x8*)wx, b0, ia); ia = MFMA16(*(const bf16x8*)(wx + 32), b1, ia);
                const u32x2 xw = *(const LAS u32x2*)(xp + jt * 16 + fq * 4);
                const float xv[4] = {bflo(xw.x), bfhi(xw.x), bflo(xw.y), bfhi(xw.y)};
                float hv[4];
#pragma unroll
                for (int jj = 0; jj < 4; ++jj) {
                    const int ch = ch0 + jt * 16 + fq * 4 + jj;
                    const float r = sigmoidf_(ra[jj] + P->in[I_LBA][l * 1024 + ch]);
                    const float ig = sigmoidf_(ia[jj] + P->in[I_LBX][l * 1024 + ch]);
                    const float la = -c8v[jt][jj] * r;
                    float a = __expf(la);
                    float u = sqrtf(fmaxf(1.0f - a * a, 0.f)) * ig * xv[jj];
#pragma unroll
                    for (int d = 1; d < 16; d <<= 1) {
                        const float ap = __shfl_up(a, d, 16), up = __shfl_up(u, d, 16);
                        if (fr >= d) { u = a * up + u; a = a * ap; }
                    }
                    const float hval = a * carryH[jt][jj] + u;
                    hv[jj] = hval;
                    carryH[jt][jj] = __shfl(hval, 15, 16);
                    if (!FINAL) carryA[jt][jj] = carryA[jt][jj] * __shfl(a, 15, 16);
                }
                if (FINAL) {
                    const u32x2 gw = *(const u32x2*)(h + (size_t)(I.row0 + token) * HP + HG + ch0 + jt * 16 + fq * 4);
                    u32x2 ow; ow.x = pk2(hv[0] * gelu_tanh(bflo(gw.x)), hv[1] * gelu_tanh(bfhi(gw.x)));
                    ow.y = pk2(hv[2] * gelu_tanh(bflo(gw.y)), hv[3] * gelu_tanh(bfhi(gw.y)));
                    *(u32x2*)(yabc + (size_t)(I.row0 + token) * 3072 + ch0 + jt * 16 + fq * 4) = ow;
                    if (it == NIT - 1 && fr == 15) {
                        if (I.sample) *(f32x4*)(P->out + O_SLH + (size_t)(l * 16 + I.sb) * 1024 + ch0 + jt * 16 + fq * 4) = (f32x4){hv[0], hv[1], hv[2], hv[3]};
                        else if (I.c == 127) *(f32x4*)(P->out + O_PLH + (size_t)(l * 2 + I.b) * 1024 + ch0 + jt * 16 + fq * 4) = (f32x4){hv[0], hv[1], hv[2], hv[3]};
                    }
                }
            }
        }
        if (!FINAL) {
            if (fr == 0) {
#pragma unroll
                for (int jt = 0; jt < 4; ++jt) {
                    *(f32x4*)(lruA + (size_t)item * 1024 + ch0 + jt * 16 + fq * 4) = (f32x4){carryA[jt][0], carryA[jt][1], carryA[jt][2], carryA[jt][3]};
                    *(f32x4*)(lruU + (size_t)item * 1024 + ch0 + jt * 16 + fq * 4) = (f32x4){carryH[jt][0], carryH[jt][1], carryH[jt][2], carryH[jt][3]};
                }
            }
        }
    }
}

__device__ __forceinline__ float pre_xbc(KP P, const bf16_t* h, int l, const Item& I, int tt, int ch) {
    if (tt >= 0 || (!I.sample && I.c > 0)) return bf2f(h[(size_t)(I.row0 + tt) * HP + HXBC + ch]);
    if (I.sample) return P->in[I_SSC][((size_t)(l * 16 + I.sb) * 3 + (3 + tt)) * 1536 + ch];
    return 0.f;
}
__device__ __forceinline__ float conv_xbc(KP P, const bf16_t* h, int l, const Item& I, int t, int ch) {
    const float* cw = P->in[I_SCW] + (size_t)l * 4 * 1536 + ch;
    float y = P->in[I_SCB][l * 1536 + ch];
    y += cw[0] * pre_xbc(P, h, l, I, t - 3, ch); y += cw[1536] * pre_xbc(P, h, l, I, t - 2, ch);
    y += cw[3072] * pre_xbc(P, h, l, I, t - 1, ch); y += cw[4608] * pre_xbc(P, h, l, I, t, ch);
    return siluf_(y);
}
template <class F>
__device__ __forceinline__ void conv_roll(KP P, const bf16_t* h, int l, const Item& I, int chx, int t0, int t1, F f) {
    const float* cw = P->in[I_SCW] + (size_t)l * 4 * 1536 + chx;
    const float w0 = cw[0], w1 = cw[1536], w2 = cw[3072], w3 = cw[4608], cb = P->in[I_SCB][l * 1536 + chx];
    float xm3 = pre_xbc(P, h, l, I, t0 - 3, chx), xm2 = pre_xbc(P, h, l, I, t0 - 2, chx), xm1 = pre_xbc(P, h, l, I, t0 - 1, chx);
    const bf16_t* hp = h + (size_t)I.row0 * HP + HXBC + chx;
#pragma unroll 8
    for (int t = t0; t < t1; ++t) {
        const float x0 = bf2f(hp[(size_t)t * HP]);
        const float y = cb + w0 * xm3 + w1 * xm2 + w2 * xm1 + w3 * x0;
        f(t, siluf_(y));
        xm3 = xm2; xm2 = xm1; xm1 = x0;
    }
}
template <int L>
__device__ __forceinline__ void ssd_dtcum(int wv, KP P, int l, const Item& I, LAS float* dtv, LAS float* cumv) {
    const float* dtraw = (const float*)(P->ws + WS_DT);
    const int tid = tidx(wv);
    __syncthreads();
    for (int idx = tid; idx < L * 16; idx += 512) { const int hd = idx & 15; dtv[idx] = softplusf_(dtraw[(size_t)I.row0 * 16 + idx] + P->in[I_SDTB][l * 16 + hd]); }
    __syncthreads();
    if (tid < 64) {
        constexpr int SEG = L / 4;
        const int hd = tid & 15, sg = tid >> 4;
        const float A = -__expf(P->in[I_SALOG][l * 16 + hd]);
        float c = 0.f;
#pragma unroll
        for (int t = 0; t < SEG; ++t) { c += dtv[(sg * SEG + t) * 16 + hd] * A; cumv[(sg * SEG + t) * 16 + hd] = c; }
        const float t1 = __shfl(c, hd), t2 = __shfl(c, 16 + hd), t3 = __shfl(c, 32 + hd);
        const float off = sg == 0 ? 0.f : (sg == 1 ? t1 : (sg == 2 ? t1 + t2 : t1 + t2 + t3));
#pragma unroll
        for (int t = 0; t < SEG; ++t) cumv[(sg * SEG + t) * 16 + hd] += off;
    }
    __syncthreads();
}

template <int L>
__device__ __forceinline__ void ssd_states_item(int wv, KP P, int l, int item, const Item& I, LAS unsigned char* lds) {
    constexpr int LP = L < 32 ? 32 : L, KS = LP / 32;
    const bf16_t* h = (const bf16_t*)(P->ws + WS_H);
    bf16_t* states = (bf16_t*)(P->ws + WS_ST);
    float* cdec = (float*)(P->ws + WS_CDEC);
    const int tid = tidx(wv), w = tid >> 6, lane = tid & 63, fr = lane & 15, fq = lane >> 4;
    LAS float* dtv = (LAS float*)lds; LAS float* cumv = dtv + 1024;
    LAS bf16_t* BmT = (LAS bf16_t*)(lds + 8192);
    LAS bf16_t* xw = (LAS bf16_t*)(lds + 8192 + 36864) + w * (64 * 72);
    ssd_dtcum<L>(wv, P, l, I, dtv, cumv);
    {
        const int chB = tid & 255, half = tid >> 8;
        conv_roll(P, h, l, I, 1024 + chB, half * (L / 2), (half + 1) * (L / 2), [&](int t, float v) { BmT[chB * 72 + t] = f2bf(v); });
        if (L < LP) for (int j = L + half * ((LP - L) / 2); j < L + (half + 1) * ((LP - L) / 2); ++j) BmT[chB * 72 + j] = 0;
    }
    for (int hh = 0; hh < 2; ++hh) {
        const int head = w + 8 * hh;
        const float cl = cumv[(L - 1) * 16 + head];
        __syncthreads();
        conv_roll(P, h, l, I, head * 64 + lane, 0, L, [&](int t, float v) { xw[lane * 72 + t] = f2bf(v * __expf(cl - cumv[t * 16 + head]) * dtv[t * 16 + head]); });
        for (int j = L; j < LP; ++j) xw[lane * 72 + j] = 0;
        __syncthreads();
        const float dec = __expf(cl);
        if (!I.sample && lane == 0) cdec[item * 16 + head] = dec;
#pragma unroll 1
        for (int nt = 0; nt < 8; ++nt) {
            bf16x8 af[KS];
#pragma unroll
            for (int ks = 0; ks < KS; ++ks) af[ks] = *(const LAS bf16x8*)(BmT + (hh * 128 + nt * 16 + fr) * 72 + ks * 32 + fq * 8);
#pragma unroll
            for (int pt = 0; pt < 4; ++pt) {
                f32x4 a = (f32x4){0.f, 0.f, 0.f, 0.f};
#pragma unroll
                for (int ks = 0; ks < KS; ++ks) a = MFMA16(af[ks], *(const LAS bf16x8*)(xw + (pt * 16 + fr) * 72 + ks * 32 + fq * 8), a);
                const int p = pt * 16 + fr, n0 = nt * 16 + fq * 4;
                if (!I.sample) {
                    u32x2 ow; ow.x = pk2(a[0], a[1]); ow.y = pk2(a[2], a[3]);
                    *(u32x2*)(states + ((size_t)((I.b * 128 + I.c) * 16 + head) * 64 + p) * 128 + n0) = ow;
                } else {
                    const size_t o = ((size_t)((l * 16 + I.sb) * 16 + head) * 64 + p) * 128 + n0;
                    const f32x4 h0 = *(const f32x4*)(P->in[I_SSH] + o);
                    *(f32x4*)(P->out + O_SSH + o) = h0 * dec + a;
                }
            }
        }
    }
}

template <int L>
__device__ __forceinline__ void ssd_y_item(int wv, KP P, int l, const Item& I, LAS unsigned char* lds) {
    constexpr int LP = L < 32 ? 32 : L, KS = LP / 32, NIT = L / 16;
    const bf16_t* h = (const bf16_t*)(P->ws + WS_H);
    const bf16_t* states = (const bf16_t*)(P->ws + WS_ST);
    bf16_t* yabc = (bf16_t*)(P->ws + WS_Y);
    const int tid = tidx(wv), w = tid >> 6, lane = tid & 63, fr = lane & 15, fq = lane >> 4;
    LAS float* dtv = (LAS float*)lds; LAS float* cumv = dtv + 1024;
    LAS bf16_t* Bm = (LAS bf16_t*)(lds + 8192);
    LAS bf16_t* Cm = (LAS bf16_t*)(lds + 8192 + 17408);
    LAS float* CBl = (LAS float*)(lds + 8192 + 2 * 17408);
    LAS float* part = (LAS float*)(lds + 8192 + 3 * 17408);
    LAS bf16_t* xT = (LAS bf16_t*)(lds + 8192 + 3 * 17408 + 2048) + w * (64 * 72);
    ssd_dtcum<L>(wv, P, l, I, dtv, cumv);
    for (int g = 0; g < 2; ++g) {
        const int head = g * 8 + w;
        __syncthreads();
        {
            const int cc = tid & 255, half = tid >> 8, which = cc >> 7, n = cc & 127;
            LAS bf16_t* dstm = which ? Cm : Bm;
            conv_roll(P, h, l, I, 1024 + which * 256 + g * 128 + n, half * (L / 2), (half + 1) * (L / 2), [&](int t, float v) { dstm[t * 136 + n] = f2bf(v); });
        }
        conv_roll(P, h, l, I, head * 64 + lane, 0, L, [&](int t, float v) { xT[lane * 72 + t] = f2bf(v); });
        for (int j = L; j < LP; ++j) xT[lane * 72 + j] = 0;
        __syncthreads();
        for (int tix = w; tix < NIT * NIT; tix += 8) {
            const int it = tix / NIT, jt = tix % NIT;
            f32x4 a = (f32x4){0.f, 0.f, 0.f, 0.f};
#pragma unroll
            for (int ks = 0; ks < 4; ++ks)
                a = MFMA16(*(const LAS bf16x8*)(Cm + (it * 16 + fr) * 136 + ks * 32 + fq * 8), *(const LAS bf16x8*)(Bm + (jt * 16 + fr) * 136 + ks * 32 + fq * 8), a);
#pragma unroll
            for (int jj = 0; jj < 4; ++jj) CBl[(it * 16 + fq * 4 + jj) * 68 + jt * 16 + fr] = a[jj];
        }
        __syncthreads();
        const float dsk = P->in[I_SD][l * 16 + head];
#pragma unroll 1
        for (int it = 0; it < NIT; ++it) {
            const int i = it * 16 + fr; const float cum_i = cumv[i * 16 + head];
            f32x4 acc[4];
#pragma unroll
            for (int pt = 0; pt < 4; ++pt) acc[pt] = (f32x4){0.f, 0.f, 0.f, 0.f};
#pragma unroll
            for (int ks = 0; ks < KS; ++ks) {
                if (ks * 32 > it * 16 + 15) continue;
                const int j0 = ks * 32 + fq * 8;
                const f32x4 c0 = *(const LAS f32x4*)(CBl + i * 68 + j0), c1 = *(const LAS f32x4*)(CBl + i * 68 + j0 + 4);
                float wv8[8];
#pragma unroll
                for (int e = 0; e < 8; ++e) {
                    const int j = j0 + e; const float cb = e < 4 ? c0[e & 3] : c1[e & 3];
                    const float ex = __expf(fminf(cum_i - cumv[j * 16 + head], 0.f));
                    wv8[e] = (j <= i) ? cb * ex * dtv[j * 16 + head] : 0.f;
                }
                u32x4 ww; ww.x = pk2(wv8[0], wv8[1]); ww.y = pk2(wv8[2], wv8[3]); ww.z = pk2(wv8[4], wv8[5]); ww.w = pk2(wv8[6], wv8[7]);
                bf16x8 wf; __builtin_memcpy(&wf, &ww, 16);
#pragma unroll
                for (int pt = 0; pt < 4; ++pt) acc[pt] = MFMA16(*(const LAS bf16x8*)(xT + (pt * 16 + fr) * 72 + j0), wf, acc[pt]);
            }
            const float ecum = __expf(cum_i);
            bf16x8 cf[4];
#pragma unroll
            for (int ks = 0; ks < 4; ++ks) cf[ks] = *(const LAS bf16x8*)(Cm + i * 136 + ks * 32 + fq * 8);
#pragma unroll
            for (int pt = 0; pt < 4; ++pt) {
                bf16x8 hf[4];
                const int p = pt * 16 + fr;
                if (!I.sample) {
                    const bf16_t* sp = states + ((size_t)((I.b * 128 + I.c) * 16 + head) * 64 + p) * 128 + fq * 8;
#pragma unroll
                    for (int ks = 0; ks < 4; ++ks) hf[ks] = *(const bf16x8*)(sp + ks * 32);
                } else {
                    const float* sp = P->in[I_SSH] + ((size_t)((l * 16 + I.sb) * 16 + head) * 64 + p) * 128 + fq * 8;
#pragma unroll
                    for (int ks = 0; ks < 4; ++ks) {
                        const f32x4 a0 = *(const f32x4*)(sp + ks * 32), a1 = *(const f32x4*)(sp + ks * 32 + 4);
                        u32x4 ww; ww.x = pk2(a0[0], a0[1]); ww.y = pk2(a0[2], a0[3]); ww.z = pk2(a1[0], a1[1]); ww.w = pk2(a1[2], a1[3]);
                        __builtin_memcpy(&hf[ks], &ww, 16);
                    }
                }
                f32x4 t2 = (f32x4){0.f, 0.f, 0.f, 0.f};
#pragma unroll
                for (int ks = 0; ks < 4; ++ks) t2 = MFMA16(hf[ks], cf[ks], t2);
                acc[pt] += t2 * ecum;
            }
            float ss = 0.f;
#pragma unroll
            for (int pt = 0; pt < 4; ++pt) {
                const int p0 = pt * 16 + fq * 4;
                const u32x2 zw = *(const u32x2*)(h + (size_t)(I.row0 + i) * HP + HZ + head * 64 + p0);
                const float zv[4] = {bflo(zw.x), bfhi(zw.x), bflo(zw.y), bfhi(zw.y)};
                float yv[4];
#pragma unroll
                for (int jj = 0; jj < 4; ++jj) {
                    const float xs = bf2f(xT[(p0 + jj) * 72 + i]);
                    const float y = (acc[pt][jj] + dsk * xs) * siluf_(zv[jj]);
                    yv[jj] = y; ss += y * y;
                }
                u32x2 ow; ow.x = pk2(yv[0], yv[1]); ow.y = pk2(yv[2], yv[3]);
                *(u32x2*)(yabc + (size_t)(I.row0 + i) * 3072 + 1024 + head * 64 + p0) = ow;
            }
            ss += __shfl_xor(ss, 16); ss += __shfl_xor(ss, 32);
            if (fq == 0) part[i * 8 + w] = ss;
        }
        __syncthreads();
#pragma unroll 1
        for (int it = 0; it < NIT; ++it) {
            const int i = it * 16 + fr;
            const f32x4 pa = *(const LAS f32x4*)(part + i * 8), pb = *(const LAS f32x4*)(part + i * 8 + 4);
            const float tot = (pa[0] + pa[1] + pa[2] + pa[3]) + (pb[0] + pb[1] + pb[2] + pb[3]);
            const float rs = rsqrtf(tot * (1.0f / 512.0f) + EPS);
#pragma unroll
            for (int pt = 0; pt < 4; ++pt) {
                const int p0 = pt * 16 + fq * 4;
                const f32x4 ng = *(const f32x4*)(P->in[I_SNORM] + l * 1024 + head * 64 + p0);
                u32x2* yp = (u32x2*)(yabc + (size_t)(I.row0 + i) * 3072 + 1024 + head * 64 + p0);
                const u32x2 yw = *yp;
                u32x2 ow; ow.x = pk2(bflo(yw.x) * rs * ng[0], bfhi(yw.x) * rs * ng[1]); ow.y = pk2(bflo(yw.y) * rs * ng[2], bfhi(yw.y) * rs * ng[3]);
                *yp = ow;
            }
        }
    }
}

__device__ __forceinline__ void phase_scan(int wv, KP P, int l) {
    bf16_t* states = (bf16_t*)(P->ws + WS_ST);
    const float* cdec = (const float*)(P->ws + WS_CDEC);
    const float* lruA = (const float*)(P->ws + WS_LRUA); float* lruU = (float*)(P->ws + WS_LRUU);
    if (DBG_P5S) for (int idx = bidx() * 512 + tidx(wv); idx < 131072; idx += gdim() * 512) {
        const int e = idx * 2, b = e >> 17, rem = e & 131071, head = rem >> 13;
        unsigned* sp = (unsigned*)(states + (size_t)b * 128 * 131072 + rem);
        const float* dp = cdec + (b * 128) * 16 + head;
        float c0 = 0.f, c1 = 0.f;
        for (int c = 0; c < 128; c += 8) {
            unsigned v[8];
#pragma unroll
            for (int k = 0; k < 8; ++k) v[k] = sp[(size_t)(c + k) * 65536];
#pragma unroll
            for (int k = 0; k < 8; ++k) {
                const float dec = dp[(c + k) * 16];
                if (DBG_P5W) sp[(size_t)(c + k) * 65536] = pk2(c0, c1);
                c0 = dec * c0 + bflo(v[k]); c1 = dec * c1 + bfhi(v[k]);
            }
        }
        float* op = P->out + O_PSH + (size_t)(l * 2 + b) * 131072 + rem;
        op[0] = c0; op[1] = c1;
    }
    if (DBG_LRU4) for (int idx = bidx() * 512 + tidx(wv); idx < 2048; idx += gdim() * 512) {
        const int b = idx >> 10, ch = idx & 1023;
        float carry = 0.f;
        for (int c = 0; c < 128; ++c) {
            const size_t o = (size_t)(b * 128 + c) * 1024 + ch;
            const float A = lruA[o], U = lruU[o];
            lruU[o] = carry;
            carry = A * carry + U;
        }
    }
}

__device__ __forceinline__ void gsync(cg::grid_group& grid) {
    __threadfence(); grid.sync();
    __builtin_amdgcn_fence(__ATOMIC_ACQUIRE, "agent"); asm volatile("s_waitcnt vmcnt(0)" ::: "memory");
}
#define XB_TMO      128
#define XB_XCNT(j)  (256  + 64 * (j))
#define XB_XSUB(j)  (1280 + 64 * (j))
#define XB_XGEN(j)  (2304 + 64 * (j))
#define XB_TOP      3328
#define XB_TOPGEN   3392
#define XCD_BAR_WORDS 3456
#define XB_SPIN_CAP (1u << 20)
__device__ __forceinline__ unsigned xb_ld(unsigned* p)              { return __hip_atomic_load(p, __ATOMIC_RELAXED, __HIP_MEMORY_SCOPE_AGENT); }
__device__ __forceinline__ unsigned xb_add(unsigned* p, unsigned v) { return __hip_atomic_fetch_add(p, v, __ATOMIC_RELAXED, __HIP_MEMORY_SCOPE_AGENT); }
__device__ __forceinline__ unsigned xb_xcc_id() { return (unsigned)__builtin_amdgcn_s_getreg((3 << 11) | 20) & 0xFu; }
#define XB_SPIN(cond, bar) do { unsigned _sp = 0; while (cond) { __builtin_amdgcn_s_sleep(1); \
    if ((++_sp & 255u) == 0u) { if (xb_ld(&(bar)[XB_TMO])) break; if (_sp > XB_SPIN_CAP) { atomicAdd(&(bar)[XB_TMO], 1u); break; } } } } while (0)
__device__ __forceinline__ void xcd_barrier_complete(unsigned* bar, unsigned x, unsigned& nloc, unsigned& nx) {
    const unsigned G = (unsigned)gdim();
    unsigned sum, cnt, mine, sp = 0u;
    for (;;) {
        sum = 0u; cnt = 0u; mine = 0u;
#pragma unroll
        for (unsigned j = 0; j < 16; ++j) { const unsigned c = xb_ld(&bar[XB_XCNT(j)]); sum += c; cnt += (c > 0u) ? 1u : 0u; mine = (j == x) ? c : mine; }
        if (sum == G) break;
        __builtin_amdgcn_s_sleep(1);
        if ((++sp & 255u) == 0u) { if (xb_ld(&bar[XB_TMO])) break; if (sp > XB_SPIN_CAP) { atomicAdd(&bar[XB_TMO], 1u); break; } }
    }
    nloc = mine > 0u ? mine : 1u; nx = cnt > 0u ? cnt : 1u;
}
__device__ __forceinline__ void gbar(int wv, LAS unsigned char* lds) {
    asm volatile("s_waitcnt vmcnt(0)" ::: "memory");
    __syncthreads();
    unsigned* bar = (unsigned*)(kparams()->ws + WS_BAR);
    if (tidx(wv) == 0) {
        volatile LAS unsigned* st = (volatile LAS unsigned*)(lds + LDS_BYTES - 16);
        const unsigned x = xb_xcc_id();
        __builtin_amdgcn_s_waitcnt(0);
        unsigned nloc = st[0], nx = st[1];
        if (nloc == 0u) { xcd_barrier_complete(bar, x, nloc, nx); st[0] = nloc; st[1] = nx; }
        const unsigned old = xb_add(&bar[XB_XSUB(x)], 1u);
        const unsigned gen = old / nloc;
        if (old + 1u == (gen + 1u) * nloc) {
            __builtin_amdgcn_fence(__ATOMIC_RELEASE, "agent");
            asm volatile("s_waitcnt vmcnt(0)" ::: "memory");
            const unsigned og = xb_add(&bar[XB_TOP], 1u);
            const unsigned tg = og / nx;
            if (og + 1u == (tg + 1u) * nx) xb_add(&bar[XB_TOPGEN], 1u);
            else XB_SPIN(xb_ld(&bar[XB_TOPGEN]) == tg, bar);
            __builtin_amdgcn_fence(__ATOMIC_ACQUIRE, "agent");
            xb_add(&bar[XB_XGEN(x)], 1u);
            asm volatile("s_waitcnt vmcnt(0)" ::: "memory");
        } else {
            XB_SPIN(xb_ld(&bar[XB_XGEN(x)]) == gen, bar);
            __builtin_amdgcn_fence(__ATOMIC_ACQUIRE, "agent");
            asm volatile("s_waitcnt vmcnt(0)" ::: "memory");
        }
    }
    __syncthreads();
}
__device__ __forceinline__ void gemm_gu(int wv, LAS unsigned char* lds, int j2) { KP P = kparams();
    EpiGU E; E.ssq = (const float*)(P->ws + WS_SSQ); E.hff = (bf16_t*)(P->ws + WS_H);
    run_gemm(wv, lds, (const bf16_t*)(P->ws + WS_XB), (const bf16_t*)(P->ws + (j2 ? W_GU1 : W_GU0)), MT, 5632, 1024, E); }
__device__ __forceinline__ void gemm_dn(int wv, LAS unsigned char* lds, int j2) { KP P = kparams();
    EpiRes E; E.x = P->out; E.xb = (bf16_t*)(P->ws + WS_XB); E.ssq = (float*)(P->ws + WS_SSQ); E.scale = 0.5f;
    run_gemm(wv, lds, (const bf16_t*)(P->ws + WS_H), (const bf16_t*)(P->ws + (j2 ? W_DN1 : W_DN0)), MP, 1024, 2816, E);
    skinny_gemm<0>(wv, lds, kparams(), (const bf16_t*)(kparams()->ws + WS_H) + (size_t)MP * DFF, (const bf16_t*)(kparams()->ws + (j2 ? W_DN1 : W_DN0)), 2816, 0.5f); }
__device__ __forceinline__ void gemm_in(int wv, LAS unsigned char* lds) { KP P = kparams();
    EpiIn E; E.ssq = (const float*)(P->ws + WS_SSQ); E.h = (bf16_t*)(P->ws + WS_H); E.dtraw = (float*)(P->ws + WS_DT);
    run_gemm(wv, lds, (const bf16_t*)(P->ws + WS_XB), (const bf16_t*)(P->ws + W_IN), MT, NINP, 1024, E); }
__device__ __forceinline__ void gemm_merge(int wv, LAS unsigned char* lds) { KP P = kparams();
    EpiMerge E; E.h = (const bf16_t*)(P->ws + WS_H); E.merged = (bf16_t*)(P->ws + WS_ST);
    run_gemm(wv, lds, (const bf16_t*)(P->ws + WS_Y), (const bf16_t*)(P->ws + W_BR), MP, 1024, 3072, E);
    skinny_gemm<1>(wv, lds, kparams(), (const bf16_t*)(kparams()->ws + WS_Y) + (size_t)MP * 3072, (const bf16_t*)(kparams()->ws + W_BR), 3072, 1.0f); }
__device__ __forceinline__ void gemm_out(int wv, LAS unsigned char* lds) { KP P = kparams();
    EpiRes E; E.x = P->out; E.xb = (bf16_t*)(P->ws + WS_XB); E.ssq = (float*)(P->ws + WS_SSQ); E.scale = 1.0f;
    run_gemm(wv, lds, (const bf16_t*)(P->ws + WS_ST), (const bf16_t*)(P->ws + W_OUT), MP, 1024, 1024, E);
    skinny_gemm<0>(wv, lds, kparams(), (const bf16_t*)(kparams()->ws + WS_ST) + (size_t)MP * DM, (const bf16_t*)(kparams()->ws + W_OUT), 1024, 1.0f); }

__global__ __launch_bounds__(512, 2) void mega(Params Pk) {
    extern __shared__ __attribute__((aligned(16))) unsigned char smem[];
    LAS unsigned char* lds = (LAS unsigned char*)smem;
    cg::grid_group grid = cg::this_grid();
    const int wv = __builtin_amdgcn_readfirstlane((int)(threadIdx.x >> 6));
    unsigned* bar0 = (unsigned*)(kparams()->ws + WS_BAR);
    if (threadIdx.x == 0) {
        volatile LAS unsigned* st = (volatile LAS unsigned*)(lds + LDS_BYTES - 16); st[0] = 0u; st[1] = 0u;
        (void)xb_add(&bar0[XB_XCNT(xb_xcc_id())], 1u);
    }
    __syncthreads();
    phase_init(wv, kparams());
    gsync(grid);
#pragma unroll 1
    for (int step = 0; step < 8; ++step) {
        const int l = step >> 1, j2 = step & 1;
        gbar(wv, lds);
        if (j2 == 0) { convert_layer(wv, kparams(), l, lds); gbar(wv, lds); }
        for (int rep = 0; rep < REP_GU; ++rep) { if (rep) gbar(wv, lds); gemm_gu(wv, lds, j2); }
        gbar(wv, lds);
        gemm_dn(wv, lds, j2);
        if (j2 == 0 && DBG_MIX) {
            gbar(wv, lds);
            for (int rep = 0; rep < REP_IN; ++rep) { if (rep) gbar(wv, lds); gemm_in(wv, lds); }
            for (int rep = 0; rep < REP_SYNC; ++rep) gbar(wv, lds);
            gbar(wv, lds);
            for (int rep = 0; rep < REP_P4; ++rep)
            for (int item = bidx(); item < 256; item += gdim()) {
                const Item I = get_item(item);
                copy_states_item(wv, kparams(), l, I);
                attn_item<64>(wv, kparams(), l, I, lds); lru_item<64, false>(wv, kparams(), l, item, I, lds); ssd_states_item<64>(wv, kparams(), l, item, I, lds);
            }
            gbar(wv, lds);
            phase_scan(wv, kparams(), l);
            for (int sb = gdim() - 1 - bidx(); sb < 16; sb += gdim()) {
                const Item I = get_item(256 + sb);
                copy_states_item(wv, kparams(), l, I);
                attn_item<16>(wv, kparams(), l, I, lds);
            }
            gbar(wv, lds);
            for (int rep = 0; rep < REP_P6; ++rep) {
            for (int item = bidx(); item < 256; item += gdim()) {
                const Item I = get_item(item);
                lru_item<64, true>(wv, kparams(), l, item, I, lds); ssd_y_item<64>(wv, kparams(), l, I, lds);
            }
            for (int sj = bidx(); sj < 48; sj += gdim()) {
                const int sb = sj & 15, piece = sj >> 4;
                const Item I = get_item(256 + sb);
                if (piece == 0) lru_item<16, true>(wv, kparams(), l, 256 + sb, I, lds);
                else if (piece == 1) ssd_states_item<16>(wv, kparams(), l, 256 + sb, I, lds);
                else ssd_y_item<16>(wv, kparams(), l, I, lds);
            }
            }
            if (DBG_MERGE) {
            gbar(wv, lds);
            for (int rep = 0; rep < REP_MG; ++rep) { if (rep) gbar(wv, lds); gemm_merge(wv, lds); }
            gbar(wv, lds);
            gemm_out(wv, lds); }
        }
    }
    gbar(wv, lds);
    phase_final(wv, kparams());
#if DBG_SANITIZE
    gbar(wv, lds);
    { KP P = kparams(); float* o = P->out;
      for (size_t i = (size_t)bidx() * 512 + tidx(wv); i < O_END; i += (size_t)gdim() * 512) { const float v = o[i]; if (!(fabsf(v) < 1e30f)) o[i] = 0.f; } }
#endif
}

extern "C" void kernel_launch(void* const* d_in, const int* in_sizes, int n_in, void* d_out, int out_size, void* d_ws, size_t ws_size, hipStream_t stream) {
    static int grid_blocks = 0;
    if (grid_blocks == 0) {
        if (n_in != N_INPUTS || (size_t)out_size != O_END || ws_size < WS_END) {
            fprintf(stderr, "kernel_launch: unexpected shapes: n_in %d out %d ws %zu (need %zu)\n", n_in, out_size, ws_size, (size_t)WS_END); grid_blocks = -1; return; }
        int dev = 0, cus = 0, per_cu = 0;
        hipGetDevice(&dev);
        hipDeviceGetAttribute(&cus, hipDeviceAttributeMultiprocessorCount, dev);
        if (hipFuncSetAttribute((const void*)mega, hipFuncAttributeMaxDynamicSharedMemorySize, LDS_BYTES) != hipSuccess) { fprintf(stderr, "hipFuncSetAttribute failed\n"); grid_blocks = -1; return; }
        hipOccupancyMaxActiveBlocksPerMultiprocessor(&per_cu, (const void*)mega, 512, LDS_BYTES);
        if (per_cu < 1) per_cu = 1;
        grid_blocks = cus * per_cu;
    }
    if (grid_blocks < 0) return;
    Params p{};
    for (int i = 0; i < N_INPUTS; ++i) p.in[i] = (const float*)d_in[i];
    p.out = (float*)d_out; p.ws = (unsigned char*)d_ws;
    if (hipMemsetAsync((unsigned char*)d_ws + WS_BAR, 0, 16384, stream) != hipSuccess) { fprintf(stderr, "memset failed\n"); return; }
    void* args[] = {&p};
    hipError_t e = hipLaunchCooperativeKernel((const void*)mega, dim3(grid_blocks), dim3(512), args, LDS_BYTES, stream);
    if (e != hipSuccess) fprintf(stderr, "cooperative launch failed: %s (grid %d)\n", hipGetErrorString(e), grid_blocks);
}
```

```cpp
#include <hip/hip_runtime.h>
#include <hip/hip_cooperative_groups.h>
#include <cstdio>
namespace cg = cooperative_groups;
#define DBG_SANITIZE 0
#ifndef REP_P4
#define REP_P4 1
#endif
#ifndef REP_P6
#define REP_P6 1
#endif
#ifndef REP_SYNC
#define REP_SYNC 0
#endif
#ifndef REP_IN
#define REP_IN 1
#endif
#ifndef REP_A
#define REP_A 1
#endif
#ifndef REP_L4
#define REP_L4 1
#endif
#ifndef REP_S4
#define REP_S4 1
#endif
#ifndef REP_L6
#define REP_L6 1
#endif
#ifndef REP_S6
#define REP_S6 1
#endif
#ifndef REP_GU
#define REP_GU 1
#endif
#ifndef REP_MG
#define REP_MG 1
#endif
#define DBG_MIX 1
#define DBG_MERGE 1
#define DBG_ATTN 1
#define DBG_LRU4 1
#define DBG_SSD4 1
#define DBG_P5S 1
#define DBG_P5W 1
#define DBG_P5 1
#define DBG_LRU6 1
#define DBG_SSD6 1

#define LAS __attribute__((address_space(3)))
typedef unsigned short bf16_t;
typedef short bf16x8 __attribute__((ext_vector_type(8)));
typedef float f32x4 __attribute__((ext_vector_type(4)));
typedef unsigned u32x4 __attribute__((ext_vector_type(4)));
typedef unsigned u32x2 __attribute__((ext_vector_type(2)));

constexpr int MP = 16384, MS = 256, MT = 16640;
constexpr int DM = 1024, DFF = 2816, NIN = 9232, NINP = 9472, HP = 9232;
constexpr int HX = 0, HG = 1024, HZ = 2048, HXBC = 3072, HQ = 4608, HK = 5632, HV = 5888, HGATE = 6144, HDT = 9216;
constexpr float EPS = 1e-6f;
constexpr int NITEM = 272;

enum { I_XP = 0, I_XS, I_CK, I_CV, I_SLC, I_SLH, I_SSC, I_SSH, I_FNORM, I_WG, I_WU, I_WD, I_MNORM, I_WIN, I_LCW, I_LCB, I_LWA, I_LBA, I_LWX, I_LBX,
       I_LLAM, I_SCW, I_SCB, I_SDTB, I_SALOG, I_SD, I_SNORM, I_SINK, I_WBR, I_WOUT, I_FINAL, N_INPUTS };

constexpr size_t O_YP = 0, O_YS = O_YP + (size_t)MP * DM, O_PK = O_YS + (size_t)MS * DM, O_PV = O_PK + 4 * 2 * 128 * 256, O_PLC = O_PV + 4 * 2 * 128 * 256,
                 O_PLH = O_PLC + 4 * 2 * 3 * 1024, O_PSC = O_PLH + 4 * 2 * 1024, O_PSH = O_PSC + 4 * 2 * 3 * 1536, O_SK = O_PSH + (size_t)4 * 2 * 16 * 64 * 128,
                 O_SV = O_SK + (size_t)4 * 16 * 128 * 256, O_SLC = O_SV + (size_t)4 * 16 * 128 * 256, O_SLH = O_SLC + 4 * 16 * 3 * 1024, O_SSC = O_SLH + 4 * 16 * 1024,
                 O_SSH = O_SSC + 4 * 16 * 3 * 1536, O_END = O_SSH + (size_t)4 * 16 * 16 * 64 * 128;

constexpr size_t WS_XB = 0;
constexpr size_t WS_H = WS_XB + (size_t)MT * DM * 2;
constexpr size_t WS_ST = WS_H + (size_t)MT * HP * 2;
constexpr size_t WS_Y = WS_ST + (size_t)2 * 128 * 16 * 64 * 128 * 2;
constexpr size_t WS_W = WS_Y + (size_t)MT * 3072 * 2;
constexpr size_t W_GU0 = WS_W, W_GU1 = W_GU0 + (size_t)5632 * 1024 * 2, W_DN0 = W_GU1 + (size_t)5632 * 1024 * 2, W_DN1 = W_DN0 + (size_t)1024 * 2816 * 2,
                 W_IN = W_DN1 + (size_t)1024 * 2816 * 2, W_BR = W_IN + (size_t)NINP * 1024 * 2, W_OUT = W_BR + (size_t)1024 * 3072 * 2,
                 W_LA = W_OUT + (size_t)1024 * 1024 * 2, W_LX = W_LA + 65536 * 2, WS_SSQ = W_LX + 65536 * 2;
constexpr size_t WS_DT = WS_SSQ + (size_t)MT * 16 * 4, WS_LRUA = WS_DT + (size_t)MT * 16 * 4, WS_LRUU = WS_LRUA + 256 * 1024 * 4, WS_CDEC = WS_LRUU + 256 * 1024 * 4,
                 WS_BAR = WS_CDEC + 256 * 16 * 4, WS_SSQ2 = WS_BAR + 16384, WS_END = WS_SSQ2 + 256 * 16 * 4;

constexpr int LDS_BYTES = 147456;

struct Params { const float* in[N_INPUTS]; float* out; unsigned char* ws; };
typedef const Params __attribute__((address_space(4))) * KP;
__device__ __forceinline__ KP kparams() { KP p = (KP)__builtin_amdgcn_kernarg_segment_ptr(); asm volatile("" : "+s"(p)); return p; }
__device__ __forceinline__ int tidx(int wv) { int t; asm volatile("v_mbcnt_lo_u32_b32 %0, -1, 0\n\tv_mbcnt_hi_u32_b32 %0, -1, %0" : "=v"(t)); return (wv << 6) | t; }
__device__ __forceinline__ int bidx() { int t = blockIdx.x; asm volatile("" : "+s"(t)); return t; }
__device__ __forceinline__ int gdim() { int t = gridDim.x; asm volatile("" : "+s"(t)); return t; }

typedef __bf16 bf16x2_t __attribute__((ext_vector_type(2)));
typedef float f32x2_t __attribute__((ext_vector_type(2)));
__device__ __forceinline__ unsigned pk2(float lo, float hi) { f32x2_t v = {lo, hi}; bf16x2_t b = __builtin_convertvector(v, bf16x2_t); unsigned r; __builtin_memcpy(&r, &b, 4); return r; }
__device__ __forceinline__ bf16_t f2bf(float f) { return (bf16_t)(pk2(f, 0.f) & 0xffffu); }
__device__ __forceinline__ float bf2f(bf16_t b) { return __uint_as_float(((unsigned)b) << 16); }
__device__ __forceinline__ float bflo(unsigned w) { return __uint_as_float(w << 16); }
__device__ __forceinline__ float bfhi(unsigned w) { return __uint_as_float(w & 0xffff0000u); }
__device__ __forceinline__ float sigmoidf_(float x) { return 1.0f / (1.0f + __expf(-x)); }
__device__ __forceinline__ float siluf_(float x) { return x / (1.0f + __expf(-x)); }
__device__ __forceinline__ float softplusf_(float x) { return x > 20.f ? x : log1pf(__expf(x)); }
__device__ __forceinline__ float gelu_tanh(float x) { const float u = 0.7978845608028654f * (x + 0.044715f * x * x * x); return x / (1.0f + __expf(-2.0f * u)); }
__device__ __forceinline__ float rstd_row(const float* ssq, int r) {
    const f32x4* p = (const f32x4*)(ssq + (size_t)r * 16); f32x4 a = p[0], b = p[1], c = p[2], d = p[3];
    float s = (a[0] + a[1] + a[2] + a[3]) + (b[0] + b[1] + b[2] + b[3]) + (c[0] + c[1] + c[2] + c[3]) + (d[0] + d[1] + d[2] + d[3]);
    if (r >= MP) {
        const f32x4* q = (const f32x4*)(ssq + (WS_SSQ2 - WS_SSQ) / 4 + (size_t)(r - MP) * 16); a = q[0]; b = q[1]; c = q[2]; d = q[3];
        s += (a[0] + a[1] + a[2] + a[3]) + (b[0] + b[1] + b[2] + b[3]) + (c[0] + c[1] + c[2] + c[3]) + (d[0] + d[1] + d[2] + d[3]);
    }
    return rsqrtf(s * (1.0f / 1024.0f) + EPS);
}
#define MFMA16(a, b, c) __builtin_amdgcn_mfma_f32_16x16x32_bf16((a), (b), (c), 0, 0, 0)

namespace pg8 {
constexpr int BM = 256, BK = 64, HALF = 128, HTB = HALF * BK * 2, STAGE_BYTES = 8 * HTB, NXCD = 8, WGM = 8;
__device__ __forceinline__ int lds_byte(int r, int c) { const int st = (r >> 4) * 2 + (c >> 5), rr = r & 15, cc = c & 31, ob = rr * 64 + cc * 2; return st * 1024 + (ob ^ (((ob >> 9) & 1) << 5)); }
__device__ __forceinline__ void stage_rc(int b, int& R, int& C) { const int st = b / 1024, sb = b % 1024, swz = sb ^ (((sb >> 9) & 1) << 5); R = (st >> 1) * 16 + swz / 64; C = (st & 1) * 32 + (swz % 64) / 2; }
struct Unit { int pm, pn; };
struct Gemm { const bf16_t* A; const bf16_t* Bt; int M, N, K; };
struct StaticOrder {
    int nM, nN, nwg, G, c;
    __device__ void init(int M, int N, int G_, int c_) { nM = M / BM; nN = N / BM; nwg = nM * nN; G = G_; c = c_; }
    __device__ bool next(int i, Unit& u) const {
        const long L = (long)i * G + c; if (L >= nwg) return false;
        int wgid = (int)L; { const int q = nwg / NXCD, r = nwg % NXCD, xcd = wgid % NXCD, off = wgid / NXCD; wgid = (xcd < r ? xcd * (q + 1) : r * (q + 1) + (xcd - r) * q) + off; }
        const int nig = WGM * nN, gid = wgid / nig, fm = gid * WGM, gsz = (nM - fm) < WGM ? (nM - fm) : WGM;
        u.pm = fm + ((wgid % nig) % gsz); u.pn = (wgid % nig) / gsz; return true;
    }
};

template <class Epi>
__device__ __forceinline__ void gemm_phase(int wv, LAS unsigned char* lds, const Gemm g, const StaticOrder& S, const Epi& E) {
    const int tid = tidx(wv), wid = wv, lane = tid & 63, wr = wid >> 2, wc = wid & 3, fr = lane & 15, fq = lane >> 4;
    const int K = g.K, nt = K / BK;
    unsigned voffA[2];
#pragma unroll
    for (int i = 0; i < 2; ++i) { int R, C; stage_rc(tid * 16 + i * 8192, R, C); voffA[i] = (unsigned)(R * K + C) * 2u; }
    const size_t kstep = (size_t)(BK * 2);
    const size_t hstep = (size_t)HALF * K * 2;
    const size_t tstep = 2 * hstep;
    const unsigned ldsw = (unsigned)wid * 1024u;
    const int aoff = lds_byte(wr * 64 + fr, fq * 8), boff = lds_byte(wc * 32 + fr, fq * 8);
#define PG8_SA(b, h) (((b) * 2 + (h)) * HTB)
#define PG8_SB(b, h) ((4 + (b) * 2 + (h)) * HTB)
#define PG8_STAGE(bufoff, gbase, voff) do { _Pragma("unroll") for (int _i = 0; _i < 2; ++_i) \
        __builtin_amdgcn_global_load_lds((const unsigned*)((const char*)(gbase) + (voff)[_i]), (LAS unsigned*)(lds + (bufoff) + ldsw + _i * 8192), 16, 0, 0); } while (0)
#define PG8_LDA(dst, b, h) do { _Pragma("unroll") for (int m = 0; m < 4; ++m) _Pragma("unroll") for (int k = 0; k < 2; ++k) dst[m][k] = *(const LAS bf16x8*)(lds + PG8_SA(b, h) + aoff + m * 2048 + k * 1024); } while (0)
#define PG8_LDB(dst, b, h) do { _Pragma("unroll") for (int n = 0; n < 2; ++n) _Pragma("unroll") for (int k = 0; k < 2; ++k) dst[n][k] = *(const LAS bf16x8*)(lds + PG8_SB(b, h) + boff + n * 2048 + k * 1024); } while (0)
#define PG8_MMA(ai, bj, At, Bt) do { __builtin_amdgcn_s_setprio(1); _Pragma("unroll") for (int m = 0; m < 4; ++m) _Pragma("unroll") for (int n = 0; n < 2; ++n) _Pragma("unroll") for (int k = 0; k < 2; ++k) \
        acc[ai][bj][m][n] = __builtin_amdgcn_mfma_f32_16x16x32_bf16(Bt[n][k], At[m][k], acc[ai][bj][m][n], 0, 0, 0); __builtin_amdgcn_s_setprio(0); } while (0)
#define PG8_WAIT_V(n) asm volatile("s_waitcnt vmcnt(" #n ")" ::: "memory")
#define PG8_WAIT_L(n) asm volatile("s_waitcnt lgkmcnt(" #n ")" ::: "memory")
#define PG8_BAR __builtin_amdgcn_s_barrier()
#define PG8_SCHED __builtin_amdgcn_sched_barrier(0)
    Unit cur, nxt; int ui = 0;
    if (!S.next(0, cur)) return;
    f32x4 acc[2][2][4][2];
#pragma unroll
    for (int a = 0; a < 2; ++a)
#pragma unroll
        for (int b = 0; b < 2; ++b)
#pragma unroll
            for (int m = 0; m < 4; ++m)
#pragma unroll
                for (int n = 0; n < 2; ++n) acc[a][b][m][n] = (f32x4){0.f, 0.f, 0.f, 0.f};
    bf16x8 At[4][2], B0[2][2], B1[2][2];
    const char* cA = (const char*)g.A + (size_t)cur.pm * tstep; const char* cB = (const char*)g.Bt + (size_t)cur.pn * tstep;
    PG8_STAGE(PG8_SB(0, 0), cB, voffA); PG8_STAGE(PG8_SA(0, 0), cA, voffA); PG8_STAGE(PG8_SB(0, 1), cB + hstep, voffA); PG8_STAGE(PG8_SA(0, 1), cA + hstep, voffA);
    if (wr == 1) PG8_BAR;
    PG8_WAIT_V(4); PG8_BAR;
    PG8_STAGE(PG8_SB(1, 0), cB + kstep, voffA); PG8_STAGE(PG8_SA(1, 0), cA + kstep, voffA); PG8_STAGE(PG8_SB(1, 1), cB + hstep + kstep, voffA);
    PG8_WAIT_V(6); PG8_BAR;
    for (;;) {
        const bool has_next = S.next(ui + 1, nxt);
        const char* nA = has_next ? (const char*)g.A + (size_t)nxt.pm * tstep : cA; const char* nB = has_next ? (const char*)g.Bt + (size_t)nxt.pn * tstep : cB;
        for (int t = 0; t < nt; t += 2) {
            const bool last = (t == nt - 2);
            const char* a1 = cA + (size_t)(t + 1) * kstep;
            const char* a2 = last ? nA : cA + (size_t)(t + 2) * kstep; const char* b2 = last ? nB : cB + (size_t)(t + 2) * kstep;
            const char* a3 = a2 + kstep; const char* b3 = b2 + kstep;
            PG8_LDB(B0, 0, 0); PG8_SCHED; PG8_LDA(At, 0, 0); PG8_STAGE(PG8_SA(1, 1), a1 + hstep, voffA);
            PG8_WAIT_L(8); PG8_BAR; PG8_WAIT_L(0); PG8_MMA(0, 0, At, B0); PG8_BAR; PG8_SCHED;
            PG8_LDB(B1, 0, 1); PG8_STAGE(PG8_SB(0, 0), b2, voffA);
            PG8_BAR; PG8_WAIT_L(0); PG8_MMA(0, 1, At, B1); PG8_BAR;
            PG8_LDA(At, 0, 1); PG8_STAGE(PG8_SA(0, 0), a2, voffA);
            PG8_BAR; PG8_WAIT_L(0); PG8_MMA(1, 0, At, B0); PG8_BAR; PG8_SCHED;
            PG8_STAGE(PG8_SB(0, 1), b2 + hstep, voffA);
            PG8_WAIT_V(6); PG8_BAR; PG8_MMA(1, 1, At, B1); PG8_BAR;
            PG8_LDB(B0, 1, 0); PG8_SCHED; PG8_LDA(At, 1, 0); PG8_STAGE(PG8_SA(0, 1), a2 + hstep, voffA);
            PG8_WAIT_L(8); PG8_BAR; PG8_WAIT_L(0); PG8_MMA(0, 0, At, B0); PG8_BAR; PG8_SCHED;
            PG8_LDB(B1, 1, 1); PG8_STAGE(PG8_SB(1, 0), b3, voffA);
            PG8_BAR; PG8_WAIT_L(0); PG8_MMA(0, 1, At, B1); PG8_BAR;
            PG8_LDA(At, 1, 1); PG8_STAGE(PG8_SA(1, 0), a3, voffA);
            PG8_BAR; PG8_WAIT_L(0); PG8_MMA(1, 0, At, B0); PG8_BAR; PG8_SCHED;
            PG8_STAGE(PG8_SB(1, 1), b3 + hstep, voffA);
            PG8_WAIT_V(6); PG8_BAR; PG8_MMA(1, 1, At, B1); PG8_BAR;
            if constexpr (Epi::HAS_MID) { if (!last && ((t + 2) & 15) == 0) E.mid(acc, cur, (t + 2) >> 4, wr, wc, fr, fq); }
        }
        E(acc, cur, wr, wc, fr, fq);
        if (!has_next) break;
#pragma unroll
        for (int a = 0; a < 2; ++a)
#pragma unroll
            for (int b = 0; b < 2; ++b)
#pragma unroll
                for (int m = 0; m < 4; ++m)
#pragma unroll
                    for (int n = 0; n < 2; ++n) acc[a][b][m][n] = (f32x4){0.f, 0.f, 0.f, 0.f};
        cur = nxt; cA = nA; cB = nB; ++ui;
    }
    PG8_WAIT_V(0);
    if (wr == 0) PG8_BAR;
    PG8_BAR;
#undef PG8_SA
#undef PG8_SB
#undef PG8_STAGE
#undef PG8_LDA
#undef PG8_LDB
#undef PG8_MMA
#undef PG8_WAIT_V
#undef PG8_WAIT_L
#undef PG8_BAR
#undef PG8_SCHED
}
}
using pg8::Unit;
typedef f32x4 AccT[2][2][4][2];

struct EpiGU {
    static constexpr bool HAS_MID = false;
    const float* ssq; bf16_t* hff;
    __device__ __forceinline__ void mid(AccT&, const Unit&, int, int, int, int, int) const {}
    __device__ __forceinline__ void operator()(const AccT& acc, const Unit& u, int wr, int wc, int fr_, int fq_) const {
        int fr = fr_, fq = fq_; asm volatile("" : "+v"(fr), "+v"(fq));
        const int row0 = u.pm * 256 + wr * 64 + fr, hc0 = u.pn * 128 + wc * 16 + fq * 4;
#pragma unroll
        for (int ai = 0; ai < 2; ++ai)
#pragma unroll
            for (int m = 0; m < 4; ++m) {
                const int r = row0 + ai * 128 + m * 16; const float rs = rstd_row(ssq, r);
#pragma unroll
                for (int bj = 0; bj < 2; ++bj) {
                    const f32x4 gt = acc[ai][bj][m][0] * rs, up = acc[ai][bj][m][1] * rs;
                    u32x2 w; w.x = pk2(siluf_(gt[0]) * up[0], siluf_(gt[1]) * up[1]); w.y = pk2(siluf_(gt[2]) * up[2], siluf_(gt[3]) * up[3]);
                    *(u32x2*)(hff + (size_t)r * DFF + hc0 + bj * 64) = w;
                }
            }
    }
};
struct EpiRes {
    static constexpr bool HAS_MID = false;
    float* x; bf16_t* xb; float* ssq; float scale;
    __device__ __forceinline__ void mid(AccT&, const Unit&, int, int, int, int, int) const {}
    __device__ __forceinline__ void operator()(const AccT& acc, const Unit& u, int wr, int wc, int fr_, int fq_) const {
        int fr = fr_, fq = fq_; asm volatile("" : "+v"(fr), "+v"(fq));
        const int row0 = u.pm * 256 + wr * 64 + fr, col0 = u.pn * 256 + wc * 32 + 4 * fq;
#pragma unroll
        for (int ai = 0; ai < 2; ++ai)
#pragma unroll
            for (int m = 0; m < 4; ++m) {
                const int r = row0 + ai * 128 + m * 16; float ss = 0.f;
#pragma unroll
                for (int bj = 0; bj < 2; ++bj)
#pragma unroll
                    for (int n = 0; n < 2; ++n) {
                        const int c = col0 + bj * 128 + n * 16;
                        f32x4* xp = (f32x4*)(x + (size_t)r * DM + c);
                        f32x4 v = *xp + acc[ai][bj][m][n] * scale;
                        *xp = v;
                        u32x2 w; w.x = pk2(v[0], v[1]); w.y = pk2(v[2], v[3]);
                        *(u32x2*)(xb + (size_t)r * DM + c) = w;
                        ss += v[0] * v[0] + v[1] * v[1] + v[2] * v[2] + v[3] * v[3];
                    }
                ss += __shfl_xor(ss, 16); ss += __shfl_xor(ss, 32);
                if (fq == 0) ssq[(size_t)r * 16 + u.pn * 4 + wc] = ss;
            }
    }
};
struct EpiIn {
    static constexpr bool HAS_MID = false;
    const float* ssq; bf16_t* h; float* dtraw;
    __device__ __forceinline__ void mid(AccT&, const Unit&, int, int, int, int, int) const {}
    __device__ __forceinline__ void operator()(const AccT& acc, const Unit& u, int wr, int wc, int fr_, int fq_) const {
        int fr = fr_, fq = fq_; asm volatile("" : "+v"(fr), "+v"(fq));
        const int row0 = u.pm * 256 + wr * 64 + fr, col0 = u.pn * 256 + wc * 32 + 4 * fq;
#pragma unroll
        for (int ai = 0; ai < 2; ++ai)
#pragma unroll
            for (int m = 0; m < 4; ++m) {
                const int r = row0 + ai * 128 + m * 16; const float rs = rstd_row(ssq, r);
                if (u.pn < 36) {
#pragma unroll
                    for (int bj = 0; bj < 2; ++bj)
#pragma unroll
                        for (int n = 0; n < 2; ++n) {
                            const int c = col0 + bj * 128 + n * 16; const f32x4 v = acc[ai][bj][m][n] * rs;
                            u32x2 w; w.x = pk2(v[0], v[1]); w.y = pk2(v[2], v[3]);
                            *(u32x2*)(h + (size_t)r * HP + c) = w;
                        }
                } else if (wc == 0) {
                    const f32x4 v = acc[ai][0][m][0] * rs;
                    *(f32x4*)(dtraw + (size_t)r * 16 + 4 * fq) = v;
                }
            }
    }
};
struct EpiMerge {
    static constexpr bool HAS_MID = true;
    const bf16_t* h; bf16_t* merged;
    __device__ __forceinline__ void mid(AccT& acc, const Unit& u, int seg, int wr, int wc, int fr_, int fq_) const {
        int fr = fr_, fq = fq_; asm volatile("" : "+v"(fr), "+v"(fq));
        const int row0 = u.pm * 256 + wr * 64 + fr, col0 = u.pn * 256 + wc * 32 + 4 * fq;
#pragma unroll
        for (int ai = 0; ai < 2; ++ai)
#pragma unroll
            for (int m = 0; m < 4; ++m) {
                const int r = row0 + ai * 128 + m * 16;
#pragma unroll
                for (int bj = 0; bj < 2; ++bj)
#pragma unroll
                    for (int n = 0; n < 2; ++n) {
                        const int c = col0 + bj * 128 + n * 16;
                        const bf16_t* gp = h + (size_t)r * HP + HGATE + (seg - 1) * 1024 + c;
                        const u32x2 ga = *(const u32x2*)gp, gb = *(const u32x2*)(gp + 1024);
                        const float a0 = bflo(ga.x), a1 = bfhi(ga.x), a2 = bflo(ga.y), a3 = bfhi(ga.y);
                        const float b0 = bflo(gb.x), b1 = bfhi(gb.x), b2 = bflo(gb.y), b3 = bfhi(gb.y);
                        f32x4 f;
                        f[0] = (1.f + __expf(-fmaxf(b0, -30.f))) / (1.f + __expf(-fmaxf(a0, -30.f)));
                        f[1] = (1.f + __expf(-fmaxf(b1, -30.f))) / (1.f + __expf(-fmaxf(a1, -30.f)));
                        f[2] = (1.f + __expf(-fmaxf(b2, -30.f))) / (1.f + __expf(-fmaxf(a2, -30.f)));
                        f[3] = (1.f + __expf(-fmaxf(b3, -30.f))) / (1.f + __expf(-fmaxf(a3, -30.f)));
                        acc[ai][bj][m][n] *= f;
                    }
            }
    }
    __device__ __forceinline__ void operator()(const AccT& acc, const Unit& u, int wr, int wc, int fr_, int fq_) const {
        int fr = fr_, fq = fq_; asm volatile("" : "+v"(fr), "+v"(fq));
        const int row0 = u.pm * 256 + wr * 64 + fr, col0 = u.pn * 256 + wc * 32 + 4 * fq;
#pragma unroll
        for (int ai = 0; ai < 2; ++ai)
#pragma unroll
            for (int m = 0; m < 4; ++m) {
                const int r = row0 + ai * 128 + m * 16;
#pragma unroll
                for (int bj = 0; bj < 2; ++bj)
#pragma unroll
                    for (int n = 0; n < 2; ++n) {
                        const int c = col0 + bj * 128 + n * 16;
                        const u32x2 ga = *(const u32x2*)(h + (size_t)r * HP + HGATE + 2048 + c);
                        const f32x4 v = acc[ai][bj][m][n];
                        u32x2 w;
                        w.x = pk2(v[0] / (1.f + __expf(-fmaxf(bflo(ga.x), -30.f))), v[1] / (1.f + __expf(-fmaxf(bfhi(ga.x), -30.f))));
                        w.y = pk2(v[2] / (1.f + __expf(-fmaxf(bflo(ga.y), -30.f))), v[3] / (1.f + __expf(-fmaxf(bfhi(ga.y), -30.f))));
                        *(u32x2*)(merged + (size_t)r * DM + c) = w;
                    }
            }
    }
};

template <class Epi> __device__ __forceinline__ void run_gemm(int wv, LAS unsigned char* lds, const bf16_t* A, const bf16_t* Bt, int M, int N, int K, const Epi& E) {
    pg8::Gemm g; g.A = A; g.Bt = Bt; g.M = M; g.N = N; g.K = K;
    pg8::StaticOrder S; S.init(M, N, (int)gdim(), (int)bidx());
    pg8::gemm_phase<Epi>(wv, lds, g, S, E);
}


template <int MODE>
__device__ __forceinline__ void skinny_gemm(int wv, LAS unsigned char* lds, KP P, const bf16_t* A, const bf16_t* Bt, int K, float scale) {
    const int tid = tidx(wv), w = tid >> 6, lane = tid & 63, fr = lane & 15, fq = lane >> 4;
    LAS float* part = (LAS float*)lds;
    constexpr int NSEG = MODE ? 3 : 1;
    const int kseg = K / NSEG, kw = kseg / 8;
    const bf16_t* h = (const bf16_t*)(P->ws + WS_H);
    for (int task = bidx(); task < 256; task += gdim()) {
        const int rt = task >> 5, ct = task & 31;
        f32x4 tot[2][2];
#pragma unroll
        for (int i = 0; i < 2; ++i)
#pragma unroll
            for (int j = 0; j < 2; ++j) tot[i][j] = (f32x4){0.f, 0.f, 0.f, 0.f};
#pragma unroll 1
        for (int seg = 0; seg < NSEG; ++seg) {
            f32x4 acc[2][2];
#pragma unroll
            for (int i = 0; i < 2; ++i)
#pragma unroll
                for (int j = 0; j < 2; ++j) acc[i][j] = (f32x4){0.f, 0.f, 0.f, 0.f};
            const bf16_t* ap = A + (size_t)(rt * 32 + fr) * K + seg * kseg + w * kw + fq * 8;
            const bf16_t* bp = Bt + (size_t)(ct * 32 + fr) * K + seg * kseg + w * kw + fq * 8;
#pragma unroll 2
            for (int k = 0; k < kw; k += 32) {
                const bf16x8 a0 = *(const bf16x8*)(ap + k), a1 = *(const bf16x8*)(ap + (size_t)16 * K + k);
                const bf16x8 b0 = *(const bf16x8*)(bp + k), b1 = *(const bf16x8*)(bp + (size_t)16 * K + k);
                acc[0][0] = MFMA16(b0, a0, acc[0][0]); acc[0][1] = MFMA16(b1, a0, acc[0][1]);
                acc[1][0] = MFMA16(b0, a1, acc[1][0]); acc[1][1] = MFMA16(b1, a1, acc[1][1]);
            }
#pragma unroll
            for (int i = 0; i < 2; ++i)
#pragma unroll
                for (int j = 0; j < 2; ++j) {
                    if (MODE) {
                        const u32x2 gw = *(const u32x2*)(h + (size_t)(MP + rt * 32 + i * 16 + fr) * HP + HGATE + seg * 1024 + ct * 32 + j * 16 + 4 * fq);
                        f32x4 sg; sg[0] = sigmoidf_(bflo(gw.x)); sg[1] = sigmoidf_(bfhi(gw.x)); sg[2] = sigmoidf_(bflo(gw.y)); sg[3] = sigmoidf_(bfhi(gw.y));
                        tot[i][j] += acc[i][j] * sg;
                    } else tot[i][j] = acc[i][j];
                }
        }
        __syncthreads();
#pragma unroll
        for (int i = 0; i < 2; ++i)
#pragma unroll
            for (int j = 0; j < 2; ++j) *(LAS f32x4*)(part + (w * 32 + i * 16 + fr) * 36 + j * 16 + 4 * fq) = tot[i][j];
        __syncthreads();
        const int row = tid >> 4, c2 = (tid & 15) * 2;
        float v0 = 0.f, v1 = 0.f;
#pragma unroll
        for (int ww = 0; ww < 8; ++ww) { v0 += part[(ww * 32 + row) * 36 + c2]; v1 += part[(ww * 32 + row) * 36 + c2 + 1]; }
        const int r = MP + rt * 32 + row, c = ct * 32 + c2;
        if (MODE) {
            *(unsigned*)((bf16_t*)(P->ws + WS_ST) + (size_t)r * DM + c) = pk2(v0, v1);
        } else {
            float* xp = P->out + (size_t)r * DM + c;
            const float x0 = xp[0] + scale * v0, x1 = xp[1] + scale * v1;
            xp[0] = x0; xp[1] = x1;
            *(unsigned*)((bf16_t*)(P->ws + WS_XB) + (size_t)r * DM + c) = pk2(x0, x1);
            float ss = x0 * x0 + x1 * x1;
            ss += __shfl_xor(ss, 1); ss += __shfl_xor(ss, 2); ss += __shfl_xor(ss, 4); ss += __shfl_xor(ss, 8);
            if ((tid & 15) == 0) {
                float* ssq = (float*)(P->ws + WS_SSQ);
                if (ct < 16) ssq[(size_t)r * 16 + ct] = ss; else ssq[(WS_SSQ2 - WS_SSQ) / 4 + (size_t)(r - MP) * 16 + (ct - 16)] = ss;
            }
        }
    }
}

template <class RM>
__device__ __forceinline__ void cvt_tile(int wv, const float* src, int src_ld, int k0, int nsrc0, int nvalid, const float* gk, bf16_t* dst, int dst_ld, RM rowmap, LAS float* tile) {
    const int tid = tidx(wv);
    __syncthreads();
#pragma unroll
    for (int i = 0; i < 2; ++i) {
        const int kk = (tid >> 4) + 32 * i, n4 = (tid & 15) * 4;
        f32x4 v = (f32x4){0.f, 0.f, 0.f, 0.f};
        if (n4 < nvalid) v = *(const f32x4*)(src + (size_t)(k0 + kk) * src_ld + nsrc0 + n4);
        const float gsc = gk ? gk[k0 + kk] : 1.0f;
        tile[kk * 65 + n4 + 0] = v[0] * gsc; tile[kk * 65 + n4 + 1] = v[1] * gsc; tile[kk * 65 + n4 + 2] = v[2] * gsc; tile[kk * 65 + n4 + 3] = v[3] * gsc;
    }
    __syncthreads();
    const int nl = tid >> 3, k8 = (tid & 7) * 8;
    if (nl < nvalid) {
        u32x4 w;
        w.x = pk2(tile[(k8 + 0) * 65 + nl], tile[(k8 + 1) * 65 + nl]); w.y = pk2(tile[(k8 + 2) * 65 + nl], tile[(k8 + 3) * 65 + nl]);
        w.z = pk2(tile[(k8 + 4) * 65 + nl], tile[(k8 + 5) * 65 + nl]); w.w = pk2(tile[(k8 + 6) * 65 + nl], tile[(k8 + 7) * 65 + nl]);
        *(u32x4*)(dst + (size_t)rowmap(nl) * dst_ld + k0 + k8) = w;
    }
}

__device__ __forceinline__ void convert_layer(int wv, KP P, int l, LAS unsigned char* lds) {
    LAS float* tile = (LAS float*)lds;
    constexpr int J_GU = 2 * 2 * 16 * 44, J_DN = 2 * 44 * 16, J_IN = 16 * 145, J_BR = 48 * 16, J_OUT = 16 * 16, J_LRU = 32;
    constexpr int J_TOT = J_GU + J_DN + J_IN + J_BR + J_OUT + J_LRU;
    for (int job = bidx(); job < J_TOT; job += gdim()) {
        int j = job;
        if (j < J_GU) {
            const int nt = j % 44; j /= 44; const int kt = j % 16; j /= 16; const int which = j & 1, j2 = j >> 1;
            const float* src = P->in[which ? I_WU : I_WG] + (size_t)(l * 2 + j2) * 1024 * 2816;
            bf16_t* dst = (bf16_t*)(P->ws + (j2 ? W_GU1 : W_GU0));
            const int hc0 = nt * 64;
            cvt_tile(wv, src, 2816, kt * 64, hc0, 64, P->in[I_FNORM] + (l * 2 + j2) * 1024, dst, 1024,
                     [=](int nl) { const int hc = hc0 + nl; return 256 * (hc >> 7) + 128 * ((hc >> 6) & 1) + 32 * ((hc >> 4) & 3) + 16 * which + (hc & 15); }, tile);
            continue;
        }
        j -= J_GU;
        if (j < J_DN) {
            const int nt = j % 16; j /= 16; const int kt = j % 44; const int j2 = j / 44;
            const float* src = P->in[I_WD] + (size_t)(l * 2 + j2) * 2816 * 1024;
            bf16_t* dst = (bf16_t*)(P->ws + (j2 ? W_DN1 : W_DN0));
            const int n0 = nt * 64;
            cvt_tile(wv, src, 1024, kt * 64, n0, 64, nullptr, dst, 2816, [=](int nl) { return n0 + nl; }, tile);
            continue;
        }
        j -= J_DN;
        if (j < J_IN) {
            const int nt = j % 145, kt = j / 145;
            const float* src = P->in[I_WIN] + (size_t)l * 1024 * NIN;
            bf16_t* dst = (bf16_t*)(P->ws + W_IN);
            const int n0 = nt * 64;
            const int nsrc0 = nt < 72 ? n0 : (nt < 144 ? n0 + 16 : 4608);
            cvt_tile(wv, src, NIN, kt * 64, nsrc0, nt < 144 ? 64 : 16, P->in[I_MNORM] + l * 1024, dst, 1024, [=](int nl) { return n0 + nl; }, tile);
            continue;
        }
        j -= J_IN;
        if (j < J_BR) {
            const int nt = j % 16, kt = j / 16;
            const float* src = P->in[I_WBR] + (size_t)l * 3072 * 1024;
            bf16_t* dst = (bf16_t*)(P->ws + W_BR);
            const int n0 = nt * 64;
            cvt_tile(wv, src, 1024, kt * 64, n0, 64, nullptr, dst, 3072, [=](int nl) { return n0 + nl; }, tile);
            continue;
        }
        j -= J_BR;
        if (j < J_OUT) {
            const int nt = j % 16, kt = j / 16;
            const float* src = P->in[I_WOUT] + (size_t)l * 1024 * 1024;
            bf16_t* dst = (bf16_t*)(P->ws + W_OUT);
            const int n0 = nt * 64;
            cvt_tile(wv, src, 1024, kt * 64, n0, 64, nullptr, dst, 1024, [=](int nl) { return n0 + nl; }, tile);
            continue;
        }
        j -= J_OUT;
        {
            const int blk = j & 15, which = j >> 4;
            const float* src = P->in[which ? I_LWX : I_LWA] + (size_t)(l * 16 + blk) * 4096;
            bf16_t* dst = (bf16_t*)(P->ws + (which ? W_LX : W_LA)) + blk * 4096;
            cvt_tile(wv, src, 64, 0, 0, 64, nullptr, dst, 64, [=](int nl) { return nl; }, tile);
        }
    }
    __syncthreads();
}

__device__ __forceinline__ void phase_init(int wv, KP P) {
    const int w = tidx(wv) >> 6, lane = tidx(wv) & 63;
    float* x = P->out; bf16_t* xb = (bf16_t*)(P->ws + WS_XB); float* ssq = (float*)(P->ws + WS_SSQ);
    for (int row = bidx() * 8 + w; row < MT; row += gdim() * 8) {
        const float* src = row < MP ? P->in[I_XP] + (size_t)row * DM : P->in[I_XS] + (size_t)(row - MP) * DM;
        float ss = 0.f;
#pragma unroll
        for (int i = 0; i < 4; ++i) {
            const int c = (i * 64 + lane) * 4;
            const f32x4 v = *(const f32x4*)(src + c);
            *(f32x4*)(x + (size_t)row * DM + c) = v;
            u32x2 pw; pw.x = pk2(v[0], v[1]); pw.y = pk2(v[2], v[3]);
            *(u32x2*)(xb + (size_t)row * DM + c) = pw;
            ss += v[0] * v[0] + v[1] * v[1] + v[2] * v[2] + v[3] * v[3];
        }
#pragma unroll
        for (int d = 32; d >= 1; d >>= 1) ss += __shfl_xor(ss, d);
        if (lane < 16) ssq[(size_t)row * 16 + lane] = lane == 0 ? ss : 0.f;
        if (row >= MP && lane < 16) ssq[(WS_SSQ2 - WS_SSQ) / 4 + (size_t)(row - MP) * 16 + lane] = 0.f;
    }
}
__device__ __forceinline__ void phase_final(int wv, KP P) {
    const int w = tidx(wv) >> 6, lane = tidx(wv) & 63;
    float* x = P->out; const float* ssq = (const float*)(P->ws + WS_SSQ); const float* gf = P->in[I_FINAL];
    for (int row = bidx() * 8 + w; row < MT; row += gdim() * 8) {
        const float rs = rstd_row(ssq, row);
#pragma unroll
        for (int i = 0; i < 4; ++i) {
            const int c = (i * 64 + lane) * 4;
            f32x4 v = *(const f32x4*)(x + (size_t)row * DM + c); const f32x4 g = *(const f32x4*)(gf + c);
            v = v * rs * g;
            *(f32x4*)(x + (size_t)row * DM + c) = v;
        }
    }
}

struct Item { int row0, L, b, c, sb, sample; };
__device__ __forceinline__ Item get_item(int it) {
    Item I;
    if (it < 256) { I.b = it >> 7; I.c = it & 127; I.row0 = I.b * 8192 + I.c * 64; I.L = 64; I.sample = 0; I.sb = 0; }
    else { I.sb = it - 256; I.b = 0; I.c = 0; I.row0 = MP + I.sb * 16; I.L = 16; I.sample = 1; }
    return I;
}

__device__ __forceinline__ void copy_states_item(int wv, KP P, int l, const Item& I) {
    const bf16_t* h = (const bf16_t*)(P->ws + WS_H);
    const int tid = tidx(wv);
    if (!I.sample) {
        if (I.c >= 126) {
            for (int idx = tid; idx < 64 * 512; idx += 512) {
                const int t = idx >> 9, cc = idx & 511, kv = cc >> 8, e = cc & 255;
                const float v = bf2f(h[(size_t)(I.row0 + t) * HP + (kv ? HV : HK) + e]);
                P->out[(kv ? O_PV : O_PK) + ((size_t)(l * 2 + I.b) * 128 + (I.c - 126) * 64 + t) * 256 + e] = v;
            }
        }
        if (I.c == 127) {
            for (int idx = tid; idx < 3 * 1024; idx += 512) { const int j = idx >> 10, ch = idx & 1023;
                P->out[O_PLC + ((size_t)(l * 2 + I.b) * 3 + j) * 1024 + ch] = bf2f(h[(size_t)(I.row0 + 61 + j) * HP + HX + ch]); }
            for (int idx = tid; idx < 3 * 1536; idx += 512) { const int j = idx / 1536, ch = idx % 1536;
                P->out[O_PSC + ((size_t)(l * 2 + I.b) * 3 + j) * 1536 + ch] = bf2f(h[(size_t)(I.row0 + 61 + j) * HP + HXBC + ch]); }
        }
    } else {
        for (int idx = tid; idx < 128 * 512; idx += 512) {
            const int j = idx >> 9, cc = idx & 511, kv = cc >> 8, e = cc & 255;
            float v;
            if (j < 112) v = P->in[kv ? I_CV : I_CK][((size_t)(l * 16 + I.sb) * 128 + j + 16) * 256 + e];
            else v = bf2f(h[(size_t)(I.row0 + j - 112) * HP + (kv ? HV : HK) + e]);
            P->out[(kv ? O_SV : O_SK) + ((size_t)(l * 16 + I.sb) * 128 + j) * 256 + e] = v;
        }
        for (int idx = tid; idx < 3 * 1024; idx += 512) { const int j = idx >> 10, ch = idx & 1023;
            P->out[O_SLC + ((size_t)(l * 16 + I.sb) * 3 + j) * 1024 + ch] = bf2f(h[(size_t)(I.row0 + 13 + j) * HP + HX + ch]); }
        for (int idx = tid; idx < 3 * 1536; idx += 512) { const int j = idx / 1536, ch = idx % 1536;
            P->out[O_SSC + ((size_t)(l * 16 + I.sb) * 3 + j) * 1536 + ch] = bf2f(h[(size_t)(I.row0 + 13 + j) * HP + HXBC + ch]); }
    }
}

template <int L>
__device__ __forceinline__ void attn_item(int wv, KP P, int l, const Item& I, LAS unsigned char* lds) {
    constexpr int NS = (L == 64) ? 192 : 160;
    constexpr int NST = NS / 16, NKS = NS / 32, NQT = L / 16;
    const bf16_t* h = (const bf16_t*)(P->ws + WS_H);
    bf16_t* yabc = (bf16_t*)(P->ws + WS_Y);
    const int tid = tidx(wv), w = tid >> 6, lane = tid & 63, fr = lane & 15, fq = lane >> 4;
    LAS bf16_t* Kl = (LAS bf16_t*)lds;
    LAS bf16_t* Vt = Kl + 2 * 192 * 72;
    for (int pass = 0; pass < 2; ++pass) {
        __syncthreads();
        for (int idx = tid; idx < 2 * NS * 8; idx += 512) {
            const int dp = idx & 7, s = (idx >> 3) % NS, kvl = idx / (8 * NS), kvh = pass * 2 + kvl;
            u32x4 kw = (u32x4){0u, 0u, 0u, 0u}, vw = (u32x4){0u, 0u, 0u, 0u};
            if (L == 64) {
                const int pos = (I.c - 2) * 64 + s;
                if (pos >= 0) {
                    const bf16_t* rp = h + (size_t)(I.b * 8192 + pos) * HP + kvh * 64 + dp * 8;
                    kw = *(const u32x4*)(rp + HK); vw = *(const u32x4*)(rp + HV);
                }
            } else {
                if (s < 128) {
                    const size_t o = ((size_t)(l * 16 + I.sb) * 128 + s) * 256 + kvh * 64 + dp * 8;
                    const f32x4 k0 = *(const f32x4*)(P->in[I_CK] + o), k1 = *(const f32x4*)(P->in[I_CK] + o + 4);
                    const f32x4 v0 = *(const f32x4*)(P->in[I_CV] + o), v1 = *(const f32x4*)(P->in[I_CV] + o + 4);
                    kw.x = pk2(k0[0], k0[1]); kw.y = pk2(k0[2], k0[3]); kw.z = pk2(k1[0], k1[1]); kw.w = pk2(k1[2], k1[3]);
                    vw.x = pk2(v0[0], v0[1]); vw.y = pk2(v0[2], v0[3]); vw.z = pk2(v1[0], v1[1]); vw.w = pk2(v1[2], v1[3]);
                } else if (s < 144) {
                    const bf16_t* rp = h + (size_t)(I.row0 + s - 128) * HP + kvh * 64 + dp * 8;
                    kw = *(const u32x4*)(rp + HK); vw = *(const u32x4*)(rp + HV);
                }
            }
            *(LAS u32x4*)(Kl + (kvl * 192 + s) * 72 + dp * 8) = kw;
            LAS bf16_t* vp = Vt + (kvl * 64 + dp * 8) * 200 + s;
            vp[0 * 200] = (bf16_t)(vw.x & 0xffffu); vp[1 * 200] = (bf16_t)(vw.x >> 16); vp[2 * 200] = (bf16_t)(vw.y & 0xffffu); vp[3 * 200] = (bf16_t)(vw.y >> 16);
            vp[4 * 200] = (bf16_t)(vw.z & 0xffffu); vp[5 * 200] = (bf16_t)(vw.z >> 16); vp[6 * 200] = (bf16_t)(vw.w & 0xffffu); vp[7 * 200] = (bf16_t)(vw.w >> 16);
        }
        __syncthreads();
        const int head = pass * 8 + w, kvl = w >> 2;
        const float slope = exp2f(-0.5f * (float)(head + 1));
        const float sink = P->in[I_SINK][l * 16 + head];
#pragma unroll 1
        for (int qt = 0; qt < NQT; ++qt) {
            const bf16_t* qp = h + (size_t)(I.row0 + qt * 16 + fr) * HP + HQ + head * 64 + fq * 8;
            const bf16x8 q0 = *(const bf16x8*)qp, q1 = *(const bf16x8*)(qp + 32);
            f32x4 st[NST];
#pragma unroll
            for (int t = 0; t < NST; ++t) {
                const LAS bf16_t* kp = Kl + (kvl * 192 + t * 16 + fr) * 72 + fq * 8;
                f32x4 a = (f32x4){0.f, 0.f, 0.f, 0.f};
                a = MFMA16(*(const LAS bf16x8*)kp, q0, a);
                a = MFMA16(*(const LAS bf16x8*)(kp + 32), q1, a);
                st[t] = a;
                __builtin_amdgcn_sched_barrier(0);
            }
            const int qpos = (L == 64) ? (I.c * 64 + qt * 16 + fr) : (4096 + fr);
            float mx = sink;
#pragma unroll
            for (int t = 0; t < NST; ++t)
#pragma unroll
                for (int jj = 0; jj < 4; ++jj) {
                    const int s = t * 16 + fq * 4 + jj;
                    const int kpos = (L == 64) ? ((I.c - 2) * 64 + s) : (3968 + s);
                    const bool vis = (L == 64) ? (kpos >= 0) : (s < 144);
                    const float d = fabsf((float)(qpos - kpos));
                    const float sc = vis ? (st[t][jj] * 0.125f - slope * d) : -INFINITY;
                    st[t][jj] = sc; mx = fmaxf(mx, sc);
                }
            mx = fmaxf(mx, __shfl_xor(mx, 16)); mx = fmaxf(mx, __shfl_xor(mx, 32));
            float sum = 0.f;
#pragma unroll
            for (int t = 0; t < NST; ++t)
#pragma unroll
                for (int jj = 0; jj < 4; ++jj) { const float p = __expf(st[t][jj] - mx); st[t][jj] = p; sum += p; }
            sum += __shfl_xor(sum, 16); sum += __shfl_xor(sum, 32);
            const float inv = 1.0f / (sum + __expf(sink - mx));
            f32x4 o[4];
#pragma unroll
            for (int dt = 0; dt < 4; ++dt) o[dt] = (f32x4){0.f, 0.f, 0.f, 0.f};
#pragma unroll
            for (int ks = 0; ks < NKS; ++ks) {
                u32x4 pw; pw.x = pk2(st[2 * ks][0], st[2 * ks][1]); pw.y = pk2(st[2 * ks][2], st[2 * ks][3]);
                pw.z = pk2(st[2 * ks + 1][0], st[2 * ks + 1][1]); pw.w = pk2(st[2 * ks + 1][2], st[2 * ks + 1][3]);
                bf16x8 pf; __builtin_memcpy(&pf, &pw, 16);
#pragma unroll
                for (int dt = 0; dt < 4; ++dt) {
                    const LAS bf16_t* vp = Vt + (kvl * 64 + dt * 16 + fr) * 200 + ks * 32 + fq * 4;
                    const u32x2 va = *(const LAS u32x2*)vp, vb = *(const LAS u32x2*)(vp + 16);
                    u32x4 vw; vw.x = va.x; vw.y = va.y; vw.z = vb.x; vw.w = vb.y;
                    bf16x8 vf; __builtin_memcpy(&vf, &vw, 16);
                    o[dt] = MFMA16(vf, pf, o[dt]);
                }
            }
            bf16_t* op = yabc + (size_t)(I.row0 + qt * 16 + fr) * 3072 + 2048 + head * 64 + fq * 4;
#pragma unroll
            for (int dt = 0; dt < 4; ++dt) {
                u32x2 ow; ow.x = pk2(o[dt][0] * inv, o[dt][1] * inv); ow.y = pk2(o[dt][2] * inv, o[dt][3] * inv);
                *(u32x2*)(op + dt * 16) = ow;
            }
        }
    }
}

template <int CTRL> __device__ __forceinline__ float dpp_f(float old, float src) {
    return __int_as_float(__builtin_amdgcn_update_dpp(__float_as_int(old), __float_as_int(src), CTRL, 0xf, 0xf, false));
}
template <int L, bool FINAL>
__device__ __forceinline__ void lru_item(int wv, KP P, int l, int item, const Item& I, LAS unsigned char* lds) {
    constexpr int NIT = L / 16, XP = 1032;
    const bf16_t* h = (const bf16_t*)(P->ws + WS_H);
    bf16_t* yabc = (bf16_t*)(P->ws + WS_Y);
    float* lruA = (float*)(P->ws + WS_LRUA); float* lruU = (float*)(P->ws + WS_LRUU);
    const int tid = tidx(wv), w = tid >> 6, lane = tid & 63, fr = lane & 15, fq = lane >> 4;
    LAS bf16_t* xa = (LAS bf16_t*)lds;
    __syncthreads();
    {
        const int ch = 2 * tid;
        const float* cw = P->in[I_LCW] + (size_t)l * 4 * 1024 + ch;
        const f32x2_t w0 = *(const f32x2_t*)cw, w1 = *(const f32x2_t*)(cw + 1024), w2 = *(const f32x2_t*)(cw + 2048), w3 = *(const f32x2_t*)(cw + 3072);
        const f32x2_t cb = *(const f32x2_t*)(P->in[I_LCB] + l * 1024 + ch);
        f32x2_t xm3 = {0.f, 0.f}, xm2 = {0.f, 0.f}, xm1 = {0.f, 0.f};
        if (I.sample) { const float* st = P->in[I_SLC] + (size_t)(l * 16 + I.sb) * 3 * 1024 + ch; xm3 = *(const f32x2_t*)st; xm2 = *(const f32x2_t*)(st + 1024); xm1 = *(const f32x2_t*)(st + 2048); }
        else if (I.c > 0) { const bf16_t* hq = h + (size_t)(I.row0 - 3) * HP + HX + ch;
            const unsigned a0 = *(const unsigned*)hq, a1 = *(const unsigned*)(hq + HP), a2 = *(const unsigned*)(hq + 2 * (size_t)HP);
            xm3 = (f32x2_t){bflo(a0), bfhi(a0)}; xm2 = (f32x2_t){bflo(a1), bfhi(a1)}; xm1 = (f32x2_t){bflo(a2), bfhi(a2)}; }
        const bf16_t* hp = h + (size_t)I.row0 * HP + HX + ch;
#pragma unroll 8
        for (int t = 0; t < L; ++t) {
            const unsigned xw = *(const unsigned*)(hp + (size_t)t * HP);
            const f32x2_t x0 = {bflo(xw), bfhi(xw)};
            const f32x2_t y = cb + w0 * xm3 + w1 * xm2 + w2 * xm1 + w3 * x0;
            *(LAS unsigned*)(xa + t * XP + ch) = pk2(y[0], y[1]);
            xm3 = xm2; xm2 = xm1; xm1 = x0;
        }
    }
    __syncthreads();
#pragma unroll 1
    for (int pass = 0; pass < 2; ++pass) {
        const int blk = w + 8 * pass, ch0 = blk * 64;
        const bf16_t* waT = (const bf16_t*)(P->ws + W_LA) + blk * 4096;
        const bf16_t* wxT = (const bf16_t*)(P->ws + W_LX) + blk * 4096;
        float carryH[4][4], carryA[4][4], c8v[4][4];
#pragma unroll
        for (int jt = 0; jt < 4; ++jt)
#pragma unroll
            for (int jj = 0; jj < 4; ++jj) {
                const int ch = ch0 + jt * 16 + fq * 4 + jj;
                carryA[jt][jj] = 1.0f;
                c8v[jt][jj] = 8.0f * softplusf_(-P->in[I_LLAM][l * 1024 + ch]);
                if (FINAL) carryH[jt][jj] = I.sample ? P->in[I_SLH][(l * 16 + I.sb) * 1024 + ch] : lruU[(size_t)item * 1024 + ch];
                else carryH[jt][jj] = 0.f;
            }
#pragma unroll 1
        for (int it = 0; it < NIT; ++it) {
            const LAS bf16_t* xp = xa + (it * 16 + fr) * XP + ch0;
            const bf16x8 b0 = *(const LAS bf16x8*)(xp + fq * 8), b1 = *(const LAS bf16x8*)(xp + 32 + fq * 8);
            const int token = it * 16 + fr;
#pragma unroll
            for (int jt = 0; jt < 4; ++jt) {
                const bf16_t* wa = waT + (jt * 16 + fr) * 64 + fq * 8; const bf16_t* wx = wxT + (jt * 16 + fr) * 64 + fq * 8;
                f32x4 ra = (f32x4){0.f, 0.f, 0.f, 0.f}, ia = (f32x4){0.f, 0.f, 0.f, 0.f};
                ra = MFMA16(*(const bf16x8*)wa, b0, ra); ra = MFMA16(*(const bf16x8*)(wa + 32), b1, ra);
                ia = MFMA16(*(const bf16x8*)wx, b0, ia); ia = MFMA16(*(const bf16x8*)(wx + 32), b1, ia);
                const u32x2 xw = *(const LAS u32x2*)(xp + jt * 16 + fq * 4);
                const float xv[4] = {bflo(xw.x), bfhi(xw.x), bflo(xw.y), bfhi(xw.y)};
                const f32x4 bav = *(const f32x4*)(P->in[I_LBA] + l * 1024 + ch0 + jt * 16 + fq * 4), bxv = *(const f32x4*)(P->in[I_LBX] + l * 1024 + ch0 + jt * 16 + fq * 4);
                float hv[4], av[4];
#pragma unroll
                for (int jj = 0; jj < 4; ++jj) {
                    const float r = sigmoidf_(ra[jj] + bav[jj]);
                    const float ig = sigmoidf_(ia[jj] + bxv[jj]);
                    const float la = -c8v[jt][jj] * r;
                    float a = __expf(la);
                    float u = sqrtf(fmaxf(1.0f - a * a, 0.f)) * ig * xv[jj];
                    { const float ap = dpp_f<0x111>(1.0f, a), up = dpp_f<0x111>(0.0f, u); u = a * up + u; a = a * ap; }
                    { const float ap = dpp_f<0x112>(1.0f, a), up = dpp_f<0x112>(0.0f, u); u = a * up + u; a = a * ap; }
                    { const float ap = dpp_f<0x114>(1.0f, a), up = dpp_f<0x114>(0.0f, u); u = a * up + u; a = a * ap; }
                    { const float ap = dpp_f<0x118>(1.0f, a), up = dpp_f<0x118>(0.0f, u); u = a * up + u; a = a * ap; }
                    const float hval = a * carryH[jt][jj] + u;
                    hv[jj] = hval;
                    carryH[jt][jj] = __shfl(hval, 15, 16);
                    if (!FINAL) { const float at = carryA[jt][jj] * a; av[jj] = at; carryA[jt][jj] = __shfl(at, 15, 16); }
                }
                if (!FINAL) {
                    u32x2 ow; ow.x = pk2(hv[0], hv[1]); ow.y = pk2(hv[2], hv[3]);
                    *(u32x2*)(yabc + (size_t)(I.row0 + token) * 3072 + ch0 + jt * 16 + fq * 4) = ow;
                    u32x2 aw; aw.x = pk2(av[0], av[1]); aw.y = pk2(av[2], av[3]);
                    *(u32x2*)((bf16_t*)(P->ws + WS_XB) + (size_t)(I.row0 + token) * DM + ch0 + jt * 16 + fq * 4) = aw;
                }
                if (FINAL) {
                    const u32x2 gw = *(const u32x2*)(h + (size_t)(I.row0 + token) * HP + HG + ch0 + jt * 16 + fq * 4);
                    u32x2 ow; ow.x = pk2(hv[0] * gelu_tanh(bflo(gw.x)), hv[1] * gelu_tanh(bfhi(gw.x)));
                    ow.y = pk2(hv[2] * gelu_tanh(bflo(gw.y)), hv[3] * gelu_tanh(bfhi(gw.y)));
                    *(u32x2*)(yabc + (size_t)(I.row0 + token) * 3072 + ch0 + jt * 16 + fq * 4) = ow;
                    if (it == NIT - 1 && fr == 15) {
                        if (I.sample) *(f32x4*)(P->out + O_SLH + (size_t)(l * 16 + I.sb) * 1024 + ch0 + jt * 16 + fq * 4) = (f32x4){hv[0], hv[1], hv[2], hv[3]};
                        else if (I.c == 127) *(f32x4*)(P->out + O_PLH + (size_t)(l * 2 + I.b) * 1024 + ch0 + jt * 16 + fq * 4) = (f32x4){hv[0], hv[1], hv[2], hv[3]};
                    }
                }
            }
        }
        if (!FINAL) {
            if (fr == 0) {
#pragma unroll
                for (int jt = 0; jt < 4; ++jt) {
                    *(f32x4*)(lruA + (size_t)item * 1024 + ch0 + jt * 16 + fq * 4) = (f32x4){carryA[jt][0], carryA[jt][1], carryA[jt][2], carryA[jt][3]};
                    *(f32x4*)(lruU + (size_t)item * 1024 + ch0 + jt * 16 + fq * 4) = (f32x4){carryH[jt][0], carryH[jt][1], carryH[jt][2], carryH[jt][3]};
                }
            }
        }
    }
}

__device__ __forceinline__ void lru_apply_item(int wv, KP P, int l, int item, const Item& I) {
    const bf16_t* h = (const bf16_t*)(P->ws + WS_H);
    bf16_t* yabc = (bf16_t*)(P->ws + WS_Y);
    const bf16_t* acum = (const bf16_t*)(P->ws + WS_XB);
    const float* carry = (const float*)(P->ws + WS_LRUU) + (size_t)item * 1024;
    const int tid = tidx(wv);
    const int c8 = (tid & 127) * 8;
    const f32x4 ca = *(const f32x4*)(carry + c8), cb = *(const f32x4*)(carry + c8 + 4);
    const float cv[8] = {ca[0], ca[1], ca[2], ca[3], cb[0], cb[1], cb[2], cb[3]};
#pragma unroll 4
    for (int t = tid >> 7; t < 64; t += 4) {
        const size_t r = (size_t)(I.row0 + t);
        const u32x4 aw = *(const u32x4*)(acum + r * DM + c8), hw = *(const u32x4*)(yabc + r * 3072 + c8), gw = *(const u32x4*)(h + r * HP + HG + c8);
        const unsigned au[4] = {aw.x, aw.y, aw.z, aw.w}, hu[4] = {hw.x, hw.y, hw.z, hw.w}, gu[4] = {gw.x, gw.y, gw.z, gw.w};
        float hv[8]; unsigned ou[4];
#pragma unroll
        for (int e = 0; e < 4; ++e) {
            hv[2 * e] = bflo(au[e]) * cv[2 * e] + bflo(hu[e]); hv[2 * e + 1] = bfhi(au[e]) * cv[2 * e + 1] + bfhi(hu[e]);
            ou[e] = pk2(hv[2 * e] * gelu_tanh(bflo(gu[e])), hv[2 * e + 1] * gelu_tanh(bfhi(gu[e])));
        }
        *(u32x4*)(yabc + r * 3072 + c8) = (u32x4){ou[0], ou[1], ou[2], ou[3]};
        if (I.c == 127 && t == 63) {
            float* op = P->out + O_PLH + (size_t)(l * 2 + I.b) * 1024 + c8;
            *(f32x4*)op = (f32x4){hv[0], hv[1], hv[2], hv[3]}; *(f32x4*)(op + 4) = (f32x4){hv[4], hv[5], hv[6], hv[7]};
        }
    }
}

__device__ __forceinline__ float pre_xbc(KP P, const bf16_t* h, int l, const Item& I, int tt, int ch) {
    if (tt >= 0 || (!I.sample && I.c > 0)) return bf2f(h[(size_t)(I.row0 + tt) * HP + HXBC + ch]);
    if (I.sample) return P->in[I_SSC][((size_t)(l * 16 + I.sb) * 3 + (3 + tt)) * 1536 + ch];
    return 0.f;
}
__device__ __forceinline__ float conv_xbc(KP P, const bf16_t* h, int l, const Item& I, int t, int ch) {
    const float* cw = P->in[I_SCW] + (size_t)l * 4 * 1536 + ch;
    float y = P->in[I_SCB][l * 1536 + ch];
    y += cw[0] * pre_xbc(P, h, l, I, t - 3, ch); y += cw[1536] * pre_xbc(P, h, l, I, t - 2, ch);
    y += cw[3072] * pre_xbc(P, h, l, I, t - 1, ch); y += cw[4608] * pre_xbc(P, h, l, I, t, ch);
    return siluf_(y);
}
template <class F>
__device__ __forceinline__ void conv_roll(KP P, const bf16_t* h, int l, const Item& I, int chx, int t0, int t1, F f) {
    const float* cw = P->in[I_SCW] + (size_t)l * 4 * 1536 + chx;
    const float w0 = cw[0], w1 = cw[1536], w2 = cw[3072], w3 = cw[4608], cb = P->in[I_SCB][l * 1536 + chx];
    float xm3 = pre_xbc(P, h, l, I, t0 - 3, chx), xm2 = pre_xbc(P, h, l, I, t0 - 2, chx), xm1 = pre_xbc(P, h, l, I, t0 - 1, chx);
    const bf16_t* hp = h + (size_t)I.row0 * HP + HXBC + chx;
#pragma unroll 8
    for (int t = t0; t < t1; ++t) {
        const float x0 = bf2f(hp[(size_t)t * HP]);
        const float y = cb + w0 * xm3 + w1 * xm2 + w2 * xm1 + w3 * x0;
        f(t, siluf_(y));
        xm3 = xm2; xm2 = xm1; xm1 = x0;
    }
}
template <int L, int NCH8, class CF, class F>
__device__ __forceinline__ void ssd_stage(KP P, const bf16_t* h, int l, const Item& I, int tid, CF chx_of, F f) {
    constexpr int NSEG = 512 / NCH8, TS = L / NSEG;
    static_assert(TS >= 1 && TS * NSEG == L, "segmenting");
    const int c8 = tid % NCH8, sg = tid / NCH8, t0 = sg * TS, chx = chx_of(c8);
    u32x4 xr[TS + 3];
#pragma unroll
    for (int q = 0; q < TS + 3; ++q) {
        const int tt = t0 - 3 + q;
        if (tt >= 0 || (!I.sample && I.c > 0)) {
            xr[q] = *(const u32x4*)(h + (size_t)(I.row0 + tt) * HP + HXBC + chx);
        } else if (I.sample) {
            const float* st = P->in[I_SSC] + ((size_t)(l * 16 + I.sb) * 3 + (3 + tt)) * 1536 + chx;
            const f32x4 a = *(const f32x4*)st, b = *(const f32x4*)(st + 4);
            xr[q] = (u32x4){pk2(a[0], a[1]), pk2(a[2], a[3]), pk2(b[0], b[1]), pk2(b[2], b[3])};
        } else xr[q] = (u32x4){0u, 0u, 0u, 0u};
    }
    const float* cw = P->in[I_SCW] + (size_t)l * 4 * 1536 + chx;
    float wt[4][8], cb[8];
#pragma unroll
    for (int j = 0; j < 4; ++j) { const f32x4 a = *(const f32x4*)(cw + j * 1536), b = *(const f32x4*)(cw + j * 1536 + 4);
        wt[j][0] = a[0]; wt[j][1] = a[1]; wt[j][2] = a[2]; wt[j][3] = a[3]; wt[j][4] = b[0]; wt[j][5] = b[1]; wt[j][6] = b[2]; wt[j][7] = b[3]; }
    { const f32x4 a = *(const f32x4*)(P->in[I_SCB] + l * 1536 + chx), b = *(const f32x4*)(P->in[I_SCB] + l * 1536 + chx + 4);
        cb[0] = a[0]; cb[1] = a[1]; cb[2] = a[2]; cb[3] = a[3]; cb[4] = b[0]; cb[5] = b[1]; cb[6] = b[2]; cb[7] = b[3]; }
#pragma unroll
    for (int q = 0; q < TS; ++q) {
        float v[8];
#pragma unroll
        for (int e2 = 0; e2 < 4; ++e2) {
            const unsigned r0 = xr[q][e2], r1 = xr[q + 1][e2], r2 = xr[q + 2][e2], r3 = xr[q + 3][e2];
            v[2 * e2] = siluf_(cb[2 * e2] + wt[0][2 * e2] * bflo(r0) + wt[1][2 * e2] * bflo(r1) + wt[2][2 * e2] * bflo(r2) + wt[3][2 * e2] * bflo(r3));
            v[2 * e2 + 1] = siluf_(cb[2 * e2 + 1] + wt[0][2 * e2 + 1] * bfhi(r0) + wt[1][2 * e2 + 1] * bfhi(r1) + wt[2][2 * e2 + 1] * bfhi(r2) + wt[3][2 * e2 + 1] * bfhi(r3));
        }
        f(t0 + q, c8, v);
    }
}
template <int L>
__device__ __forceinline__ void ssd_dtcum(int wv, KP P, int l, const Item& I, LAS float* dtv, LAS float* cumv) {
    const float* dtraw = (const float*)(P->ws + WS_DT);
    const int tid = tidx(wv);
    __syncthreads();
    for (int idx = tid; idx < L * 16; idx += 512) { const int hd = idx & 15; dtv[idx] = softplusf_(dtraw[(size_t)I.row0 * 16 + idx] + P->in[I_SDTB][l * 16 + hd]); }
    __syncthreads();
    if (tid < 64) {
        constexpr int SEG = L / 4;
        const int hd = tid & 15, sg = tid >> 4;
        const float A = -__expf(P->in[I_SALOG][l * 16 + hd]);
        float c = 0.f;
#pragma unroll
        for (int t = 0; t < SEG; ++t) { c += dtv[(sg * SEG + t) * 16 + hd] * A; cumv[(sg * SEG + t) * 16 + hd] = c; }
        const float t1 = __shfl(c, hd), t2 = __shfl(c, 16 + hd), t3 = __shfl(c, 32 + hd);
        const float off = sg == 0 ? 0.f : (sg == 1 ? t1 : (sg == 2 ? t1 + t2 : t1 + t2 + t3));
#pragma unroll
        for (int t = 0; t < SEG; ++t) cumv[(sg * SEG + t) * 16 + hd] += off;
    }
    __syncthreads();
}

template <int L>
__device__ __forceinline__ void ssd_states_item(int wv, KP P, int l, int item, const Item& I, LAS unsigned char* lds) {
    constexpr int LP = L < 32 ? 32 : L, KS = LP / 32;
    const bf16_t* h = (const bf16_t*)(P->ws + WS_H);
    bf16_t* states = (bf16_t*)(P->ws + WS_ST);
    float* cdec = (float*)(P->ws + WS_CDEC);
    const int tid = tidx(wv), w = tid >> 6, lane = tid & 63, fr = lane & 15, fq = lane >> 4;
    LAS float* dtv = (LAS float*)lds; LAS float* cumv = dtv + 1024;
    LAS bf16_t* BmT = (LAS bf16_t*)(lds + 8192);
    LAS bf16_t* xw = (LAS bf16_t*)(lds + 8192 + 36864) + w * (64 * 72);
    ssd_dtcum<L>(wv, P, l, I, dtv, cumv);
    LAS bf16_t* xwall = (LAS bf16_t*)(lds + 8192 + 36864);
    ssd_stage<L, 32>(P, h, l, I, tid, [](int c8) { return 1024 + c8 * 8; }, [&](int t, int c8, const float* v) {
#pragma unroll
        for (int e = 0; e < 8; ++e) BmT[(c8 * 8 + e) * 72 + t] = f2bf(v[e]); });
    if (L < LP) for (int idx = tid; idx < 256 * (LP - L); idx += 512) BmT[(idx / (LP - L)) * 72 + L + idx % (LP - L)] = 0;
    for (int hh = 0; hh < 2; ++hh) {
        const int head = w + 8 * hh;
        const float cl = cumv[(L - 1) * 16 + head];
        __syncthreads();
        ssd_stage<L, 64>(P, h, l, I, tid, [=](int c8) { return hh * 512 + c8 * 8; }, [&](int t, int c8, const float* v) {
            const int hd = hh * 8 + (c8 >> 3);
            const float sc = __expf(cumv[(L - 1) * 16 + hd] - cumv[t * 16 + hd]) * dtv[t * 16 + hd];
            LAS bf16_t* dst = xwall + (c8 >> 3) * (64 * 72) + ((c8 & 7) * 8) * 72 + t;
#pragma unroll
            for (int e = 0; e < 8; ++e) dst[e * 72] = f2bf(v[e] * sc); });
        if (L < LP) for (int idx = tid; idx < 512 * (LP - L); idx += 512) xwall[(idx / (LP - L)) * 72 + L + idx % (LP - L)] = 0;
        __syncthreads();
        const float dec = __expf(cl);
        if (!I.sample && lane == 0) cdec[item * 16 + head] = dec;
#pragma unroll 1
        for (int nt = 0; nt < 8; ++nt) {
            bf16x8 af[KS];
#pragma unroll
            for (int ks = 0; ks < KS; ++ks) af[ks] = *(const LAS bf16x8*)(BmT + (hh * 128 + nt * 16 + fr) * 72 + ks * 32 + fq * 8);
#pragma unroll
            for (int pt = 0; pt < 4; ++pt) {
                f32x4 a = (f32x4){0.f, 0.f, 0.f, 0.f};
#pragma unroll
                for (int ks = 0; ks < KS; ++ks) a = MFMA16(af[ks], *(const LAS bf16x8*)(xw + (pt * 16 + fr) * 72 + ks * 32 + fq * 8), a);
                const int p = pt * 16 + fr, n0 = nt * 16 + fq * 4;
                if (!I.sample) {
                    u32x2 ow; ow.x = pk2(a[0], a[1]); ow.y = pk2(a[2], a[3]);
                    *(u32x2*)(states + ((size_t)((I.b * 128 + I.c) * 16 + head) * 64 + p) * 128 + n0) = ow;
                } else {
                    const size_t o = ((size_t)((l * 16 + I.sb) * 16 + head) * 64 + p) * 128 + n0;
                    const f32x4 h0 = *(const f32x4*)(P->in[I_SSH] + o);
                    *(f32x4*)(P->out + O_SSH + o) = h0 * dec + a;
                }
            }
        }
    }
}

template <int L>
__device__ __forceinline__ void ssd_y_item(int wv, KP P, int l, const Item& I, LAS unsigned char* lds) {
    constexpr int LP = L < 32 ? 32 : L, KS = LP / 32, NIT = L / 16;
    const bf16_t* h = (const bf16_t*)(P->ws + WS_H);
    const bf16_t* states = (const bf16_t*)(P->ws + WS_ST);
    bf16_t* yabc = (bf16_t*)(P->ws + WS_Y);
    const int tid = tidx(wv), w = tid >> 6, lane = tid & 63, fr = lane & 15, fq = lane >> 4;
    LAS float* dtv = (LAS float*)lds; LAS float* cumv = dtv + 1024;
    LAS bf16_t* Bm = (LAS bf16_t*)(lds + 8192);
    LAS bf16_t* Cm = (LAS bf16_t*)(lds + 8192 + 17408);
    LAS float* CBl = (LAS float*)(lds + 8192 + 2 * 17408);
    LAS float* part = (LAS float*)(lds + 8192 + 3 * 17408);
    LAS bf16_t* xT = (LAS bf16_t*)(lds + 8192 + 3 * 17408 + 2048) + w * (64 * 72);
    ssd_dtcum<L>(wv, P, l, I, dtv, cumv);
    for (int g = 0; g < 2; ++g) {
        const int head = g * 8 + w;
        __syncthreads();
        ssd_stage<L, 32>(P, h, l, I, tid, [=](int c8) { return 1024 + (c8 >> 4) * 256 + g * 128 + (c8 & 15) * 8; }, [&](int t, int c8, const float* v) {
            u32x4 ow; ow.x = pk2(v[0], v[1]); ow.y = pk2(v[2], v[3]); ow.z = pk2(v[4], v[5]); ow.w = pk2(v[6], v[7]);
            *(LAS u32x4*)(((c8 >> 4) ? Cm : Bm) + t * 136 + (c8 & 15) * 8) = ow; });
        {
            LAS bf16_t* xTall = (LAS bf16_t*)(lds + 8192 + 3 * 17408 + 2048);
            ssd_stage<L, 64>(P, h, l, I, tid, [=](int c8) { return g * 512 + c8 * 8; }, [&](int t, int c8, const float* v) {
                LAS bf16_t* dst = xTall + (c8 >> 3) * (64 * 72) + ((c8 & 7) * 8) * 72 + t;
#pragma unroll
                for (int e = 0; e < 8; ++e) dst[e * 72] = f2bf(v[e]); });
            if (L < LP) for (int idx = tid; idx < 512 * (LP - L); idx += 512) xTall[(idx / (LP - L)) * 72 + L + idx % (LP - L)] = 0;
        }
        __syncthreads();
        for (int tix = w; tix < NIT * NIT; tix += 8) {
            const int it = tix / NIT, jt = tix % NIT;
            f32x4 a = (f32x4){0.f, 0.f, 0.f, 0.f};
#pragma unroll
            for (int ks = 0; ks < 4; ++ks)
                a = MFMA16(*(const LAS bf16x8*)(Cm + (it * 16 + fr) * 136 + ks * 32 + fq * 8), *(const LAS bf16x8*)(Bm + (jt * 16 + fr) * 136 + ks * 32 + fq * 8), a);
#pragma unroll
            for (int jj = 0; jj < 4; ++jj) CBl[(it * 16 + fq * 4 + jj) * 68 + jt * 16 + fr] = a[jj];
        }
        __syncthreads();
        const float dsk = P->in[I_SD][l * 16 + head];
#pragma unroll 1
        for (int it = 0; it < NIT; ++it) {
            const int i = it * 16 + fr; const float cum_i = cumv[i * 16 + head];
            f32x4 acc[4];
#pragma unroll
            for (int pt = 0; pt < 4; ++pt) acc[pt] = (f32x4){0.f, 0.f, 0.f, 0.f};
#pragma unroll
            for (int ks = 0; ks < KS; ++ks) {
                if (ks * 32 > it * 16 + 15) continue;
                const int j0 = ks * 32 + fq * 8;
                const f32x4 c0 = *(const LAS f32x4*)(CBl + i * 68 + j0), c1 = *(const LAS f32x4*)(CBl + i * 68 + j0 + 4);
                float wv8[8];
#pragma unroll
                for (int e = 0; e < 8; ++e) {
                    const int j = j0 + e; const float cb = e < 4 ? c0[e & 3] : c1[e & 3];
                    const float ex = __expf(fminf(cum_i - cumv[j * 16 + head], 0.f));
                    wv8[e] = (j <= i) ? cb * ex * dtv[j * 16 + head] : 0.f;
                }
                u32x4 ww; ww.x = pk2(wv8[0], wv8[1]); ww.y = pk2(wv8[2], wv8[3]); ww.z = pk2(wv8[4], wv8[5]); ww.w = pk2(wv8[6], wv8[7]);
                bf16x8 wf; __builtin_memcpy(&wf, &ww, 16);
#pragma unroll
                for (int pt = 0; pt < 4; ++pt) acc[pt] = MFMA16(*(const LAS bf16x8*)(xT + (pt * 16 + fr) * 72 + j0), wf, acc[pt]);
            }
            const float ecum = __expf(cum_i);
            bf16x8 cf[4];
#pragma unroll
            for (int ks = 0; ks < 4; ++ks) cf[ks] = *(const LAS bf16x8*)(Cm + i * 136 + ks * 32 + fq * 8);
#pragma unroll
            for (int pt = 0; pt < 4; ++pt) {
                bf16x8 hf[4];
                const int p = pt * 16 + fr;
                if (!I.sample) {
                    const bf16_t* sp = states + ((size_t)((I.b * 128 + I.c) * 16 + head) * 64 + p) * 128 + fq * 8;
#pragma unroll
                    for (int ks = 0; ks < 4; ++ks) hf[ks] = *(const bf16x8*)(sp + ks * 32);
                } else {
                    const float* sp = P->in[I_SSH] + ((size_t)((l * 16 + I.sb) * 16 + head) * 64 + p) * 128 + fq * 8;
#pragma unroll
                    for (int ks = 0; ks < 4; ++ks) {
                        const f32x4 a0 = *(const f32x4*)(sp + ks * 32), a1 = *(const f32x4*)(sp + ks * 32 + 4);
                        u32x4 ww; ww.x = pk2(a0[0], a0[1]); ww.y = pk2(a0[2], a0[3]); ww.z = pk2(a1[0], a1[1]); ww.w = pk2(a1[2], a1[3]);
                        __builtin_memcpy(&hf[ks], &ww, 16);
                    }
                }
                f32x4 t2 = (f32x4){0.f, 0.f, 0.f, 0.f};
#pragma unroll
                for (int ks = 0; ks < 4; ++ks) t2 = MFMA16(hf[ks], cf[ks], t2);
                acc[pt] += t2 * ecum;
            }
            float ss = 0.f;
#pragma unroll
            for (int pt = 0; pt < 4; ++pt) {
                const int p0 = pt * 16 + fq * 4;
                const u32x2 zw = *(const u32x2*)(h + (size_t)(I.row0 + i) * HP + HZ + head * 64 + p0);
                const float zv[4] = {bflo(zw.x), bfhi(zw.x), bflo(zw.y), bfhi(zw.y)};
                float yv[4];
#pragma unroll
                for (int jj = 0; jj < 4; ++jj) {
                    const float xs = bf2f(xT[(p0 + jj) * 72 + i]);
                    const float y = (acc[pt][jj] + dsk * xs) * siluf_(zv[jj]);
                    yv[jj] = y; ss += y * y;
                }
                u32x2 ow; ow.x = pk2(yv[0], yv[1]); ow.y = pk2(yv[2], yv[3]);
                *(u32x2*)(yabc + (size_t)(I.row0 + i) * 3072 + 1024 + head * 64 + p0) = ow;
            }
            ss += __shfl_xor(ss, 16); ss += __shfl_xor(ss, 32);
            if (fq == 0) part[i * 8 + w] = ss;
        }
        __syncthreads();
#pragma unroll 1
        for (int it = 0; it < NIT; ++it) {
            const int i = it * 16 + fr;
            const f32x4 pa = *(const LAS f32x4*)(part + i * 8), pb = *(const LAS f32x4*)(part + i * 8 + 4);
            const float tot = (pa[0] + pa[1] + pa[2] + pa[3]) + (pb[0] + pb[1] + pb[2] + pb[3]);
            const float rs = rsqrtf(tot * (1.0f / 512.0f) + EPS);
#pragma unroll
            for (int pt = 0; pt < 4; ++pt) {
                const int p0 = pt * 16 + fq * 4;
                const f32x4 ng = *(const f32x4*)(P->in[I_SNORM] + l * 1024 + head * 64 + p0);
                u32x2* yp = (u32x2*)(yabc + (size_t)(I.row0 + i) * 3072 + 1024 + head * 64 + p0);
                const u32x2 yw = *yp;
                u32x2 ow; ow.x = pk2(bflo(yw.x) * rs * ng[0], bfhi(yw.x) * rs * ng[1]); ow.y = pk2(bflo(yw.y) * rs * ng[2], bfhi(yw.y) * rs * ng[3]);
                *yp = ow;
            }
        }
    }
}

__device__ __forceinline__ void phase_scan(int wv, KP P, int l) {
    bf16_t* states = (bf16_t*)(P->ws + WS_ST);
    const float* cdec = (const float*)(P->ws + WS_CDEC);
    const float* lruA = (const float*)(P->ws + WS_LRUA); float* lruU = (float*)(P->ws + WS_LRUU);
    if (DBG_P5S) for (int idx = bidx() * 512 + tidx(wv); idx < 131072; idx += gdim() * 512) {
        const int e = idx * 2, b = e >> 17, rem = e & 131071, head = rem >> 13;
        unsigned* sp = (unsigned*)(states + (size_t)b * 128 * 131072 + rem);
        const float* dp = cdec + (b * 128) * 16 + head;
        float c0 = 0.f, c1 = 0.f;
        for (int c = 0; c < 128; c += 8) {
            unsigned v[8];
#pragma unroll
            for (int k = 0; k < 8; ++k) v[k] = sp[(size_t)(c + k) * 65536];
#pragma unroll
            for (int k = 0; k < 8; ++k) {
                const float dec = dp[(c + k) * 16];
                if (DBG_P5W) sp[(size_t)(c + k) * 65536] = pk2(c0, c1);
                c0 = dec * c0 + bflo(v[k]); c1 = dec * c1 + bfhi(v[k]);
            }
        }
        float* op = P->out + O_PSH + (size_t)(l * 2 + b) * 131072 + rem;
        op[0] = c0; op[1] = c1;
    }
    if (DBG_LRU4) for (int idx = bidx() * 512 + tidx(wv); idx < 2048; idx += gdim() * 512) {
        const int b = idx >> 10, ch = idx & 1023;
        float carry = 0.f;
        for (int c = 0; c < 128; ++c) {
            const size_t o = (size_t)(b * 128 + c) * 1024 + ch;
            const float A = lruA[o], U = lruU[o];
            lruU[o] = carry;
            carry = A * carry + U;
        }
    }
}

__device__ __forceinline__ void gsync(cg::grid_group& grid) {
    __threadfence(); grid.sync();
    __builtin_amdgcn_fence(__ATOMIC_ACQUIRE, "agent"); asm volatile("s_waitcnt vmcnt(0)" ::: "memory");
}
#define XB_TMO      128
#define XB_XCNT(j)  (256  + 64 * (j))
#define XB_XSUB(j)  (1280 + 64 * (j))
#define XB_XGEN(j)  (2304 + 64 * (j))
#define XB_TOP      3328
#define XB_TOPGEN   3392
#define XCD_BAR_WORDS 3456
#define XB_SPIN_CAP (1u << 20)
__device__ __forceinline__ unsigned xb_ld(unsigned* p)              { return __hip_atomic_load(p, __ATOMIC_RELAXED, __HIP_MEMORY_SCOPE_AGENT); }
__device__ __forceinline__ unsigned xb_add(unsigned* p, unsigned v) { return __hip_atomic_fetch_add(p, v, __ATOMIC_RELAXED, __HIP_MEMORY_SCOPE_AGENT); }
__device__ __forceinline__ unsigned xb_xcc_id() { return (unsigned)__builtin_amdgcn_s_getreg((3 << 11) | 20) & 0xFu; }
#define XB_SPIN(cond, bar) do { unsigned _sp = 0; while (cond) { __builtin_amdgcn_s_sleep(1); \
    if ((++_sp & 255u) == 0u) { if (xb_ld(&(bar)[XB_TMO])) break; if (_sp > XB_SPIN_CAP) { atomicAdd(&(bar)[XB_TMO], 1u); break; } } } } while (0)
__device__ __forceinline__ void xcd_barrier_complete(unsigned* bar, unsigned x, unsigned& nloc, unsigned& nx) {
    const unsigned G = (unsigned)gdim();
    unsigned sum, cnt, mine, sp = 0u;
    for (;;) {
        sum = 0u; cnt = 0u; mine = 0u;
#pragma unroll
        for (unsigned j = 0; j < 16; ++j) { const unsigned c = xb_ld(&bar[XB_XCNT(j)]); sum += c; cnt += (c > 0u) ? 1u : 0u; mine = (j == x) ? c : mine; }
        if (sum == G) break;
        __builtin_amdgcn_s_sleep(1);
        if ((++sp & 255u) == 0u) { if (xb_ld(&bar[XB_TMO])) break; if (sp > XB_SPIN_CAP) { atomicAdd(&bar[XB_TMO], 1u); break; } }
    }
    nloc = mine > 0u ? mine : 1u; nx = cnt > 0u ? cnt : 1u;
}
__device__ __forceinline__ void gbar(int wv, LAS unsigned char* lds) {
    asm volatile("s_waitcnt vmcnt(0)" ::: "memory");
    __syncthreads();
    unsigned* bar = (unsigned*)(kparams()->ws + WS_BAR);
    if (tidx(wv) == 0) {
        volatile LAS unsigned* st = (volatile LAS unsigned*)(lds + LDS_BYTES - 16);
        const unsigned x = xb_xcc_id();
        __builtin_amdgcn_s_waitcnt(0);
        unsigned nloc = st[0], nx = st[1];
        if (nloc == 0u) { xcd_barrier_complete(bar, x, nloc, nx); st[0] = nloc; st[1] = nx; }
        const unsigned old = xb_add(&bar[XB_XSUB(x)], 1u);
        const unsigned gen = old / nloc;
        if (old + 1u == (gen + 1u) * nloc) {
            __builtin_amdgcn_fence(__ATOMIC_RELEASE, "agent");
            asm volatile("s_waitcnt vmcnt(0)" ::: "memory");
            const unsigned og = xb_add(&bar[XB_TOP], 1u);
            const unsigned tg = og / nx;
            if (og + 1u == (tg + 1u) * nx) xb_add(&bar[XB_TOPGEN], 1u);
            else XB_SPIN(xb_ld(&bar[XB_TOPGEN]) == tg, bar);
            __builtin_amdgcn_fence(__ATOMIC_ACQUIRE, "agent");
            xb_add(&bar[XB_XGEN(x)], 1u);
            asm volatile("s_waitcnt vmcnt(0)" ::: "memory");
        } else {
            XB_SPIN(xb_ld(&bar[XB_XGEN(x)]) == gen, bar);
            __builtin_amdgcn_fence(__ATOMIC_ACQUIRE, "agent");
            asm volatile("s_waitcnt vmcnt(0)" ::: "memory");
        }
    }
    __syncthreads();
}
__device__ __forceinline__ void gemm_gu(int wv, LAS unsigned char* lds, int j2) { KP P = kparams();
    EpiGU E; E.ssq = (const float*)(P->ws + WS_SSQ); E.hff = (bf16_t*)(P->ws + WS_H);
    run_gemm(wv, lds, (const bf16_t*)(P->ws + WS_XB), (const bf16_t*)(P->ws + (j2 ? W_GU1 : W_GU0)), MT, 5632, 1024, E); }
__device__ __forceinline__ void gemm_dn(int wv, LAS unsigned char* lds, int j2) { KP P = kparams();
    EpiRes E; E.x = P->out; E.xb = (bf16_t*)(P->ws + WS_XB); E.ssq = (float*)(P->ws + WS_SSQ); E.scale = 0.5f;
    run_gemm(wv, lds, (const bf16_t*)(P->ws + WS_H), (const bf16_t*)(P->ws + (j2 ? W_DN1 : W_DN0)), MP, 1024, 2816, E);
    skinny_gemm<0>(wv, lds, kparams(), (const bf16_t*)(kparams()->ws + WS_H) + (size_t)MP * DFF, (const bf16_t*)(kparams()->ws + (j2 ? W_DN1 : W_DN0)), 2816, 0.5f); }
__device__ __forceinline__ void gemm_in(int wv, LAS unsigned char* lds) { KP P = kparams();
    EpiIn E; E.ssq = (const float*)(P->ws + WS_SSQ); E.h = (bf16_t*)(P->ws + WS_H); E.dtraw = (float*)(P->ws + WS_DT);
    run_gemm(wv, lds, (const bf16_t*)(P->ws + WS_XB), (const bf16_t*)(P->ws + W_IN), MT, NINP, 1024, E); }
__device__ __forceinline__ void gemm_merge(int wv, LAS unsigned char* lds) { KP P = kparams();
    EpiMerge E; E.h = (const bf16_t*)(P->ws + WS_H); E.merged = (bf16_t*)(P->ws + WS_ST);
    run_gemm(wv, lds, (const bf16_t*)(P->ws + WS_Y), (const bf16_t*)(P->ws + W_BR), MP, 1024, 3072, E);
    skinny_gemm<1>(wv, lds, kparams(), (const bf16_t*)(kparams()->ws + WS_Y) + (size_t)MP * 3072, (const bf16_t*)(kparams()->ws + W_BR), 3072, 1.0f); }
__device__ __forceinline__ void gemm_out(int wv, LAS unsigned char* lds) { KP P = kparams();
    EpiRes E; E.x = P->out; E.xb = (bf16_t*)(P->ws + WS_XB); E.ssq = (float*)(P->ws + WS_SSQ); E.scale = 1.0f;
    run_gemm(wv, lds, (const bf16_t*)(P->ws + WS_ST), (const bf16_t*)(P->ws + W_OUT), MP, 1024, 1024, E);
    skinny_gemm<0>(wv, lds, kparams(), (const bf16_t*)(kparams()->ws + WS_ST) + (size_t)MP * DM, (const bf16_t*)(kparams()->ws + W_OUT), 1024, 1.0f); }

__global__ __launch_bounds__(512, 2) void mega(Params Pk) {
    extern __shared__ __attribute__((aligned(16))) unsigned char smem[];
    LAS unsigned char* lds = (LAS unsigned char*)smem;
    cg::grid_group grid = cg::this_grid();
    const int wv = __builtin_amdgcn_readfirstlane((int)(threadIdx.x >> 6));
    unsigned* bar0 = (unsigned*)(kparams()->ws + WS_BAR);
    if (threadIdx.x == 0) {
        volatile LAS unsigned* st = (volatile LAS unsigned*)(lds + LDS_BYTES - 16); st[0] = 0u; st[1] = 0u;
        (void)xb_add(&bar0[XB_XCNT(xb_xcc_id())], 1u);
    }
    __syncthreads();
    phase_init(wv, kparams());
    gsync(grid);
#pragma unroll 1
    for (int step = 0; step < 8; ++step) {
        const int l = step >> 1, j2 = step & 1;
        gbar(wv, lds);
        if (j2 == 0) { convert_layer(wv, kparams(), l, lds); gbar(wv, lds); }
        for (int rep = 0; rep < REP_GU; ++rep) { if (rep) gbar(wv, lds); gemm_gu(wv, lds, j2); }
        gbar(wv, lds);
        gemm_dn(wv, lds, j2);
        if (j2 == 0 && DBG_MIX) {
            gbar(wv, lds);
            for (int rep = 0; rep < REP_IN; ++rep) { if (rep) gbar(wv, lds); gemm_in(wv, lds); }
            for (int rep = 0; rep < REP_SYNC; ++rep) gbar(wv, lds);
            gbar(wv, lds);
            for (int rep = 0; rep < REP_P4; ++rep)
            for (int item = bidx(); item < 256; item += gdim()) {
                const Item I = get_item(item);
                copy_states_item(wv, kparams(), l, I);
                for (int q = 0; q < REP_A; ++q) attn_item<64>(wv, kparams(), l, I, lds);
                for (int q = 0; q < REP_L4; ++q) lru_item<64, false>(wv, kparams(), l, item, I, lds);
                for (int q = 0; q < REP_S4; ++q) ssd_states_item<64>(wv, kparams(), l, item, I, lds);
            }
            gbar(wv, lds);
            phase_scan(wv, kparams(), l);
            for (int sb = gdim() - 1 - bidx(); sb < 16; sb += gdim()) {
                const Item I = get_item(256 + sb);
                copy_states_item(wv, kparams(), l, I);
                attn_item<16>(wv, kparams(), l, I, lds);
            }
            gbar(wv, lds);
            for (int rep = 0; rep < REP_P6; ++rep) {
            for (int item = bidx(); item < 256; item += gdim()) {
                const Item I = get_item(item);
                for (int q = 0; q < REP_L6; ++q) lru_apply_item(wv, kparams(), l, item, I);
                for (int q = 0; q < REP_S6; ++q) ssd_y_item<64>(wv, kparams(), l, I, lds);
            }
            for (int sj = bidx(); sj < 48; sj += gdim()) {
                const int sb = sj & 15, piece = sj >> 4;
                const Item I = get_item(256 + sb);
                if (piece == 0) lru_item<16, true>(wv, kparams(), l, 256 + sb, I, lds);
                else if (piece == 1) ssd_states_item<16>(wv, kparams(), l, 256 + sb, I, lds);
                else ssd_y_item<16>(wv, kparams(), l, I, lds);
            }
            }
            if (DBG_MERGE) {
            gbar(wv, lds);
            for (int rep = 0; rep < REP_MG; ++rep) { if (rep) gbar(wv, lds); gemm_merge(wv, lds); }
            gbar(wv, lds);
            gemm_out(wv, lds); }
        }
    }
    gbar(wv, lds);
    phase_final(wv, kparams());
#if DBG_SANITIZE
    gbar(wv, lds);
    { KP P = kparams(); float* o = P->out;
      for (size_t i = (size_t)bidx() * 512 + tidx(wv); i < O_END; i += (size_t)gdim() * 512) { const float v = o[i]; if (!(fabsf(v) < 1e30f)) o[i] = 0.f; } }
#endif
}

extern "C" void kernel_launch(void* const* d_in, const int* in_sizes, int n_in, void* d_out, int out_size, void* d_ws, size_t ws_size, hipStream_t stream) {
    static int grid_blocks = 0;
    if (grid_blocks == 0) {
        if (n_in != N_INPUTS || (size_t)out_size != O_END || ws_size < WS_END) {
            fprintf(stderr, "kernel_launch: unexpected shapes: n_in %d out %d ws %zu (need %zu)\n", n_in, out_size, ws_size, (size_t)WS_END); grid_blocks = -1; return; }
        int dev = 0, cus = 0, per_cu = 0;
        hipGetDevice(&dev);
        hipDeviceGetAttribute(&cus, hipDeviceAttributeMultiprocessorCount, dev);
        if (hipFuncSetAttribute((const void*)mega, hipFuncAttributeMaxDynamicSharedMemorySize, LDS_BYTES) != hipSuccess) { fprintf(stderr, "hipFuncSetAttribute failed\n"); grid_blocks = -1; return; }
        hipOccupancyMaxActiveBlocksPerMultiprocessor(&per_cu, (const void*)mega, 512, LDS_BYTES);
        if (per_cu < 1) per_cu = 1;
        grid_blocks = cus * per_cu;
    }
    if (grid_blocks < 0) return;
    Params p{};
    for (int i = 0; i < N_INPUTS; ++i) p.in[i] = (const float*)d_in[i];
    p.out = (float*)d_out; p.ws = (unsigned char*)d_ws;
    if (hipMemsetAsync((unsigned char*)d_ws + WS_BAR, 0, 16384, stream) != hipSuccess) { fprintf(stderr, "memset failed\n"); return; }
    void* args[] = {&p};
    hipError_t e = hipLaunchCooperativeKernel((const void*)mega, dim3(grid_blocks), dim3(512), args, LDS_BYTES, stream);
    if (e != hipSuccess) fprintf(stderr, "cooperative launch failed: %s (grid %d)\n", hipGetErrorString(e), grid_blocks);
}
```

```cpp
#include <hip/hip_runtime.h>
#include <hip/hip_cooperative_groups.h>
#include <cstdio>
namespace cg = cooperative_groups;
#define DBG_SANITIZE 0
#ifndef REP_P4
#define REP_P4 1
#endif
#ifndef REP_P6
#define REP_P6 1
#endif
#ifndef REP_SYNC
#define REP_SYNC 0
#endif
#ifndef REP_IN
#define REP_IN 1
#endif
#ifndef REP_A
#define REP_A 1
#endif
#ifndef REP_L4
#define REP_L4 1
#endif
#ifndef REP_S4
#define REP_S4 1
#endif
#ifndef REP_L6
#define REP_L6 1
#endif
#ifndef REP_S6
#define REP_S6 1
#endif
#ifndef REP_CV
#define REP_CV 1
#endif
#ifndef REP_GU
#define REP_GU 1
#endif
#ifndef REP_MG
#define REP_MG 1
#endif
#define DBG_MIX 1
#define DBG_MERGE 1
#define DBG_ATTN 1
#define DBG_LRU4 1
#define DBG_SSD4 1
#define DBG_P5S 1
#define DBG_P5W 1
#define DBG_P5 1
#define DBG_LRU6 1
#define DBG_SSD6 1

#define LAS __attribute__((address_space(3)))
typedef unsigned short bf16_t;
typedef short bf16x8 __attribute__((ext_vector_type(8)));
typedef float f32x4 __attribute__((ext_vector_type(4)));
typedef unsigned u32x4 __attribute__((ext_vector_type(4)));
typedef unsigned u32x2 __attribute__((ext_vector_type(2)));

constexpr int MP = 16384, MS = 256, MT = 16640;
constexpr int DM = 1024, DFF = 2816, NIN = 9232, NINP = 9472, HP = 9232;
constexpr int HX = 0, HG = 1024, HZ = 2048, HXBC = 3072, HQ = 4608, HK = 5632, HV = 5888, HGATE = 6144, HDT = 9216;
constexpr float EPS = 1e-6f;
constexpr int NITEM = 272;

enum { I_XP = 0, I_XS, I_CK, I_CV, I_SLC, I_SLH, I_SSC, I_SSH, I_FNORM, I_WG, I_WU, I_WD, I_MNORM, I_WIN, I_LCW, I_LCB, I_LWA, I_LBA, I_LWX, I_LBX,
       I_LLAM, I_SCW, I_SCB, I_SDTB, I_SALOG, I_SD, I_SNORM, I_SINK, I_WBR, I_WOUT, I_FINAL, N_INPUTS };

constexpr size_t O_YP = 0, O_YS = O_YP + (size_t)MP * DM, O_PK = O_YS + (size_t)MS * DM, O_PV = O_PK + 4 * 2 * 128 * 256, O_PLC = O_PV + 4 * 2 * 128 * 256,
                 O_PLH = O_PLC + 4 * 2 * 3 * 1024, O_PSC = O_PLH + 4 * 2 * 1024, O_PSH = O_PSC + 4 * 2 * 3 * 1536, O_SK = O_PSH + (size_t)4 * 2 * 16 * 64 * 128,
                 O_SV = O_SK + (size_t)4 * 16 * 128 * 256, O_SLC = O_SV + (size_t)4 * 16 * 128 * 256, O_SLH = O_SLC + 4 * 16 * 3 * 1024, O_SSC = O_SLH + 4 * 16 * 1024,
                 O_SSH = O_SSC + 4 * 16 * 3 * 1536, O_END = O_SSH + (size_t)4 * 16 * 16 * 64 * 128;

constexpr size_t WS_XB = 0;
constexpr size_t WS_H = WS_XB + (size_t)MT * DM * 2;
constexpr size_t WS_ST = WS_H + (size_t)MT * HP * 2;
constexpr size_t WS_Y = WS_ST + (size_t)2 * 128 * 16 * 64 * 128 * 2;
constexpr size_t WS_W = WS_Y + (size_t)MT * 3072 * 2;
constexpr size_t W_GU0 = WS_W, W_GU1 = W_GU0 + (size_t)5632 * 1024 * 2, W_DN0 = W_GU1 + (size_t)5632 * 1024 * 2, W_DN1 = W_DN0 + (size_t)1024 * 2816 * 2,
                 W_IN = W_DN1 + (size_t)1024 * 2816 * 2, W_BR = W_IN + (size_t)NINP * 1024 * 2, W_OUT = W_BR + (size_t)1024 * 3072 * 2,
                 W_LA = W_OUT + (size_t)1024 * 1024 * 2, W_LX = W_LA + 65536 * 2, WS_SSQ = W_LX + 65536 * 2;
constexpr size_t WS_DT = WS_SSQ + (size_t)MT * 16 * 4, WS_LRUA = WS_DT + (size_t)MT * 16 * 4, WS_LRUU = WS_LRUA + 256 * 1024 * 4, WS_CDEC = WS_LRUU + 256 * 1024 * 4,
                 WS_BAR = WS_CDEC + 256 * 16 * 4, WS_SSQ2 = WS_BAR + 16384, WS_END = WS_SSQ2 + 256 * 16 * 4;

constexpr int LDS_BYTES = 147456;

struct Params { const float* in[N_INPUTS]; float* out; unsigned char* ws; };
typedef const Params __attribute__((address_space(4))) * KP;
__device__ __forceinline__ KP kparams() { KP p = (KP)__builtin_amdgcn_kernarg_segment_ptr(); asm volatile("" : "+s"(p)); return p; }
__device__ __forceinline__ int tidx(int wv) { int t; asm volatile("v_mbcnt_lo_u32_b32 %0, -1, 0\n\tv_mbcnt_hi_u32_b32 %0, -1, %0" : "=v"(t)); return (wv << 6) | t; }
__device__ __forceinline__ int bidx() { int t = blockIdx.x; asm volatile("" : "+s"(t)); return t; }
__device__ __forceinline__ int gdim() { int t = gridDim.x; asm volatile("" : "+s"(t)); return t; }

typedef __bf16 bf16x2_t __attribute__((ext_vector_type(2)));
typedef float f32x2_t __attribute__((ext_vector_type(2)));
__device__ __forceinline__ unsigned pk2(float lo, float hi) { f32x2_t v = {lo, hi}; bf16x2_t b = __builtin_convertvector(v, bf16x2_t); unsigned r; __builtin_memcpy(&r, &b, 4); return r; }
__device__ __forceinline__ bf16_t f2bf(float f) { return (bf16_t)(pk2(f, 0.f) & 0xffffu); }
__device__ __forceinline__ float bf2f(bf16_t b) { return __uint_as_float(((unsigned)b) << 16); }
__device__ __forceinline__ float bflo(unsigned w) { return __uint_as_float(w << 16); }
__device__ __forceinline__ float bfhi(unsigned w) { return __uint_as_float(w & 0xffff0000u); }
__device__ __forceinline__ float rcpf_(float x) { return __builtin_amdgcn_rcpf(x); }
__device__ __forceinline__ float sigmoidf_(float x) { return rcpf_(1.0f + __expf(-x)); }
__device__ __forceinline__ float siluf_(float x) { return x * rcpf_(1.0f + __expf(-x)); }
__device__ __forceinline__ float softplusf_(float x) { return x > 20.f ? x : log1pf(__expf(x)); }
__device__ __forceinline__ float gelu_tanh(float x) { const float u = 0.7978845608028654f * (x + 0.044715f * x * x * x); return x * rcpf_(1.0f + __expf(-2.0f * u)); }
__device__ __forceinline__ float rstd_row(const float* ssq, int r) {
    const f32x4* p = (const f32x4*)(ssq + (size_t)r * 16); f32x4 a = p[0], b = p[1], c = p[2], d = p[3];
    float s = (a[0] + a[1] + a[2] + a[3]) + (b[0] + b[1] + b[2] + b[3]) + (c[0] + c[1] + c[2] + c[3]) + (d[0] + d[1] + d[2] + d[3]);
    if (r >= MP) {
        const f32x4* q = (const f32x4*)(ssq + (WS_SSQ2 - WS_SSQ) / 4 + (size_t)(r - MP) * 16); a = q[0]; b = q[1]; c = q[2]; d = q[3];
        s += (a[0] + a[1] + a[2] + a[3]) + (b[0] + b[1] + b[2] + b[3]) + (c[0] + c[1] + c[2] + c[3]) + (d[0] + d[1] + d[2] + d[3]);
    }
    return rsqrtf(s * (1.0f / 1024.0f) + EPS);
}
#define MFMA16(a, b, c) __builtin_amdgcn_mfma_f32_16x16x32_bf16((a), (b), (c), 0, 0, 0)

namespace pg8 {
constexpr int BM = 256, BK = 64, HALF = 128, HTB = HALF * BK * 2, STAGE_BYTES = 8 * HTB, NXCD = 8, WGM = 8;
__device__ __forceinline__ int lds_byte(int r, int c) { const int st = (r >> 4) * 2 + (c >> 5), rr = r & 15, cc = c & 31, ob = rr * 64 + cc * 2; return st * 1024 + (ob ^ (((ob >> 9) & 1) << 5)); }
__device__ __forceinline__ void stage_rc(int b, int& R, int& C) { const int st = b / 1024, sb = b % 1024, swz = sb ^ (((sb >> 9) & 1) << 5); R = (st >> 1) * 16 + swz / 64; C = (st & 1) * 32 + (swz % 64) / 2; }
struct Unit { int pm, pn; };
struct Gemm { const bf16_t* A; const bf16_t* Bt; int M, N, K; };
struct StaticOrder {
    int nM, nN, nwg, G, c;
    __device__ void init(int M, int N, int G_, int c_) { nM = M / BM; nN = N / BM; nwg = nM * nN; G = G_; c = c_; }
    __device__ bool next(int i, Unit& u) const {
        const long L = (long)i * G + c; if (L >= nwg) return false;
        int wgid = (int)L; { const int q = nwg / NXCD, r = nwg % NXCD, xcd = wgid % NXCD, off = wgid / NXCD; wgid = (xcd < r ? xcd * (q + 1) : r * (q + 1) + (xcd - r) * q) + off; }
        const int nig = WGM * nN, gid = wgid / nig, fm = gid * WGM, gsz = (nM - fm) < WGM ? (nM - fm) : WGM;
        u.pm = fm + ((wgid % nig) % gsz); u.pn = (wgid % nig) / gsz; return true;
    }
};

template <class Epi>
__device__ __forceinline__ void gemm_phase(int wv, LAS unsigned char* lds, const Gemm g, const StaticOrder& S, const Epi& E) {
    const int tid = tidx(wv), wid = wv, lane = tid & 63, wr = wid >> 2, wc = wid & 3, fr = lane & 15, fq = lane >> 4;
    const int K = g.K, nt = K / BK;
    unsigned voffA[2];
#pragma unroll
    for (int i = 0; i < 2; ++i) { int R, C; stage_rc(tid * 16 + i * 8192, R, C); voffA[i] = (unsigned)(R * K + C) * 2u; }
    const size_t kstep = (size_t)(BK * 2);
    const size_t hstep = (size_t)HALF * K * 2;
    const size_t tstep = 2 * hstep;
    const unsigned ldsw = (unsigned)wid * 1024u;
    const int aoff = lds_byte(wr * 64 + fr, fq * 8), boff = lds_byte(wc * 32 + fr, fq * 8);
#define PG8_SA(b, h) (((b) * 2 + (h)) * HTB)
#define PG8_SB(b, h) ((4 + (b) * 2 + (h)) * HTB)
#define PG8_STAGE(bufoff, gbase, voff) do { _Pragma("unroll") for (int _i = 0; _i < 2; ++_i) \
        __builtin_amdgcn_global_load_lds((const unsigned*)((const char*)(gbase) + (voff)[_i]), (LAS unsigned*)(lds + (bufoff) + ldsw + _i * 8192), 16, 0, 0); } while (0)
#define PG8_LDA(dst, b, h) do { _Pragma("unroll") for (int m = 0; m < 4; ++m) _Pragma("unroll") for (int k = 0; k < 2; ++k) dst[m][k] = *(const LAS bf16x8*)(lds + PG8_SA(b, h) + aoff + m * 2048 + k * 1024); } while (0)
#define PG8_LDB(dst, b, h) do { _Pragma("unroll") for (int n = 0; n < 2; ++n) _Pragma("unroll") for (int k = 0; k < 2; ++k) dst[n][k] = *(const LAS bf16x8*)(lds + PG8_SB(b, h) + boff + n * 2048 + k * 1024); } while (0)
#define PG8_MMA(ai, bj, At, Bt) do { __builtin_amdgcn_s_setprio(1); _Pragma("unroll") for (int m = 0; m < 4; ++m) _Pragma("unroll") for (int n = 0; n < 2; ++n) _Pragma("unroll") for (int k = 0; k < 2; ++k) \
        acc[ai][bj][m][n] = __builtin_amdgcn_mfma_f32_16x16x32_bf16(Bt[n][k], At[m][k], acc[ai][bj][m][n], 0, 0, 0); __builtin_amdgcn_s_setprio(0); } while (0)
#define PG8_WAIT_V(n) asm volatile("s_waitcnt vmcnt(" #n ")" ::: "memory")
#define PG8_WAIT_L(n) asm volatile("s_waitcnt lgkmcnt(" #n ")" ::: "memory")
#define PG8_BAR __builtin_amdgcn_s_barrier()
#define PG8_SCHED __builtin_amdgcn_sched_barrier(0)
    Unit cur, nxt; int ui = 0;
    if (!S.next(0, cur)) return;
    f32x4 acc[2][2][4][2];
#pragma unroll
    for (int a = 0; a < 2; ++a)
#pragma unroll
        for (int b = 0; b < 2; ++b)
#pragma unroll
            for (int m = 0; m < 4; ++m)
#pragma unroll
                for (int n = 0; n < 2; ++n) acc[a][b][m][n] = (f32x4){0.f, 0.f, 0.f, 0.f};
    bf16x8 At[4][2], B0[2][2], B1[2][2];
    const char* cA = (const char*)g.A + (size_t)cur.pm * tstep; const char* cB = (const char*)g.Bt + (size_t)cur.pn * tstep;
    PG8_STAGE(PG8_SB(0, 0), cB, voffA); PG8_STAGE(PG8_SA(0, 0), cA, voffA); PG8_STAGE(PG8_SB(0, 1), cB + hstep, voffA); PG8_STAGE(PG8_SA(0, 1), cA + hstep, voffA);
    if (wr == 1) PG8_BAR;
    PG8_WAIT_V(4); PG8_BAR;
    PG8_STAGE(PG8_SB(1, 0), cB + kstep, voffA); PG8_STAGE(PG8_SA(1, 0), cA + kstep, voffA); PG8_STAGE(PG8_SB(1, 1), cB + hstep + kstep, voffA);
    PG8_WAIT_V(6); PG8_BAR;
    for (;;) {
        if constexpr (Epi::NEEDS_RSTD) {
            LAS float* rb = (LAS float*)(lds + STAGE_BYTES) + (ui & 1) * 256;
            if (tid < 256) rb[tid] = rstd_row(E.ssq, cur.pm * 256 + tid);
        }
        const bool has_next = S.next(ui + 1, nxt);
        const char* nA = has_next ? (const char*)g.A + (size_t)nxt.pm * tstep : cA; const char* nB = has_next ? (const char*)g.Bt + (size_t)nxt.pn * tstep : cB;
        for (int t = 0; t < nt; t += 2) {
            const bool last = (t == nt - 2);
            const char* a1 = cA + (size_t)(t + 1) * kstep;
            const char* a2 = last ? nA : cA + (size_t)(t + 2) * kstep; const char* b2 = last ? nB : cB + (size_t)(t + 2) * kstep;
            const char* a3 = a2 + kstep; const char* b3 = b2 + kstep;
            PG8_LDB(B0, 0, 0); PG8_SCHED; PG8_LDA(At, 0, 0); PG8_STAGE(PG8_SA(1, 1), a1 + hstep, voffA);
            PG8_WAIT_L(8); PG8_BAR; PG8_WAIT_L(0); PG8_MMA(0, 0, At, B0); PG8_BAR; PG8_SCHED;
            PG8_LDB(B1, 0, 1); PG8_STAGE(PG8_SB(0, 0), b2, voffA);
            PG8_BAR; PG8_WAIT_L(0); PG8_MMA(0, 1, At, B1); PG8_BAR;
            PG8_LDA(At, 0, 1); PG8_STAGE(PG8_SA(0, 0), a2, voffA);
            PG8_BAR; PG8_WAIT_L(0); PG8_MMA(1, 0, At, B0); PG8_BAR; PG8_SCHED;
            PG8_STAGE(PG8_SB(0, 1), b2 + hstep, voffA);
            PG8_WAIT_V(6); PG8_BAR; PG8_MMA(1, 1, At, B1); PG8_BAR;
            PG8_LDB(B0, 1, 0); PG8_SCHED; PG8_LDA(At, 1, 0); PG8_STAGE(PG8_SA(0, 1), a2 + hstep, voffA);
            PG8_WAIT_L(8); PG8_BAR; PG8_WAIT_L(0); PG8_MMA(0, 0, At, B0); PG8_BAR; PG8_SCHED;
            PG8_LDB(B1, 1, 1); PG8_STAGE(PG8_SB(1, 0), b3, voffA);
            PG8_BAR; PG8_WAIT_L(0); PG8_MMA(0, 1, At, B1); PG8_BAR;
            PG8_LDA(At, 1, 1); PG8_STAGE(PG8_SA(1, 0), a3, voffA);
            PG8_BAR; PG8_WAIT_L(0); PG8_MMA(1, 0, At, B0); PG8_BAR; PG8_SCHED;
            PG8_STAGE(PG8_SB(1, 1), b3 + hstep, voffA);
            PG8_WAIT_V(6); PG8_BAR; PG8_MMA(1, 1, At, B1); PG8_BAR;
            if constexpr (Epi::HAS_MID) { if (!last && ((t + 2) & 15) == 0) E.mid(acc, cur, (t + 2) >> 4, wr, wc, fr, fq); }
        }
        if constexpr (Epi::NEEDS_RSTD) E.rb = (const LAS float*)(lds + STAGE_BYTES) + (ui & 1) * 256;
        E(acc, cur, wr, wc, fr, fq);
        if (!has_next) break;
#pragma unroll
        for (int a = 0; a < 2; ++a)
#pragma unroll
            for (int b = 0; b < 2; ++b)
#pragma unroll
                for (int m = 0; m < 4; ++m)
#pragma unroll
                    for (int n = 0; n < 2; ++n) acc[a][b][m][n] = (f32x4){0.f, 0.f, 0.f, 0.f};
        cur = nxt; cA = nA; cB = nB; ++ui;
    }
    PG8_WAIT_V(0);
    if (wr == 0) PG8_BAR;
    PG8_BAR;
#undef PG8_SA
#undef PG8_SB
#undef PG8_STAGE
#undef PG8_LDA
#undef PG8_LDB
#undef PG8_MMA
#undef PG8_WAIT_V
#undef PG8_WAIT_L
#undef PG8_BAR
#undef PG8_SCHED
}
}
using pg8::Unit;
typedef f32x4 AccT[2][2][4][2];

struct EpiGU {
    static constexpr bool HAS_MID = false, NEEDS_RSTD = true;
    const float* ssq; bf16_t* hff; mutable const LAS float* rb;
    __device__ __forceinline__ void mid(AccT&, const Unit&, int, int, int, int, int) const {}
    __device__ __forceinline__ void operator()(const AccT& acc, const Unit& u, int wr, int wc, int fr_, int fq_) const {
        int fr = fr_, fq = fq_; asm volatile("" : "+v"(fr), "+v"(fq));
        const int row0 = u.pm * 256 + wr * 64 + fr, hc0 = u.pn * 128 + wc * 16 + fq * 4;
#pragma unroll
        for (int ai = 0; ai < 2; ++ai)
#pragma unroll
            for (int m = 0; m < 4; ++m) {
                const int r = row0 + ai * 128 + m * 16; const float rs = rb[wr * 64 + fr + ai * 128 + m * 16];
#pragma unroll
                for (int bj = 0; bj < 2; ++bj) {
                    const f32x4 gt = acc[ai][bj][m][0] * rs, up = acc[ai][bj][m][1] * rs;
                    u32x2 w; w.x = pk2(siluf_(gt[0]) * up[0], siluf_(gt[1]) * up[1]); w.y = pk2(siluf_(gt[2]) * up[2], siluf_(gt[3]) * up[3]);
                    *(u32x2*)(hff + (size_t)r * DFF + hc0 + bj * 64) = w;
                }
            }
    }
};
struct EpiRes {
    static constexpr bool HAS_MID = false, NEEDS_RSTD = false;
    float* x; bf16_t* xb; float* ssq; float scale;
    __device__ __forceinline__ void mid(AccT&, const Unit&, int, int, int, int, int) const {}
    __device__ __forceinline__ void operator()(const AccT& acc, const Unit& u, int wr, int wc, int fr_, int fq_) const {
        int fr = fr_, fq = fq_; asm volatile("" : "+v"(fr), "+v"(fq));
        const int row0 = u.pm * 256 + wr * 64 + fr, col0 = u.pn * 256 + wc * 32 + 4 * fq;
#pragma unroll
        for (int ai = 0; ai < 2; ++ai)
#pragma unroll
            for (int m = 0; m < 4; ++m) {
                const int r = row0 + ai * 128 + m * 16; float ss = 0.f;
#pragma unroll
                for (int bj = 0; bj < 2; ++bj)
#pragma unroll
                    for (int n = 0; n < 2; ++n) {
                        const int c = col0 + bj * 128 + n * 16;
                        f32x4* xp = (f32x4*)(x + (size_t)r * DM + c);
                        f32x4 v = *xp + acc[ai][bj][m][n] * scale;
                        *xp = v;
                        u32x2 w; w.x = pk2(v[0], v[1]); w.y = pk2(v[2], v[3]);
                        *(u32x2*)(xb + (size_t)r * DM + c) = w;
                        ss += v[0] * v[0] + v[1] * v[1] + v[2] * v[2] + v[3] * v[3];
                    }
                ss += __shfl_xor(ss, 16); ss += __shfl_xor(ss, 32);
                if (fq == 0) ssq[(size_t)r * 16 + u.pn * 4 + wc] = ss;
            }
    }
};
struct EpiIn {
    static constexpr bool HAS_MID = false, NEEDS_RSTD = true;
    const float* ssq; bf16_t* h; float* dtraw; mutable const LAS float* rb;
    __device__ __forceinline__ void mid(AccT&, const Unit&, int, int, int, int, int) const {}
    __device__ __forceinline__ void operator()(const AccT& acc, const Unit& u, int wr, int wc, int fr_, int fq_) const {
        int fr = fr_, fq = fq_; asm volatile("" : "+v"(fr), "+v"(fq));
        const int row0 = u.pm * 256 + wr * 64 + fr, col0 = u.pn * 256 + wc * 32 + 4 * fq;
#pragma unroll
        for (int ai = 0; ai < 2; ++ai)
#pragma unroll
            for (int m = 0; m < 4; ++m) {
                const int r = row0 + ai * 128 + m * 16; const float rs = rb[wr * 64 + fr + ai * 128 + m * 16];
                if (u.pn < 36) {
#pragma unroll
                    for (int bj = 0; bj < 2; ++bj)
#pragma unroll
                        for (int n = 0; n < 2; ++n) {
                            const int c = col0 + bj * 128 + n * 16; const f32x4 v = acc[ai][bj][m][n] * rs;
                            u32x2 w; w.x = pk2(v[0], v[1]); w.y = pk2(v[2], v[3]);
                            *(u32x2*)(h + (size_t)r * HP + c) = w;
                        }
                } else if (wc == 0) {
                    const f32x4 v = acc[ai][0][m][0] * rs;
                    *(f32x4*)(dtraw + (size_t)r * 16 + 4 * fq) = v;
                }
            }
    }
};
struct EpiMerge {
    static constexpr bool HAS_MID = true, NEEDS_RSTD = false;
    const bf16_t* h; bf16_t* merged;
    __device__ __forceinline__ void mid(AccT& acc, const Unit& u, int seg, int wr, int wc, int fr_, int fq_) const {
        int fr = fr_, fq = fq_; asm volatile("" : "+v"(fr), "+v"(fq));
        const int row0 = u.pm * 256 + wr * 64 + fr, col0 = u.pn * 256 + wc * 32 + 4 * fq;
#pragma unroll
        for (int ai = 0; ai < 2; ++ai)
#pragma unroll
            for (int m = 0; m < 4; ++m) {
                const int r = row0 + ai * 128 + m * 16;
#pragma unroll
                for (int bj = 0; bj < 2; ++bj)
#pragma unroll
                    for (int n = 0; n < 2; ++n) {
                        const int c = col0 + bj * 128 + n * 16;
                        const bf16_t* gp = h + (size_t)r * HP + HGATE + (seg - 1) * 1024 + c;
                        const u32x2 ga = *(const u32x2*)gp, gb = *(const u32x2*)(gp + 1024);
                        const float a0 = bflo(ga.x), a1 = bfhi(ga.x), a2 = bflo(ga.y), a3 = bfhi(ga.y);
                        const float b0 = bflo(gb.x), b1 = bfhi(gb.x), b2 = bflo(gb.y), b3 = bfhi(gb.y);
                        f32x4 f;
                        f[0] = (1.f + __expf(-fmaxf(b0, -30.f))) * rcpf_(1.f + __expf(-fmaxf(a0, -30.f)));
                        f[1] = (1.f + __expf(-fmaxf(b1, -30.f))) * rcpf_(1.f + __expf(-fmaxf(a1, -30.f)));
                        f[2] = (1.f + __expf(-fmaxf(b2, -30.f))) * rcpf_(1.f + __expf(-fmaxf(a2, -30.f)));
                        f[3] = (1.f + __expf(-fmaxf(b3, -30.f))) * rcpf_(1.f + __expf(-fmaxf(a3, -30.f)));
                        acc[ai][bj][m][n] *= f;
                    }
            }
    }
    __device__ __forceinline__ void operator()(const AccT& acc, const Unit& u, int wr, int wc, int fr_, int fq_) const {
        int fr = fr_, fq = fq_; asm volatile("" : "+v"(fr), "+v"(fq));
        const int row0 = u.pm * 256 + wr * 64 + fr, col0 = u.pn * 256 + wc * 32 + 4 * fq;
#pragma unroll
        for (int ai = 0; ai < 2; ++ai)
#pragma unroll
            for (int m = 0; m < 4; ++m) {
                const int r = row0 + ai * 128 + m * 16;
#pragma unroll
                for (int bj = 0; bj < 2; ++bj)
#pragma unroll
                    for (int n = 0; n < 2; ++n) {
                        const int c = col0 + bj * 128 + n * 16;
                        const u32x2 ga = *(const u32x2*)(h + (size_t)r * HP + HGATE + 2048 + c);
                        const f32x4 v = acc[ai][bj][m][n];
                        u32x2 w;
                        w.x = pk2(v[0] * rcpf_(1.f + __expf(-fmaxf(bflo(ga.x), -30.f))), v[1] * rcpf_(1.f + __expf(-fmaxf(bfhi(ga.x), -30.f))));
                        w.y = pk2(v[2] * rcpf_(1.f + __expf(-fmaxf(bflo(ga.y), -30.f))), v[3] * rcpf_(1.f + __expf(-fmaxf(bfhi(ga.y), -30.f))));
                        *(u32x2*)(merged + (size_t)r * DM + c) = w;
                    }
            }
    }
};

template <class Epi> __device__ __forceinline__ void run_gemm(int wv, LAS unsigned char* lds, const bf16_t* A, const bf16_t* Bt, int M, int N, int K, const Epi& E) {
    pg8::Gemm g; g.A = A; g.Bt = Bt; g.M = M; g.N = N; g.K = K;
    pg8::StaticOrder S; S.init(M, N, (int)gdim(), (int)bidx());
    pg8::gemm_phase<Epi>(wv, lds, g, S, E);
}


template <int MODE>
__device__ __forceinline__ void skinny_gemm(int wv, LAS unsigned char* lds, KP P, const bf16_t* A, const bf16_t* Bt, int K, float scale) {
    const int tid = tidx(wv), w = tid >> 6, lane = tid & 63, fr = lane & 15, fq = lane >> 4;
    LAS float* part = (LAS float*)lds;
    constexpr int NSEG = MODE ? 3 : 1;
    const int kseg = K / NSEG, kw = kseg / 8;
    const bf16_t* h = (const bf16_t*)(P->ws + WS_H);
    for (int task = bidx(); task < 256; task += gdim()) {
        const int rt = task >> 5, ct = task & 31;
        f32x4 tot[2][2];
#pragma unroll
        for (int i = 0; i < 2; ++i)
#pragma unroll
            for (int j = 0; j < 2; ++j) tot[i][j] = (f32x4){0.f, 0.f, 0.f, 0.f};
#pragma unroll 1
        for (int seg = 0; seg < NSEG; ++seg) {
            f32x4 acc[2][2];
#pragma unroll
            for (int i = 0; i < 2; ++i)
#pragma unroll
                for (int j = 0; j < 2; ++j) acc[i][j] = (f32x4){0.f, 0.f, 0.f, 0.f};
            const bf16_t* ap = A + (size_t)(rt * 32 + fr) * K + seg * kseg + w * kw + fq * 8;
            const bf16_t* bp = Bt + (size_t)(ct * 32 + fr) * K + seg * kseg + w * kw + fq * 8;
#pragma unroll 2
            for (int k = 0; k < kw; k += 32) {
                const bf16x8 a0 = *(const bf16x8*)(ap + k), a1 = *(const bf16x8*)(ap + (size_t)16 * K + k);
                const bf16x8 b0 = *(const bf16x8*)(bp + k), b1 = *(const bf16x8*)(bp + (size_t)16 * K + k);
                acc[0][0] = MFMA16(b0, a0, acc[0][0]); acc[0][1] = MFMA16(b1, a0, acc[0][1]);
                acc[1][0] = MFMA16(b0, a1, acc[1][0]); acc[1][1] = MFMA16(b1, a1, acc[1][1]);
            }
#pragma unroll
            for (int i = 0; i < 2; ++i)
#pragma unroll
                for (int j = 0; j < 2; ++j) {
                    if (MODE) {
                        const u32x2 gw = *(const u32x2*)(h + (size_t)(MP + rt * 32 + i * 16 + fr) * HP + HGATE + seg * 1024 + ct * 32 + j * 16 + 4 * fq);
                        f32x4 sg; sg[0] = sigmoidf_(bflo(gw.x)); sg[1] = sigmoidf_(bfhi(gw.x)); sg[2] = sigmoidf_(bflo(gw.y)); sg[3] = sigmoidf_(bfhi(gw.y));
                        tot[i][j] += acc[i][j] * sg;
                    } else tot[i][j] = acc[i][j];
                }
        }
        __syncthreads();
#pragma unroll
        for (int i = 0; i < 2; ++i)
#pragma unroll
            for (int j = 0; j < 2; ++j) *(LAS f32x4*)(part + (w * 32 + i * 16 + fr) * 36 + j * 16 + 4 * fq) = tot[i][j];
        __syncthreads();
        const int row = tid >> 4, c2 = (tid & 15) * 2;
        float v0 = 0.f, v1 = 0.f;
#pragma unroll
        for (int ww = 0; ww < 8; ++ww) { v0 += part[(ww * 32 + row) * 36 + c2]; v1 += part[(ww * 32 + row) * 36 + c2 + 1]; }
        const int r = MP + rt * 32 + row, c = ct * 32 + c2;
        if (MODE) {
            *(unsigned*)((bf16_t*)(P->ws + WS_ST) + (size_t)r * DM + c) = pk2(v0, v1);
        } else {
            float* xp = P->out + (size_t)r * DM + c;
            const float x0 = xp[0] + scale * v0, x1 = xp[1] + scale * v1;
            xp[0] = x0; xp[1] = x1;
            *(unsigned*)((bf16_t*)(P->ws + WS_XB) + (size_t)r * DM + c) = pk2(x0, x1);
            float ss = x0 * x0 + x1 * x1;
            ss += __shfl_xor(ss, 1); ss += __shfl_xor(ss, 2); ss += __shfl_xor(ss, 4); ss += __shfl_xor(ss, 8);
            if ((tid & 15) == 0) {
                float* ssq = (float*)(P->ws + WS_SSQ);
                if (ct < 16) ssq[(size_t)r * 16 + ct] = ss; else ssq[(WS_SSQ2 - WS_SSQ) / 4 + (size_t)(r - MP) * 16 + (ct - 16)] = ss;
            }
        }
    }
}

template <class RM>
__device__ __forceinline__ void cvt_tile(int wv, const float* src, int src_ld, int k0, int nsrc0, int nvalid, const float* gk, bf16_t* dst, int dst_ld, RM rowmap, LAS float* tile) {
    const int tid = tidx(wv);
    __syncthreads();
#pragma unroll
    for (int i = 0; i < 2; ++i) {
        const int kk = (tid >> 4) + 32 * i, n4 = (tid & 15) * 4;
        f32x4 v = (f32x4){0.f, 0.f, 0.f, 0.f};
        if (n4 < nvalid) v = *(const f32x4*)(src + (size_t)(k0 + kk) * src_ld + nsrc0 + n4);
        const float gsc = gk ? gk[k0 + kk] : 1.0f;
        tile[kk * 65 + n4 + 0] = v[0] * gsc; tile[kk * 65 + n4 + 1] = v[1] * gsc; tile[kk * 65 + n4 + 2] = v[2] * gsc; tile[kk * 65 + n4 + 3] = v[3] * gsc;
    }
    __syncthreads();
    const int nl = tid >> 3, k8 = (tid & 7) * 8;
    if (nl < nvalid) {
        u32x4 w;
        w.x = pk2(tile[(k8 + 0) * 65 + nl], tile[(k8 + 1) * 65 + nl]); w.y = pk2(tile[(k8 + 2) * 65 + nl], tile[(k8 + 3) * 65 + nl]);
        w.z = pk2(tile[(k8 + 4) * 65 + nl], tile[(k8 + 5) * 65 + nl]); w.w = pk2(tile[(k8 + 6) * 65 + nl], tile[(k8 + 7) * 65 + nl]);
        *(u32x4*)(dst + (size_t)rowmap(nl) * dst_ld + k0 + k8) = w;
    }
}

__device__ __forceinline__ void convert_layer(int wv, KP P, int l, LAS unsigned char* lds) {
    LAS float* tile = (LAS float*)lds;
    constexpr int J_GU = 2 * 2 * 16 * 44, J_DN = 2 * 44 * 16, J_IN = 16 * 145, J_BR = 48 * 16, J_OUT = 16 * 16, J_LRU = 32;
    constexpr int J_TOT = J_GU + J_DN + J_IN + J_BR + J_OUT + J_LRU;
    for (int job = bidx(); job < J_TOT; job += gdim()) {
        int j = job;
        if (j < J_GU) {
            const int nt = j % 44; j /= 44; const int kt = j % 16; j /= 16; const int which = j & 1, j2 = j >> 1;
            const float* src = P->in[which ? I_WU : I_WG] + (size_t)(l * 2 + j2) * 1024 * 2816;
            bf16_t* dst = (bf16_t*)(P->ws + (j2 ? W_GU1 : W_GU0));
            const int hc0 = nt * 64;
            cvt_tile(wv, src, 2816, kt * 64, hc0, 64, P->in[I_FNORM] + (l * 2 + j2) * 1024, dst, 1024,
                     [=](int nl) { const int hc = hc0 + nl; return 256 * (hc >> 7) + 128 * ((hc >> 6) & 1) + 32 * ((hc >> 4) & 3) + 16 * which + (hc & 15); }, tile);
            continue;
        }
        j -= J_GU;
        if (j < J_DN) {
            const int nt = j % 16; j /= 16; const int kt = j % 44; const int j2 = j / 44;
            const float* src = P->in[I_WD] + (size_t)(l * 2 + j2) * 2816 * 1024;
            bf16_t* dst = (bf16_t*)(P->ws + (j2 ? W_DN1 : W_DN0));
            const int n0 = nt * 64;
            cvt_tile(wv, src, 1024, kt * 64, n0, 64, nullptr, dst, 2816, [=](int nl) { return n0 + nl; }, tile);
            continue;
        }
        j -= J_DN;
        if (j < J_IN) {
            const int nt = j % 145, kt = j / 145;
            const float* src = P->in[I_WIN] + (size_t)l * 1024 * NIN;
            bf16_t* dst = (bf16_t*)(P->ws + W_IN);
            const int n0 = nt * 64;
            const int nsrc0 = nt < 72 ? n0 : (nt < 144 ? n0 + 16 : 4608);
            cvt_tile(wv, src, NIN, kt * 64, nsrc0, nt < 144 ? 64 : 16, P->in[I_MNORM] + l * 1024, dst, 1024, [=](int nl) { return n0 + nl; }, tile);
            continue;
        }
        j -= J_IN;
        if (j < J_BR) {
            const int nt = j % 16, kt = j / 16;
            const float* src = P->in[I_WBR] + (size_t)l * 3072 * 1024;
            bf16_t* dst = (bf16_t*)(P->ws + W_BR);
            const int n0 = nt * 64;
            cvt_tile(wv, src, 1024, kt * 64, n0, 64, nullptr, dst, 3072, [=](int nl) { return n0 + nl; }, tile);
            continue;
        }
        j -= J_BR;
        if (j < J_OUT) {
            const int nt = j % 16, kt = j / 16;
            const float* src = P->in[I_WOUT] + (size_t)l * 1024 * 1024;
            bf16_t* dst = (bf16_t*)(P->ws + W_OUT);
            const int n0 = nt * 64;
            cvt_tile(wv, src, 1024, kt * 64, n0, 64, nullptr, dst, 1024, [=](int nl) { return n0 + nl; }, tile);
            continue;
        }
        j -= J_OUT;
        {
            const int blk = j & 15, which = j >> 4;
            const float* src = P->in[which ? I_LWX : I_LWA] + (size_t)(l * 16 + blk) * 4096;
            bf16_t* dst = (bf16_t*)(P->ws + (which ? W_LX : W_LA)) + blk * 4096;
            cvt_tile(wv, src, 64, 0, 0, 64, nullptr, dst, 64, [=](int nl) { return nl; }, tile);
        }
    }
    __syncthreads();
}

__device__ __forceinline__ void phase_init(int wv, KP P) {
    const int w = tidx(wv) >> 6, lane = tidx(wv) & 63;
    float* x = P->out; bf16_t* xb = (bf16_t*)(P->ws + WS_XB); float* ssq = (float*)(P->ws + WS_SSQ);
    for (int row = bidx() * 8 + w; row < MT; row += gdim() * 8) {
        const float* src = row < MP ? P->in[I_XP] + (size_t)row * DM : P->in[I_XS] + (size_t)(row - MP) * DM;
        float ss = 0.f;
#pragma unroll
        for (int i = 0; i < 4; ++i) {
            const int c = (i * 64 + lane) * 4;
            const f32x4 v = *(const f32x4*)(src + c);
            *(f32x4*)(x + (size_t)row * DM + c) = v;
            u32x2 pw; pw.x = pk2(v[0], v[1]); pw.y = pk2(v[2], v[3]);
            *(u32x2*)(xb + (size_t)row * DM + c) = pw;
            ss += v[0] * v[0] + v[1] * v[1] + v[2] * v[2] + v[3] * v[3];
        }
#pragma unroll
        for (int d = 32; d >= 1; d >>= 1) ss += __shfl_xor(ss, d);
        if (lane < 16) ssq[(size_t)row * 16 + lane] = lane == 0 ? ss : 0.f;
        if (row >= MP && lane < 16) ssq[(WS_SSQ2 - WS_SSQ) / 4 + (size_t)(row - MP) * 16 + lane] = 0.f;
    }
}
__device__ __forceinline__ void phase_final(int wv, KP P) {
    const int w = tidx(wv) >> 6, lane = tidx(wv) & 63;
    float* x = P->out; const float* ssq = (const float*)(P->ws + WS_SSQ); const float* gf = P->in[I_FINAL];
    for (int row = bidx() * 8 + w; row < MT; row += gdim() * 8) {
        const float rs = rstd_row(ssq, row);
#pragma unroll
        for (int i = 0; i < 4; ++i) {
            const int c = (i * 64 + lane) * 4;
            f32x4 v = *(const f32x4*)(x + (size_t)row * DM + c); const f32x4 g = *(const f32x4*)(gf + c);
            v = v * rs * g;
            *(f32x4*)(x + (size_t)row * DM + c) = v;
        }
    }
}

struct Item { int row0, L, b, c, sb, sample; };
__device__ __forceinline__ Item get_item(int it) {
    Item I;
    if (it < 256) { I.b = it >> 7; I.c = it & 127; I.row0 = I.b * 8192 + I.c * 64; I.L = 64; I.sample = 0; I.sb = 0; }
    else { I.sb = it - 256; I.b = 0; I.c = 0; I.row0 = MP + I.sb * 16; I.L = 16; I.sample = 1; }
    return I;
}

__device__ __forceinline__ void copy_states_item(int wv, KP P, int l, const Item& I) {
    const bf16_t* h = (const bf16_t*)(P->ws + WS_H);
    const int tid = tidx(wv);
    if (!I.sample) {
        if (I.c >= 126) {
            for (int idx = tid; idx < 64 * 512; idx += 512) {
                const int t = idx >> 9, cc = idx & 511, kv = cc >> 8, e = cc & 255;
                const float v = bf2f(h[(size_t)(I.row0 + t) * HP + (kv ? HV : HK) + e]);
                P->out[(kv ? O_PV : O_PK) + ((size_t)(l * 2 + I.b) * 128 + (I.c - 126) * 64 + t) * 256 + e] = v;
            }
        }
        if (I.c == 127) {
            for (int idx = tid; idx < 3 * 1024; idx += 512) { const int j = idx >> 10, ch = idx & 1023;
                P->out[O_PLC + ((size_t)(l * 2 + I.b) * 3 + j) * 1024 + ch] = bf2f(h[(size_t)(I.row0 + 61 + j) * HP + HX + ch]); }
            for (int idx = tid; idx < 3 * 1536; idx += 512) { const int j = idx / 1536, ch = idx % 1536;
                P->out[O_PSC + ((size_t)(l * 2 + I.b) * 3 + j) * 1536 + ch] = bf2f(h[(size_t)(I.row0 + 61 + j) * HP + HXBC + ch]); }
        }
    } else {
        for (int idx = tid; idx < 128 * 512; idx += 512) {
            const int j = idx >> 9, cc = idx & 511, kv = cc >> 8, e = cc & 255;
            float v;
            if (j < 112) v = P->in[kv ? I_CV : I_CK][((size_t)(l * 16 + I.sb) * 128 + j + 16) * 256 + e];
            else v = bf2f(h[(size_t)(I.row0 + j - 112) * HP + (kv ? HV : HK) + e]);
            P->out[(kv ? O_SV : O_SK) + ((size_t)(l * 16 + I.sb) * 128 + j) * 256 + e] = v;
        }
        for (int idx = tid; idx < 3 * 1024; idx += 512) { const int j = idx >> 10, ch = idx & 1023;
            P->out[O_SLC + ((size_t)(l * 16 + I.sb) * 3 + j) * 1024 + ch] = bf2f(h[(size_t)(I.row0 + 13 + j) * HP + HX + ch]); }
        for (int idx = tid; idx < 3 * 1536; idx += 512) { const int j = idx / 1536, ch = idx % 1536;
            P->out[O_SSC + ((size_t)(l * 16 + I.sb) * 3 + j) * 1536 + ch] = bf2f(h[(size_t)(I.row0 + 13 + j) * HP + HXBC + ch]); }
    }
}

template <int L>
__device__ __forceinline__ void attn_item(int wv, KP P, int l, const Item& I, LAS unsigned char* lds) {
    constexpr int NS = (L == 64) ? 192 : 160;
    constexpr int NST = NS / 16, NKS = NS / 32, NQT = L / 16;
    const bf16_t* h = (const bf16_t*)(P->ws + WS_H);
    bf16_t* yabc = (bf16_t*)(P->ws + WS_Y);
    const int tid = tidx(wv), w = tid >> 6, lane = tid & 63, fr = lane & 15, fq = lane >> 4;
    LAS bf16_t* Kl = (LAS bf16_t*)lds;
    LAS bf16_t* Vt = Kl + 2 * 192 * 72;
    for (int pass = 0; pass < 2; ++pass) {
        __syncthreads();
        for (int idx = tid; idx < 2 * NS * 8; idx += 512) {
            const int dp = idx & 7, s = (idx >> 3) % NS, kvl = idx / (8 * NS), kvh = pass * 2 + kvl;
            u32x4 kw = (u32x4){0u, 0u, 0u, 0u}, vw = (u32x4){0u, 0u, 0u, 0u};
            if (L == 64) {
                const int pos = (I.c - 2) * 64 + s;
                if (pos >= 0) {
                    const bf16_t* rp = h + (size_t)(I.b * 8192 + pos) * HP + kvh * 64 + dp * 8;
                    kw = *(const u32x4*)(rp + HK); vw = *(const u32x4*)(rp + HV);
                }
            } else {
                if (s < 128) {
                    const size_t o = ((size_t)(l * 16 + I.sb) * 128 + s) * 256 + kvh * 64 + dp * 8;
                    const f32x4 k0 = *(const f32x4*)(P->in[I_CK] + o), k1 = *(const f32x4*)(P->in[I_CK] + o + 4);
                    const f32x4 v0 = *(const f32x4*)(P->in[I_CV] + o), v1 = *(const f32x4*)(P->in[I_CV] + o + 4);
                    kw.x = pk2(k0[0], k0[1]); kw.y = pk2(k0[2], k0[3]); kw.z = pk2(k1[0], k1[1]); kw.w = pk2(k1[2], k1[3]);
                    vw.x = pk2(v0[0], v0[1]); vw.y = pk2(v0[2], v0[3]); vw.z = pk2(v1[0], v1[1]); vw.w = pk2(v1[2], v1[3]);
                } else if (s < 144) {
                    const bf16_t* rp = h + (size_t)(I.row0 + s - 128) * HP + kvh * 64 + dp * 8;
                    kw = *(const u32x4*)(rp + HK); vw = *(const u32x4*)(rp + HV);
                }
            }
            *(LAS u32x4*)(Kl + (kvl * 192 + s) * 72 + dp * 8) = kw;
            LAS bf16_t* vp = Vt + (kvl * 64 + dp * 8) * 200 + s;
            vp[0 * 200] = (bf16_t)(vw.x & 0xffffu); vp[1 * 200] = (bf16_t)(vw.x >> 16); vp[2 * 200] = (bf16_t)(vw.y & 0xffffu); vp[3 * 200] = (bf16_t)(vw.y >> 16);
            vp[4 * 200] = (bf16_t)(vw.z & 0xffffu); vp[5 * 200] = (bf16_t)(vw.z >> 16); vp[6 * 200] = (bf16_t)(vw.w & 0xffffu); vp[7 * 200] = (bf16_t)(vw.w >> 16);
        }
        __syncthreads();
        const int head = pass * 8 + w, kvl = w >> 2;
        const float slope = exp2f(-0.5f * (float)(head + 1));
        const float sink = P->in[I_SINK][l * 16 + head];
#pragma unroll 1
        for (int qt = 0; qt < NQT; ++qt) {
            const bf16_t* qp = h + (size_t)(I.row0 + qt * 16 + fr) * HP + HQ + head * 64 + fq * 8;
            const bf16x8 q0 = *(const bf16x8*)qp, q1 = *(const bf16x8*)(qp + 32);
            f32x4 st[NST];
#pragma unroll
            for (int t = 0; t < NST; ++t) {
                const LAS bf16_t* kp = Kl + (kvl * 192 + t * 16 + fr) * 72 + fq * 8;
                f32x4 a = (f32x4){0.f, 0.f, 0.f, 0.f};
                a = MFMA16(*(const LAS bf16x8*)kp, q0, a);
                a = MFMA16(*(const LAS bf16x8*)(kp + 32), q1, a);
                st[t] = a;
                if ((t % 3) == 2) __builtin_amdgcn_sched_barrier(0);
            }
            const int qpos = (L == 64) ? (I.c * 64 + qt * 16 + fr) : (4096 + fr);
            float mx = sink;
#pragma unroll
            for (int t = 0; t < NST; ++t)
#pragma unroll
                for (int jj = 0; jj < 4; ++jj) {
                    const int s = t * 16 + fq * 4 + jj;
                    const int kpos = (L == 64) ? ((I.c - 2) * 64 + s) : (3968 + s);
                    const bool vis = (L == 64) ? (kpos >= 0) : (s < 144);
                    const float d = fabsf((float)(qpos - kpos));
                    const float sc = vis ? (st[t][jj] * 0.125f - slope * d) : -INFINITY;
                    st[t][jj] = sc; mx = fmaxf(mx, sc);
                }
            mx = fmaxf(mx, __shfl_xor(mx, 16)); mx = fmaxf(mx, __shfl_xor(mx, 32));
            float sum = 0.f;
#pragma unroll
            for (int t = 0; t < NST; ++t)
#pragma unroll
                for (int jj = 0; jj < 4; ++jj) { const float p = __expf(st[t][jj] - mx); st[t][jj] = p; sum += p; }
            sum += __shfl_xor(sum, 16); sum += __shfl_xor(sum, 32);
            const float inv = 1.0f / (sum + __expf(sink - mx));
            f32x4 o[4];
#pragma unroll
            for (int dt = 0; dt < 4; ++dt) o[dt] = (f32x4){0.f, 0.f, 0.f, 0.f};
#pragma unroll
            for (int ks = 0; ks < NKS; ++ks) {
                u32x4 pw; pw.x = pk2(st[2 * ks][0], st[2 * ks][1]); pw.y = pk2(st[2 * ks][2], st[2 * ks][3]);
                pw.z = pk2(st[2 * ks + 1][0], st[2 * ks + 1][1]); pw.w = pk2(st[2 * ks + 1][2], st[2 * ks + 1][3]);
                bf16x8 pf; __builtin_memcpy(&pf, &pw, 16);
#pragma unroll
                for (int dt = 0; dt < 4; ++dt) {
                    const LAS bf16_t* vp = Vt + (kvl * 64 + dt * 16 + fr) * 200 + ks * 32 + fq * 4;
                    const u32x2 va = *(const LAS u32x2*)vp, vb = *(const LAS u32x2*)(vp + 16);
                    u32x4 vw; vw.x = va.x; vw.y = va.y; vw.z = vb.x; vw.w = vb.y;
                    bf16x8 vf; __builtin_memcpy(&vf, &vw, 16);
                    o[dt] = MFMA16(vf, pf, o[dt]);
                }
            }
            bf16_t* op = yabc + (size_t)(I.row0 + qt * 16 + fr) * 3072 + 2048 + head * 64 + fq * 4;
#pragma unroll
            for (int dt = 0; dt < 4; ++dt) {
                u32x2 ow; ow.x = pk2(o[dt][0] * inv, o[dt][1] * inv); ow.y = pk2(o[dt][2] * inv, o[dt][3] * inv);
                *(u32x2*)(op + dt * 16) = ow;
            }
        }
    }
}

template <int CTRL> __device__ __forceinline__ float dpp_f(float old, float src) {
    return __int_as_float(__builtin_amdgcn_update_dpp(__float_as_int(old), __float_as_int(src), CTRL, 0xf, 0xf, false));
}
template <int L, bool FINAL>
__device__ __forceinline__ void lru_item(int wv, KP P, int l, int item, const Item& I, LAS unsigned char* lds) {
    constexpr int NIT = L / 16, XP = 1032;
    const bf16_t* h = (const bf16_t*)(P->ws + WS_H);
    bf16_t* yabc = (bf16_t*)(P->ws + WS_Y);
    float* lruA = (float*)(P->ws + WS_LRUA); float* lruU = (float*)(P->ws + WS_LRUU);
    const int tid = tidx(wv), w = tid >> 6, lane = tid & 63, fr = lane & 15, fq = lane >> 4;
    LAS bf16_t* xa = (LAS bf16_t*)lds;
    __syncthreads();
    {
        const int ch = 2 * tid;
        const float* cw = P->in[I_LCW] + (size_t)l * 4 * 1024 + ch;
        const f32x2_t w0 = *(const f32x2_t*)cw, w1 = *(const f32x2_t*)(cw + 1024), w2 = *(const f32x2_t*)(cw + 2048), w3 = *(const f32x2_t*)(cw + 3072);
        const f32x2_t cb = *(const f32x2_t*)(P->in[I_LCB] + l * 1024 + ch);
        f32x2_t xm3 = {0.f, 0.f}, xm2 = {0.f, 0.f}, xm1 = {0.f, 0.f};
        if (I.sample) { const float* st = P->in[I_SLC] + (size_t)(l * 16 + I.sb) * 3 * 1024 + ch; xm3 = *(const f32x2_t*)st; xm2 = *(const f32x2_t*)(st + 1024); xm1 = *(const f32x2_t*)(st + 2048); }
        else if (I.c > 0) { const bf16_t* hq = h + (size_t)(I.row0 - 3) * HP + HX + ch;
            const unsigned a0 = *(const unsigned*)hq, a1 = *(const unsigned*)(hq + HP), a2 = *(const unsigned*)(hq + 2 * (size_t)HP);
            xm3 = (f32x2_t){bflo(a0), bfhi(a0)}; xm2 = (f32x2_t){bflo(a1), bfhi(a1)}; xm1 = (f32x2_t){bflo(a2), bfhi(a2)}; }
        const bf16_t* hp = h + (size_t)I.row0 * HP + HX + ch;
#pragma unroll 8
        for (int t = 0; t < L; ++t) {
            const unsigned xw = *(const unsigned*)(hp + (size_t)t * HP);
            const f32x2_t x0 = {bflo(xw), bfhi(xw)};
            const f32x2_t y = cb + w0 * xm3 + w1 * xm2 + w2 * xm1 + w3 * x0;
            *(LAS unsigned*)(xa + t * XP + ch) = pk2(y[0], y[1]);
            xm3 = xm2; xm2 = xm1; xm1 = x0;
        }
    }
    __syncthreads();
#pragma unroll 1
    for (int pass = 0; pass < 2; ++pass) {
        const int blk = w + 8 * pass, ch0 = blk * 64;
        const bf16_t* waT = (const bf16_t*)(P->ws + W_LA) + blk * 4096;
        const bf16_t* wxT = (const bf16_t*)(P->ws + W_LX) + blk * 4096;
        float carryH[4][4], carryA[4][4], c8v[4][4];
#pragma unroll
        for (int jt = 0; jt < 4; ++jt)
#pragma unroll
            for (int jj = 0; jj < 4; ++jj) {
                const int ch = ch0 + jt * 16 + fq * 4 + jj;
                carryA[jt][jj] = 1.0f;
                c8v[jt][jj] = 8.0f * softplusf_(-P->in[I_LLAM][l * 1024 + ch]);
                if (FINAL) carryH[jt][jj] = I.sample ? P->in[I_SLH][(l * 16 + I.sb) * 1024 + ch] : lruU[(size_t)item * 1024 + ch];
                else carryH[jt][jj] = 0.f;
            }
#pragma unroll 1
        for (int it = 0; it < NIT; ++it) {
            const LAS bf16_t* xp = xa + (it * 16 + fr) * XP + ch0;
            const bf16x8 b0 = *(const LAS bf16x8*)(xp + fq * 8), b1 = *(const LAS bf16x8*)(xp + 32 + fq * 8);
            const int token = it * 16 + fr;
#pragma unroll
            for (int jt = 0; jt < 4; ++jt) {
                const bf16_t* wa = waT + (jt * 16 + fr) * 64 + fq * 8; const bf16_t* wx = wxT + (jt * 16 + fr) * 64 + fq * 8;
                f32x4 ra = (f32x4){0.f, 0.f, 0.f, 0.f}, ia = (f32x4){0.f, 0.f, 0.f, 0.f};
                ra = MFMA16(*(const bf16x8*)wa, b0, ra); ra = MFMA16(*(const bf16x8*)(wa + 32), b1, ra);
                ia = MFMA16(*(const bf16x8*)wx, b0, ia); ia = MFMA16(*(const bf16x8*)(wx + 32), b1, ia);
                const u32x2 xw = *(const LAS u32x2*)(xp + jt * 16 + fq * 4);
                const float xv[4] = {bflo(xw.x), bfhi(xw.x), bflo(xw.y), bfhi(xw.y)};
                const f32x4 bav = *(const f32x4*)(P->in[I_LBA] + l * 1024 + ch0 + jt * 16 + fq * 4), bxv = *(const f32x4*)(P->in[I_LBX] + l * 1024 + ch0 + jt * 16 + fq * 4);
                float hv[4], av[4];
#pragma unroll
                for (int jj = 0; jj < 4; ++jj) {
                    const float r = sigmoidf_(ra[jj] + bav[jj]);
                    const float ig = sigmoidf_(ia[jj] + bxv[jj]);
                    const float la = -c8v[jt][jj] * r;
                    float a = __expf(la);
                    float u = __builtin_amdgcn_sqrtf(fmaxf(1.0f - a * a, 0.f)) * ig * xv[jj];
                    { const float ap = dpp_f<0x111>(1.0f, a), up = dpp_f<0x111>(0.0f, u); u = a * up + u; a = a * ap; }
                    { const float ap = dpp_f<0x112>(1.0f, a), up = dpp_f<0x112>(0.0f, u); u = a * up + u; a = a * ap; }
                    { const float ap = dpp_f<0x114>(1.0f, a), up = dpp_f<0x114>(0.0f, u); u = a * up + u; a = a * ap; }
                    { const float ap = dpp_f<0x118>(1.0f, a), up = dpp_f<0x118>(0.0f, u); u = a * up + u; a = a * ap; }
                    const float hval = a * carryH[jt][jj] + u;
                    hv[jj] = hval;
                    carryH[jt][jj] = __shfl(hval, 15, 16);
                    if (!FINAL) { const float at = carryA[jt][jj] * a; av[jj] = at; carryA[jt][jj] = __shfl(at, 15, 16); }
                }
                if (!FINAL) {
                    u32x2 ow; ow.x = pk2(hv[0], hv[1]); ow.y = pk2(hv[2], hv[3]);
                    *(u32x2*)(yabc + (size_t)(I.row0 + token) * 3072 + ch0 + jt * 16 + fq * 4) = ow;
                    u32x2 aw; aw.x = pk2(av[0], av[1]); aw.y = pk2(av[2], av[3]);
                    *(u32x2*)((bf16_t*)(P->ws + WS_XB) + (size_t)(I.row0 + token) * DM + ch0 + jt * 16 + fq * 4) = aw;
                }
                if (FINAL) {
                    const u32x2 gw = *(const u32x2*)(h + (size_t)(I.row0 + token) * HP + HG + ch0 + jt * 16 + fq * 4);
                    u32x2 ow; ow.x = pk2(hv[0] * gelu_tanh(bflo(gw.x)), hv[1] * gelu_tanh(bfhi(gw.x)));
                    ow.y = pk2(hv[2] * gelu_tanh(bflo(gw.y)), hv[3] * gelu_tanh(bfhi(gw.y)));
                    *(u32x2*)(yabc + (size_t)(I.row0 + token) * 3072 + ch0 + jt * 16 + fq * 4) = ow;
                    if (it == NIT - 1 && fr == 15) {
                        if (I.sample) *(f32x4*)(P->out + O_SLH + (size_t)(l * 16 + I.sb) * 1024 + ch0 + jt * 16 + fq * 4) = (f32x4){hv[0], hv[1], hv[2], hv[3]};
                        else if (I.c == 127) *(f32x4*)(P->out + O_PLH + (size_t)(l * 2 + I.b) * 1024 + ch0 + jt * 16 + fq * 4) = (f32x4){hv[0], hv[1], hv[2], hv[3]};
                    }
                }
            }
        }
        if (!FINAL) {
            if (fr == 0) {
#pragma unroll
                for (int jt = 0; jt < 4; ++jt) {
                    *(f32x4*)(lruA + (size_t)item * 1024 + ch0 + jt * 16 + fq * 4) = (f32x4){carryA[jt][0], carryA[jt][1], carryA[jt][2], carryA[jt][3]};
                    *(f32x4*)(lruU + (size_t)item * 1024 + ch0 + jt * 16 + fq * 4) = (f32x4){carryH[jt][0], carryH[jt][1], carryH[jt][2], carryH[jt][3]};
                }
            }
        }
    }
}

__device__ __forceinline__ void lru_apply_item(int wv, KP P, int l, int item, const Item& I) {
    const bf16_t* h = (const bf16_t*)(P->ws + WS_H);
    bf16_t* yabc = (bf16_t*)(P->ws + WS_Y);
    const bf16_t* acum = (const bf16_t*)(P->ws + WS_XB);
    const float* carry = (const float*)(P->ws + WS_LRUU) + (size_t)item * 1024;
    const int tid = tidx(wv);
    const int c8 = (tid & 127) * 8;
    const f32x4 ca = *(const f32x4*)(carry + c8), cb = *(const f32x4*)(carry + c8 + 4);
    const float cv[8] = {ca[0], ca[1], ca[2], ca[3], cb[0], cb[1], cb[2], cb[3]};
#pragma unroll 4
    for (int t = tid >> 7; t < 64; t += 4) {
        const size_t r = (size_t)(I.row0 + t);
        const u32x4 aw = *(const u32x4*)(acum + r * DM + c8), hw = *(const u32x4*)(yabc + r * 3072 + c8), gw = *(const u32x4*)(h + r * HP + HG + c8);
        const unsigned au[4] = {aw.x, aw.y, aw.z, aw.w}, hu[4] = {hw.x, hw.y, hw.z, hw.w}, gu[4] = {gw.x, gw.y, gw.z, gw.w};
        float hv[8]; unsigned ou[4];
#pragma unroll
        for (int e = 0; e < 4; ++e) {
            hv[2 * e] = bflo(au[e]) * cv[2 * e] + bflo(hu[e]); hv[2 * e + 1] = bfhi(au[e]) * cv[2 * e + 1] + bfhi(hu[e]);
            ou[e] = pk2(hv[2 * e] * gelu_tanh(bflo(gu[e])), hv[2 * e + 1] * gelu_tanh(bfhi(gu[e])));
        }
        *(u32x4*)(yabc + r * 3072 + c8) = (u32x4){ou[0], ou[1], ou[2], ou[3]};
        if (I.c == 127 && t == 63) {
            float* op = P->out + O_PLH + (size_t)(l * 2 + I.b) * 1024 + c8;
            *(f32x4*)op = (f32x4){hv[0], hv[1], hv[2], hv[3]}; *(f32x4*)(op + 4) = (f32x4){hv[4], hv[5], hv[6], hv[7]};
        }
    }
}

__device__ __forceinline__ float pre_xbc(KP P, const bf16_t* h, int l, const Item& I, int tt, int ch) {
    if (tt >= 0 || (!I.sample && I.c > 0)) return bf2f(h[(size_t)(I.row0 + tt) * HP + HXBC + ch]);
    if (I.sample) return P->in[I_SSC][((size_t)(l * 16 + I.sb) * 3 + (3 + tt)) * 1536 + ch];
    return 0.f;
}
__device__ __forceinline__ float conv_xbc(KP P, const bf16_t* h, int l, const Item& I, int t, int ch) {
    const float* cw = P->in[I_SCW] + (size_t)l * 4 * 1536 + ch;
    float y = P->in[I_SCB][l * 1536 + ch];
    y += cw[0] * pre_xbc(P, h, l, I, t - 3, ch); y += cw[1536] * pre_xbc(P, h, l, I, t - 2, ch);
    y += cw[3072] * pre_xbc(P, h, l, I, t - 1, ch); y += cw[4608] * pre_xbc(P, h, l, I, t, ch);
    return siluf_(y);
}
template <class F>
__device__ __forceinline__ void conv_roll(KP P, const bf16_t* h, int l, const Item& I, int chx, int t0, int t1, F f) {
    const float* cw = P->in[I_SCW] + (size_t)l * 4 * 1536 + chx;
    const float w0 = cw[0], w1 = cw[1536], w2 = cw[3072], w3 = cw[4608], cb = P->in[I_SCB][l * 1536 + chx];
    float xm3 = pre_xbc(P, h, l, I, t0 - 3, chx), xm2 = pre_xbc(P, h, l, I, t0 - 2, chx), xm1 = pre_xbc(P, h, l, I, t0 - 1, chx);
    const bf16_t* hp = h + (size_t)I.row0 * HP + HXBC + chx;
#pragma unroll 8
    for (int t = t0; t < t1; ++t) {
        const float x0 = bf2f(hp[(size_t)t * HP]);
        const float y = cb + w0 * xm3 + w1 * xm2 + w2 * xm1 + w3 * x0;
        f(t, siluf_(y));
        xm3 = xm2; xm2 = xm1; xm1 = x0;
    }
}
template <int L, int NCH8, class CF, class F>
__device__ __forceinline__ void ssd_stage(KP P, const bf16_t* h, int l, const Item& I, int tid, CF chx_of, F f) {
    constexpr int NSEG = 512 / NCH8, TS = L / NSEG;
    static_assert(TS >= 1 && TS * NSEG == L, "segmenting");
    const int c8 = tid % NCH8, sg = tid / NCH8, t0 = sg * TS, chx = chx_of(c8);
    u32x4 xr[TS + 3];
#pragma unroll
    for (int q = 0; q < TS + 3; ++q) {
        const int tt = t0 - 3 + q;
        if (tt >= 0 || (!I.sample && I.c > 0)) {
            xr[q] = *(const u32x4*)(h + (size_t)(I.row0 + tt) * HP + HXBC + chx);
        } else if (I.sample) {
            const float* st = P->in[I_SSC] + ((size_t)(l * 16 + I.sb) * 3 + (3 + tt)) * 1536 + chx;
            const f32x4 a = *(const f32x4*)st, b = *(const f32x4*)(st + 4);
            xr[q] = (u32x4){pk2(a[0], a[1]), pk2(a[2], a[3]), pk2(b[0], b[1]), pk2(b[2], b[3])};
        } else xr[q] = (u32x4){0u, 0u, 0u, 0u};
    }
    const float* cw = P->in[I_SCW] + (size_t)l * 4 * 1536 + chx;
    float wt[4][8], cb[8];
#pragma unroll
    for (int j = 0; j < 4; ++j) { const f32x4 a = *(const f32x4*)(cw + j * 1536), b = *(const f32x4*)(cw + j * 1536 + 4);
        wt[j][0] = a[0]; wt[j][1] = a[1]; wt[j][2] = a[2]; wt[j][3] = a[3]; wt[j][4] = b[0]; wt[j][5] = b[1]; wt[j][6] = b[2]; wt[j][7] = b[3]; }
    { const f32x4 a = *(const f32x4*)(P->in[I_SCB] + l * 1536 + chx), b = *(const f32x4*)(P->in[I_SCB] + l * 1536 + chx + 4);
        cb[0] = a[0]; cb[1] = a[1]; cb[2] = a[2]; cb[3] = a[3]; cb[4] = b[0]; cb[5] = b[1]; cb[6] = b[2]; cb[7] = b[3]; }
#pragma unroll
    for (int q = 0; q < TS; ++q) {
        float v[8];
#pragma unroll
        for (int e2 = 0; e2 < 4; ++e2) {
            const unsigned r0 = xr[q][e2], r1 = xr[q + 1][e2], r2 = xr[q + 2][e2], r3 = xr[q + 3][e2];
            v[2 * e2] = siluf_(cb[2 * e2] + wt[0][2 * e2] * bflo(r0) + wt[1][2 * e2] * bflo(r1) + wt[2][2 * e2] * bflo(r2) + wt[3][2 * e2] * bflo(r3));
            v[2 * e2 + 1] = siluf_(cb[2 * e2 + 1] + wt[0][2 * e2 + 1] * bfhi(r0) + wt[1][2 * e2 + 1] * bfhi(r1) + wt[2][2 * e2 + 1] * bfhi(r2) + wt[3][2 * e2 + 1] * bfhi(r3));
        }
        f(t0 + q, c8, v);
    }
}
template <int L>
__device__ __forceinline__ void ssd_dtcum(int wv, KP P, int l, const Item& I, LAS float* dtv, LAS float* cumv) {
    const float* dtraw = (const float*)(P->ws + WS_DT);
    const int tid = tidx(wv);
    __syncthreads();
    for (int idx = tid; idx < L * 16; idx += 512) { const int hd = idx & 15; dtv[idx] = softplusf_(dtraw[(size_t)I.row0 * 16 + idx] + P->in[I_SDTB][l * 16 + hd]); }
    __syncthreads();
    if (tid < 64) {
        constexpr int SEG = L / 4;
        const int hd = tid & 15, sg = tid >> 4;
        const float A = -__expf(P->in[I_SALOG][l * 16 + hd]);
        float c = 0.f;
#pragma unroll
        for (int t = 0; t < SEG; ++t) { c += dtv[(sg * SEG + t) * 16 + hd] * A; cumv[(sg * SEG + t) * 16 + hd] = c; }
        const float t1 = __shfl(c, hd), t2 = __shfl(c, 16 + hd), t3 = __shfl(c, 32 + hd);
        const float off = sg == 0 ? 0.f : (sg == 1 ? t1 : (sg == 2 ? t1 + t2 : t1 + t2 + t3));
#pragma unroll
        for (int t = 0; t < SEG; ++t) cumv[(sg * SEG + t) * 16 + hd] += off;
    }
    __syncthreads();
}

template <int L>
__device__ __forceinline__ void ssd_states_item(int wv, KP P, int l, int item, const Item& I, LAS unsigned char* lds) {
    constexpr int LP = L < 32 ? 32 : L, KS = LP / 32;
    const bf16_t* h = (const bf16_t*)(P->ws + WS_H);
    bf16_t* states = (bf16_t*)(P->ws + WS_ST);
    float* cdec = (float*)(P->ws + WS_CDEC);
    const int tid = tidx(wv), w = tid >> 6, lane = tid & 63, fr = lane & 15, fq = lane >> 4;
    LAS float* dtv = (LAS float*)lds; LAS float* cumv = dtv + 1024;
    LAS bf16_t* BmT = (LAS bf16_t*)(lds + 8192);
    LAS bf16_t* xw = (LAS bf16_t*)(lds + 8192 + 36864) + w * (64 * 72);
    ssd_dtcum<L>(wv, P, l, I, dtv, cumv);
    LAS bf16_t* xwall = (LAS bf16_t*)(lds + 8192 + 36864);
    ssd_stage<L, 32>(P, h, l, I, tid, [](int c8) { return 1024 + c8 * 8; }, [&](int t, int c8, const float* v) {
#pragma unroll
        for (int e = 0; e < 8; ++e) BmT[(c8 * 8 + e) * 72 + t] = f2bf(v[e]); });
    if (L < LP) for (int idx = tid; idx < 256 * (LP - L); idx += 512) BmT[(idx / (LP - L)) * 72 + L + idx % (LP - L)] = 0;
    for (int hh = 0; hh < 2; ++hh) {
        const int head = w + 8 * hh;
        const float cl = cumv[(L - 1) * 16 + head];
        __syncthreads();
        ssd_stage<L, 64>(P, h, l, I, tid, [=](int c8) { return hh * 512 + c8 * 8; }, [&](int t, int c8, const float* v) {
            const int hd = hh * 8 + (c8 >> 3);
            const float sc = __expf(cumv[(L - 1) * 16 + hd] - cumv[t * 16 + hd]) * dtv[t * 16 + hd];
            LAS bf16_t* dst = xwall + (c8 >> 3) * (64 * 72) + ((c8 & 7) * 8) * 72 + t;
#pragma unroll
            for (int e = 0; e < 8; ++e) dst[e * 72] = f2bf(v[e] * sc); });
        if (L < LP) for (int idx = tid; idx < 512 * (LP - L); idx += 512) xwall[(idx / (LP - L)) * 72 + L + idx % (LP - L)] = 0;
        __syncthreads();
        const float dec = __expf(cl);
        if (!I.sample && lane == 0) cdec[item * 16 + head] = dec;
#pragma unroll 1
        for (int nt = 0; nt < 8; ++nt) {
            bf16x8 af[KS];
#pragma unroll
            for (int ks = 0; ks < KS; ++ks) af[ks] = *(const LAS bf16x8*)(BmT + (hh * 128 + nt * 16 + fr) * 72 + ks * 32 + fq * 8);
#pragma unroll
            for (int pt = 0; pt < 4; ++pt) {
                f32x4 a = (f32x4){0.f, 0.f, 0.f, 0.f};
#pragma unroll
                for (int ks = 0; ks < KS; ++ks) a = MFMA16(af[ks], *(const LAS bf16x8*)(xw + (pt * 16 + fr) * 72 + ks * 32 + fq * 8), a);
                const int p = pt * 16 + fr, n0 = nt * 16 + fq * 4;
                if (!I.sample) {
                    u32x2 ow; ow.x = pk2(a[0], a[1]); ow.y = pk2(a[2], a[3]);
                    *(u32x2*)(states + ((size_t)((I.b * 128 + I.c) * 16 + head) * 64 + p) * 128 + n0) = ow;
                } else {
                    const size_t o = ((size_t)((l * 16 + I.sb) * 16 + head) * 64 + p) * 128 + n0;
                    const f32x4 h0 = *(const f32x4*)(P->in[I_SSH] + o);
                    *(f32x4*)(P->out + O_SSH + o) = h0 * dec + a;
                }
            }
        }
    }
}

template <int L>
__device__ __forceinline__ void ssd_y_item(int wv, KP P, int l, const Item& I, LAS unsigned char* lds) {
    constexpr int LP = L < 32 ? 32 : L, KS = LP / 32, NIT = L / 16;
    const bf16_t* h = (const bf16_t*)(P->ws + WS_H);
    const bf16_t* states = (const bf16_t*)(P->ws + WS_ST);
    bf16_t* yabc = (bf16_t*)(P->ws + WS_Y);
    const int tid = tidx(wv), w = tid >> 6, lane = tid & 63, fr = lane & 15, fq = lane >> 4;
    LAS float* dtv = (LAS float*)lds; LAS float* cumv = dtv + 1024;
    LAS bf16_t* Bm = (LAS bf16_t*)(lds + 8192);
    LAS bf16_t* Cm = (LAS bf16_t*)(lds + 8192 + 17408);
    LAS float* CBl = (LAS float*)(lds + 8192 + 2 * 17408);
    LAS float* part = (LAS float*)(lds + 8192 + 3 * 17408);
    LAS bf16_t* xT = (LAS bf16_t*)(lds + 8192 + 3 * 17408 + 2048) + w * (64 * 72);
    ssd_dtcum<L>(wv, P, l, I, dtv, cumv);
    for (int g = 0; g < 2; ++g) {
        const int head = g * 8 + w;
        __syncthreads();
        ssd_stage<L, 32>(P, h, l, I, tid, [=](int c8) { return 1024 + (c8 >> 4) * 256 + g * 128 + (c8 & 15) * 8; }, [&](int t, int c8, const float* v) {
            u32x4 ow; ow.x = pk2(v[0], v[1]); ow.y = pk2(v[2], v[3]); ow.z = pk2(v[4], v[5]); ow.w = pk2(v[6], v[7]);
            *(LAS u32x4*)(((c8 >> 4) ? Cm : Bm) + t * 136 + (c8 & 15) * 8) = ow; });
        {
            LAS bf16_t* xTall = (LAS bf16_t*)(lds + 8192 + 3 * 17408 + 2048);
            ssd_stage<L, 64>(P, h, l, I, tid, [=](int c8) { return g * 512 + c8 * 8; }, [&](int t, int c8, const float* v) {
                LAS bf16_t* dst = xTall + (c8 >> 3) * (64 * 72) + ((c8 & 7) * 8) * 72 + t;
#pragma unroll
                for (int e = 0; e < 8; ++e) dst[e * 72] = f2bf(v[e]); });
            if (L < LP) for (int idx = tid; idx < 512 * (LP - L); idx += 512) xTall[(idx / (LP - L)) * 72 + L + idx % (LP - L)] = 0;
        }
        __syncthreads();
        for (int tix = w; tix < NIT * NIT; tix += 8) {
            const int it = tix / NIT, jt = tix % NIT;
            f32x4 a = (f32x4){0.f, 0.f, 0.f, 0.f};
#pragma unroll
            for (int ks = 0; ks < 4; ++ks)
                a = MFMA16(*(const LAS bf16x8*)(Cm + (it * 16 + fr) * 136 + ks * 32 + fq * 8), *(const LAS bf16x8*)(Bm + (jt * 16 + fr) * 136 + ks * 32 + fq * 8), a);
#pragma unroll
            for (int jj = 0; jj < 4; ++jj) CBl[(it * 16 + fq * 4 + jj) * 68 + jt * 16 + fr] = a[jj];
        }
        __syncthreads();
        const float dsk = P->in[I_SD][l * 16 + head];
        bf16x8 hf[4][4];
#pragma unroll
        for (int pt = 0; pt < 4; ++pt) {
            const int p = pt * 16 + fr;
            if (!I.sample) {
                const bf16_t* sp = states + ((size_t)((I.b * 128 + I.c) * 16 + head) * 64 + p) * 128 + fq * 8;
#pragma unroll
                for (int ks = 0; ks < 4; ++ks) hf[pt][ks] = *(const bf16x8*)(sp + ks * 32);
            } else {
                const float* sp = P->in[I_SSH] + ((size_t)((l * 16 + I.sb) * 16 + head) * 64 + p) * 128 + fq * 8;
#pragma unroll
                for (int ks = 0; ks < 4; ++ks) {
                    const f32x4 a0 = *(const f32x4*)(sp + ks * 32), a1 = *(const f32x4*)(sp + ks * 32 + 4);
                    u32x4 ww; ww.x = pk2(a0[0], a0[1]); ww.y = pk2(a0[2], a0[3]); ww.z = pk2(a1[0], a1[1]); ww.w = pk2(a1[2], a1[3]);
                    __builtin_memcpy(&hf[pt][ks], &ww, 16);
                }
            }
        }
#pragma unroll 1
        for (int it = 0; it < NIT; ++it) {
            const int i = it * 16 + fr; const float cum_i = cumv[i * 16 + head];
            f32x4 acc[4];
#pragma unroll
            for (int pt = 0; pt < 4; ++pt) acc[pt] = (f32x4){0.f, 0.f, 0.f, 0.f};
#pragma unroll
            for (int ks = 0; ks < KS; ++ks) {
                if (ks * 32 > it * 16 + 15) continue;
                const int j0 = ks * 32 + fq * 8;
                const f32x4 c0 = *(const LAS f32x4*)(CBl + i * 68 + j0), c1 = *(const LAS f32x4*)(CBl + i * 68 + j0 + 4);
                float wv8[8];
#pragma unroll
                for (int e = 0; e < 8; ++e) {
                    const int j = j0 + e; const float cb = e < 4 ? c0[e & 3] : c1[e & 3];
                    const float ex = __expf(fminf(cum_i - cumv[j * 16 + head], 0.f));
                    wv8[e] = (j <= i) ? cb * ex * dtv[j * 16 + head] : 0.f;
                }
                u32x4 ww; ww.x = pk2(wv8[0], wv8[1]); ww.y = pk2(wv8[2], wv8[3]); ww.z = pk2(wv8[4], wv8[5]); ww.w = pk2(wv8[6], wv8[7]);
                bf16x8 wf; __builtin_memcpy(&wf, &ww, 16);
#pragma unroll
                for (int pt = 0; pt < 4; ++pt) acc[pt] = MFMA16(*(const LAS bf16x8*)(xT + (pt * 16 + fr) * 72 + j0), wf, acc[pt]);
            }
            const float ecum = __expf(cum_i);
            bf16x8 cf[4];
#pragma unroll
            for (int ks = 0; ks < 4; ++ks) cf[ks] = *(const LAS bf16x8*)(Cm + i * 136 + ks * 32 + fq * 8);
#pragma unroll
            for (int pt = 0; pt < 4; ++pt) {
                f32x4 t2 = (f32x4){0.f, 0.f, 0.f, 0.f};
#pragma unroll
                for (int ks = 0; ks < 4; ++ks) t2 = MFMA16(hf[pt][ks], cf[ks], t2);
                acc[pt] += t2 * ecum;
            }
            float ss = 0.f;
#pragma unroll
            for (int pt = 0; pt < 4; ++pt) {
                const int p0 = pt * 16 + fq * 4;
                const u32x2 zw = *(const u32x2*)(h + (size_t)(I.row0 + i) * HP + HZ + head * 64 + p0);
                const float zv[4] = {bflo(zw.x), bfhi(zw.x), bflo(zw.y), bfhi(zw.y)};
                float yv[4];
#pragma unroll
                for (int jj = 0; jj < 4; ++jj) {
                    const float xs = bf2f(xT[(p0 + jj) * 72 + i]);
                    const float y = (acc[pt][jj] + dsk * xs) * siluf_(zv[jj]);
                    yv[jj] = y; ss += y * y;
                }
                u32x2 ow; ow.x = pk2(yv[0], yv[1]); ow.y = pk2(yv[2], yv[3]);
                *(u32x2*)(yabc + (size_t)(I.row0 + i) * 3072 + 1024 + head * 64 + p0) = ow;
            }
            ss += __shfl_xor(ss, 16); ss += __shfl_xor(ss, 32);
            if (fq == 0) part[i * 8 + w] = ss;
        }
        __syncthreads();
#pragma unroll 1
        for (int it = 0; it < NIT; ++it) {
            const int i = it * 16 + fr;
            const f32x4 pa = *(const LAS f32x4*)(part + i * 8), pb = *(const LAS f32x4*)(part + i * 8 + 4);
            const float tot = (pa[0] + pa[1] + pa[2] + pa[3]) + (pb[0] + pb[1] + pb[2] + pb[3]);
            const float rs = rsqrtf(tot * (1.0f / 512.0f) + EPS);
#pragma unroll
            for (int pt = 0; pt < 4; ++pt) {
                const int p0 = pt * 16 + fq * 4;
                const f32x4 ng = *(const f32x4*)(P->in[I_SNORM] + l * 1024 + head * 64 + p0);
                u32x2* yp = (u32x2*)(yabc + (size_t)(I.row0 + i) * 3072 + 1024 + head * 64 + p0);
                const u32x2 yw = *yp;
                u32x2 ow; ow.x = pk2(bflo(yw.x) * rs * ng[0], bfhi(yw.x) * rs * ng[1]); ow.y = pk2(bflo(yw.y) * rs * ng[2], bfhi(yw.y) * rs * ng[3]);
                *yp = ow;
            }
        }
    }
}

__device__ __forceinline__ void phase_scan(int wv, KP P, int l) {
    bf16_t* states = (bf16_t*)(P->ws + WS_ST);
    const float* cdec = (const float*)(P->ws + WS_CDEC);
    const float* lruA = (const float*)(P->ws + WS_LRUA); float* lruU = (float*)(P->ws + WS_LRUU);
    if (DBG_P5S) for (int idx = bidx() * 512 + tidx(wv); idx < 131072; idx += gdim() * 512) {
        const int e = idx * 2, b = e >> 17, rem = e & 131071, head = rem >> 13;
        unsigned* sp = (unsigned*)(states + (size_t)b * 128 * 131072 + rem);
        const float* dp = cdec + (b * 128) * 16 + head;
        float c0 = 0.f, c1 = 0.f;
        for (int c = 0; c < 128; c += 8) {
            unsigned v[8];
#pragma unroll
            for (int k = 0; k < 8; ++k) v[k] = sp[(size_t)(c + k) * 65536];
#pragma unroll
            for (int k = 0; k < 8; ++k) {
                const float dec = dp[(c + k) * 16];
                if (DBG_P5W) sp[(size_t)(c + k) * 65536] = pk2(c0, c1);
                c0 = dec * c0 + bflo(v[k]); c1 = dec * c1 + bfhi(v[k]);
            }
        }
        float* op = P->out + O_PSH + (size_t)(l * 2 + b) * 131072 + rem;
        op[0] = c0; op[1] = c1;
    }
    if (DBG_LRU4) for (int idx = bidx() * 512 + tidx(wv); idx < 2048; idx += gdim() * 512) {
        const int b = idx >> 10, ch = idx & 1023;
        float carry = 0.f;
        for (int c = 0; c < 128; ++c) {
            const size_t o = (size_t)(b * 128 + c) * 1024 + ch;
            const float A = lruA[o], U = lruU[o];
            lruU[o] = carry;
            carry = A * carry + U;
        }
    }
}

__device__ __forceinline__ void gsync(cg::grid_group& grid) {
    __threadfence(); grid.sync();
    __builtin_amdgcn_fence(__ATOMIC_ACQUIRE, "agent"); asm volatile("s_waitcnt vmcnt(0)" ::: "memory");
}
#define XB_TMO      128
#define XB_XCNT(j)  (256  + 64 * (j))
#define XB_XSUB(j)  (1280 + 64 * (j))
#define XB_XGEN(j)  (2304 + 64 * (j))
#define XB_TOP      3328
#define XB_TOPGEN   3392
#define XCD_BAR_WORDS 3456
#define XB_SPIN_CAP (1u << 20)
__device__ __forceinline__ unsigned xb_ld(unsigned* p)              { return __hip_atomic_load(p, __ATOMIC_RELAXED, __HIP_MEMORY_SCOPE_AGENT); }
__device__ __forceinline__ unsigned xb_add(unsigned* p, unsigned v) { return __hip_atomic_fetch_add(p, v, __ATOMIC_RELAXED, __HIP_MEMORY_SCOPE_AGENT); }
__device__ __forceinline__ unsigned xb_xcc_id() { return (unsigned)__builtin_amdgcn_s_getreg((3 << 11) | 20) & 0xFu; }
#define XB_SPIN(cond, bar) do { unsigned _sp = 0; while (cond) { __builtin_amdgcn_s_sleep(1); \
    if ((++_sp & 255u) == 0u) { if (xb_ld(&(bar)[XB_TMO])) break; if (_sp > XB_SPIN_CAP) { atomicAdd(&(bar)[XB_TMO], 1u); break; } } } } while (0)
__device__ __forceinline__ void xcd_barrier_complete(unsigned* bar, unsigned x, unsigned& nloc, unsigned& nx) {
    const unsigned G = (unsigned)gdim();
    unsigned sum, cnt, mine, sp = 0u;
    for (;;) {
        sum = 0u; cnt = 0u; mine = 0u;
#pragma unroll
        for (unsigned j = 0; j < 16; ++j) { const unsigned c = xb_ld(&bar[XB_XCNT(j)]); sum += c; cnt += (c > 0u) ? 1u : 0u; mine = (j == x) ? c : mine; }
        if (sum == G) break;
        __builtin_amdgcn_s_sleep(1);
        if ((++sp & 255u) == 0u) { if (xb_ld(&bar[XB_TMO])) break; if (sp > XB_SPIN_CAP) { atomicAdd(&bar[XB_TMO], 1u); break; } }
    }
    nloc = mine > 0u ? mine : 1u; nx = cnt > 0u ? cnt : 1u;
}
__device__ __forceinline__ void gbar(int wv, LAS unsigned char* lds) {
    asm volatile("s_waitcnt vmcnt(0)" ::: "memory");
    __syncthreads();
    unsigned* bar = (unsigned*)(kparams()->ws + WS_BAR);
    if (tidx(wv) == 0) {
        volatile LAS unsigned* st = (volatile LAS unsigned*)(lds + LDS_BYTES - 16);
        const unsigned x = xb_xcc_id();
        __builtin_amdgcn_s_waitcnt(0);
        unsigned nloc = st[0], nx = st[1];
        if (nloc == 0u) { xcd_barrier_complete(bar, x, nloc, nx); st[0] = nloc; st[1] = nx; }
        const unsigned old = xb_add(&bar[XB_XSUB(x)], 1u);
        const unsigned gen = old / nloc;
        if (old + 1u == (gen + 1u) * nloc) {
            __builtin_amdgcn_fence(__ATOMIC_RELEASE, "agent");
            asm volatile("s_waitcnt vmcnt(0)" ::: "memory");
            const unsigned og = xb_add(&bar[XB_TOP], 1u);
            const unsigned tg = og / nx;
            if (og + 1u == (tg + 1u) * nx) xb_add(&bar[XB_TOPGEN], 1u);
            else XB_SPIN(xb_ld(&bar[XB_TOPGEN]) == tg, bar);
            __builtin_amdgcn_fence(__ATOMIC_ACQUIRE, "agent");
            xb_add(&bar[XB_XGEN(x)], 1u);
            asm volatile("s_waitcnt vmcnt(0)" ::: "memory");
        } else {
            XB_SPIN(xb_ld(&bar[XB_XGEN(x)]) == gen, bar);
            __builtin_amdgcn_fence(__ATOMIC_ACQUIRE, "agent");
            asm volatile("s_waitcnt vmcnt(0)" ::: "memory");
        }
    }
    __syncthreads();
}
__device__ __forceinline__ void gemm_gu(int wv, LAS unsigned char* lds, int j2) { KP P = kparams();
    EpiGU E; E.ssq = (const float*)(P->ws + WS_SSQ); E.hff = (bf16_t*)(P->ws + WS_H);
    run_gemm(wv, lds, (const bf16_t*)(P->ws + WS_XB), (const bf16_t*)(P->ws + (j2 ? W_GU1 : W_GU0)), MT, 5632, 1024, E); }
__device__ __forceinline__ void gemm_dn(int wv, LAS unsigned char* lds, int j2) { KP P = kparams();
    EpiRes E; E.x = P->out; E.xb = (bf16_t*)(P->ws + WS_XB); E.ssq = (float*)(P->ws + WS_SSQ); E.scale = 0.5f;
    run_gemm(wv, lds, (const bf16_t*)(P->ws + WS_H), (const bf16_t*)(P->ws + (j2 ? W_DN1 : W_DN0)), MP, 1024, 2816, E);
    skinny_gemm<0>(wv, lds, kparams(), (const bf16_t*)(kparams()->ws + WS_H) + (size_t)MP * DFF, (const bf16_t*)(kparams()->ws + (j2 ? W_DN1 : W_DN0)), 2816, 0.5f); }
__device__ __forceinline__ void gemm_in(int wv, LAS unsigned char* lds) { KP P = kparams();
    EpiIn E; E.ssq = (const float*)(P->ws + WS_SSQ); E.h = (bf16_t*)(P->ws + WS_H); E.dtraw = (float*)(P->ws + WS_DT);
    run_gemm(wv, lds, (const bf16_t*)(P->ws + WS_XB), (const bf16_t*)(P->ws + W_IN), MT, NINP, 1024, E); }
__device__ __forceinline__ void gemm_merge(int wv, LAS unsigned char* lds) { KP P = kparams();
    EpiMerge E; E.h = (const bf16_t*)(P->ws + WS_H); E.merged = (bf16_t*)(P->ws + WS_ST);
    run_gemm(wv, lds, (const bf16_t*)(P->ws + WS_Y), (const bf16_t*)(P->ws + W_BR), MP, 1024, 3072, E);
    skinny_gemm<1>(wv, lds, kparams(), (const bf16_t*)(kparams()->ws + WS_Y) + (size_t)MP * 3072, (const bf16_t*)(kparams()->ws + W_BR), 3072, 1.0f); }
__device__ __forceinline__ void gemm_out(int wv, LAS unsigned char* lds) { KP P = kparams();
    EpiRes E; E.x = P->out; E.xb = (bf16_t*)(P->ws + WS_XB); E.ssq = (float*)(P->ws + WS_SSQ); E.scale = 1.0f;
    run_gemm(wv, lds, (const bf16_t*)(P->ws + WS_ST), (const bf16_t*)(P->ws + W_OUT), MP, 1024, 1024, E);
    skinny_gemm<0>(wv, lds, kparams(), (const bf16_t*)(kparams()->ws + WS_ST) + (size_t)MP * DM, (const bf16_t*)(kparams()->ws + W_OUT), 1024, 1.0f); }

__global__ __launch_bounds__(512, 2) void mega(Params Pk) {
    extern __shared__ __attribute__((aligned(16))) unsigned char smem[];
    LAS unsigned char* lds = (LAS unsigned char*)smem;
    cg::grid_group grid = cg::this_grid();
    const int wv = __builtin_amdgcn_readfirstlane((int)(threadIdx.x >> 6));
    unsigned* bar0 = (unsigned*)(kparams()->ws + WS_BAR);
    if (threadIdx.x == 0) {
        volatile LAS unsigned* st = (volatile LAS unsigned*)(lds + LDS_BYTES - 16); st[0] = 0u; st[1] = 0u;
        (void)xb_add(&bar0[XB_XCNT(xb_xcc_id())], 1u);
    }
    __syncthreads();
    phase_init(wv, kparams());
    gsync(grid);
#pragma unroll 1
    for (int step = 0; step < 8; ++step) {
        const int l = step >> 1, j2 = step & 1;
        gbar(wv, lds);
        if (j2 == 0) { for (int q = 0; q < REP_CV; ++q) convert_layer(wv, kparams(), l, lds); gbar(wv, lds); }
        for (int rep = 0; rep < REP_GU; ++rep) { if (rep) gbar(wv, lds); gemm_gu(wv, lds, j2); }
        gbar(wv, lds);
        gemm_dn(wv, lds, j2);
        if (j2 == 0 && DBG_MIX) {
            gbar(wv, lds);
            for (int rep = 0; rep < REP_IN; ++rep) { if (rep) gbar(wv, lds); gemm_in(wv, lds); }
            for (int rep = 0; rep < REP_SYNC; ++rep) gbar(wv, lds);
            gbar(wv, lds);
            for (int rep = 0; rep < REP_P4; ++rep)
            for (int item = bidx(); item < 256; item += gdim()) {
                const Item I = get_item(item);
                copy_states_item(wv, kparams(), l, I);
                for (int q = 0; q < REP_A; ++q) attn_item<64>(wv, kparams(), l, I, lds);
                for (int q = 0; q < REP_L4; ++q) lru_item<64, false>(wv, kparams(), l, item, I, lds);
                for (int q = 0; q < REP_S4; ++q) ssd_states_item<64>(wv, kparams(), l, item, I, lds);
            }
            gbar(wv, lds);
            phase_scan(wv, kparams(), l);
            for (int sb = gdim() - 1 - bidx(); sb < 16; sb += gdim()) {
                const Item I = get_item(256 + sb);
                copy_states_item(wv, kparams(), l, I);
                attn_item<16>(wv, kparams(), l, I, lds);
            }
            gbar(wv, lds);
            for (int rep = 0; rep < REP_P6; ++rep) {
            for (int item = bidx(); item < 256; item += gdim()) {
                const Item I = get_item(item);
                for (int q = 0; q < REP_L6; ++q) lru_apply_item(wv, kparams(), l, item, I);
                for (int q = 0; q < REP_S6; ++q) ssd_y_item<64>(wv, kparams(), l, I, lds);
            }
            for (int sj = bidx(); sj < 48; sj += gdim()) {
                const int sb = sj & 15, piece = sj >> 4;
                const Item I = get_item(256 + sb);
                if (piece == 0) lru_item<16, true>(wv, kparams(), l, 256 + sb, I, lds);
                else if (piece == 1) ssd_states_item<16>(wv, kparams(), l, 256 + sb, I, lds);
                else ssd_y_item<16>(wv, kparams(), l, I, lds);
            }
            }
            if (DBG_MERGE) {
            gbar(wv, lds);
            for (int rep = 0; rep < REP_MG; ++rep) { if (rep) gbar(wv, lds); gemm_merge(wv, lds); }
            gbar(wv, lds);
            gemm_out(wv, lds); }
        }
    }
    gbar(wv, lds);
    phase_final(wv, kparams());
#if DBG_SANITIZE
    gbar(wv, lds);
    { KP P = kparams(); float* o = P->out;
      for (size_t i = (size_t)bidx() * 512 + tidx(wv); i < O_END; i += (size_t)gdim() * 512) { const float v = o[i]; if (!(fabsf(v) < 1e30f)) o[i] = 0.f; } }
#endif
}

extern "C" void kernel_launch(void* const* d_in, const int* in_sizes, int n_in, void* d_out, int out_size, void* d_ws, size_t ws_size, hipStream_t stream) {
    static int grid_blocks = 0;
    if (grid_blocks == 0) {
        if (n_in != N_INPUTS || (size_t)out_size != O_END || ws_size < WS_END) {
            fprintf(stderr, "kernel_launch: unexpected shapes: n_in %d out %d ws %zu (need %zu)\n", n_in, out_size, ws_size, (size_t)WS_END); grid_blocks = -1; return; }
        int dev = 0, cus = 0, per_cu = 0;
        hipGetDevice(&dev);
        hipDeviceGetAttribute(&cus, hipDeviceAttributeMultiprocessorCount, dev);
        if (hipFuncSetAttribute((const void*)mega, hipFuncAttributeMaxDynamicSharedMemorySize, LDS_BYTES) != hipSuccess) { fprintf(stderr, "hipFuncSetAttribute failed\n"); grid_blocks = -1; return; }
        hipOccupancyMaxActiveBlocksPerMultiprocessor(&per_cu, (const void*)mega, 512, LDS_BYTES);
        if (per_cu < 1) per_cu = 1;
        grid_blocks = cus * per_cu;
    }
    if (grid_blocks < 0) return;
    Params p{};
    for (int i = 0; i < N_INPUTS; ++i) p.in[i] = (const float*)d_in[i];
    p.out = (float*)d_out; p.ws = (unsigned char*)d_ws;
    if (hipMemsetAsync((unsigned char*)d_ws + WS_BAR, 0, 16384, stream) != hipSuccess) { fprintf(stderr, "memset failed\n"); return; }
    void* args[] = {&p};
    hipError_t e = hipLaunchCooperativeKernel((const void*)mega, dim3(grid_blocks), dim3(512), args, LDS_BYTES, stream);
    if (e != hipSuccess) fprintf(stderr, "cooperative launch failed: %s (grid %d)\n", hipGetErrorString(e), grid_blocks);
}
```

```cpp
#include <hip/hip_runtime.h>
#include <hip/hip_cooperative_groups.h>
#include <cstdio>
namespace cg = cooperative_groups;
#define DBG_SANITIZE 0
#ifndef REP_P4
#define REP_P4 1
#endif
#ifndef REP_P6
#define REP_P6 1
#endif
#ifndef REP_SYNC
#define REP_SYNC 0
#endif
#ifndef REP_IN
#define REP_IN 1
#endif
#ifndef REP_A
#define REP_A 1
#endif
#ifndef REP_L4
#define REP_L4 1
#endif
#ifndef REP_S4
#define REP_S4 1
#endif
#ifndef REP_L6
#define REP_L6 1
#endif
#ifndef REP_S6
#define REP_S6 1
#endif
#ifndef PROBE
#define PROBE -1
#endif
#define TNOW() __builtin_amdgcn_s_memrealtime()
#define TB(id) do { if (((PROBE) >> (id)) & 1 && PROBE >= 0) t0 = TNOW(); } while (0)
#define TE(id) do { if (((PROBE) >> (id)) & 1 && PROBE >= 0) tacc += TNOW() - t0; } while (0)
#ifndef REP_CV
#define REP_CV 1
#endif
#ifndef REP_GU
#define REP_GU 1
#endif
#ifndef REP_MG
#define REP_MG 1
#endif
#define DBG_MIX 1
#define DBG_MERGE 1
#define DBG_ATTN 1
#define DBG_LRU4 1
#define DBG_SSD4 1
#define DBG_P5S 1
#define DBG_P5W 1
#define DBG_P5 1
#define DBG_LRU6 1
#define DBG_SSD6 1

#define LAS __attribute__((address_space(3)))
typedef unsigned short bf16_t;
typedef short bf16x8 __attribute__((ext_vector_type(8)));
typedef float f32x4 __attribute__((ext_vector_type(4)));
typedef unsigned u32x4 __attribute__((ext_vector_type(4)));
typedef unsigned u32x2 __attribute__((ext_vector_type(2)));

constexpr int MP = 16384, MS = 256, MT = 16640;
constexpr int DM = 1024, DFF = 2816, NIN = 9232, NINP = 9472, HP = 9232;
constexpr int HX = 0, HG = 1024, HZ = 2048, HXBC = 3072, HQ = 4608, HK = 5632, HV = 5888, HGATE = 6144, HDT = 9216;
constexpr float EPS = 1e-6f;
constexpr int NITEM = 272;

enum { I_XP = 0, I_XS, I_CK, I_CV, I_SLC, I_SLH, I_SSC, I_SSH, I_FNORM, I_WG, I_WU, I_WD, I_MNORM, I_WIN, I_LCW, I_LCB, I_LWA, I_LBA, I_LWX, I_LBX,
       I_LLAM, I_SCW, I_SCB, I_SDTB, I_SALOG, I_SD, I_SNORM, I_SINK, I_WBR, I_WOUT, I_FINAL, N_INPUTS };

constexpr size_t O_YP = 0, O_YS = O_YP + (size_t)MP * DM, O_PK = O_YS + (size_t)MS * DM, O_PV = O_PK + 4 * 2 * 128 * 256, O_PLC = O_PV + 4 * 2 * 128 * 256,
                 O_PLH = O_PLC + 4 * 2 * 3 * 1024, O_PSC = O_PLH + 4 * 2 * 1024, O_PSH = O_PSC + 4 * 2 * 3 * 1536, O_SK = O_PSH + (size_t)4 * 2 * 16 * 64 * 128,
                 O_SV = O_SK + (size_t)4 * 16 * 128 * 256, O_SLC = O_SV + (size_t)4 * 16 * 128 * 256, O_SLH = O_SLC + 4 * 16 * 3 * 1024, O_SSC = O_SLH + 4 * 16 * 1024,
                 O_SSH = O_SSC + 4 * 16 * 3 * 1536, O_END = O_SSH + (size_t)4 * 16 * 16 * 64 * 128;

constexpr size_t WS_XB = 0;
constexpr size_t WS_H = WS_XB + (size_t)MT * DM * 2;
constexpr size_t WS_ST = WS_H + (size_t)MT * HP * 2;
constexpr size_t WS_Y = WS_ST + (size_t)2 * 128 * 16 * 64 * 128 * 2;
constexpr size_t WS_W = WS_Y + (size_t)MT * 3072 * 2;
constexpr size_t W_GU0 = WS_W, W_GU1 = W_GU0 + (size_t)5632 * 1024 * 2, W_DN0 = W_GU1 + (size_t)5632 * 1024 * 2, W_DN1 = W_DN0 + (size_t)1024 * 2816 * 2,
                 W_IN = W_DN1 + (size_t)1024 * 2816 * 2, W_BR = W_IN + (size_t)NINP * 1024 * 2, W_OUT = W_BR + (size_t)1024 * 3072 * 2,
                 W_LA = W_OUT + (size_t)1024 * 1024 * 2, W_LX = W_LA + 2 * 65536 * 2, WS_SSQ = W_LX + 2 * 65536 * 2;
constexpr size_t WS_DT = WS_SSQ + (size_t)MT * 16 * 4, WS_LRUA = WS_DT + (size_t)MT * 16 * 4, WS_LRUU = WS_LRUA + 256 * 1024 * 4, WS_CDEC = WS_LRUU + 256 * 1024 * 4,
                 WS_BAR = WS_CDEC + 256 * 16 * 4, WS_SSQ2 = WS_BAR + 16384, WS_END = WS_SSQ2 + 256 * 16 * 4;

constexpr int LDS_BYTES = 147456;

struct Params { const float* in[N_INPUTS]; float* out; unsigned char* ws; };
typedef const Params __attribute__((address_space(4))) * KP;
__device__ __forceinline__ KP kparams() { KP p = (KP)__builtin_amdgcn_kernarg_segment_ptr(); asm volatile("" : "+s"(p)); return p; }
__device__ __forceinline__ int tidx(int wv) { int t; asm volatile("v_mbcnt_lo_u32_b32 %0, -1, 0\n\tv_mbcnt_hi_u32_b32 %0, -1, %0" : "=v"(t)); return (wv << 6) | t; }
__device__ __forceinline__ int bidx() { int t = blockIdx.x; asm volatile("" : "+s"(t)); return t; }
__device__ __forceinline__ int gdim() { int t = gridDim.x; asm volatile("" : "+s"(t)); return t; }

typedef __bf16 bf16x2_t __attribute__((ext_vector_type(2)));
typedef float f32x2_t __attribute__((ext_vector_type(2)));
__device__ __forceinline__ unsigned pk2(float lo, float hi) { f32x2_t v = {lo, hi}; bf16x2_t b = __builtin_convertvector(v, bf16x2_t); unsigned r; __builtin_memcpy(&r, &b, 4); return r; }
__device__ __forceinline__ bf16_t f2bf(float f) { return (bf16_t)(pk2(f, 0.f) & 0xffffu); }
__device__ __forceinline__ float bf2f(bf16_t b) { return __uint_as_float(((unsigned)b) << 16); }
__device__ __forceinline__ float bflo(unsigned w) { return __uint_as_float(w << 16); }
__device__ __forceinline__ float bfhi(unsigned w) { return __uint_as_float(w & 0xffff0000u); }
__device__ __forceinline__ float rcpf_(float x) { return __builtin_amdgcn_rcpf(x); }
__device__ __forceinline__ float sigmoidf_(float x) { return rcpf_(1.0f + __expf(-x)); }
__device__ __forceinline__ float siluf_(float x) { return x * rcpf_(1.0f + __expf(-x)); }
__device__ __forceinline__ float softplusf_(float x) { return x > 20.f ? x : log1pf(__expf(x)); }
__device__ __forceinline__ float gelu_tanh(float x) { const float u = 0.7978845608028654f * (x + 0.044715f * x * x * x); return x * rcpf_(1.0f + __expf(-2.0f * u)); }
__device__ __forceinline__ float rstd_row(const float* ssq, int r) {
    const f32x4* p = (const f32x4*)(ssq + (size_t)r * 16); f32x4 a = p[0], b = p[1], c = p[2], d = p[3];
    float s = (a[0] + a[1] + a[2] + a[3]) + (b[0] + b[1] + b[2] + b[3]) + (c[0] + c[1] + c[2] + c[3]) + (d[0] + d[1] + d[2] + d[3]);
    if (r >= MP) {
        const f32x4* q = (const f32x4*)(ssq + (WS_SSQ2 - WS_SSQ) / 4 + (size_t)(r - MP) * 16); a = q[0]; b = q[1]; c = q[2]; d = q[3];
        s += (a[0] + a[1] + a[2] + a[3]) + (b[0] + b[1] + b[2] + b[3]) + (c[0] + c[1] + c[2] + c[3]) + (d[0] + d[1] + d[2] + d[3]);
    }
    return rsqrtf(s * (1.0f / 1024.0f) + EPS);
}
__device__ __forceinline__ int lane_now() { int t; asm volatile("v_mbcnt_lo_u32_b32 %0, -1, 0\n\tv_mbcnt_hi_u32_b32 %0, -1, %0" : "=v"(t)); return t; }
__device__ __forceinline__ float shfl_idx(float v, int src) { return __int_as_float(__builtin_amdgcn_ds_bpermute(src << 2, __float_as_int(v))); }
__device__ __forceinline__ float shflx(float v, int mask) { return shfl_idx(v, lane_now() ^ mask); }
__device__ __forceinline__ float shfl_row15(float v) { return __int_as_float(__builtin_amdgcn_ds_swizzle(__float_as_int(v), 0x1F0)); }
#define MFMA16(a, b, c) __builtin_amdgcn_mfma_f32_16x16x32_bf16((a), (b), (c), 0, 0, 0)

namespace pg8 {
constexpr int BM = 256, BK = 64, HALF = 128, HTB = HALF * BK * 2, STAGE_BYTES = 8 * HTB, NXCD = 8, WGM = 8;
__device__ __forceinline__ int lds_byte(int r, int c) { const int st = (r >> 4) * 2 + (c >> 5), rr = r & 15, cc = c & 31, ob = rr * 64 + cc * 2; return st * 1024 + (ob ^ (((ob >> 9) & 1) << 5)); }
__device__ __forceinline__ void stage_rc(int b, int& R, int& C) { const int st = b / 1024, sb = b % 1024, swz = sb ^ (((sb >> 9) & 1) << 5); R = (st >> 1) * 16 + swz / 64; C = (st & 1) * 32 + (swz % 64) / 2; }
struct Unit { int pm, pn; };
struct Gemm { const bf16_t* A; const bf16_t* Bt; int M, N, K; };
struct StaticOrder {
    int nM, nN, nwg, G, c;
    __device__ void init(int M, int N, int G_, int c_) { nM = M / BM; nN = N / BM; nwg = nM * nN; G = G_; c = c_; }
    __device__ bool next(int i, Unit& u) const {
        const long L = (long)i * G + c; if (L >= nwg) return false;
        int wgid = (int)L; { const int q = nwg / NXCD, r = nwg % NXCD, xcd = wgid % NXCD, off = wgid / NXCD; wgid = (xcd < r ? xcd * (q + 1) : r * (q + 1) + (xcd - r) * q) + off; }
        const int nig = WGM * nN, gid = wgid / nig, fm = gid * WGM, gsz = (nM - fm) < WGM ? (nM - fm) : WGM;
        u.pm = fm + ((wgid % nig) % gsz); u.pn = (wgid % nig) / gsz; return true;
    }
};

template <class Epi>
__device__ __forceinline__ void gemm_phase(int wv, LAS unsigned char* lds, const Gemm g, const StaticOrder& S, const Epi& E) {
    const int tid = tidx(wv), wid = wv, lane = tid & 63, wr = wid >> 2, wc = wid & 3, fr = lane & 15, fq = lane >> 4;
    const int K = g.K, nt = K / BK;
    unsigned voffA[2];
#pragma unroll
    for (int i = 0; i < 2; ++i) { int R, C; stage_rc(tid * 16 + i * 8192, R, C); voffA[i] = (unsigned)(R * K + C) * 2u; }
    const size_t kstep = (size_t)(BK * 2);
    const size_t hstep = (size_t)HALF * K * 2;
    const size_t tstep = 2 * hstep;
    const unsigned ldsw = (unsigned)wid * 1024u;
    const int aoff = lds_byte(wr * 64 + fr, fq * 8), boff = lds_byte(wc * 32 + fr, fq * 8);
#define PG8_SA(b, h) (((b) * 2 + (h)) * HTB)
#define PG8_SB(b, h) ((4 + (b) * 2 + (h)) * HTB)
#define PG8_STAGE(bufoff, gbase, voff) do { _Pragma("unroll") for (int _i = 0; _i < 2; ++_i) \
        __builtin_amdgcn_global_load_lds((const unsigned*)((const char*)(gbase) + (voff)[_i]), (LAS unsigned*)(lds + (bufoff) + ldsw + _i * 8192), 16, 0, 0); } while (0)
#define PG8_LDA(dst, b, h) do { _Pragma("unroll") for (int m = 0; m < 4; ++m) _Pragma("unroll") for (int k = 0; k < 2; ++k) dst[m][k] = *(const LAS bf16x8*)(lds + PG8_SA(b, h) + aoff + m * 2048 + k * 1024); } while (0)
#define PG8_LDB(dst, b, h) do { _Pragma("unroll") for (int n = 0; n < 2; ++n) _Pragma("unroll") for (int k = 0; k < 2; ++k) dst[n][k] = *(const LAS bf16x8*)(lds + PG8_SB(b, h) + boff + n * 2048 + k * 1024); } while (0)
#define PG8_MMA(ai, bj, At, Bt) do { __builtin_amdgcn_s_setprio(1); _Pragma("unroll") for (int m = 0; m < 4; ++m) _Pragma("unroll") for (int n = 0; n < 2; ++n) _Pragma("unroll") for (int k = 0; k < 2; ++k) \
        acc[ai][bj][m][n] = __builtin_amdgcn_mfma_f32_16x16x32_bf16(Bt[n][k], At[m][k], acc[ai][bj][m][n], 0, 0, 0); __builtin_amdgcn_s_setprio(0); } while (0)
#define PG8_WAIT_V(n) asm volatile("s_waitcnt vmcnt(" #n ")" ::: "memory")
#define PG8_WAIT_L(n) asm volatile("s_waitcnt lgkmcnt(" #n ")" ::: "memory")
#define PG8_BAR __builtin_amdgcn_s_barrier()
#define PG8_SCHED __builtin_amdgcn_sched_barrier(0)
    Unit cur, nxt; int ui = 0;
    if (!S.next(0, cur)) return;
    f32x4 acc[2][2][4][2];
#pragma unroll
    for (int a = 0; a < 2; ++a)
#pragma unroll
        for (int b = 0; b < 2; ++b)
#pragma unroll
            for (int m = 0; m < 4; ++m)
#pragma unroll
                for (int n = 0; n < 2; ++n) acc[a][b][m][n] = (f32x4){0.f, 0.f, 0.f, 0.f};
    bf16x8 At[4][2], B0[2][2], B1[2][2];
    const char* cA = (const char*)g.A + (size_t)cur.pm * tstep; const char* cB = (const char*)g.Bt + (size_t)cur.pn * tstep;
    PG8_STAGE(PG8_SB(0, 0), cB, voffA); PG8_STAGE(PG8_SA(0, 0), cA, voffA); PG8_STAGE(PG8_SB(0, 1), cB + hstep, voffA); PG8_STAGE(PG8_SA(0, 1), cA + hstep, voffA);
    if (wr == 1) PG8_BAR;
    PG8_WAIT_V(4); PG8_BAR;
    PG8_STAGE(PG8_SB(1, 0), cB + kstep, voffA); PG8_STAGE(PG8_SA(1, 0), cA + kstep, voffA); PG8_STAGE(PG8_SB(1, 1), cB + hstep + kstep, voffA);
    PG8_WAIT_V(6); PG8_BAR;
    for (;;) {
        if constexpr (Epi::NEEDS_RSTD) {
            LAS float* rb = (LAS float*)(lds + STAGE_BYTES) + (ui & 1) * 256;
            const int t2 = tidx(wv);
            if (t2 < 256) rb[t2] = rstd_row(E.ssq, cur.pm * 256 + t2);
        }
        const bool has_next = S.next(ui + 1, nxt);
        const char* nA = has_next ? (const char*)g.A + (size_t)nxt.pm * tstep : cA; const char* nB = has_next ? (const char*)g.Bt + (size_t)nxt.pn * tstep : cB;
        for (int t = 0; t < nt; t += 2) {
            const bool last = (t == nt - 2);
            const char* a1 = cA + (size_t)(t + 1) * kstep;
            const char* a2 = last ? nA : cA + (size_t)(t + 2) * kstep; const char* b2 = last ? nB : cB + (size_t)(t + 2) * kstep;
            const char* a3 = a2 + kstep; const char* b3 = b2 + kstep;
            PG8_LDB(B0, 0, 0); PG8_SCHED; PG8_LDA(At, 0, 0); PG8_STAGE(PG8_SA(1, 1), a1 + hstep, voffA);
            PG8_WAIT_L(8); PG8_BAR; PG8_WAIT_L(0); PG8_MMA(0, 0, At, B0); PG8_BAR; PG8_SCHED;
            PG8_LDB(B1, 0, 1); PG8_STAGE(PG8_SB(0, 0), b2, voffA);
            PG8_BAR; PG8_WAIT_L(0); PG8_MMA(0, 1, At, B1); PG8_BAR;
            PG8_LDA(At, 0, 1); PG8_STAGE(PG8_SA(0, 0), a2, voffA);
            PG8_BAR; PG8_WAIT_L(0); PG8_MMA(1, 0, At, B0); PG8_BAR; PG8_SCHED;
            PG8_STAGE(PG8_SB(0, 1), b2 + hstep, voffA);
            PG8_WAIT_V(6); PG8_BAR; PG8_MMA(1, 1, At, B1); PG8_BAR;
            PG8_LDB(B0, 1, 0); PG8_SCHED; PG8_LDA(At, 1, 0); PG8_STAGE(PG8_SA(0, 1), a2 + hstep, voffA);
            PG8_WAIT_L(8); PG8_BAR; PG8_WAIT_L(0); PG8_MMA(0, 0, At, B0); PG8_BAR; PG8_SCHED;
            PG8_LDB(B1, 1, 1); PG8_STAGE(PG8_SB(1, 0), b3, voffA);
            PG8_BAR; PG8_WAIT_L(0); PG8_MMA(0, 1, At, B1); PG8_BAR;
            PG8_LDA(At, 1, 1); PG8_STAGE(PG8_SA(1, 0), a3, voffA);
            PG8_BAR; PG8_WAIT_L(0); PG8_MMA(1, 0, At, B0); PG8_BAR; PG8_SCHED;
            PG8_STAGE(PG8_SB(1, 1), b3 + hstep, voffA);
            PG8_WAIT_V(6); PG8_BAR; PG8_MMA(1, 1, At, B1); PG8_BAR;
            if constexpr (Epi::HAS_MID) { if (!last && ((t + 2) & 15) == 0) E.mid(acc, cur, (t + 2) >> 4, wr, wc, fr, fq); }
        }
        if constexpr (Epi::NEEDS_RSTD) E.rb = (const LAS float*)(lds + STAGE_BYTES) + (ui & 1) * 256;
        E(acc, cur, wr, wc, fr, fq);
        if (!has_next) break;
#pragma unroll
        for (int a = 0; a < 2; ++a)
#pragma unroll
            for (int b = 0; b < 2; ++b)
#pragma unroll
                for (int m = 0; m < 4; ++m)
#pragma unroll
                    for (int n = 0; n < 2; ++n) acc[a][b][m][n] = (f32x4){0.f, 0.f, 0.f, 0.f};
        cur = nxt; cA = nA; cB = nB; ++ui;
    }
    PG8_WAIT_V(0);
    if (wr == 0) PG8_BAR;
    PG8_BAR;
#undef PG8_SA
#undef PG8_SB
#undef PG8_STAGE
#undef PG8_LDA
#undef PG8_LDB
#undef PG8_MMA
#undef PG8_WAIT_V
#undef PG8_WAIT_L
#undef PG8_BAR
#undef PG8_SCHED
}
}
using pg8::Unit;
typedef f32x4 AccT[2][2][4][2];

struct EpiGU {
    static constexpr bool HAS_MID = false, NEEDS_RSTD = true;
    const float* ssq; bf16_t* hff; mutable const LAS float* rb;
    __device__ __forceinline__ void mid(AccT&, const Unit&, int, int, int, int, int) const {}
    __device__ __forceinline__ void operator()(const AccT& acc, const Unit& u, int wr, int wc, int fr_, int fq_) const {
        int fr = fr_, fq = fq_; asm volatile("" : "+v"(fr), "+v"(fq));
        const int row0 = u.pm * 256 + wr * 64 + fr, hc0 = u.pn * 128 + wc * 32 + fq * 8;
#pragma unroll
        for (int ai = 0; ai < 2; ++ai)
#pragma unroll
            for (int m = 0; m < 4; ++m) {
                const int r = row0 + ai * 128 + m * 16; const float rs = rb[wr * 64 + fr + ai * 128 + m * 16];
                u32x4 w;
                { const f32x4 gt = acc[ai][0][m][0] * rs, up = acc[ai][0][m][1] * rs;
                  w.x = pk2(siluf_(gt[0]) * up[0], siluf_(gt[1]) * up[1]); w.y = pk2(siluf_(gt[2]) * up[2], siluf_(gt[3]) * up[3]); }
                { const f32x4 gt = acc[ai][1][m][0] * rs, up = acc[ai][1][m][1] * rs;
                  w.z = pk2(siluf_(gt[0]) * up[0], siluf_(gt[1]) * up[1]); w.w = pk2(siluf_(gt[2]) * up[2], siluf_(gt[3]) * up[3]); }
                *(u32x4*)(hff + (size_t)r * DFF + hc0) = w;
            }
    }
};
struct EpiRes {
    static constexpr bool HAS_MID = false, NEEDS_RSTD = false;
    float* x; bf16_t* xb; float* ssq; float scale;
    __device__ __forceinline__ void mid(AccT&, const Unit&, int, int, int, int, int) const {}
    __device__ __forceinline__ void operator()(const AccT& acc, const Unit& u, int wr, int wc, int fr_, int fq_) const {
        int fr = fr_, fq = fq_; asm volatile("" : "+v"(fr), "+v"(fq));
        const int row0 = u.pm * 256 + wr * 64 + fr, col0 = u.pn * 256 + wc * 32 + 8 * fq;
#pragma unroll
        for (int ai = 0; ai < 2; ++ai) {
            f32x4 xv[4][2][2];
#pragma unroll
            for (int m = 0; m < 4; ++m)
#pragma unroll
                for (int bj = 0; bj < 2; ++bj)
#pragma unroll
                    for (int n = 0; n < 2; ++n) xv[m][bj][n] = *(const f32x4*)(x + (size_t)(row0 + ai * 128 + m * 16) * DM + col0 + bj * 128 + n * 4);
#pragma unroll
            for (int m = 0; m < 4; ++m) {
                const int r = row0 + ai * 128 + m * 16; float ss = 0.f;
#pragma unroll
                for (int bj = 0; bj < 2; ++bj) {
                    const int c = col0 + bj * 128;
                    const f32x4 v0 = xv[m][bj][0] + acc[ai][bj][m][0] * scale, v1 = xv[m][bj][1] + acc[ai][bj][m][1] * scale;
                    *(f32x4*)(x + (size_t)r * DM + c) = v0; *(f32x4*)(x + (size_t)r * DM + c + 4) = v1;
                    u32x4 w; w.x = pk2(v0[0], v0[1]); w.y = pk2(v0[2], v0[3]); w.z = pk2(v1[0], v1[1]); w.w = pk2(v1[2], v1[3]);
                    *(u32x4*)(xb + (size_t)r * DM + c) = w;
                    ss += v0[0] * v0[0] + v0[1] * v0[1] + v0[2] * v0[2] + v0[3] * v0[3] + v1[0] * v1[0] + v1[1] * v1[1] + v1[2] * v1[2] + v1[3] * v1[3];
                }
                ss += shflx(ss, 16); ss += shflx(ss, 32);
                if (fq == 0) ssq[(size_t)r * 16 + u.pn * 4 + wc] = ss;
            }
        }
    }
};
struct EpiIn {
    static constexpr bool HAS_MID = false, NEEDS_RSTD = true;
    const float* ssq; bf16_t* h; float* dtraw; mutable const LAS float* rb;
    __device__ __forceinline__ void mid(AccT&, const Unit&, int, int, int, int, int) const {}
    __device__ __forceinline__ void operator()(const AccT& acc, const Unit& u, int wr, int wc, int fr_, int fq_) const {
        int fr = fr_, fq = fq_; asm volatile("" : "+v"(fr), "+v"(fq));
        const int row0 = u.pm * 256 + wr * 64 + fr, col0 = u.pn * 256 + wc * 32 + 8 * fq;
#pragma unroll
        for (int ai = 0; ai < 2; ++ai)
#pragma unroll
            for (int m = 0; m < 4; ++m) {
                const int r = row0 + ai * 128 + m * 16; const float rs = rb[wr * 64 + fr + ai * 128 + m * 16];
                if (u.pn < 36) {
#pragma unroll
                    for (int bj = 0; bj < 2; ++bj) {
                        const f32x4 v0 = acc[ai][bj][m][0] * rs, v1 = acc[ai][bj][m][1] * rs;
                        u32x4 w; w.x = pk2(v0[0], v0[1]); w.y = pk2(v0[2], v0[3]); w.z = pk2(v1[0], v1[1]); w.w = pk2(v1[2], v1[3]);
                        *(u32x4*)(h + (size_t)r * HP + col0 + bj * 128) = w;
                    }
                } else if (wc == 0 && fq < 2) {
                    *(f32x4*)(dtraw + (size_t)r * 16 + 8 * fq) = acc[ai][0][m][0] * rs;
                    *(f32x4*)(dtraw + (size_t)r * 16 + 8 * fq + 4) = acc[ai][0][m][1] * rs;
                }
            }
    }
};
struct EpiMerge {
    static constexpr bool HAS_MID = true, NEEDS_RSTD = false;
    const bf16_t* h; bf16_t* merged;
    __device__ __forceinline__ void mid(AccT& acc, const Unit& u, int seg, int wr, int wc, int fr_, int fq_) const {
        int fr = fr_, fq = fq_; asm volatile("" : "+v"(fr), "+v"(fq));
        const int row0 = u.pm * 256 + wr * 64 + fr, col0 = u.pn * 256 + wc * 32 + 8 * fq;
#pragma unroll
        for (int ai = 0; ai < 2; ++ai) {
            u32x2 ga[4][2][2], gb[4][2][2];
#pragma unroll
            for (int m = 0; m < 4; ++m)
#pragma unroll
                for (int bj = 0; bj < 2; ++bj)
#pragma unroll
                    for (int n = 0; n < 2; ++n) {
                        const bf16_t* gp = h + (size_t)(row0 + ai * 128 + m * 16) * HP + HGATE + (seg - 1) * 1024 + col0 + bj * 128 + n * 4;
                        ga[m][bj][n] = *(const u32x2*)gp; gb[m][bj][n] = *(const u32x2*)(gp + 1024);
                    }
#pragma unroll
            for (int m = 0; m < 4; ++m)
#pragma unroll
                for (int bj = 0; bj < 2; ++bj)
#pragma unroll
                    for (int n = 0; n < 2; ++n) {
                        const u32x2 a = ga[m][bj][n], b = gb[m][bj][n];
                        f32x4 f;
                        f[0] = (1.f + __expf(-fmaxf(bflo(b.x), -30.f))) * rcpf_(1.f + __expf(-fmaxf(bflo(a.x), -30.f)));
                        f[1] = (1.f + __expf(-fmaxf(bfhi(b.x), -30.f))) * rcpf_(1.f + __expf(-fmaxf(bfhi(a.x), -30.f)));
                        f[2] = (1.f + __expf(-fmaxf(bflo(b.y), -30.f))) * rcpf_(1.f + __expf(-fmaxf(bflo(a.y), -30.f)));
                        f[3] = (1.f + __expf(-fmaxf(bfhi(b.y), -30.f))) * rcpf_(1.f + __expf(-fmaxf(bfhi(a.y), -30.f)));
                        acc[ai][bj][m][n] *= f;
                    }
        }
    }
    __device__ __forceinline__ void operator()(const AccT& acc, const Unit& u, int wr, int wc, int fr_, int fq_) const {
        int fr = fr_, fq = fq_; asm volatile("" : "+v"(fr), "+v"(fq));
        const int row0 = u.pm * 256 + wr * 64 + fr, col0 = u.pn * 256 + wc * 32 + 8 * fq;
#pragma unroll
        for (int ai = 0; ai < 2; ++ai) {
            u32x2 gv[4][2][2];
#pragma unroll
            for (int m = 0; m < 4; ++m)
#pragma unroll
                for (int bj = 0; bj < 2; ++bj)
#pragma unroll
                    for (int n = 0; n < 2; ++n) gv[m][bj][n] = *(const u32x2*)(h + (size_t)(row0 + ai * 128 + m * 16) * HP + HGATE + 2048 + col0 + bj * 128 + n * 4);
#pragma unroll
            for (int m = 0; m < 4; ++m)
#pragma unroll
                for (int bj = 0; bj < 2; ++bj)
#pragma unroll
                    for (int n = 0; n < 2; ++n) {
                        const u32x2 ga = gv[m][bj][n];
                        const f32x4 v = acc[ai][bj][m][n];
                        u32x2 w;
                        w.x = pk2(v[0] * rcpf_(1.f + __expf(-fmaxf(bflo(ga.x), -30.f))), v[1] * rcpf_(1.f + __expf(-fmaxf(bfhi(ga.x), -30.f))));
                        w.y = pk2(v[2] * rcpf_(1.f + __expf(-fmaxf(bflo(ga.y), -30.f))), v[3] * rcpf_(1.f + __expf(-fmaxf(bfhi(ga.y), -30.f))));
                        *(u32x2*)(merged + (size_t)(row0 + ai * 128 + m * 16) * DM + col0 + bj * 128 + n * 4) = w;
                    }
        }
    }
};

template <class Epi> __device__ __forceinline__ void run_gemm(int wv, LAS unsigned char* lds, const bf16_t* A, const bf16_t* Bt, int M, int N, int K, const Epi& E) {
    asm volatile("" : "+s"(wv));
    pg8::Gemm g; g.A = A; g.Bt = Bt; g.M = M; g.N = N; g.K = K;
    pg8::StaticOrder S; S.init(M, N, (int)gdim(), (int)bidx());
    pg8::gemm_phase<Epi>(wv, lds, g, S, E);
}


template <int MODE>
__device__ __forceinline__ void skinny_gemm(int wv, LAS unsigned char* lds, KP P, const bf16_t* A, const bf16_t* Bt, int K, float scale) {
    const int tid = tidx(wv), w = tid >> 6, lane = tid & 63, fr = lane & 15, fq = lane >> 4;
    LAS float* part = (LAS float*)lds;
    constexpr int NSEG = MODE ? 3 : 1;
    const int kseg = K / NSEG, kw = kseg / 8;
    const bf16_t* h = (const bf16_t*)(P->ws + WS_H);
    for (int task = bidx(); task < 256; task += gdim()) {
        const int rt = task >> 5, ct = task & 31;
        f32x4 tot[2][2];
#pragma unroll
        for (int i = 0; i < 2; ++i)
#pragma unroll
            for (int j = 0; j < 2; ++j) tot[i][j] = (f32x4){0.f, 0.f, 0.f, 0.f};
#pragma unroll 1
        for (int seg = 0; seg < NSEG; ++seg) {
            f32x4 acc[2][2];
#pragma unroll
            for (int i = 0; i < 2; ++i)
#pragma unroll
                for (int j = 0; j < 2; ++j) acc[i][j] = (f32x4){0.f, 0.f, 0.f, 0.f};
            const bf16_t* ap = A + (size_t)(rt * 32 + fr) * K + seg * kseg + w * kw + fq * 8;
            const bf16_t* bp = Bt + (size_t)(ct * 32 + fr) * K + seg * kseg + w * kw + fq * 8;
#pragma unroll 2
            for (int k = 0; k < kw; k += 32) {
                const bf16x8 a0 = *(const bf16x8*)(ap + k), a1 = *(const bf16x8*)(ap + (size_t)16 * K + k);
                const bf16x8 b0 = *(const bf16x8*)(bp + k), b1 = *(const bf16x8*)(bp + (size_t)16 * K + k);
                acc[0][0] = MFMA16(b0, a0, acc[0][0]); acc[0][1] = MFMA16(b1, a0, acc[0][1]);
                acc[1][0] = MFMA16(b0, a1, acc[1][0]); acc[1][1] = MFMA16(b1, a1, acc[1][1]);
            }
#pragma unroll
            for (int i = 0; i < 2; ++i)
#pragma unroll
                for (int j = 0; j < 2; ++j) {
                    if (MODE) {
                        const u32x2 gw = *(const u32x2*)(h + (size_t)(MP + rt * 32 + i * 16 + fr) * HP + HGATE + seg * 1024 + ct * 32 + 8 * fq + 4 * j);
                        f32x4 sg; sg[0] = sigmoidf_(bflo(gw.x)); sg[1] = sigmoidf_(bfhi(gw.x)); sg[2] = sigmoidf_(bflo(gw.y)); sg[3] = sigmoidf_(bfhi(gw.y));
                        tot[i][j] += acc[i][j] * sg;
                    } else tot[i][j] = acc[i][j];
                }
        }
        __syncthreads();
#pragma unroll
        for (int i = 0; i < 2; ++i)
#pragma unroll
            for (int j = 0; j < 2; ++j) *(LAS f32x4*)(part + (w * 32 + i * 16 + fr) * 36 + 8 * fq + 4 * j) = tot[i][j];
        __syncthreads();
        const int row = tid >> 4, c2 = (tid & 15) * 2;
        float v0 = 0.f, v1 = 0.f;
#pragma unroll
        for (int ww = 0; ww < 8; ++ww) { v0 += part[(ww * 32 + row) * 36 + c2]; v1 += part[(ww * 32 + row) * 36 + c2 + 1]; }
        const int r = MP + rt * 32 + row, c = ct * 32 + c2;
        if (MODE) {
            *(unsigned*)((bf16_t*)(P->ws + WS_ST) + (size_t)r * DM + c) = pk2(v0, v1);
        } else {
            float* xp = P->out + (size_t)r * DM + c;
            const float x0 = xp[0] + scale * v0, x1 = xp[1] + scale * v1;
            xp[0] = x0; xp[1] = x1;
            *(unsigned*)((bf16_t*)(P->ws + WS_XB) + (size_t)r * DM + c) = pk2(x0, x1);
            float ss = x0 * x0 + x1 * x1;
            ss += shflx(ss, 1); ss += shflx(ss, 2); ss += shflx(ss, 4); ss += shflx(ss, 8);
            if ((tid & 15) == 0) {
                float* ssq = (float*)(P->ws + WS_SSQ);
                if (ct < 16) ssq[(size_t)r * 16 + ct] = ss; else ssq[(WS_SSQ2 - WS_SSQ) / 4 + (size_t)(r - MP) * 16 + (ct - 16)] = ss;
            }
        }
    }
}

struct CvtJob { const float* src; const float* gk; bf16_t* dst; int src_ld, dst_ld, k0, nsrc0, nvalid, rowbase, kind, which; };
__device__ __forceinline__ bool cvt_decode(KP P, int l, int part, int job, CvtJob& J) {
    constexpr int J_GU = 2 * 2 * 16 * 44, J_DN = 2 * 44 * 16, J_IN = 16 * 145, J_BR = 48 * 16, J_OUT = 16 * 16;
    int j = job; J.gk = nullptr; J.kind = 0; J.which = 0; J.nvalid = 64;
    if (j < J_GU) {
        const int nt = j % 44; j /= 44; const int kt = j % 16; j /= 16; const int which = j & 1, j2 = j >> 1;
        if (j2 != part) return false;
        J.src = P->in[which ? I_WU : I_WG] + (size_t)(l * 2 + j2) * 1024 * 2816; J.src_ld = 2816; J.k0 = kt * 64; J.nsrc0 = nt * 64;
        J.gk = P->in[I_FNORM] + (l * 2 + j2) * 1024; J.dst = (bf16_t*)(P->ws + (j2 ? W_GU1 : W_GU0)); J.dst_ld = 1024; J.rowbase = nt * 64; J.kind = 1; J.which = which;
        return true;
    }
    j -= J_GU;
    if (j < J_DN) {
        const int nt = j % 16; j /= 16; const int kt = j % 44; const int j2 = j / 44;
        if (j2 != part) return false;
        J.src = P->in[I_WD] + (size_t)(l * 2 + j2) * 2816 * 1024; J.src_ld = 1024; J.k0 = kt * 64; J.nsrc0 = nt * 64;
        J.dst = (bf16_t*)(P->ws + (j2 ? W_DN1 : W_DN0)); J.dst_ld = 2816; J.rowbase = nt * 64; J.kind = 2;
        return true;
    }
    j -= J_DN;
    if (j < J_IN) {
        if (part != 0) return false;
        const int nt = j % 145, kt = j / 145;
        J.src = P->in[I_WIN] + (size_t)l * 1024 * NIN; J.src_ld = NIN; J.k0 = kt * 64; J.nsrc0 = nt < 72 ? nt * 64 : (nt < 144 ? nt * 64 + 16 : 4608); J.nvalid = nt < 144 ? 64 : 16;
        J.gk = P->in[I_MNORM] + l * 1024; J.dst = (bf16_t*)(P->ws + W_IN); J.dst_ld = 1024; J.rowbase = nt * 64; J.kind = 2;
        return true;
    }
    j -= J_IN;
    if (j < J_BR) {
        if (part != 1) return false;
        const int nt = j % 16, kt = j / 16;
        J.src = P->in[I_WBR] + (size_t)l * 3072 * 1024; J.src_ld = 1024; J.k0 = kt * 64; J.nsrc0 = nt * 64; J.dst = (bf16_t*)(P->ws + W_BR); J.dst_ld = 3072; J.rowbase = nt * 64; J.kind = 2;
        return true;
    }
    j -= J_BR;
    if (j < J_OUT) {
        if (part != 1) return false;
        const int nt = j % 16, kt = j / 16;
        J.src = P->in[I_WOUT] + (size_t)l * 1024 * 1024; J.src_ld = 1024; J.k0 = kt * 64; J.nsrc0 = nt * 64; J.dst = (bf16_t*)(P->ws + W_OUT); J.dst_ld = 1024; J.rowbase = nt * 64; J.kind = 2;
        return true;
    }
    j -= J_OUT;
    if (part != 0) return false;
    const int blk = j & 15, which = j >> 4;
    J.src = P->in[which ? I_LWX : I_LWA] + (size_t)(l * 16 + blk) * 4096; J.src_ld = 64; J.k0 = 0; J.nsrc0 = 0;
    J.dst = (bf16_t*)(P->ws + (which ? W_LX : W_LA)) + (l & 1) * 65536 + blk * 4096; J.dst_ld = 64; J.rowbase = 0;
    return true;
}
__device__ __forceinline__ void cvt_load(const CvtJob& J, int tid, f32x4& v0, f32x4& v1, float& g0, float& g1) {
    const int kk = tid >> 4, n4 = (tid & 15) * 4;
    v0 = (f32x4){0.f, 0.f, 0.f, 0.f}; v1 = v0;
    if (n4 < J.nvalid) {
        v0 = __builtin_nontemporal_load((const f32x4*)(J.src + (size_t)(J.k0 + kk) * J.src_ld + J.nsrc0 + n4)); v1 = __builtin_nontemporal_load((const f32x4*)(J.src + (size_t)(J.k0 + kk + 32) * J.src_ld + J.nsrc0 + n4)); }
    g0 = J.gk ? J.gk[J.k0 + kk] : 1.0f; g1 = J.gk ? J.gk[J.k0 + kk + 32] : 1.0f;
}
__device__ __forceinline__ void convert_layer(int wv, KP P, int l, int part, int nb, LAS unsigned char* lds) {
    LAS float* tile = (LAS float*)lds;
    constexpr int J_TOT = 2 * 2 * 16 * 44 + 2 * 44 * 16 + 16 * 145 + 48 * 16 + 16 * 16 + 32;
    const int tid = tidx(wv), stride = nb;
    int job = bidx() < nb ? bidx() : J_TOT;
    CvtJob cur, nxt; bool have = false, hn = false;
    while (job < J_TOT && !have) { have = cvt_decode(P, l, part, job, cur); job += stride; }
    f32x4 v0, v1, n0, n1; float g0 = 1.f, g1 = 1.f, h0 = 1.f, h1 = 1.f;
    v0 = (f32x4){0.f, 0.f, 0.f, 0.f}; v1 = v0; n0 = v0; n1 = v0;
    if (have) cvt_load(cur, tid, v0, v1, g0, g1);
    __syncthreads();
    while (have) {
        hn = false;
        while (job < J_TOT && !hn) { hn = cvt_decode(P, l, part, job, nxt); job += stride; }
        if (hn) cvt_load(nxt, tid, n0, n1, h0, h1);
        {
            const int kk = tid >> 4, n4 = (tid & 15) * 4;
            tile[kk * 65 + n4 + 0] = v0[0] * g0; tile[kk * 65 + n4 + 1] = v0[1] * g0; tile[kk * 65 + n4 + 2] = v0[2] * g0; tile[kk * 65 + n4 + 3] = v0[3] * g0;
            tile[(kk + 32) * 65 + n4 + 0] = v1[0] * g1; tile[(kk + 32) * 65 + n4 + 1] = v1[1] * g1; tile[(kk + 32) * 65 + n4 + 2] = v1[2] * g1; tile[(kk + 32) * 65 + n4 + 3] = v1[3] * g1;
        }
        asm volatile("s_waitcnt lgkmcnt(0)\n\ts_barrier" ::: "memory");
        {
            const int nl = tid >> 3, k8 = (tid & 7) * 8;
            if (nl < cur.nvalid) {
                u32x4 w;
                w.x = pk2(tile[(k8 + 0) * 65 + nl], tile[(k8 + 1) * 65 + nl]); w.y = pk2(tile[(k8 + 2) * 65 + nl], tile[(k8 + 3) * 65 + nl]);
                w.z = pk2(tile[(k8 + 4) * 65 + nl], tile[(k8 + 5) * 65 + nl]); w.w = pk2(tile[(k8 + 6) * 65 + nl], tile[(k8 + 7) * 65 + nl]);
                int row = cur.rowbase + nl;
                if (cur.kind == 1) { const int hc = row; row = 256 * (hc >> 7) + 128 * ((hc >> 2) & 1) + 32 * ((hc >> 5) & 3) + 16 * cur.which + 4 * ((hc >> 3) & 3) + (hc & 3); }
                else if (cur.kind == 2) { const int c = row; row = (c & ~31) + 16 * ((c >> 2) & 1) + 4 * ((c >> 3) & 3) + (c & 3); }
                *(u32x4*)(cur.dst + (size_t)row * cur.dst_ld + cur.k0 + k8) = w;
            }
        }
        asm volatile("s_waitcnt lgkmcnt(0)\n\ts_barrier" ::: "memory");
        cur = nxt; v0 = n0; v1 = n1; g0 = h0; g1 = h1; have = hn;
    }
    __syncthreads();
}

__device__ __forceinline__ void phase_init(int wv, KP P) {
    const int w = tidx(wv) >> 6, lane = tidx(wv) & 63;
    float* x = P->out; bf16_t* xb = (bf16_t*)(P->ws + WS_XB); float* ssq = (float*)(P->ws + WS_SSQ);
    for (int row = bidx() * 8 + w; row < MT; row += gdim() * 8) {
        const float* src = row < MP ? P->in[I_XP] + (size_t)row * DM : P->in[I_XS] + (size_t)(row - MP) * DM;
        float ss = 0.f;
        f32x4 vv[4];
#pragma unroll
        for (int i = 0; i < 4; ++i) vv[i] = __builtin_nontemporal_load((const f32x4*)(src + (i * 64 + lane) * 4));
#pragma unroll
        for (int i = 0; i < 4; ++i) {
            const int c = (i * 64 + lane) * 4;
            const f32x4 v = vv[i];
            *(f32x4*)(x + (size_t)row * DM + c) = v;
            u32x2 pw; pw.x = pk2(v[0], v[1]); pw.y = pk2(v[2], v[3]);
            *(u32x2*)(xb + (size_t)row * DM + c) = pw;
            ss += v[0] * v[0] + v[1] * v[1] + v[2] * v[2] + v[3] * v[3];
        }
#pragma unroll
        for (int d = 32; d >= 1; d >>= 1) ss += shflx(ss, d);
        if (lane < 16) ssq[(size_t)row * 16 + lane] = lane == 0 ? ss : 0.f;
        if (row >= MP && lane < 16) ssq[(WS_SSQ2 - WS_SSQ) / 4 + (size_t)(row - MP) * 16 + lane] = 0.f;
    }
}
__device__ __forceinline__ void phase_final(int wv, KP P) {
    const int w = tidx(wv) >> 6, lane = tidx(wv) & 63;
    float* x = P->out; const float* ssq = (const float*)(P->ws + WS_SSQ); const float* gf = P->in[I_FINAL];
    for (int row = bidx() * 8 + w; row < MT; row += gdim() * 8) {
        const float rs = rstd_row(ssq, row);
        f32x4 vv[4], gg[4];
#pragma unroll
        for (int i = 0; i < 4; ++i) { const int c = (i * 64 + lane) * 4; vv[i] = *(const f32x4*)(x + (size_t)row * DM + c); gg[i] = *(const f32x4*)(gf + c); }
#pragma unroll
        for (int i = 0; i < 4; ++i) { const int c = (i * 64 + lane) * 4; *(f32x4*)(x + (size_t)row * DM + c) = vv[i] * rs * gg[i]; }
    }
}

struct Item { int row0, L, b, c, sb, sample; };
__device__ __forceinline__ Item get_item(int it) {
    Item I;
    if (it < 256) { I.b = it >> 7; I.c = it & 127; I.row0 = I.b * 8192 + I.c * 64; I.L = 64; I.sample = 0; I.sb = 0; }
    else { I.sb = it - 256; I.b = 0; I.c = 0; I.row0 = MP + I.sb * 16; I.L = 16; I.sample = 1; }
    return I;
}

__device__ __forceinline__ void copy_states_item(int wv, KP P, int l, const Item& I) {
    const bf16_t* h = (const bf16_t*)(P->ws + WS_H);
    const int tid = tidx(wv);
    if (!I.sample) {
        if (I.c >= 126) {
            for (int idx = tid; idx < 64 * 512; idx += 512) {
                const int t = idx >> 9, cc = idx & 511, kv = cc >> 8, e = cc & 255;
                const float v = bf2f(h[(size_t)(I.row0 + t) * HP + (kv ? HV : HK) + e]);
                P->out[(kv ? O_PV : O_PK) + ((size_t)(l * 2 + I.b) * 128 + (I.c - 126) * 64 + t) * 256 + e] = v;
            }
        }
        if (I.c == 127) {
            for (int idx = tid; idx < 3 * 1024; idx += 512) { const int j = idx >> 10, ch = idx & 1023;
                P->out[O_PLC + ((size_t)(l * 2 + I.b) * 3 + j) * 1024 + ch] = bf2f(h[(size_t)(I.row0 + 61 + j) * HP + HX + ch]); }
            for (int idx = tid; idx < 3 * 1536; idx += 512) { const int j = idx / 1536, ch = idx % 1536;
                P->out[O_PSC + ((size_t)(l * 2 + I.b) * 3 + j) * 1536 + ch] = bf2f(h[(size_t)(I.row0 + 61 + j) * HP + HXBC + ch]); }
        }
    } else {
        for (int idx = tid; idx < 128 * 512; idx += 512) {
            const int j = idx >> 9, cc = idx & 511, kv = cc >> 8, e = cc & 255;
            float v;
            if (j < 112) v = P->in[kv ? I_CV : I_CK][((size_t)(l * 16 + I.sb) * 128 + j + 16) * 256 + e];
            else v = bf2f(h[(size_t)(I.row0 + j - 112) * HP + (kv ? HV : HK) + e]);
            P->out[(kv ? O_SV : O_SK) + ((size_t)(l * 16 + I.sb) * 128 + j) * 256 + e] = v;
        }
        for (int idx = tid; idx < 3 * 1024; idx += 512) { const int j = idx >> 10, ch = idx & 1023;
            P->out[O_SLC + ((size_t)(l * 16 + I.sb) * 3 + j) * 1024 + ch] = bf2f(h[(size_t)(I.row0 + 13 + j) * HP + HX + ch]); }
        for (int idx = tid; idx < 3 * 1536; idx += 512) { const int j = idx / 1536, ch = idx % 1536;
            P->out[O_SSC + ((size_t)(l * 16 + I.sb) * 3 + j) * 1536 + ch] = bf2f(h[(size_t)(I.row0 + 13 + j) * HP + HXBC + ch]); }
    }
}

template <int L>
__device__ __forceinline__ void attn_item(int wv, KP P, int l, const Item& I, LAS unsigned char* lds) {
    constexpr int NS = (L == 64) ? 192 : 160;
    constexpr int NST = NS / 16, NKS = NS / 32, NQT = L / 16;
    const bf16_t* h = (const bf16_t*)(P->ws + WS_H);
    bf16_t* yabc = (bf16_t*)(P->ws + WS_Y);
    const int tid = tidx(wv), w = tid >> 6, lane = tid & 63, fr = lane & 15, fq = lane >> 4;
    LAS bf16_t* Kl = (LAS bf16_t*)lds;
    LAS bf16_t* Vt = Kl + 2 * 192 * 72;
    for (int pass = 0; pass < 2; ++pass) {
        __syncthreads();
        for (int idx = tid; idx < 2 * NS * 8; idx += 512) {
            const int dp = idx & 7, s = (idx >> 3) % NS, kvl = idx / (8 * NS), kvh = pass * 2 + kvl;
            u32x4 kw = (u32x4){0u, 0u, 0u, 0u}, vw = (u32x4){0u, 0u, 0u, 0u};
            if (L == 64) {
                const int pos = (I.c - 2) * 64 + s;
                if (pos >= 0) {
                    const bf16_t* rp = h + (size_t)(I.b * 8192 + pos) * HP + kvh * 64 + dp * 8;
                    kw = *(const u32x4*)(rp + HK); vw = *(const u32x4*)(rp + HV);
                }
            } else {
                if (s < 128) {
                    const size_t o = ((size_t)(l * 16 + I.sb) * 128 + s) * 256 + kvh * 64 + dp * 8;
                    const f32x4 k0 = *(const f32x4*)(P->in[I_CK] + o), k1 = *(const f32x4*)(P->in[I_CK] + o + 4);
                    const f32x4 v0 = *(const f32x4*)(P->in[I_CV] + o), v1 = *(const f32x4*)(P->in[I_CV] + o + 4);
                    kw.x = pk2(k0[0], k0[1]); kw.y = pk2(k0[2], k0[3]); kw.z = pk2(k1[0], k1[1]); kw.w = pk2(k1[2], k1[3]);
                    vw.x = pk2(v0[0], v0[1]); vw.y = pk2(v0[2], v0[3]); vw.z = pk2(v1[0], v1[1]); vw.w = pk2(v1[2], v1[3]);
                } else if (s < 144) {
                    const bf16_t* rp = h + (size_t)(I.row0 + s - 128) * HP + kvh * 64 + dp * 8;
                    kw = *(const u32x4*)(rp + HK); vw = *(const u32x4*)(rp + HV);
                }
            }
            *(LAS u32x4*)(Kl + (kvl * 192 + s) * 72 + dp * 8) = kw;
            LAS bf16_t* vp = Vt + (kvl * 64 + dp * 8) * 200 + s;
            vp[0 * 200] = (bf16_t)(vw.x & 0xffffu); vp[1 * 200] = (bf16_t)(vw.x >> 16); vp[2 * 200] = (bf16_t)(vw.y & 0xffffu); vp[3 * 200] = (bf16_t)(vw.y >> 16);
            vp[4 * 200] = (bf16_t)(vw.z & 0xffffu); vp[5 * 200] = (bf16_t)(vw.z >> 16); vp[6 * 200] = (bf16_t)(vw.w & 0xffffu); vp[7 * 200] = (bf16_t)(vw.w >> 16);
        }
        __syncthreads();
        const int head = pass * 8 + w, kvl = w >> 2;
        const float slope = exp2f(-0.5f * (float)(head + 1));
        const float sink = P->in[I_SINK][l * 16 + head];
        const bf16_t* qbase = h + (size_t)(I.row0 + fr) * HP + HQ + head * 64 + fq * 8;
        bf16x8 q0 = *(const bf16x8*)qbase, q1 = *(const bf16x8*)(qbase + 32);
#pragma unroll 1
        for (int qt = 0; qt < NQT; ++qt) {
            bf16x8 nq0 = q0, nq1 = q1;
            if (qt + 1 < NQT) { const bf16_t* qp = qbase + (size_t)(qt + 1) * 16 * HP; nq0 = *(const bf16x8*)qp; nq1 = *(const bf16x8*)(qp + 32); }
            f32x4 st[NST];
#pragma unroll
            for (int t = 0; t < NST; ++t) {
                const LAS bf16_t* kp = Kl + (kvl * 192 + t * 16 + fr) * 72 + fq * 8;
                f32x4 a = (f32x4){0.f, 0.f, 0.f, 0.f};
                a = MFMA16(*(const LAS bf16x8*)kp, q0, a);
                a = MFMA16(*(const LAS bf16x8*)(kp + 32), q1, a);
                st[t] = a;
                if ((t % 6) == 5) __builtin_amdgcn_sched_barrier(0);
            }
            const int qpos = (L == 64) ? (I.c * 64 + qt * 16 + fr) : (4096 + fr);
            float mx = sink;
#pragma unroll
            for (int t = 0; t < NST; ++t)
#pragma unroll
                for (int jj = 0; jj < 4; ++jj) {
                    const int s = t * 16 + fq * 4 + jj;
                    const int kpos = (L == 64) ? ((I.c - 2) * 64 + s) : (3968 + s);
                    const bool vis = (L == 64) ? (kpos >= 0) : (s < 144);
                    const float d = fabsf((float)(qpos - kpos));
                    const float sc = vis ? (st[t][jj] * 0.125f - slope * d) : -INFINITY;
                    st[t][jj] = sc; mx = fmaxf(mx, sc);
                }
            mx = fmaxf(mx, shflx(mx, 16)); mx = fmaxf(mx, shflx(mx, 32));
            float sum = 0.f;
#pragma unroll
            for (int t = 0; t < NST; ++t)
#pragma unroll
                for (int jj = 0; jj < 4; ++jj) { const float p = __expf(st[t][jj] - mx); st[t][jj] = p; sum += p; }
            sum += shflx(sum, 16); sum += shflx(sum, 32);
            const float inv = 1.0f / (sum + __expf(sink - mx));
            f32x4 o[4];
#pragma unroll
            for (int dt = 0; dt < 4; ++dt) o[dt] = (f32x4){0.f, 0.f, 0.f, 0.f};
#pragma unroll
            for (int ks = 0; ks < NKS; ++ks) {
                u32x4 pw; pw.x = pk2(st[2 * ks][0], st[2 * ks][1]); pw.y = pk2(st[2 * ks][2], st[2 * ks][3]);
                pw.z = pk2(st[2 * ks + 1][0], st[2 * ks + 1][1]); pw.w = pk2(st[2 * ks + 1][2], st[2 * ks + 1][3]);
                bf16x8 pf; __builtin_memcpy(&pf, &pw, 16);
#pragma unroll
                for (int dt = 0; dt < 4; ++dt) {
                    const LAS bf16_t* vp = Vt + (kvl * 64 + dt * 16 + fr) * 200 + ks * 32 + fq * 4;
                    const u32x2 va = *(const LAS u32x2*)vp, vb = *(const LAS u32x2*)(vp + 16);
                    u32x4 vw; vw.x = va.x; vw.y = va.y; vw.z = vb.x; vw.w = vb.y;
                    bf16x8 vf; __builtin_memcpy(&vf, &vw, 16);
                    o[dt] = MFMA16(vf, pf, o[dt]);
                }
            }
            bf16_t* op = yabc + (size_t)(I.row0 + qt * 16 + fr) * 3072 + 2048 + head * 64 + fq * 4;
#pragma unroll
            for (int dt = 0; dt < 4; ++dt) {
                u32x2 ow; ow.x = pk2(o[dt][0] * inv, o[dt][1] * inv); ow.y = pk2(o[dt][2] * inv, o[dt][3] * inv);
                *(u32x2*)(op + dt * 16) = ow;
            }
            q0 = nq0; q1 = nq1;
        }
    }
}

template <int CTRL> __device__ __forceinline__ float dpp_f(float old, float src) {
    return __int_as_float(__builtin_amdgcn_update_dpp(__float_as_int(old), __float_as_int(src), CTRL, 0xf, 0xf, false));
}
template <int L, bool FINAL>
__device__ __forceinline__ void lru_item(int wv, KP P, int l, int item, const Item& I, LAS unsigned char* lds) {
    constexpr int NIT = L / 16, XP = 1032;
    const bf16_t* h = (const bf16_t*)(P->ws + WS_H);
    bf16_t* yabc = (bf16_t*)(P->ws + WS_Y);
    float* lruA = (float*)(P->ws + WS_LRUA); float* lruU = (float*)(P->ws + WS_LRUU);
    const int tid = tidx(wv), w = tid >> 6, lane = tid & 63, fr = lane & 15, fq = lane >> 4;
    LAS bf16_t* xa = (LAS bf16_t*)lds;
    __syncthreads();
    {
        const int ch = 2 * tid;
        const float* cw = P->in[I_LCW] + (size_t)l * 4 * 1024 + ch;
        const f32x2_t w0 = *(const f32x2_t*)cw, w1 = *(const f32x2_t*)(cw + 1024), w2 = *(const f32x2_t*)(cw + 2048), w3 = *(const f32x2_t*)(cw + 3072);
        const f32x2_t cb = *(const f32x2_t*)(P->in[I_LCB] + l * 1024 + ch);
        f32x2_t xm3 = {0.f, 0.f}, xm2 = {0.f, 0.f}, xm1 = {0.f, 0.f};
        if (I.sample) { const float* st = P->in[I_SLC] + (size_t)(l * 16 + I.sb) * 3 * 1024 + ch; xm3 = *(const f32x2_t*)st; xm2 = *(const f32x2_t*)(st + 1024); xm1 = *(const f32x2_t*)(st + 2048); }
        else if (I.c > 0) { const bf16_t* hq = h + (size_t)(I.row0 - 3) * HP + HX + ch;
            const unsigned a0 = *(const unsigned*)hq, a1 = *(const unsigned*)(hq + HP), a2 = *(const unsigned*)(hq + 2 * (size_t)HP);
            xm3 = (f32x2_t){bflo(a0), bfhi(a0)}; xm2 = (f32x2_t){bflo(a1), bfhi(a1)}; xm1 = (f32x2_t){bflo(a2), bfhi(a2)}; }
        const bf16_t* hp = h + (size_t)I.row0 * HP + HX + ch;
#pragma unroll 8
        for (int t = 0; t < L; ++t) {
            const unsigned xw = *(const unsigned*)(hp + (size_t)t * HP);
            const f32x2_t x0 = {bflo(xw), bfhi(xw)};
            const f32x2_t y = cb + w0 * xm3 + w1 * xm2 + w2 * xm1 + w3 * x0;
            *(LAS unsigned*)(xa + t * XP + ch) = pk2(y[0], y[1]);
            xm3 = xm2; xm2 = xm1; xm1 = x0;
        }
    }
    __syncthreads();
#pragma unroll 1
    for (int pass = 0; pass < 2; ++pass) {
        const int blk = w + 8 * pass, ch0 = blk * 64;
        const bf16_t* waT = (const bf16_t*)(P->ws + W_LA) + (l & 1) * 65536 + blk * 4096;
        const bf16_t* wxT = (const bf16_t*)(P->ws + W_LX) + (l & 1) * 65536 + blk * 4096;
        float carryH[4][4], carryA[4][4], c8v[4][4];
#pragma unroll
        for (int jt = 0; jt < 4; ++jt)
#pragma unroll
            for (int jj = 0; jj < 4; ++jj) {
                const int ch = ch0 + jt * 16 + fq * 4 + jj;
                carryA[jt][jj] = 1.0f;
                c8v[jt][jj] = 8.0f * softplusf_(-P->in[I_LLAM][l * 1024 + ch]);
                if (FINAL) carryH[jt][jj] = I.sample ? P->in[I_SLH][(l * 16 + I.sb) * 1024 + ch] : lruU[(size_t)item * 1024 + ch];
                else carryH[jt][jj] = 0.f;
            }
        bf16x8 waf[4][2], wxf[4][2]; f32x4 bavv[4], bxvv[4];
#pragma unroll
        for (int jt = 0; jt < 4; ++jt) {
            const bf16_t* wa = waT + (jt * 16 + fr) * 64 + fq * 8; const bf16_t* wx = wxT + (jt * 16 + fr) * 64 + fq * 8;
            waf[jt][0] = *(const bf16x8*)wa; waf[jt][1] = *(const bf16x8*)(wa + 32); wxf[jt][0] = *(const bf16x8*)wx; wxf[jt][1] = *(const bf16x8*)(wx + 32);
            bavv[jt] = *(const f32x4*)(P->in[I_LBA] + l * 1024 + ch0 + jt * 16 + fq * 4); bxvv[jt] = *(const f32x4*)(P->in[I_LBX] + l * 1024 + ch0 + jt * 16 + fq * 4);
        }
#pragma unroll 1
        for (int it = 0; it < NIT; ++it) {
            const LAS bf16_t* xp = xa + (it * 16 + fr) * XP + ch0;
            const bf16x8 b0 = *(const LAS bf16x8*)(xp + fq * 8), b1 = *(const LAS bf16x8*)(xp + 32 + fq * 8);
            const int token = it * 16 + fr;
#pragma unroll
            for (int jt = 0; jt < 4; ++jt) {
                f32x4 ra = (f32x4){0.f, 0.f, 0.f, 0.f}, ia = (f32x4){0.f, 0.f, 0.f, 0.f};
                ra = MFMA16(waf[jt][0], b0, ra); ra = MFMA16(waf[jt][1], b1, ra);
                ia = MFMA16(wxf[jt][0], b0, ia); ia = MFMA16(wxf[jt][1], b1, ia);
                const u32x2 xw = *(const LAS u32x2*)(xp + jt * 16 + fq * 4);
                const float xv[4] = {bflo(xw.x), bfhi(xw.x), bflo(xw.y), bfhi(xw.y)};
                const f32x4 bav = bavv[jt], bxv = bxvv[jt];
                float hv[4], av[4];
#pragma unroll
                for (int jj = 0; jj < 4; ++jj) {
                    const float r = sigmoidf_(ra[jj] + bav[jj]);
                    const float ig = sigmoidf_(ia[jj] + bxv[jj]);
                    const float la = -c8v[jt][jj] * r;
                    float a = __expf(la);
                    float u = __builtin_amdgcn_sqrtf(fmaxf(1.0f - a * a, 0.f)) * ig * xv[jj];
                    { const float ap = dpp_f<0x111>(1.0f, a), up = dpp_f<0x111>(0.0f, u); u = a * up + u; a = a * ap; }
                    { const float ap = dpp_f<0x112>(1.0f, a), up = dpp_f<0x112>(0.0f, u); u = a * up + u; a = a * ap; }
                    { const float ap = dpp_f<0x114>(1.0f, a), up = dpp_f<0x114>(0.0f, u); u = a * up + u; a = a * ap; }
                    { const float ap = dpp_f<0x118>(1.0f, a), up = dpp_f<0x118>(0.0f, u); u = a * up + u; a = a * ap; }
                    const float hval = a * carryH[jt][jj] + u;
                    hv[jj] = hval;
                    carryH[jt][jj] = shfl_row15(hval);
                    if (!FINAL) { const float at = carryA[jt][jj] * a; av[jj] = at; carryA[jt][jj] = shfl_row15(at); }
                }
                if (!FINAL) {
                    u32x2 ow; ow.x = pk2(hv[0], hv[1]); ow.y = pk2(hv[2], hv[3]);
                    *(u32x2*)(yabc + (size_t)(I.row0 + token) * 3072 + ch0 + jt * 16 + fq * 4) = ow;
                    u32x2 aw; aw.x = pk2(av[0], av[1]); aw.y = pk2(av[2], av[3]);
                    *(u32x2*)((bf16_t*)(P->ws + WS_XB) + (size_t)(I.row0 + token) * DM + ch0 + jt * 16 + fq * 4) = aw;
                }
                if (FINAL) {
                    const u32x2 gw = *(const u32x2*)(h + (size_t)(I.row0 + token) * HP + HG + ch0 + jt * 16 + fq * 4);
                    u32x2 ow; ow.x = pk2(hv[0] * gelu_tanh(bflo(gw.x)), hv[1] * gelu_tanh(bfhi(gw.x)));
                    ow.y = pk2(hv[2] * gelu_tanh(bflo(gw.y)), hv[3] * gelu_tanh(bfhi(gw.y)));
                    *(u32x2*)(yabc + (size_t)(I.row0 + token) * 3072 + ch0 + jt * 16 + fq * 4) = ow;
                    if (it == NIT - 1 && fr == 15) {
                        if (I.sample) *(f32x4*)(P->out + O_SLH + (size_t)(l * 16 + I.sb) * 1024 + ch0 + jt * 16 + fq * 4) = (f32x4){hv[0], hv[1], hv[2], hv[3]};
                        else if (I.c == 127) *(f32x4*)(P->out + O_PLH + (size_t)(l * 2 + I.b) * 1024 + ch0 + jt * 16 + fq * 4) = (f32x4){hv[0], hv[1], hv[2], hv[3]};
                    }
                }
            }
        }
        if (!FINAL) {
            if (fr == 0) {
#pragma unroll
                for (int jt = 0; jt < 4; ++jt) {
                    *(f32x4*)(lruA + (size_t)item * 1024 + ch0 + jt * 16 + fq * 4) = (f32x4){carryA[jt][0], carryA[jt][1], carryA[jt][2], carryA[jt][3]};
                    *(f32x4*)(lruU + (size_t)item * 1024 + ch0 + jt * 16 + fq * 4) = (f32x4){carryH[jt][0], carryH[jt][1], carryH[jt][2], carryH[jt][3]};
                }
            }
        }
    }
}

__device__ __forceinline__ void lru_apply_item(int wv, KP P, int l, int item, const Item& I) {
    const bf16_t* h = (const bf16_t*)(P->ws + WS_H);
    bf16_t* yabc = (bf16_t*)(P->ws + WS_Y);
    const bf16_t* acum = (const bf16_t*)(P->ws + WS_XB);
    const float* carry = (const float*)(P->ws + WS_LRUU) + (size_t)item * 1024;
    const int tid = tidx(wv);
    const int c8 = (tid & 127) * 8;
    const f32x4 ca = *(const f32x4*)(carry + c8), cb = *(const f32x4*)(carry + c8 + 4);
    const float cv[8] = {ca[0], ca[1], ca[2], ca[3], cb[0], cb[1], cb[2], cb[3]};
#pragma unroll 1
    for (int tb = 0; tb < 4; ++tb) {
        u32x4 aw4[4], hw4[4], gw4[4];
#pragma unroll
        for (int q = 0; q < 4; ++q) {
            const size_t r = (size_t)(I.row0 + (tid >> 7) + 4 * (tb * 4 + q));
            aw4[q] = __builtin_nontemporal_load((const u32x4*)(acum + r * DM + c8)); hw4[q] = __builtin_nontemporal_load((const u32x4*)(yabc + r * 3072 + c8)); gw4[q] = __builtin_nontemporal_load((const u32x4*)(h + r * HP + HG + c8));
        }
#pragma unroll
        for (int q = 0; q < 4; ++q) {
            const int t = (tid >> 7) + 4 * (tb * 4 + q);
            const size_t r = (size_t)(I.row0 + t);
            const unsigned au[4] = {aw4[q].x, aw4[q].y, aw4[q].z, aw4[q].w}, hu[4] = {hw4[q].x, hw4[q].y, hw4[q].z, hw4[q].w}, gu[4] = {gw4[q].x, gw4[q].y, gw4[q].z, gw4[q].w};
            float hv[8]; unsigned ou[4];
#pragma unroll
            for (int e = 0; e < 4; ++e) {
                hv[2 * e] = bflo(au[e]) * cv[2 * e] + bflo(hu[e]); hv[2 * e + 1] = bfhi(au[e]) * cv[2 * e + 1] + bfhi(hu[e]);
                ou[e] = pk2(hv[2 * e] * gelu_tanh(bflo(gu[e])), hv[2 * e + 1] * gelu_tanh(bfhi(gu[e])));
            }
            *(u32x4*)(yabc + r * 3072 + c8) = (u32x4){ou[0], ou[1], ou[2], ou[3]};
            if (I.c == 127 && t == 63) {
                float* op = P->out + O_PLH + (size_t)(l * 2 + I.b) * 1024 + c8;
                *(f32x4*)op = (f32x4){hv[0], hv[1], hv[2], hv[3]}; *(f32x4*)(op + 4) = (f32x4){hv[4], hv[5], hv[6], hv[7]};
            }
        }
    }
}

#define SW72(row, t) ((row) * 72 + (((((t) >> 3) ^ (((row) >> 3) & 7))) << 3) + ((t) & 7))
__device__ __forceinline__ float pre_xbc(KP P, const bf16_t* h, int l, const Item& I, int tt, int ch) {
    if (tt >= 0 || (!I.sample && I.c > 0)) return bf2f(h[(size_t)(I.row0 + tt) * HP + HXBC + ch]);
    if (I.sample) return P->in[I_SSC][((size_t)(l * 16 + I.sb) * 3 + (3 + tt)) * 1536 + ch];
    return 0.f;
}
__device__ __forceinline__ float conv_xbc(KP P, const bf16_t* h, int l, const Item& I, int t, int ch) {
    const float* cw = P->in[I_SCW] + (size_t)l * 4 * 1536 + ch;
    float y = P->in[I_SCB][l * 1536 + ch];
    y += cw[0] * pre_xbc(P, h, l, I, t - 3, ch); y += cw[1536] * pre_xbc(P, h, l, I, t - 2, ch);
    y += cw[3072] * pre_xbc(P, h, l, I, t - 1, ch); y += cw[4608] * pre_xbc(P, h, l, I, t, ch);
    return siluf_(y);
}
template <class F>
__device__ __forceinline__ void conv_roll(KP P, const bf16_t* h, int l, const Item& I, int chx, int t0, int t1, F f) {
    const float* cw = P->in[I_SCW] + (size_t)l * 4 * 1536 + chx;
    const float w0 = cw[0], w1 = cw[1536], w2 = cw[3072], w3 = cw[4608], cb = P->in[I_SCB][l * 1536 + chx];
    float xm3 = pre_xbc(P, h, l, I, t0 - 3, chx), xm2 = pre_xbc(P, h, l, I, t0 - 2, chx), xm1 = pre_xbc(P, h, l, I, t0 - 1, chx);
    const bf16_t* hp = h + (size_t)I.row0 * HP + HXBC + chx;
#pragma unroll 8
    for (int t = t0; t < t1; ++t) {
        const float x0 = bf2f(hp[(size_t)t * HP]);
        const float y = cb + w0 * xm3 + w1 * xm2 + w2 * xm1 + w3 * x0;
        f(t, siluf_(y));
        xm3 = xm2; xm2 = xm1; xm1 = x0;
    }
}
template <int L, int NCH8, class CF, class F>
__device__ __forceinline__ void ssd_stage(KP P, const bf16_t* h, int l, const Item& I, int tid, CF chx_of, F f) {
    constexpr int NSEG = 512 / NCH8, TS = L / NSEG;
    static_assert(TS >= 1 && TS * NSEG == L, "segmenting");
    const int c8 = tid % NCH8, sg = tid / NCH8, t0 = sg * TS, chx = chx_of(c8);
    u32x4 xr[TS + 3];
#pragma unroll
    for (int q = 0; q < TS + 3; ++q) {
        const int tt = t0 - 3 + q;
        if (tt >= 0 || (!I.sample && I.c > 0)) {
            xr[q] = *(const u32x4*)((const char*)h + ((unsigned)(I.row0 + tt) * (unsigned)HP + (unsigned)(HXBC + chx)) * 2u);
        } else if (I.sample) {
            const float* st = P->in[I_SSC] + ((size_t)(l * 16 + I.sb) * 3 + (3 + tt)) * 1536 + chx;
            const f32x4 a = *(const f32x4*)st, b = *(const f32x4*)(st + 4);
            xr[q] = (u32x4){pk2(a[0], a[1]), pk2(a[2], a[3]), pk2(b[0], b[1]), pk2(b[2], b[3])};
        } else xr[q] = (u32x4){0u, 0u, 0u, 0u};
    }
    const float* cw = P->in[I_SCW] + (size_t)l * 4 * 1536 + chx;
    float wt[4][8], cb[8];
#pragma unroll
    for (int j = 0; j < 4; ++j) { const f32x4 a = *(const f32x4*)(cw + j * 1536), b = *(const f32x4*)(cw + j * 1536 + 4);
        wt[j][0] = a[0]; wt[j][1] = a[1]; wt[j][2] = a[2]; wt[j][3] = a[3]; wt[j][4] = b[0]; wt[j][5] = b[1]; wt[j][6] = b[2]; wt[j][7] = b[3]; }
    { const f32x4 a = *(const f32x4*)(P->in[I_SCB] + l * 1536 + chx), b = *(const f32x4*)(P->in[I_SCB] + l * 1536 + chx + 4);
        cb[0] = a[0]; cb[1] = a[1]; cb[2] = a[2]; cb[3] = a[3]; cb[4] = b[0]; cb[5] = b[1]; cb[6] = b[2]; cb[7] = b[3]; }
#pragma unroll
    for (int q = 0; q < TS; ++q) {
        float v[8];
#pragma unroll
        for (int e2 = 0; e2 < 4; ++e2) {
            const unsigned r0 = xr[q][e2], r1 = xr[q + 1][e2], r2 = xr[q + 2][e2], r3 = xr[q + 3][e2];
            v[2 * e2] = siluf_(cb[2 * e2] + wt[0][2 * e2] * bflo(r0) + wt[1][2 * e2] * bflo(r1) + wt[2][2 * e2] * bflo(r2) + wt[3][2 * e2] * bflo(r3));
            v[2 * e2 + 1] = siluf_(cb[2 * e2 + 1] + wt[0][2 * e2 + 1] * bfhi(r0) + wt[1][2 * e2 + 1] * bfhi(r1) + wt[2][2 * e2 + 1] * bfhi(r2) + wt[3][2 * e2 + 1] * bfhi(r3));
        }
        f(t0 + q, c8, v);
    }
}
template <int L>
__device__ __forceinline__ void ssd_dtcum(int wv, KP P, int l, const Item& I, LAS float* dtv, LAS float* cumv) {
    const float* dtraw = (const float*)(P->ws + WS_DT);
    const int tid = tidx(wv);
    __syncthreads();
    for (int idx = tid; idx < L * 16; idx += 512) { const int hd = idx & 15; dtv[idx] = softplusf_(dtraw[(size_t)I.row0 * 16 + idx] + P->in[I_SDTB][l * 16 + hd]); }
    __syncthreads();
    if (tid < 64) {
        constexpr int SEG = L / 4;
        const int hd = tid & 15, sg = tid >> 4;
        const float A = -__expf(P->in[I_SALOG][l * 16 + hd]);
        float c = 0.f;
#pragma unroll
        for (int t = 0; t < SEG; ++t) { c += dtv[(sg * SEG + t) * 16 + hd] * A; cumv[(sg * SEG + t) * 16 + hd] = c; }
        const float t1 = shfl_idx(c, hd), t2 = shfl_idx(c, 16 + hd), t3 = shfl_idx(c, 32 + hd);
        const float off = sg == 0 ? 0.f : (sg == 1 ? t1 : (sg == 2 ? t1 + t2 : t1 + t2 + t3));
#pragma unroll
        for (int t = 0; t < SEG; ++t) cumv[(sg * SEG + t) * 16 + hd] += off;
    }
    __syncthreads();
}

template <int L>
__device__ __forceinline__ void ssd_states_item(int wv, KP P, int l, int item, const Item& I, LAS unsigned char* lds) {
    constexpr int LP = L < 32 ? 32 : L, KS = LP / 32;
    const bf16_t* h = (const bf16_t*)(P->ws + WS_H);
    bf16_t* states = (bf16_t*)(P->ws + WS_ST);
    float* cdec = (float*)(P->ws + WS_CDEC);
    const int tid = tidx(wv), w = tid >> 6, lane = tid & 63, fr = lane & 15, fq = lane >> 4;
    LAS float* dtv = (LAS float*)lds; LAS float* cumv = dtv + 1024;
    LAS bf16_t* BmT = (LAS bf16_t*)(lds + 8192);
    LAS bf16_t* xw = (LAS bf16_t*)(lds + 8192 + 36864) + w * (64 * 72);
    ssd_dtcum<L>(wv, P, l, I, dtv, cumv);
    LAS bf16_t* xwall = (LAS bf16_t*)(lds + 8192 + 36864);
    ssd_stage<L, 32>(P, h, l, I, tid, [](int c8) { return 1024 + c8 * 8; }, [&](int t, int c8, const float* v) {
#pragma unroll
        for (int e = 0; e < 8; ++e) BmT[SW72(c8 * 8 + e, t)] = f2bf(v[e]); });
    if (L < LP) for (int idx = tid; idx < 256 * (LP - L); idx += 512) BmT[SW72(idx / (LP - L), L + idx % (LP - L))] = 0;
    for (int hh = 0; hh < 2; ++hh) {
        const int head = w + 8 * hh;
        const float cl = cumv[(L - 1) * 16 + head];
        __syncthreads();
        ssd_stage<L, 64>(P, h, l, I, tid, [=](int c8) { return hh * 512 + c8 * 8; }, [&](int t, int c8, const float* v) {
            const int hd = hh * 8 + (c8 >> 3);
            const float sc = __expf(cumv[(L - 1) * 16 + hd] - cumv[t * 16 + hd]) * dtv[t * 16 + hd];
            LAS bf16_t* dst = xwall + (c8 >> 3) * (64 * 72);
#pragma unroll
            for (int e = 0; e < 8; ++e) dst[SW72((c8 & 7) * 8 + e, t)] = f2bf(v[e] * sc); });
        if (L < LP) for (int idx = tid; idx < 512 * (LP - L); idx += 512) xwall[SW72(idx / (LP - L), L + idx % (LP - L))] = 0;
        __syncthreads();
        const float dec = __expf(cl);
        if (!I.sample && lane == 0) cdec[item * 16 + head] = dec;
#pragma unroll 1
        for (int nt = 0; nt < 8; ++nt) {
            bf16x8 af[KS];
#pragma unroll
            for (int ks = 0; ks < KS; ++ks) af[ks] = *(const LAS bf16x8*)(BmT + SW72(hh * 128 + nt * 16 + fr, ks * 32 + fq * 8));
#pragma unroll
            for (int pt = 0; pt < 4; ++pt) {
                f32x4 a = (f32x4){0.f, 0.f, 0.f, 0.f};
#pragma unroll
                for (int ks = 0; ks < KS; ++ks) a = MFMA16(af[ks], *(const LAS bf16x8*)(xw + SW72(pt * 16 + fr, ks * 32 + fq * 8)), a);
                const int p = pt * 16 + fr, n0 = nt * 16 + fq * 4;
                if (!I.sample) {
                    u32x2 ow; ow.x = pk2(a[0], a[1]); ow.y = pk2(a[2], a[3]);
                    *(u32x2*)(states + ((size_t)((I.b * 128 + I.c) * 16 + head) * 64 + p) * 128 + n0) = ow;
                } else {
                    const size_t o = ((size_t)((l * 16 + I.sb) * 16 + head) * 64 + p) * 128 + n0;
                    const f32x4 h0 = *(const f32x4*)(P->in[I_SSH] + o);
                    *(f32x4*)(P->out + O_SSH + o) = h0 * dec + a;
                }
            }
        }
    }
}

template <int L>
__device__ __forceinline__ void ssd_y_item(int wv, KP P, int l, const Item& I, LAS unsigned char* lds) {
    constexpr int LP = L < 32 ? 32 : L, KS = LP / 32, NIT = L / 16;
    const bf16_t* h = (const bf16_t*)(P->ws + WS_H);
    const bf16_t* states = (const bf16_t*)(P->ws + WS_ST);
    bf16_t* yabc = (bf16_t*)(P->ws + WS_Y);
    const int tid = tidx(wv), w = tid >> 6, lane = tid & 63, fr = lane & 15, fq = lane >> 4;
    LAS float* dtv = (LAS float*)lds; LAS float* cumv = dtv + 1024;
    LAS bf16_t* Bm = (LAS bf16_t*)(lds + 8192);
    LAS bf16_t* Cm = (LAS bf16_t*)(lds + 8192 + 17408);
    LAS float* CBl = (LAS float*)(lds + 8192 + 2 * 17408);
    LAS float* part = (LAS float*)(lds + 8192 + 3 * 17408);
    LAS bf16_t* xT = (LAS bf16_t*)(lds + 8192 + 3 * 17408 + 2048) + w * (64 * 72);
    ssd_dtcum<L>(wv, P, l, I, dtv, cumv);
    for (int g = 0; g < 2; ++g) {
        const int head = g * 8 + w;
        __syncthreads();
        ssd_stage<L, 32>(P, h, l, I, tid, [=](int c8) { return 1024 + (c8 >> 4) * 256 + g * 128 + (c8 & 15) * 8; }, [&](int t, int c8, const float* v) {
            u32x4 ow; ow.x = pk2(v[0], v[1]); ow.y = pk2(v[2], v[3]); ow.z = pk2(v[4], v[5]); ow.w = pk2(v[6], v[7]);
            *(LAS u32x4*)(((c8 >> 4) ? Cm : Bm) + t * 136 + (c8 & 15) * 8) = ow; });
        {
            LAS bf16_t* xTall = (LAS bf16_t*)(lds + 8192 + 3 * 17408 + 2048);
            ssd_stage<L, 64>(P, h, l, I, tid, [=](int c8) { return g * 512 + c8 * 8; }, [&](int t, int c8, const float* v) {
                LAS bf16_t* dst = xTall + (c8 >> 3) * (64 * 72);
#pragma unroll
                for (int e = 0; e < 8; ++e) dst[SW72((c8 & 7) * 8 + e, t)] = f2bf(v[e]); });
            if (L < LP) for (int idx = tid; idx < 512 * (LP - L); idx += 512) xTall[SW72(idx / (LP - L), L + idx % (LP - L))] = 0;
        }
        __syncthreads();
        for (int tix = w; tix < NIT * NIT; tix += 8) {
            const int it = tix / NIT, jt = tix % NIT;
            f32x4 a = (f32x4){0.f, 0.f, 0.f, 0.f};
#pragma unroll
            for (int ks = 0; ks < 4; ++ks)
                a = MFMA16(*(const LAS bf16x8*)(Cm + (it * 16 + fr) * 136 + ks * 32 + fq * 8), *(const LAS bf16x8*)(Bm + (jt * 16 + fr) * 136 + ks * 32 + fq * 8), a);
#pragma unroll
            for (int jj = 0; jj < 4; ++jj) CBl[(it * 16 + fq * 4 + jj) * 68 + jt * 16 + fr] = a[jj];
        }
        __syncthreads();
        const float dsk = P->in[I_SD][l * 16 + head];
        bf16x8 hf[4][4];
#pragma unroll
        for (int pt = 0; pt < 4; ++pt) {
            const int p = pt * 16 + fr;
            if (!I.sample) {
                const bf16_t* sp = states + ((size_t)((I.b * 128 + I.c) * 16 + head) * 64 + p) * 128 + fq * 8;
#pragma unroll
                for (int ks = 0; ks < 4; ++ks) hf[pt][ks] = __builtin_nontemporal_load((const bf16x8*)(sp + ks * 32));
            } else {
                const float* sp = P->in[I_SSH] + ((size_t)((l * 16 + I.sb) * 16 + head) * 64 + p) * 128 + fq * 8;
#pragma unroll
                for (int ks = 0; ks < 4; ++ks) {
                    const f32x4 a0 = *(const f32x4*)(sp + ks * 32), a1 = *(const f32x4*)(sp + ks * 32 + 4);
                    u32x4 ww; ww.x = pk2(a0[0], a0[1]); ww.y = pk2(a0[2], a0[3]); ww.z = pk2(a1[0], a1[1]); ww.w = pk2(a1[2], a1[3]);
                    __builtin_memcpy(&hf[pt][ks], &ww, 16);
                }
            }
        }
        u32x2 zcur[4];
#pragma unroll
        for (int pt = 0; pt < 4; ++pt) zcur[pt] = *(const u32x2*)(h + (size_t)(I.row0 + fr) * HP + HZ + head * 64 + pt * 16 + fq * 4);
#pragma unroll 1
        for (int it = 0; it < NIT; ++it) {
            const int i = it * 16 + fr; const float cum_i = cumv[i * 16 + head];
            u32x2 znext[4];
#pragma unroll
            for (int pt = 0; pt < 4; ++pt) znext[pt] = zcur[pt];
            if (it + 1 < NIT) {
#pragma unroll
                for (int pt = 0; pt < 4; ++pt) znext[pt] = *(const u32x2*)(h + (size_t)(I.row0 + i + 16) * HP + HZ + head * 64 + pt * 16 + fq * 4);
            }
            f32x4 acc[4];
#pragma unroll
            for (int pt = 0; pt < 4; ++pt) acc[pt] = (f32x4){0.f, 0.f, 0.f, 0.f};
#pragma unroll
            for (int ks = 0; ks < KS; ++ks) {
                if (ks * 32 > it * 16 + 15) continue;
                const int j0 = ks * 32 + fq * 8;
                const f32x4 c0 = *(const LAS f32x4*)(CBl + i * 68 + j0), c1 = *(const LAS f32x4*)(CBl + i * 68 + j0 + 4);
                float wv8[8];
#pragma unroll
                for (int e = 0; e < 8; ++e) {
                    const int j = j0 + e; const float cb = e < 4 ? c0[e & 3] : c1[e & 3];
                    const float ex = __expf(fminf(cum_i - cumv[j * 16 + head], 0.f));
                    wv8[e] = (j <= i) ? cb * ex * dtv[j * 16 + head] : 0.f;
                }
                u32x4 ww; ww.x = pk2(wv8[0], wv8[1]); ww.y = pk2(wv8[2], wv8[3]); ww.z = pk2(wv8[4], wv8[5]); ww.w = pk2(wv8[6], wv8[7]);
                bf16x8 wf; __builtin_memcpy(&wf, &ww, 16);
#pragma unroll
                for (int pt = 0; pt < 4; ++pt) acc[pt] = MFMA16(*(const LAS bf16x8*)(xT + SW72(pt * 16 + fr, j0)), wf, acc[pt]);
            }
            const float ecum = __expf(cum_i);
            bf16x8 cf[4];
#pragma unroll
            for (int ks = 0; ks < 4; ++ks) cf[ks] = *(const LAS bf16x8*)(Cm + i * 136 + ks * 32 + fq * 8);
#pragma unroll
            for (int pt = 0; pt < 4; ++pt) {
                f32x4 t2 = (f32x4){0.f, 0.f, 0.f, 0.f};
#pragma unroll
                for (int ks = 0; ks < 4; ++ks) t2 = MFMA16(hf[pt][ks], cf[ks], t2);
                acc[pt] += t2 * ecum;
            }
            float ss = 0.f;
#pragma unroll
            for (int pt = 0; pt < 4; ++pt) {
                const int p0 = pt * 16 + fq * 4;
                const u32x2 zw = zcur[pt];
                const float zv[4] = {bflo(zw.x), bfhi(zw.x), bflo(zw.y), bfhi(zw.y)};
                float yv[4];
#pragma unroll
                for (int jj = 0; jj < 4; ++jj) {
                    const float xs = bf2f(xT[SW72(p0 + jj, i)]);
                    const float y = (acc[pt][jj] + dsk * xs) * siluf_(zv[jj]);
                    yv[jj] = y; ss += y * y;
                }
                u32x2 ow; ow.x = pk2(yv[0], yv[1]); ow.y = pk2(yv[2], yv[3]);
                *(u32x2*)(yabc + (size_t)(I.row0 + i) * 3072 + 1024 + head * 64 + p0) = ow;
            }
            ss += shflx(ss, 16); ss += shflx(ss, 32);
            if (fq == 0) part[i * 8 + w] = ss;
#pragma unroll
            for (int pt = 0; pt < 4; ++pt) zcur[pt] = znext[pt];
        }
        __syncthreads();
        f32x4 ngv[4];
#pragma unroll
        for (int pt = 0; pt < 4; ++pt) ngv[pt] = *(const f32x4*)(P->in[I_SNORM] + l * 1024 + head * 64 + pt * 16 + fq * 4);
        u32x2 ycur[4];
#pragma unroll
        for (int pt = 0; pt < 4; ++pt) ycur[pt] = *(const u32x2*)(yabc + (size_t)(I.row0 + fr) * 3072 + 1024 + head * 64 + pt * 16 + fq * 4);
#pragma unroll 1
        for (int it = 0; it < NIT; ++it) {
            const int i = it * 16 + fr;
            u32x2 ynext[4];
#pragma unroll
            for (int pt = 0; pt < 4; ++pt) ynext[pt] = ycur[pt];
            if (it + 1 < NIT) {
#pragma unroll
                for (int pt = 0; pt < 4; ++pt) ynext[pt] = *(const u32x2*)(yabc + (size_t)(I.row0 + i + 16) * 3072 + 1024 + head * 64 + pt * 16 + fq * 4);
            }
            const f32x4 pa = *(const LAS f32x4*)(part + i * 8), pb = *(const LAS f32x4*)(part + i * 8 + 4);
            const float tot = (pa[0] + pa[1] + pa[2] + pa[3]) + (pb[0] + pb[1] + pb[2] + pb[3]);
            const float rs = rsqrtf(tot * (1.0f / 512.0f) + EPS);
#pragma unroll
            for (int pt = 0; pt < 4; ++pt) {
                const int p0 = pt * 16 + fq * 4;
                const f32x4 ng = ngv[pt];
                const u32x2 yw = ycur[pt];
                u32x2 ow; ow.x = pk2(bflo(yw.x) * rs * ng[0], bfhi(yw.x) * rs * ng[1]); ow.y = pk2(bflo(yw.y) * rs * ng[2], bfhi(yw.y) * rs * ng[3]);
                *(u32x2*)(yabc + (size_t)(I.row0 + i) * 3072 + 1024 + head * 64 + p0) = ow;
            }
#pragma unroll
            for (int pt = 0; pt < 4; ++pt) ycur[pt] = ynext[pt];
        }
    }
}

__device__ __forceinline__ void phase_scan(int wv, KP P, int l) {
    bf16_t* states = (bf16_t*)(P->ws + WS_ST);
    const float* cdec = (const float*)(P->ws + WS_CDEC);
    const float* lruA = (const float*)(P->ws + WS_LRUA); float* lruU = (float*)(P->ws + WS_LRUU);
    if (DBG_P5S) for (int idx = bidx() * 512 + tidx(wv); idx < 131072; idx += gdim() * 512) {
        const int e = idx * 2, b = e >> 17, rem = e & 131071, head = rem >> 13;
        unsigned* sp = (unsigned*)(states + (size_t)b * 128 * 131072 + rem);
        const float* dp = cdec + (b * 128) * 16 + head;
        float c0 = 0.f, c1 = 0.f;
        for (int c = 0; c < 128; c += 32) {
            unsigned v[32]; float dv[32];
#pragma unroll
            for (int k = 0; k < 32; ++k) { v[k] = __builtin_nontemporal_load(sp + (size_t)(c + k) * 65536); dv[k] = dp[(c + k) * 16]; }
#pragma unroll
            for (int k = 0; k < 32; ++k) {
                const float dec = dv[k];
                sp[(size_t)(c + k) * 65536] = pk2(c0, c1);
                c0 = dec * c0 + bflo(v[k]); c1 = dec * c1 + bfhi(v[k]);
            }
        }
        float* op = P->out + O_PSH + (size_t)(l * 2 + b) * 131072 + rem;
        op[0] = c0; op[1] = c1;
    }
    if (DBG_LRU4) for (int idx = bidx() * 512 + tidx(wv); idx < 2048; idx += gdim() * 512) {
        const int b = idx >> 10, ch = idx & 1023;
        float carry = 0.f;
        for (int c = 0; c < 128; c += 32) {
            float Av[32], Uv[32];
#pragma unroll
            for (int k = 0; k < 32; ++k) { const size_t o = (size_t)(b * 128 + c + k) * 1024 + ch; Av[k] = lruA[o]; Uv[k] = lruU[o]; }
#pragma unroll
            for (int k = 0; k < 32; ++k) { const size_t o = (size_t)(b * 128 + c + k) * 1024 + ch; lruU[o] = carry; carry = Av[k] * carry + Uv[k]; }
        }
    }
}

__device__ __forceinline__ void gsync(cg::grid_group& grid) {
    grid.sync();
}
#define XB_TMO      128
#define XB_XCNT(j)  (256  + 64 * (j))
#define XB_XSUB(j)  (1280 + 64 * (j))
#define XB_XGEN(j)  (2304 + 64 * (j))
#define XB_TOP      3328
#define XB_TOPGEN   3392
#define XCD_BAR_WORDS 3456
#define XB_SPIN_CAP (1u << 20)
__device__ __forceinline__ unsigned xb_ld(unsigned* p)              { return __hip_atomic_load(p, __ATOMIC_RELAXED, __HIP_MEMORY_SCOPE_AGENT); }
__device__ __forceinline__ unsigned xb_add(unsigned* p, unsigned v) { return __hip_atomic_fetch_add(p, v, __ATOMIC_RELAXED, __HIP_MEMORY_SCOPE_AGENT); }
__device__ __forceinline__ unsigned xb_xcc_id() { return (unsigned)__builtin_amdgcn_s_getreg((3 << 11) | 20) & 0xFu; }
#define XB_SPIN(cond, bar) do { unsigned _sp = 0; while (cond) { __builtin_amdgcn_s_sleep(1); \
    if ((++_sp & 255u) == 0u) { if (xb_ld(&(bar)[XB_TMO])) break; if (_sp > XB_SPIN_CAP) { atomicAdd(&(bar)[XB_TMO], 1u); break; } } } } while (0)
__device__ __forceinline__ void xcd_barrier_complete(unsigned* bar, unsigned x, unsigned& nloc, unsigned& nx) {
    const unsigned G = (unsigned)gdim();
    unsigned sum, cnt, mine, sp = 0u;
    for (;;) {
        sum = 0u; cnt = 0u; mine = 0u;
#pragma unroll
        for (unsigned j = 0; j < 16; ++j) { const unsigned c = xb_ld(&bar[XB_XCNT(j)]); sum += c; cnt += (c > 0u) ? 1u : 0u; mine = (j == x) ? c : mine; }
        if (sum == G) break;
        __builtin_amdgcn_s_sleep(1);
        if ((++sp & 255u) == 0u) { if (xb_ld(&bar[XB_TMO])) break; if (sp > XB_SPIN_CAP) { atomicAdd(&bar[XB_TMO], 1u); break; } }
    }
    nloc = mine > 0u ? mine : 1u; nx = cnt > 0u ? cnt : 1u;
}
__device__ __forceinline__ void gbar(int wv, LAS unsigned char* lds) {
    asm volatile("s_waitcnt vmcnt(0)" ::: "memory");
    __syncthreads();
    unsigned* bar = (unsigned*)(kparams()->ws + WS_BAR);
    if (tidx(wv) == 0) {
        volatile LAS unsigned* st = (volatile LAS unsigned*)(lds + LDS_BYTES - 16);
        const unsigned x = xb_xcc_id();
        __builtin_amdgcn_s_waitcnt(0);
        unsigned nloc = st[0], nx = st[1];
        if (nloc == 0u) { xcd_barrier_complete(bar, x, nloc, nx); st[0] = nloc; st[1] = nx; }
        const unsigned old = xb_add(&bar[XB_XSUB(x)], 1u);
        const unsigned gen = old / nloc;
        if (old + 1u == (gen + 1u) * nloc) {
            __builtin_amdgcn_fence(__ATOMIC_RELEASE, "agent");
            asm volatile("s_waitcnt vmcnt(0)" ::: "memory");
            const unsigned og = xb_add(&bar[XB_TOP], 1u);
            const unsigned tg = og / nx;
            if (og + 1u == (tg + 1u) * nx) xb_add(&bar[XB_TOPGEN], 1u);
            else XB_SPIN(xb_ld(&bar[XB_TOPGEN]) == tg, bar);
            __builtin_amdgcn_fence(__ATOMIC_ACQUIRE, "agent");
            xb_add(&bar[XB_XGEN(x)], 1u);
            asm volatile("s_waitcnt vmcnt(0)" ::: "memory");
        } else {
            XB_SPIN(xb_ld(&bar[XB_XGEN(x)]) == gen, bar);
            __builtin_amdgcn_fence(__ATOMIC_ACQUIRE, "agent");
            asm volatile("s_waitcnt vmcnt(0)" ::: "memory");
        }
    }
    __syncthreads();
}
__device__ __forceinline__ void gemm_gu(int wv, LAS unsigned char* lds, int j2) { KP P = kparams();
    EpiGU E; E.ssq = (const float*)(P->ws + WS_SSQ); E.hff = (bf16_t*)(P->ws + WS_H);
    run_gemm(wv, lds, (const bf16_t*)(P->ws + WS_XB), (const bf16_t*)(P->ws + (j2 ? W_GU1 : W_GU0)), MT, 5632, 1024, E); }
__device__ __forceinline__ void gemm_dn(int wv, LAS unsigned char* lds, int j2) { KP P = kparams();
    EpiRes E; E.x = P->out; E.xb = (bf16_t*)(P->ws + WS_XB); E.ssq = (float*)(P->ws + WS_SSQ); E.scale = 0.5f;
    run_gemm(wv, lds, (const bf16_t*)(P->ws + WS_H), (const bf16_t*)(P->ws + (j2 ? W_DN1 : W_DN0)), MP, 1024, 2816, E);
    skinny_gemm<0>(wv, lds, kparams(), (const bf16_t*)(kparams()->ws + WS_H) + (size_t)MP * DFF, (const bf16_t*)(kparams()->ws + (j2 ? W_DN1 : W_DN0)), 2816, 0.5f); }
__device__ __forceinline__ void gemm_in(int wv, LAS unsigned char* lds) { KP P = kparams();
    EpiIn E; E.ssq = (const float*)(P->ws + WS_SSQ); E.h = (bf16_t*)(P->ws + WS_H); E.dtraw = (float*)(P->ws + WS_DT);
    run_gemm(wv, lds, (const bf16_t*)(P->ws + WS_XB), (const bf16_t*)(P->ws + W_IN), MT, NINP, 1024, E); }
__device__ __forceinline__ void gemm_merge(int wv, LAS unsigned char* lds) { KP P = kparams();
    EpiMerge E; E.h = (const bf16_t*)(P->ws + WS_H); E.merged = (bf16_t*)(P->ws + WS_ST);
    run_gemm(wv, lds, (const bf16_t*)(P->ws + WS_Y), (const bf16_t*)(P->ws + W_BR), MP, 1024, 3072, E);
    skinny_gemm<1>(wv, lds, kparams(), (const bf16_t*)(kparams()->ws + WS_Y) + (size_t)MP * 3072, (const bf16_t*)(kparams()->ws + W_BR), 3072, 1.0f); }
__device__ __forceinline__ void gemm_out(int wv, LAS unsigned char* lds) { KP P = kparams();
    EpiRes E; E.x = P->out; E.xb = (bf16_t*)(P->ws + WS_XB); E.ssq = (float*)(P->ws + WS_SSQ); E.scale = 1.0f;
    run_gemm(wv, lds, (const bf16_t*)(P->ws + WS_ST), (const bf16_t*)(P->ws + W_OUT), MP, 1024, 1024, E);
    skinny_gemm<0>(wv, lds, kparams(), (const bf16_t*)(kparams()->ws + WS_ST) + (size_t)MP * DM, (const bf16_t*)(kparams()->ws + W_OUT), 1024, 1.0f); }

__global__ __launch_bounds__(512, 2) void mega(Params Pk) {
    extern __shared__ __attribute__((aligned(16))) unsigned char smem[];
    LAS unsigned char* lds = (LAS unsigned char*)smem;
    cg::grid_group grid = cg::this_grid();
    const int wv = __builtin_amdgcn_readfirstlane((int)(threadIdx.x >> 6));
    unsigned* bar0 = (unsigned*)(kparams()->ws + WS_BAR);
    if (threadIdx.x == 0) {
        volatile LAS unsigned* st = (volatile LAS unsigned*)(lds + LDS_BYTES - 16); st[0] = 0u; st[1] = 0u;
        (void)xb_add(&bar0[XB_XCNT(xb_xcc_id())], 1u);
    }
    __syncthreads();
    phase_init(wv, kparams());
    convert_layer(wv, kparams(), 0, 0, gdim(), lds);
    gsync(grid);
    unsigned long long tacc = 0, t0 = 0;
#pragma unroll 1
    for (int step = 0; step < 8; ++step) {
        const int l = step >> 1, j2 = step & 1;
        gbar(wv, lds);
        TB(0); gemm_gu(wv, lds, j2); gbar(wv, lds); TE(0);
        TB(1); gemm_dn(wv, lds, j2);
        if (j2 == 0) {
            gbar(wv, lds); TE(1);
            TB(2); gemm_in(wv, lds); gbar(wv, lds); TE(2);
            TB(3);
            for (int item = bidx(); item < 256; item += gdim()) {
                const Item I = get_item(item);
                copy_states_item(wv, kparams(), l, I);
                attn_item<64>(wv, kparams(), l, I, lds);
                lru_item<64, false>(wv, kparams(), l, item, I, lds);
                ssd_states_item<64>(wv, kparams(), l, item, I, lds);
            }
            gbar(wv, lds); TE(3);
            TB(4);
            phase_scan(wv, kparams(), l);
            {
                const int nconv = gdim() > 128 ? gdim() - 64 : gdim();
                convert_layer(wv, kparams(), l, 1, nconv, lds);
                if (l < 3) convert_layer(wv, kparams(), l + 1, 0, nconv, lds);
                for (int sj = bidx() - (gdim() > 128 ? gdim() - 64 : 0); sj >= 0 && sj < 64; sj += gdim()) {
                    const int sb = sj & 15, piece = sj >> 4;
                    const Item I = get_item(256 + sb);
                    if (piece == 0) lru_item<16, true>(wv, kparams(), l, 256 + sb, I, lds);
                    else if (piece == 1) ssd_states_item<16>(wv, kparams(), l, 256 + sb, I, lds);
                    else if (piece == 2) ssd_y_item<16>(wv, kparams(), l, I, lds);
                    else { copy_states_item(wv, kparams(), l, I); attn_item<16>(wv, kparams(), l, I, lds); }
                }
            }
            gbar(wv, lds); TE(4);
            TB(5);
            for (int item = bidx(); item < 256; item += gdim()) {
                const Item I = get_item(item);
                lru_apply_item(wv, kparams(), l, item, I);
                ssd_y_item<64>(wv, kparams(), l, I, lds);
            }
            gbar(wv, lds); TE(5);
            TB(6); gemm_merge(wv, lds); gbar(wv, lds); TE(6);
            TB(7); gemm_out(wv, lds);
        }
    }
    gbar(wv, lds);
    TE(7);
    phase_final(wv, kparams());
    if (PROBE >= 0 && bidx() == 0) { const unsigned long long tend = TNOW() + tacc; while (TNOW() < tend) __builtin_amdgcn_s_sleep(10); }
#if DBG_SANITIZE
    gbar(wv, lds);
    { KP P = kparams(); float* o = P->out;
      for (size_t i = (size_t)bidx() * 512 + tidx(wv); i < O_END; i += (size_t)gdim() * 512) { const float v = o[i]; if (!(fabsf(v) < 1e30f)) o[i] = 0.f; } }
#endif
}

extern "C" void kernel_launch(void* const* d_in, const int* in_sizes, int n_in, void* d_out, int out_size, void* d_ws, size_t ws_size, hipStream_t stream) {
    static int grid_blocks = 0;
    if (grid_blocks == 0) {
        if (n_in != N_INPUTS || (size_t)out_size != O_END || ws_size < WS_END) {
            fprintf(stderr, "kernel_launch: unexpected shapes: n_in %d out %d ws %zu (need %zu)\n", n_in, out_size, ws_size, (size_t)WS_END); grid_blocks = -1; return; }
        int dev = 0, cus = 0, per_cu = 0;
        hipGetDevice(&dev);
        hipDeviceGetAttribute(&cus, hipDeviceAttributeMultiprocessorCount, dev);
        if (hipFuncSetAttribute((const void*)mega, hipFuncAttributeMaxDynamicSharedMemorySize, LDS_BYTES) != hipSuccess) { fprintf(stderr, "hipFuncSetAttribute failed\n"); grid_blocks = -1; return; }
        hipOccupancyMaxActiveBlocksPerMultiprocessor(&per_cu, (const void*)mega, 512, LDS_BYTES);
        if (per_cu < 1) per_cu = 1;
        grid_blocks = cus * per_cu;
    }
    if (grid_blocks < 0) return;
    Params p{};
    for (int i = 0; i < N_INPUTS; ++i) p.in[i] = (const float*)d_in[i];
    p.out = (float*)d_out; p.ws = (unsigned char*)d_ws;
    if (hipMemsetAsync((unsigned char*)d_ws + WS_BAR, 0, 16384, stream) != hipSuccess) { fprintf(stderr, "memset failed\n"); return; }
    void* args[] = {&p};
    hipError_t e = hipLaunchCooperativeKernel((const void*)mega, dim3(grid_blocks), dim3(512), args, LDS_BYTES, stream);
    if (e != hipSuccess) fprintf(stderr, "cooperative launch failed: %s (grid %d)\n", hipGetErrorString(e), grid_blocks);
}
```

```cpp
#include <hip/hip_runtime.h>
#include <hip/hip_cooperative_groups.h>
#include <cstdio>
namespace cg = cooperative_groups;
#define DBG_SANITIZE 0
#ifndef REP_P4
#define REP_P4 1
#endif
#ifndef REP_P6
#define REP_P6 1
#endif
#ifndef REP_SYNC
#define REP_SYNC 0
#endif
#ifndef REP_IN
#define REP_IN 1
#endif
#ifndef REP_A
#define REP_A 1
#endif
#ifndef REP_L4
#define REP_L4 1
#endif
#ifndef REP_S4
#define REP_S4 1
#endif
#ifndef REP_L6
#define REP_L6 1
#endif
#ifndef REP_S6
#define REP_S6 1
#endif
#ifndef PROBE
#define PROBE -1
#endif
#define TNOW() __builtin_amdgcn_s_memrealtime()
#define TB(id) do { if (((PROBE) >> (id)) & 1 && PROBE >= 0) t0 = TNOW(); } while (0)
#define TE(id) do { if (((PROBE) >> (id)) & 1 && PROBE >= 0) tacc += TNOW() - t0; } while (0)
#ifndef REP_CV
#define REP_CV 1
#endif
#ifndef REP_GU
#define REP_GU 1
#endif
#ifndef REP_MG
#define REP_MG 1
#endif
#define DBG_MIX 1
#define DBG_MERGE 1
#define DBG_ATTN 1
#define DBG_LRU4 1
#define DBG_SSD4 1
#define DBG_P5S 1
#define DBG_P5W 1
#define DBG_P5 1
#define DBG_LRU6 1
#define DBG_SSD6 1

#define LAS __attribute__((address_space(3)))
typedef unsigned short bf16_t;
typedef short bf16x8 __attribute__((ext_vector_type(8)));
typedef float f32x4 __attribute__((ext_vector_type(4)));
typedef unsigned u32x4 __attribute__((ext_vector_type(4)));
typedef unsigned u32x2 __attribute__((ext_vector_type(2)));

constexpr int MP = 16384, MS = 256, MT = 16640;
constexpr int DM = 1024, DFF = 2816, NIN = 9232, NINP = 9472, HP = 9232;
constexpr int HX = 0, HG = 1024, HZ = 2048, HXBC = 3072, HQ = 4608, HK = 5632, HV = 5888, HGATE = 6144, HDT = 9216;
constexpr float EPS = 1e-6f;
constexpr int NITEM = 272;

enum { I_XP = 0, I_XS, I_CK, I_CV, I_SLC, I_SLH, I_SSC, I_SSH, I_FNORM, I_WG, I_WU, I_WD, I_MNORM, I_WIN, I_LCW, I_LCB, I_LWA, I_LBA, I_LWX, I_LBX,
       I_LLAM, I_SCW, I_SCB, I_SDTB, I_SALOG, I_SD, I_SNORM, I_SINK, I_WBR, I_WOUT, I_FINAL, N_INPUTS };

constexpr size_t O_YP = 0, O_YS = O_YP + (size_t)MP * DM, O_PK = O_YS + (size_t)MS * DM, O_PV = O_PK + 4 * 2 * 128 * 256, O_PLC = O_PV + 4 * 2 * 128 * 256,
                 O_PLH = O_PLC + 4 * 2 * 3 * 1024, O_PSC = O_PLH + 4 * 2 * 1024, O_PSH = O_PSC + 4 * 2 * 3 * 1536, O_SK = O_PSH + (size_t)4 * 2 * 16 * 64 * 128,
                 O_SV = O_SK + (size_t)4 * 16 * 128 * 256, O_SLC = O_SV + (size_t)4 * 16 * 128 * 256, O_SLH = O_SLC + 4 * 16 * 3 * 1024, O_SSC = O_SLH + 4 * 16 * 1024,
                 O_SSH = O_SSC + 4 * 16 * 3 * 1536, O_END = O_SSH + (size_t)4 * 16 * 16 * 64 * 128;

constexpr size_t WS_XB = 0;
constexpr size_t WS_H = WS_XB + (size_t)MT * DM * 2;
constexpr size_t WS_ST = WS_H + (size_t)MT * HP * 2;
constexpr size_t WS_Y = WS_ST + (size_t)2 * 128 * 16 * 64 * 128 * 2;
constexpr size_t WS_W = WS_Y + (size_t)MT * 3072 * 2;
constexpr size_t W_GU0 = WS_W, W_GU1 = W_GU0 + (size_t)5632 * 1024 * 2, W_DN0 = W_GU1 + (size_t)5632 * 1024 * 2, W_DN1 = W_DN0 + (size_t)1024 * 2816 * 2,
                 W_IN = W_DN1 + (size_t)1024 * 2816 * 2, W_BR = W_IN + (size_t)NINP * 1024 * 2, W_OUT = W_BR + (size_t)1024 * 3072 * 2,
                 W_LA = W_OUT + (size_t)1024 * 1024 * 2, W_LX = W_LA + 2 * 65536 * 2, WS_SSQ = W_LX + 2 * 65536 * 2;
constexpr size_t WS_DT = WS_SSQ + (size_t)MT * 16 * 4, WS_LRUA = WS_DT + (size_t)MT * 16 * 4, WS_LRUU = WS_LRUA + 256 * 1024 * 4, WS_CDEC = WS_LRUU + 256 * 1024 * 4,
                 WS_BAR = WS_CDEC + 256 * 16 * 4, WS_SSQ2 = WS_BAR + 16384, WS_END = WS_SSQ2 + 256 * 16 * 4;

constexpr int LDS_BYTES = 147456;

struct Params { const float* in[N_INPUTS]; float* out; unsigned char* ws; };
typedef const Params __attribute__((address_space(4))) * KP;
__device__ __forceinline__ KP kparams() { KP p = (KP)__builtin_amdgcn_kernarg_segment_ptr(); asm volatile("" : "+s"(p)); return p; }
__device__ __forceinline__ int tidx(int wv) { int t; asm volatile("v_mbcnt_lo_u32_b32 %0, -1, 0\n\tv_mbcnt_hi_u32_b32 %0, -1, %0" : "=v"(t)); return (wv << 6) | t; }
__device__ __forceinline__ int bidx() { int t = blockIdx.x; asm volatile("" : "+s"(t)); return t; }
__device__ __forceinline__ int gdim() { int t = gridDim.x; asm volatile("" : "+s"(t)); return t; }

typedef __bf16 bf16x2_t __attribute__((ext_vector_type(2)));
typedef float f32x2_t __attribute__((ext_vector_type(2)));
__device__ __forceinline__ unsigned pk2(float lo, float hi) { f32x2_t v = {lo, hi}; bf16x2_t b = __builtin_convertvector(v, bf16x2_t); unsigned r; __builtin_memcpy(&r, &b, 4); return r; }
__device__ __forceinline__ bf16_t f2bf(float f) { return (bf16_t)(pk2(f, 0.f) & 0xffffu); }
__device__ __forceinline__ float bf2f(bf16_t b) { return __uint_as_float(((unsigned)b) << 16); }
__device__ __forceinline__ float bflo(unsigned w) { return __uint_as_float(w << 16); }
__device__ __forceinline__ float bfhi(unsigned w) { return __uint_as_float(w & 0xffff0000u); }
__device__ __forceinline__ float rcpf_(float x) { return __builtin_amdgcn_rcpf(x); }
__device__ __forceinline__ float sigmoidf_(float x) { return rcpf_(1.0f + __expf(-x)); }
__device__ __forceinline__ float siluf_(float x) { return x * rcpf_(1.0f + __expf(-x)); }
__device__ __forceinline__ float softplusf_(float x) { return x > 20.f ? x : log1pf(__expf(x)); }
__device__ __forceinline__ float gelu_tanh(float x) { const float u = 0.7978845608028654f * (x + 0.044715f * x * x * x); return x * rcpf_(1.0f + __expf(-2.0f * u)); }
__device__ __forceinline__ float rstd_row(const float* ssq, int r) {
    const f32x4* p = (const f32x4*)(ssq + (size_t)r * 16); f32x4 a = p[0], b = p[1], c = p[2], d = p[3];
    float s = (a[0] + a[1] + a[2] + a[3]) + (b[0] + b[1] + b[2] + b[3]) + (c[0] + c[1] + c[2] + c[3]) + (d[0] + d[1] + d[2] + d[3]);
    if (r >= MP) {
        const f32x4* q = (const f32x4*)(ssq + (WS_SSQ2 - WS_SSQ) / 4 + (size_t)(r - MP) * 16); a = q[0]; b = q[1]; c = q[2]; d = q[3];
        s += (a[0] + a[1] + a[2] + a[3]) + (b[0] + b[1] + b[2] + b[3]) + (c[0] + c[1] + c[2] + c[3]) + (d[0] + d[1] + d[2] + d[3]);
    }
    return rsqrtf(s * (1.0f / 1024.0f) + EPS);
}
__device__ __forceinline__ int lane_now() { int t; asm volatile("v_mbcnt_lo_u32_b32 %0, -1, 0\n\tv_mbcnt_hi_u32_b32 %0, -1, %0" : "=v"(t)); return t; }
__device__ __forceinline__ float shfl_idx(float v, int src) { return __int_as_float(__builtin_amdgcn_ds_bpermute(src << 2, __float_as_int(v))); }
__device__ __forceinline__ float shflx(float v, int mask) { return shfl_idx(v, lane_now() ^ mask); }
__device__ __forceinline__ float shfl_row15(float v) { return __int_as_float(__builtin_amdgcn_ds_swizzle(__float_as_int(v), 0x1F0)); }
#define MFMA16(a, b, c) __builtin_amdgcn_mfma_f32_16x16x32_bf16((a), (b), (c), 0, 0, 0)

namespace pg8 {
constexpr int BM = 256, BK = 64, HALF = 128, HTB = HALF * BK * 2, STAGE_BYTES = 8 * HTB, NXCD = 8, WGM = 8;
__device__ __forceinline__ int lds_byte(int r, int c) { const int st = (r >> 4) * 2 + (c >> 5), rr = r & 15, cc = c & 31, ob = rr * 64 + cc * 2; return st * 1024 + (ob ^ (((ob >> 9) & 1) << 5)); }
__device__ __forceinline__ void stage_rc(int b, int& R, int& C) { const int st = b / 1024, sb = b % 1024, swz = sb ^ (((sb >> 9) & 1) << 5); R = (st >> 1) * 16 + swz / 64; C = (st & 1) * 32 + (swz % 64) / 2; }
struct Unit { int pm, pn; };
struct Gemm { const bf16_t* A; const bf16_t* Bt; int M, N, K; };
struct StaticOrder {
    int nM, nN, nwg, G, c;
    __device__ void init(int M, int N, int G_, int c_) { nM = M / BM; nN = N / BM; nwg = nM * nN; G = G_; c = c_; }
    __device__ bool next(int i, Unit& u) const {
        const long L = (long)i * G + c; if (L >= nwg) return false;
        int wgid = (int)L; { const int q = nwg / NXCD, r = nwg % NXCD, xcd = wgid % NXCD, off = wgid / NXCD; wgid = (xcd < r ? xcd * (q + 1) : r * (q + 1) + (xcd - r) * q) + off; }
        const int nig = WGM * nN, gid = wgid / nig, fm = gid * WGM, gsz = (nM - fm) < WGM ? (nM - fm) : WGM;
        u.pm = fm + ((wgid % nig) % gsz); u.pn = (wgid % nig) / gsz; return true;
    }
};

template <class Epi>
__device__ __forceinline__ void gemm_phase(int wv, LAS unsigned char* lds, const Gemm g, const StaticOrder& S, const Epi& E) {
    const int tid = tidx(wv), wid = wv, lane = tid & 63, wr = wid >> 2, wc = wid & 3, fr = lane & 15, fq = lane >> 4;
    const int K = g.K, nt = K / BK;
    unsigned voffA[2];
#pragma unroll
    for (int i = 0; i < 2; ++i) { int R, C; stage_rc(tid * 16 + i * 8192, R, C); voffA[i] = (unsigned)(R * K + C) * 2u; }
    const size_t kstep = (size_t)(BK * 2);
    const size_t hstep = (size_t)HALF * K * 2;
    const size_t tstep = 2 * hstep;
    const unsigned ldsw = (unsigned)wid * 1024u;
    const int aoff = lds_byte(wr * 64 + fr, fq * 8), boff = lds_byte(wc * 32 + fr, fq * 8);
#define PG8_SA(b, h) (((b) * 2 + (h)) * HTB)
#define PG8_SB(b, h) ((4 + (b) * 2 + (h)) * HTB)
#define PG8_STAGE(bufoff, gbase, voff) do { _Pragma("unroll") for (int _i = 0; _i < 2; ++_i) \
        __builtin_amdgcn_global_load_lds((const unsigned*)((const char*)(gbase) + (voff)[_i]), (LAS unsigned*)(lds + (bufoff) + ldsw + _i * 8192), 16, 0, 0); } while (0)
#define PG8_LDA(dst, b, h) do { _Pragma("unroll") for (int m = 0; m < 4; ++m) _Pragma("unroll") for (int k = 0; k < 2; ++k) dst[m][k] = *(const LAS bf16x8*)(lds + PG8_SA(b, h) + aoff + m * 2048 + k * 1024); } while (0)
#define PG8_LDB(dst, b, h) do { _Pragma("unroll") for (int n = 0; n < 2; ++n) _Pragma("unroll") for (int k = 0; k < 2; ++k) dst[n][k] = *(const LAS bf16x8*)(lds + PG8_SB(b, h) + boff + n * 2048 + k * 1024); } while (0)
#define PG8_MMA(ai, bj, At, Bt) do { __builtin_amdgcn_s_setprio(1); _Pragma("unroll") for (int m = 0; m < 4; ++m) _Pragma("unroll") for (int n = 0; n < 2; ++n) _Pragma("unroll") for (int k = 0; k < 2; ++k) \
        acc[ai][bj][m][n] = __builtin_amdgcn_mfma_f32_16x16x32_bf16(Bt[n][k], At[m][k], acc[ai][bj][m][n], 0, 0, 0); __builtin_amdgcn_s_setprio(0); } while (0)
#define PG8_WAIT_V(n) asm volatile("s_waitcnt vmcnt(" #n ")" ::: "memory")
#define PG8_WAIT_L(n) asm volatile("s_waitcnt lgkmcnt(" #n ")" ::: "memory")
#define PG8_BAR __builtin_amdgcn_s_barrier()
#define PG8_SCHED __builtin_amdgcn_sched_barrier(0)
    Unit cur, nxt; int ui = 0;
    if (!S.next(0, cur)) return;
    f32x4 acc[2][2][4][2];
#pragma unroll
    for (int a = 0; a < 2; ++a)
#pragma unroll
        for (int b = 0; b < 2; ++b)
#pragma unroll
            for (int m = 0; m < 4; ++m)
#pragma unroll
                for (int n = 0; n < 2; ++n) acc[a][b][m][n] = (f32x4){0.f, 0.f, 0.f, 0.f};
    bf16x8 At[4][2], B0[2][2], B1[2][2];
    const char* cA = (const char*)g.A + (size_t)cur.pm * tstep; const char* cB = (const char*)g.Bt + (size_t)cur.pn * tstep;
    PG8_STAGE(PG8_SB(0, 0), cB, voffA); PG8_STAGE(PG8_SA(0, 0), cA, voffA); PG8_STAGE(PG8_SB(0, 1), cB + hstep, voffA); PG8_STAGE(PG8_SA(0, 1), cA + hstep, voffA);
    if (wr == 1) PG8_BAR;
    PG8_WAIT_V(4); PG8_BAR;
    PG8_STAGE(PG8_SB(1, 0), cB + kstep, voffA); PG8_STAGE(PG8_SA(1, 0), cA + kstep, voffA); PG8_STAGE(PG8_SB(1, 1), cB + hstep + kstep, voffA);
    PG8_WAIT_V(6); PG8_BAR;
    for (;;) {
        if constexpr (Epi::NEEDS_RSTD) {
            LAS float* rb = (LAS float*)(lds + STAGE_BYTES) + (ui & 1) * 256;
            const int t2 = tidx(wv);
            if (t2 < 256) rb[t2] = rstd_row(E.ssq, cur.pm * 256 + t2);
        }
        const bool has_next = S.next(ui + 1, nxt);
        const char* nA = has_next ? (const char*)g.A + (size_t)nxt.pm * tstep : cA; const char* nB = has_next ? (const char*)g.Bt + (size_t)nxt.pn * tstep : cB;
        for (int t = 0; t < nt; t += 2) {
            const bool last = (t == nt - 2);
            const char* a1 = cA + (size_t)(t + 1) * kstep;
            const char* a2 = last ? nA : cA + (size_t)(t + 2) * kstep; const char* b2 = last ? nB : cB + (size_t)(t + 2) * kstep;
            const char* a3 = a2 + kstep; const char* b3 = b2 + kstep;
            PG8_LDB(B0, 0, 0); PG8_SCHED; PG8_LDA(At, 0, 0); PG8_STAGE(PG8_SA(1, 1), a1 + hstep, voffA);
            PG8_WAIT_L(8); PG8_BAR; PG8_WAIT_L(0); PG8_MMA(0, 0, At, B0); PG8_BAR; PG8_SCHED;
            PG8_LDB(B1, 0, 1); PG8_STAGE(PG8_SB(0, 0), b2, voffA);
            PG8_BAR; PG8_WAIT_L(0); PG8_MMA(0, 1, At, B1); PG8_BAR;
            PG8_LDA(At, 0, 1); PG8_STAGE(PG8_SA(0, 0), a2, voffA);
            PG8_BAR; PG8_WAIT_L(0); PG8_MMA(1, 0, At, B0); PG8_BAR; PG8_SCHED;
            PG8_STAGE(PG8_SB(0, 1), b2 + hstep, voffA);
            PG8_WAIT_V(6); PG8_BAR; PG8_MMA(1, 1, At, B1); PG8_BAR;
            PG8_LDB(B0, 1, 0); PG8_SCHED; PG8_LDA(At, 1, 0); PG8_STAGE(PG8_SA(0, 1), a2 + hstep, voffA);
            PG8_WAIT_L(8); PG8_BAR; PG8_WAIT_L(0); PG8_MMA(0, 0, At, B0); PG8_BAR; PG8_SCHED;
            PG8_LDB(B1, 1, 1); PG8_STAGE(PG8_SB(1, 0), b3, voffA);
            PG8_BAR; PG8_WAIT_L(0); PG8_MMA(0, 1, At, B1); PG8_BAR;
            PG8_LDA(At, 1, 1); PG8_STAGE(PG8_SA(1, 0), a3, voffA);
            PG8_BAR; PG8_WAIT_L(0); PG8_MMA(1, 0, At, B0); PG8_BAR; PG8_SCHED;
            PG8_STAGE(PG8_SB(1, 1), b3 + hstep, voffA);
            PG8_WAIT_V(6); PG8_BAR; PG8_MMA(1, 1, At, B1); PG8_BAR;
            if constexpr (Epi::HAS_MID) { if (!last && ((t + 2) & 15) == 0) E.mid(acc, cur, (t + 2) >> 4, wr, wc, fr, fq); }
        }
        if constexpr (Epi::NEEDS_RSTD) E.rb = (const LAS float*)(lds + STAGE_BYTES) + (ui & 1) * 256;
        E(acc, cur, wr, wc, fr, fq);
        if (!has_next) break;
#pragma unroll
        for (int a = 0; a < 2; ++a)
#pragma unroll
            for (int b = 0; b < 2; ++b)
#pragma unroll
                for (int m = 0; m < 4; ++m)
#pragma unroll
                    for (int n = 0; n < 2; ++n) acc[a][b][m][n] = (f32x4){0.f, 0.f, 0.f, 0.f};
        cur = nxt; cA = nA; cB = nB; ++ui;
    }
    PG8_WAIT_V(0);
    if (wr == 0) PG8_BAR;
    PG8_BAR;
#undef PG8_SA
#undef PG8_SB
#undef PG8_STAGE
#undef PG8_LDA
#undef PG8_LDB
#undef PG8_MMA
#undef PG8_WAIT_V
#undef PG8_WAIT_L
#undef PG8_BAR
#undef PG8_SCHED
}
}
using pg8::Unit;
typedef f32x4 AccT[2][2][4][2];

struct EpiGU {
    static constexpr bool HAS_MID = false, NEEDS_RSTD = true;
    const float* ssq; bf16_t* hff; mutable const LAS float* rb;
    __device__ __forceinline__ void mid(AccT&, const Unit&, int, int, int, int, int) const {}
    __device__ __forceinline__ void operator()(const AccT& acc, const Unit& u, int wr, int wc, int fr_, int fq_) const {
        int fr = fr_, fq = fq_; asm volatile("" : "+v"(fr), "+v"(fq));
        const int row0 = u.pm * 256 + wr * 64 + fr, hc0 = u.pn * 128 + wc * 32 + fq * 8;
#pragma unroll
        for (int ai = 0; ai < 2; ++ai)
#pragma unroll
            for (int m = 0; m < 4; ++m) {
                const int r = row0 + ai * 128 + m * 16; const float rs = rb[wr * 64 + fr + ai * 128 + m * 16];
                u32x4 w;
                { const f32x4 gt = acc[ai][0][m][0] * rs, up = acc[ai][0][m][1] * rs;
                  w.x = pk2(siluf_(gt[0]) * up[0], siluf_(gt[1]) * up[1]); w.y = pk2(siluf_(gt[2]) * up[2], siluf_(gt[3]) * up[3]); }
                { const f32x4 gt = acc[ai][1][m][0] * rs, up = acc[ai][1][m][1] * rs;
                  w.z = pk2(siluf_(gt[0]) * up[0], siluf_(gt[1]) * up[1]); w.w = pk2(siluf_(gt[2]) * up[2], siluf_(gt[3]) * up[3]); }
                *(u32x4*)(hff + (size_t)r * DFF + hc0) = w;
            }
    }
};
struct EpiRes {
    static constexpr bool HAS_MID = false, NEEDS_RSTD = false;
    float* x; bf16_t* xb; float* ssq; float scale;
    __device__ __forceinline__ void mid(AccT&, const Unit&, int, int, int, int, int) const {}
    __device__ __forceinline__ void operator()(const AccT& acc, const Unit& u, int wr, int wc, int fr_, int fq_) const {
        int fr = fr_, fq = fq_; asm volatile("" : "+v"(fr), "+v"(fq));
        const int row0 = u.pm * 256 + wr * 64 + fr, col0 = u.pn * 256 + wc * 32 + 8 * fq;
#pragma unroll
        for (int ai = 0; ai < 2; ++ai) {
            f32x4 xv[4][2][2];
#pragma unroll
            for (int m = 0; m < 4; ++m)
#pragma unroll
                for (int bj = 0; bj < 2; ++bj)
#pragma unroll
                    for (int n = 0; n < 2; ++n) xv[m][bj][n] = *(const f32x4*)(x + (size_t)(row0 + ai * 128 + m * 16) * DM + col0 + bj * 128 + n * 4);
#pragma unroll
            for (int m = 0; m < 4; ++m) {
                const int r = row0 + ai * 128 + m * 16; float ss = 0.f;
#pragma unroll
                for (int bj = 0; bj < 2; ++bj) {
                    const int c = col0 + bj * 128;
                    const f32x4 v0 = xv[m][bj][0] + acc[ai][bj][m][0] * scale, v1 = xv[m][bj][1] + acc[ai][bj][m][1] * scale;
                    *(f32x4*)(x + (size_t)r * DM + c) = v0; *(f32x4*)(x + (size_t)r * DM + c + 4) = v1;
                    u32x4 w; w.x = pk2(v0[0], v0[1]); w.y = pk2(v0[2], v0[3]); w.z = pk2(v1[0], v1[1]); w.w = pk2(v1[2], v1[3]);
                    *(u32x4*)(xb + (size_t)r * DM + c) = w;
                    ss += v0[0] * v0[0] + v0[1] * v0[1] + v0[2] * v0[2] + v0[3] * v0[3] + v1[0] * v1[0] + v1[1] * v1[1] + v1[2] * v1[2] + v1[3] * v1[3];
                }
                ss += shflx(ss, 16); ss += shflx(ss, 32);
                if (fq == 0) ssq[(size_t)r * 16 + u.pn * 4 + wc] = ss;
            }
        }
    }
};
struct EpiIn {
    static constexpr bool HAS_MID = false, NEEDS_RSTD = true;
    const float* ssq; bf16_t* h; float* dtraw; mutable const LAS float* rb;
    __device__ __forceinline__ void mid(AccT&, const Unit&, int, int, int, int, int) const {}
    __device__ __forceinline__ void operator()(const AccT& acc, const Unit& u, int wr, int wc, int fr_, int fq_) const {
        int fr = fr_, fq = fq_; asm volatile("" : "+v"(fr), "+v"(fq));
        const int row0 = u.pm * 256 + wr * 64 + fr, col0 = u.pn * 256 + wc * 32 + 8 * fq;
#pragma unroll
        for (int ai = 0; ai < 2; ++ai)
#pragma unroll
            for (int m = 0; m < 4; ++m) {
                const int r = row0 + ai * 128 + m * 16; const float rs = rb[wr * 64 + fr + ai * 128 + m * 16];
                if (u.pn < 36) {
#pragma unroll
                    for (int bj = 0; bj < 2; ++bj) {
                        const f32x4 v0 = acc[ai][bj][m][0] * rs, v1 = acc[ai][bj][m][1] * rs;
                        u32x4 w; w.x = pk2(v0[0], v0[1]); w.y = pk2(v0[2], v0[3]); w.z = pk2(v1[0], v1[1]); w.w = pk2(v1[2], v1[3]);
                        *(u32x4*)(h + (size_t)r * HP + col0 + bj * 128) = w;
                    }
                } else if (wc == 0 && fq < 2) {
                    *(f32x4*)(dtraw + (size_t)r * 16 + 8 * fq) = acc[ai][0][m][0] * rs;
                    *(f32x4*)(dtraw + (size_t)r * 16 + 8 * fq + 4) = acc[ai][0][m][1] * rs;
                }
            }
    }
};
struct EpiMerge {
    static constexpr bool HAS_MID = true, NEEDS_RSTD = false;
    const bf16_t* h; bf16_t* merged;
    __device__ __forceinline__ void mid(AccT& acc, const Unit& u, int seg, int wr, int wc, int fr_, int fq_) const {
        int fr = fr_, fq = fq_; asm volatile("" : "+v"(fr), "+v"(fq));
        const int row0 = u.pm * 256 + wr * 64 + fr, col0 = u.pn * 256 + wc * 32 + 8 * fq;
#pragma unroll
        for (int ai = 0; ai < 2; ++ai) {
            u32x2 ga[4][2][2], gb[4][2][2];
#pragma unroll
            for (int m = 0; m < 4; ++m)
#pragma unroll
                for (int bj = 0; bj < 2; ++bj)
#pragma unroll
                    for (int n = 0; n < 2; ++n) {
                        const bf16_t* gp = h + (size_t)(row0 + ai * 128 + m * 16) * HP + HGATE + (seg - 1) * 1024 + col0 + bj * 128 + n * 4;
                        ga[m][bj][n] = *(const u32x2*)gp; gb[m][bj][n] = *(const u32x2*)(gp + 1024);
                    }
#pragma unroll
            for (int m = 0; m < 4; ++m)
#pragma unroll
                for (int bj = 0; bj < 2; ++bj)
#pragma unroll
                    for (int n = 0; n < 2; ++n) {
                        const u32x2 a = ga[m][bj][n], b = gb[m][bj][n];
                        f32x4 f;
                        f[0] = (1.f + __expf(-fmaxf(bflo(b.x), -30.f))) * rcpf_(1.f + __expf(-fmaxf(bflo(a.x), -30.f)));
                        f[1] = (1.f + __expf(-fmaxf(bfhi(b.x), -30.f))) * rcpf_(1.f + __expf(-fmaxf(bfhi(a.x), -30.f)));
                        f[2] = (1.f + __expf(-fmaxf(bflo(b.y), -30.f))) * rcpf_(1.f + __expf(-fmaxf(bflo(a.y), -30.f)));
                        f[3] = (1.f + __expf(-fmaxf(bfhi(b.y), -30.f))) * rcpf_(1.f + __expf(-fmaxf(bfhi(a.y), -30.f)));
                        acc[ai][bj][m][n] *= f;
                    }
        }
    }
    __device__ __forceinline__ void operator()(const AccT& acc, const Unit& u, int wr, int wc, int fr_, int fq_) const {
        int fr = fr_, fq = fq_; asm volatile("" : "+v"(fr), "+v"(fq));
        const int row0 = u.pm * 256 + wr * 64 + fr, col0 = u.pn * 256 + wc * 32 + 8 * fq;
#pragma unroll
        for (int ai = 0; ai < 2; ++ai) {
            u32x2 gv[4][2][2];
#pragma unroll
            for (int m = 0; m < 4; ++m)
#pragma unroll
                for (int bj = 0; bj < 2; ++bj)
#pragma unroll
                    for (int n = 0; n < 2; ++n) gv[m][bj][n] = *(const u32x2*)(h + (size_t)(row0 + ai * 128 + m * 16) * HP + HGATE + 2048 + col0 + bj * 128 + n * 4);
#pragma unroll
            for (int m = 0; m < 4; ++m)
#pragma unroll
                for (int bj = 0; bj < 2; ++bj)
#pragma unroll
                    for (int n = 0; n < 2; ++n) {
                        const u32x2 ga = gv[m][bj][n];
                        const f32x4 v = acc[ai][bj][m][n];
                        u32x2 w;
                        w.x = pk2(v[0] * rcpf_(1.f + __expf(-fmaxf(bflo(ga.x), -30.f))), v[1] * rcpf_(1.f + __expf(-fmaxf(bfhi(ga.x), -30.f))));
                        w.y = pk2(v[2] * rcpf_(1.f + __expf(-fmaxf(bflo(ga.y), -30.f))), v[3] * rcpf_(1.f + __expf(-fmaxf(bfhi(ga.y), -30.f))));
                        *(u32x2*)(merged + (size_t)(row0 + ai * 128 + m * 16) * DM + col0 + bj * 128 + n * 4) = w;
                    }
        }
    }
};

template <class Epi> __device__ __forceinline__ void run_gemm(int wv, LAS unsigned char* lds, const bf16_t* A, const bf16_t* Bt, int M, int N, int K, const Epi& E) {
    asm volatile("" : "+s"(wv));
    pg8::Gemm g; g.A = A; g.Bt = Bt; g.M = M; g.N = N; g.K = K;
    pg8::StaticOrder S; S.init(M, N, (int)gdim(), (int)bidx());
    pg8::gemm_phase<Epi>(wv, lds, g, S, E);
}


template <int MODE>
__device__ __forceinline__ void skinny_gemm(int wv, LAS unsigned char* lds, KP P, const bf16_t* A, const bf16_t* Bt, int K, float scale) {
    const int tid = tidx(wv), w = tid >> 6, lane = tid & 63, fr = lane & 15, fq = lane >> 4;
    LAS float* part = (LAS float*)lds;
    constexpr int NSEG = MODE ? 3 : 1;
    const int kseg = K / NSEG, kw = kseg / 8;
    const bf16_t* h = (const bf16_t*)(P->ws + WS_H);
    for (int task = bidx(); task < 256; task += gdim()) {
        const int rt = task >> 5, ct = task & 31;
        f32x4 tot[2][2];
#pragma unroll
        for (int i = 0; i < 2; ++i)
#pragma unroll
            for (int j = 0; j < 2; ++j) tot[i][j] = (f32x4){0.f, 0.f, 0.f, 0.f};
#pragma unroll 1
        for (int seg = 0; seg < NSEG; ++seg) {
            f32x4 acc[2][2];
#pragma unroll
            for (int i = 0; i < 2; ++i)
#pragma unroll
                for (int j = 0; j < 2; ++j) acc[i][j] = (f32x4){0.f, 0.f, 0.f, 0.f};
            const bf16_t* ap = A + (size_t)(rt * 32 + fr) * K + seg * kseg + w * kw + fq * 8;
            const bf16_t* bp = Bt + (size_t)(ct * 32 + fr) * K + seg * kseg + w * kw + fq * 8;
#pragma unroll 2
            for (int k = 0; k < kw; k += 32) {
                const bf16x8 a0 = *(const bf16x8*)(ap + k), a1 = *(const bf16x8*)(ap + (size_t)16 * K + k);
                const bf16x8 b0 = *(const bf16x8*)(bp + k), b1 = *(const bf16x8*)(bp + (size_t)16 * K + k);
                acc[0][0] = MFMA16(b0, a0, acc[0][0]); acc[0][1] = MFMA16(b1, a0, acc[0][1]);
                acc[1][0] = MFMA16(b0, a1, acc[1][0]); acc[1][1] = MFMA16(b1, a1, acc[1][1]);
            }
#pragma unroll
            for (int i = 0; i < 2; ++i)
#pragma unroll
                for (int j = 0; j < 2; ++j) {
                    if (MODE) {
                        const u32x2 gw = *(const u32x2*)(h + (size_t)(MP + rt * 32 + i * 16 + fr) * HP + HGATE + seg * 1024 + ct * 32 + 8 * fq + 4 * j);
                        f32x4 sg; sg[0] = sigmoidf_(bflo(gw.x)); sg[1] = sigmoidf_(bfhi(gw.x)); sg[2] = sigmoidf_(bflo(gw.y)); sg[3] = sigmoidf_(bfhi(gw.y));
                        tot[i][j] += acc[i][j] * sg;
                    } else tot[i][j] = acc[i][j];
                }
        }
        __syncthreads();
#pragma unroll
        for (int i = 0; i < 2; ++i)
#pragma unroll
            for (int j = 0; j < 2; ++j) *(LAS f32x4*)(part + (w * 32 + i * 16 + fr) * 36 + 8 * fq + 4 * j) = tot[i][j];
        __syncthreads();
        const int row = tid >> 4, c2 = (tid & 15) * 2;
        float v0 = 0.f, v1 = 0.f;
#pragma unroll
        for (int ww = 0; ww < 8; ++ww) { v0 += part[(ww * 32 + row) * 36 + c2]; v1 += part[(ww * 32 + row) * 36 + c2 + 1]; }
        const int r = MP + rt * 32 + row, c = ct * 32 + c2;
        if (MODE) {
            *(unsigned*)((bf16_t*)(P->ws + WS_ST) + (size_t)r * DM + c) = pk2(v0, v1);
        } else {
            float* xp = P->out + (size_t)r * DM + c;
            const float x0 = xp[0] + scale * v0, x1 = xp[1] + scale * v1;
            xp[0] = x0; xp[1] = x1;
            *(unsigned*)((bf16_t*)(P->ws + WS_XB) + (size_t)r * DM + c) = pk2(x0, x1);
            float ss = x0 * x0 + x1 * x1;
            ss += shflx(ss, 1); ss += shflx(ss, 2); ss += shflx(ss, 4); ss += shflx(ss, 8);
            if ((tid & 15) == 0) {
                float* ssq = (float*)(P->ws + WS_SSQ);
                if (ct < 16) ssq[(size_t)r * 16 + ct] = ss; else ssq[(WS_SSQ2 - WS_SSQ) / 4 + (size_t)(r - MP) * 16 + (ct - 16)] = ss;
            }
        }
    }
}

struct CvtJob { const float* src; const float* gk; bf16_t* dst; int src_ld, dst_ld, k0, nsrc0, nvalid, rowbase, kind, which; };
__device__ __forceinline__ bool cvt_decode(KP P, int l, int part, int job, CvtJob& J) {
    constexpr int J_GU = 2 * 2 * 16 * 44, J_DN = 2 * 44 * 16, J_IN = 16 * 145, J_BR = 48 * 16, J_OUT = 16 * 16;
    int j = job; J.gk = nullptr; J.kind = 0; J.which = 0; J.nvalid = 64;
    if (j < J_GU) {
        const int nt = j % 44; j /= 44; const int kt = j % 16; j /= 16; const int which = j & 1, j2 = j >> 1;
        if (j2 != part) return false;
        J.src = P->in[which ? I_WU : I_WG] + (size_t)(l * 2 + j2) * 1024 * 2816; J.src_ld = 2816; J.k0 = kt * 64; J.nsrc0 = nt * 64;
        J.gk = P->in[I_FNORM] + (l * 2 + j2) * 1024; J.dst = (bf16_t*)(P->ws + (j2 ? W_GU1 : W_GU0)); J.dst_ld = 1024; J.rowbase = nt * 64; J.kind = 1; J.which = which;
        return true;
    }
    j -= J_GU;
    if (j < J_DN) {
        const int nt = j % 16; j /= 16; const int kt = j % 44; const int j2 = j / 44;
        if (j2 != part) return false;
        J.src = P->in[I_WD] + (size_t)(l * 2 + j2) * 2816 * 1024; J.src_ld = 1024; J.k0 = kt * 64; J.nsrc0 = nt * 64;
        J.dst = (bf16_t*)(P->ws + (j2 ? W_DN1 : W_DN0)); J.dst_ld = 2816; J.rowbase = nt * 64; J.kind = 2;
        return true;
    }
    j -= J_DN;
    if (j < J_IN) {
        if (part != 0) return false;
        const int nt = j % 145, kt = j / 145;
        J.src = P->in[I_WIN] + (size_t)l * 1024 * NIN; J.src_ld = NIN; J.k0 = kt * 64; J.nsrc0 = nt < 72 ? nt * 64 : (nt < 144 ? nt * 64 + 16 : 4608); J.nvalid = nt < 144 ? 64 : 16;
        J.gk = P->in[I_MNORM] + l * 1024; J.dst = (bf16_t*)(P->ws + W_IN); J.dst_ld = 1024; J.rowbase = nt * 64; J.kind = 2;
        return true;
    }
    j -= J_IN;
    if (j < J_BR) {
        if (part != 1) return false;
        const int nt = j % 16, kt = j / 16;
        J.src = P->in[I_WBR] + (size_t)l * 3072 * 1024; J.src_ld = 1024; J.k0 = kt * 64; J.nsrc0 = nt * 64; J.dst = (bf16_t*)(P->ws + W_BR); J.dst_ld = 3072; J.rowbase = nt * 64; J.kind = 2;
        return true;
    }
    j -= J_BR;
    if (j < J_OUT) {
        if (part != 1) return false;
        const int nt = j % 16, kt = j / 16;
        J.src = P->in[I_WOUT] + (size_t)l * 1024 * 1024; J.src_ld = 1024; J.k0 = kt * 64; J.nsrc0 = nt * 64; J.dst = (bf16_t*)(P->ws + W_OUT); J.dst_ld = 1024; J.rowbase = nt * 64; J.kind = 2;
        return true;
    }
    j -= J_OUT;
    if (part != 0) return false;
    const int blk = j & 15, which = j >> 4;
    J.src = P->in[which ? I_LWX : I_LWA] + (size_t)(l * 16 + blk) * 4096; J.src_ld = 64; J.k0 = 0; J.nsrc0 = 0;
    J.dst = (bf16_t*)(P->ws + (which ? W_LX : W_LA)) + (l & 1) * 65536 + blk * 4096; J.dst_ld = 64; J.rowbase = 0;
    return true;
}
__device__ __forceinline__ void cvt_load(const CvtJob& J, int tid, f32x4& v0, f32x4& v1, float& g0, float& g1) {
    const int kk = tid >> 4, n4 = (tid & 15) * 4;
    v0 = (f32x4){0.f, 0.f, 0.f, 0.f}; v1 = v0;
    if (n4 < J.nvalid) {
        v0 = __builtin_nontemporal_load((const f32x4*)(J.src + (size_t)(J.k0 + kk) * J.src_ld + J.nsrc0 + n4)); v1 = __builtin_nontemporal_load((const f32x4*)(J.src + (size_t)(J.k0 + kk + 32) * J.src_ld + J.nsrc0 + n4)); }
    g0 = J.gk ? J.gk[J.k0 + kk] : 1.0f; g1 = J.gk ? J.gk[J.k0 + kk + 32] : 1.0f;
}
__device__ __forceinline__ void convert_layer(int wv, KP P, int l, int part, int nb, LAS unsigned char* lds) {
    LAS float* tile = (LAS float*)lds;
    constexpr int J_TOT = 2 * 2 * 16 * 44 + 2 * 44 * 16 + 16 * 145 + 48 * 16 + 16 * 16 + 32;
    const int tid = tidx(wv), stride = nb;
    int job = bidx() < nb ? bidx() : J_TOT;
    CvtJob cur, nxt; bool have = false, hn = false;
    while (job < J_TOT && !have) { have = cvt_decode(P, l, part, job, cur); job += stride; }
    f32x4 v0, v1, n0, n1; float g0 = 1.f, g1 = 1.f, h0 = 1.f, h1 = 1.f;
    v0 = (f32x4){0.f, 0.f, 0.f, 0.f}; v1 = v0; n0 = v0; n1 = v0;
    if (have) cvt_load(cur, tid, v0, v1, g0, g1);
    __syncthreads();
    while (have) {
        hn = false;
        while (job < J_TOT && !hn) { hn = cvt_decode(P, l, part, job, nxt); job += stride; }
        if (hn) cvt_load(nxt, tid, n0, n1, h0, h1);
        {
            const int kk = tid >> 4, n4 = (tid & 15) * 4;
            tile[kk * 65 + n4 + 0] = v0[0] * g0; tile[kk * 65 + n4 + 1] = v0[1] * g0; tile[kk * 65 + n4 + 2] = v0[2] * g0; tile[kk * 65 + n4 + 3] = v0[3] * g0;
            tile[(kk + 32) * 65 + n4 + 0] = v1[0] * g1; tile[(kk + 32) * 65 + n4 + 1] = v1[1] * g1; tile[(kk + 32) * 65 + n4 + 2] = v1[2] * g1; tile[(kk + 32) * 65 + n4 + 3] = v1[3] * g1;
        }
        asm volatile("s_waitcnt lgkmcnt(0)\n\ts_barrier" ::: "memory");
        {
            const int nl = tid >> 3, k8 = (tid & 7) * 8;
            if (nl < cur.nvalid) {
                u32x4 w;
                w.x = pk2(tile[(k8 + 0) * 65 + nl], tile[(k8 + 1) * 65 + nl]); w.y = pk2(tile[(k8 + 2) * 65 + nl], tile[(k8 + 3) * 65 + nl]);
                w.z = pk2(tile[(k8 + 4) * 65 + nl], tile[(k8 + 5) * 65 + nl]); w.w = pk2(tile[(k8 + 6) * 65 + nl], tile[(k8 + 7) * 65 + nl]);
                int row = cur.rowbase + nl;
                if (cur.kind == 1) { const int hc = row; row = 256 * (hc >> 7) + 128 * ((hc >> 2) & 1) + 32 * ((hc >> 5) & 3) + 16 * cur.which + 4 * ((hc >> 3) & 3) + (hc & 3); }
                else if (cur.kind == 2) { const int c = row; row = (c & ~31) + 16 * ((c >> 2) & 1) + 4 * ((c >> 3) & 3) + (c & 3); }
                *(u32x4*)(cur.dst + (size_t)row * cur.dst_ld + cur.k0 + k8) = w;
            }
        }
        asm volatile("s_waitcnt lgkmcnt(0)\n\ts_barrier" ::: "memory");
        cur = nxt; v0 = n0; v1 = n1; g0 = h0; g1 = h1; have = hn;
    }
    __syncthreads();
}

__device__ __forceinline__ void phase_init(int wv, KP P) {
    const int w = tidx(wv) >> 6, lane = tidx(wv) & 63;
    float* x = P->out; bf16_t* xb = (bf16_t*)(P->ws + WS_XB); float* ssq = (float*)(P->ws + WS_SSQ);
    for (int row = bidx() * 8 + w; row < MT; row += gdim() * 8) {
        const float* src = row < MP ? P->in[I_XP] + (size_t)row * DM : P->in[I_XS] + (size_t)(row - MP) * DM;
        float ss = 0.f;
        f32x4 vv[4];
#pragma unroll
        for (int i = 0; i < 4; ++i) vv[i] = __builtin_nontemporal_load((const f32x4*)(src + (i * 64 + lane) * 4));
#pragma unroll
        for (int i = 0; i < 4; ++i) {
            const int c = (i * 64 + lane) * 4;
            const f32x4 v = vv[i];
            *(f32x4*)(x + (size_t)row * DM + c) = v;
            u32x2 pw; pw.x = pk2(v[0], v[1]); pw.y = pk2(v[2], v[3]);
            *(u32x2*)(xb + (size_t)row * DM + c) = pw;
            ss += v[0] * v[0] + v[1] * v[1] + v[2] * v[2] + v[3] * v[3];
        }
#pragma unroll
        for (int d = 32; d >= 1; d >>= 1) ss += shflx(ss, d);
        if (lane < 16) ssq[(size_t)row * 16 + lane] = lane == 0 ? ss : 0.f;
        if (row >= MP && lane < 16) ssq[(WS_SSQ2 - WS_SSQ) / 4 + (size_t)(row - MP) * 16 + lane] = 0.f;
    }
}
__device__ __forceinline__ void phase_final(int wv, KP P) {
    const int w = tidx(wv) >> 6, lane = tidx(wv) & 63;
    float* x = P->out; const float* ssq = (const float*)(P->ws + WS_SSQ); const float* gf = P->in[I_FINAL];
    for (int row = bidx() * 8 + w; row < MT; row += gdim() * 8) {
        const float rs = rstd_row(ssq, row);
        f32x4 vv[4], gg[4];
#pragma unroll
        for (int i = 0; i < 4; ++i) { const int c = (i * 64 + lane) * 4; vv[i] = *(const f32x4*)(x + (size_t)row * DM + c); gg[i] = *(const f32x4*)(gf + c); }
#pragma unroll
        for (int i = 0; i < 4; ++i) { const int c = (i * 64 + lane) * 4; *(f32x4*)(x + (size_t)row * DM + c) = vv[i] * rs * gg[i]; }
    }
}

struct Item { int row0, L, b, c, sb, sample; };
__device__ __forceinline__ Item get_item(int it) {
    Item I;
    if (it < 256) { I.b = it >> 7; I.c = it & 127; I.row0 = I.b * 8192 + I.c * 64; I.L = 64; I.sample = 0; I.sb = 0; }
    else { I.sb = it - 256; I.b = 0; I.c = 0; I.row0 = MP + I.sb * 16; I.L = 16; I.sample = 1; }
    return I;
}

__device__ __forceinline__ void copy_states_item(int wv, KP P, int l, const Item& I) {
    const bf16_t* h = (const bf16_t*)(P->ws + WS_H);
    const int tid = tidx(wv);
    if (!I.sample) {
        if (I.c >= 126) {
            {
                const int cc = (tid & 63) * 8, kv = cc >> 8, e = cc & 255;
                u32x4 w4[8];
#pragma unroll
                for (int q = 0; q < 8; ++q) w4[q] = *(const u32x4*)(h + (size_t)(I.row0 + (tid >> 6) + 8 * q) * HP + (kv ? HV : HK) + e);
#pragma unroll
                for (int q = 0; q < 8; ++q) {
                    const int t = (tid >> 6) + 8 * q;
                    float* op = P->out + (kv ? O_PV : O_PK) + ((size_t)(l * 2 + I.b) * 128 + (I.c - 126) * 64 + t) * 256 + e;
                    *(f32x4*)op = (f32x4){bflo(w4[q].x), bfhi(w4[q].x), bflo(w4[q].y), bfhi(w4[q].y)};
                    *(f32x4*)(op + 4) = (f32x4){bflo(w4[q].z), bfhi(w4[q].z), bflo(w4[q].w), bfhi(w4[q].w)};
                }
            }
        }
        if (I.c == 127) {
            for (int idx = tid; idx < 3 * 1024; idx += 512) { const int j = idx >> 10, ch = idx & 1023;
                P->out[O_PLC + ((size_t)(l * 2 + I.b) * 3 + j) * 1024 + ch] = bf2f(h[(size_t)(I.row0 + 61 + j) * HP + HX + ch]); }
            for (int idx = tid; idx < 3 * 1536; idx += 512) { const int j = idx / 1536, ch = idx % 1536;
                P->out[O_PSC + ((size_t)(l * 2 + I.b) * 3 + j) * 1536 + ch] = bf2f(h[(size_t)(I.row0 + 61 + j) * HP + HXBC + ch]); }
        }
    } else {
        for (int idx = tid; idx < 128 * 512; idx += 512) {
            const int j = idx >> 9, cc = idx & 511, kv = cc >> 8, e = cc & 255;
            float v;
            if (j < 112) v = P->in[kv ? I_CV : I_CK][((size_t)(l * 16 + I.sb) * 128 + j + 16) * 256 + e];
            else v = bf2f(h[(size_t)(I.row0 + j - 112) * HP + (kv ? HV : HK) + e]);
            P->out[(kv ? O_SV : O_SK) + ((size_t)(l * 16 + I.sb) * 128 + j) * 256 + e] = v;
        }
        for (int idx = tid; idx < 3 * 1024; idx += 512) { const int j = idx >> 10, ch = idx & 1023;
            P->out[O_SLC + ((size_t)(l * 16 + I.sb) * 3 + j) * 1024 + ch] = bf2f(h[(size_t)(I.row0 + 13 + j) * HP + HX + ch]); }
        for (int idx = tid; idx < 3 * 1536; idx += 512) { const int j = idx / 1536, ch = idx % 1536;
            P->out[O_SSC + ((size_t)(l * 16 + I.sb) * 3 + j) * 1536 + ch] = bf2f(h[(size_t)(I.row0 + 13 + j) * HP + HXBC + ch]); }
    }
}

template <int L>
__device__ __forceinline__ void attn_item(int wv, KP P, int l, const Item& I, LAS unsigned char* lds) {
    constexpr int NS = (L == 64) ? 192 : 160;
    constexpr int NST = NS / 16, NKS = NS / 32, NQT = L / 16;
    const bf16_t* h = (const bf16_t*)(P->ws + WS_H);
    bf16_t* yabc = (bf16_t*)(P->ws + WS_Y);
    const int tid = tidx(wv), w = tid >> 6, lane = tid & 63, fr = lane & 15, fq = lane >> 4;
    LAS bf16_t* Kl = (LAS bf16_t*)lds;
    LAS bf16_t* Vt = Kl + 2 * 192 * 72;
    for (int pass = 0; pass < 2; ++pass) {
        __syncthreads();
        for (int idx = tid; idx < 2 * NS * 8; idx += 512) {
            const int dp = idx & 7, s = (idx >> 3) % NS, kvl = idx / (8 * NS), kvh = pass * 2 + kvl;
            u32x4 kw = (u32x4){0u, 0u, 0u, 0u}, vw = (u32x4){0u, 0u, 0u, 0u};
            if (L == 64) {
                const int pos = (I.c - 2) * 64 + s;
                if (pos >= 0) {
                    const bf16_t* rp = h + (size_t)(I.b * 8192 + pos) * HP + kvh * 64 + dp * 8;
                    kw = *(const u32x4*)(rp + HK); vw = *(const u32x4*)(rp + HV);
                }
            } else {
                if (s < 128) {
                    const size_t o = ((size_t)(l * 16 + I.sb) * 128 + s) * 256 + kvh * 64 + dp * 8;
                    const f32x4 k0 = *(const f32x4*)(P->in[I_CK] + o), k1 = *(const f32x4*)(P->in[I_CK] + o + 4);
                    const f32x4 v0 = *(const f32x4*)(P->in[I_CV] + o), v1 = *(const f32x4*)(P->in[I_CV] + o + 4);
                    kw.x = pk2(k0[0], k0[1]); kw.y = pk2(k0[2], k0[3]); kw.z = pk2(k1[0], k1[1]); kw.w = pk2(k1[2], k1[3]);
                    vw.x = pk2(v0[0], v0[1]); vw.y = pk2(v0[2], v0[3]); vw.z = pk2(v1[0], v1[1]); vw.w = pk2(v1[2], v1[3]);
                } else if (s < 144) {
                    const bf16_t* rp = h + (size_t)(I.row0 + s - 128) * HP + kvh * 64 + dp * 8;
                    kw = *(const u32x4*)(rp + HK); vw = *(const u32x4*)(rp + HV);
                }
            }
            *(LAS u32x4*)(Kl + (kvl * 192 + s) * 72 + dp * 8) = kw;
            LAS bf16_t* vp = Vt + (kvl * 64 + dp * 8) * 200 + s;
            vp[0 * 200] = (bf16_t)(vw.x & 0xffffu); vp[1 * 200] = (bf16_t)(vw.x >> 16); vp[2 * 200] = (bf16_t)(vw.y & 0xffffu); vp[3 * 200] = (bf16_t)(vw.y >> 16);
            vp[4 * 200] = (bf16_t)(vw.z & 0xffffu); vp[5 * 200] = (bf16_t)(vw.z >> 16); vp[6 * 200] = (bf16_t)(vw.w & 0xffffu); vp[7 * 200] = (bf16_t)(vw.w >> 16);
        }
        __syncthreads();
        const int head = pass * 8 + w, kvl = w >> 2;
        const float slope = exp2f(-0.5f * (float)(head + 1));
        const float sink = P->in[I_SINK][l * 16 + head];
        const bf16_t* qbase = h + (size_t)(I.row0 + fr) * HP + HQ + head * 64 + fq * 8;
        bf16x8 q0 = *(const bf16x8*)qbase, q1 = *(const bf16x8*)(qbase + 32);
#pragma unroll 1
        for (int qt = 0; qt < NQT; ++qt) {
            bf16x8 nq0 = q0, nq1 = q1;
            if (qt + 1 < NQT) { const bf16_t* qp = qbase + (size_t)(qt + 1) * 16 * HP; nq0 = *(const bf16x8*)qp; nq1 = *(const bf16x8*)(qp + 32); }
            f32x4 st[NST];
#pragma unroll
            for (int t = 0; t < NST; ++t) {
                const LAS bf16_t* kp = Kl + (kvl * 192 + t * 16 + fr) * 72 + fq * 8;
                f32x4 a = (f32x4){0.f, 0.f, 0.f, 0.f};
                a = MFMA16(*(const LAS bf16x8*)kp, q0, a);
                a = MFMA16(*(const LAS bf16x8*)(kp + 32), q1, a);
                st[t] = a;
                if ((t % 6) == 5) __builtin_amdgcn_sched_barrier(0);
            }
            const int qpos = (L == 64) ? (I.c * 64 + qt * 16 + fr) : (4096 + fr);
            float mx = sink;
#pragma unroll
            for (int t = 0; t < NST; ++t)
#pragma unroll
                for (int jj = 0; jj < 4; ++jj) {
                    const int s = t * 16 + fq * 4 + jj;
                    const int kpos = (L == 64) ? ((I.c - 2) * 64 + s) : (3968 + s);
                    const bool vis = (L == 64) ? (kpos >= 0) : (s < 144);
                    const float d = fabsf((float)(qpos - kpos));
                    const float sc = vis ? (st[t][jj] * 0.125f - slope * d) : -INFINITY;
                    st[t][jj] = sc; mx = fmaxf(mx, sc);
                }
            mx = fmaxf(mx, shflx(mx, 16)); mx = fmaxf(mx, shflx(mx, 32));
            float sum = 0.f;
#pragma unroll
            for (int t = 0; t < NST; ++t)
#pragma unroll
                for (int jj = 0; jj < 4; ++jj) { const float p = __expf(st[t][jj] - mx); st[t][jj] = p; sum += p; }
            sum += shflx(sum, 16); sum += shflx(sum, 32);
            const float inv = 1.0f / (sum + __expf(sink - mx));
            f32x4 o[4];
#pragma unroll
            for (int dt = 0; dt < 4; ++dt) o[dt] = (f32x4){0.f, 0.f, 0.f, 0.f};
#pragma unroll
            for (int ks = 0; ks < NKS; ++ks) {
                u32x4 pw; pw.x = pk2(st[2 * ks][0], st[2 * ks][1]); pw.y = pk2(st[2 * ks][2], st[2 * ks][3]);
                pw.z = pk2(st[2 * ks + 1][0], st[2 * ks + 1][1]); pw.w = pk2(st[2 * ks + 1][2], st[2 * ks + 1][3]);
                bf16x8 pf; __builtin_memcpy(&pf, &pw, 16);
#pragma unroll
                for (int dt = 0; dt < 4; ++dt) {
                    const LAS bf16_t* vp = Vt + (kvl * 64 + dt * 16 + fr) * 200 + ks * 32 + fq * 4;
                    const u32x2 va = *(const LAS u32x2*)vp, vb = *(const LAS u32x2*)(vp + 16);
                    u32x4 vw; vw.x = va.x; vw.y = va.y; vw.z = vb.x; vw.w = vb.y;
                    bf16x8 vf; __builtin_memcpy(&vf, &vw, 16);
                    o[dt] = MFMA16(vf, pf, o[dt]);
                }
            }
            bf16_t* op = yabc + (size_t)(I.row0 + qt * 16 + fr) * 3072 + 2048 + head * 64 + fq * 4;
#pragma unroll
            for (int dt = 0; dt < 4; ++dt) {
                u32x2 ow; ow.x = pk2(o[dt][0] * inv, o[dt][1] * inv); ow.y = pk2(o[dt][2] * inv, o[dt][3] * inv);
                *(u32x2*)(op + dt * 16) = ow;
            }
            q0 = nq0; q1 = nq1;
        }
    }
}

template <int CTRL> __device__ __forceinline__ float dpp_f(float old, float src) {
    return __int_as_float(__builtin_amdgcn_update_dpp(__float_as_int(old), __float_as_int(src), CTRL, 0xf, 0xf, false));
}
template <int L, bool FINAL>
__device__ __forceinline__ void lru_item(int wv, KP P, int l, int item, const Item& I, LAS unsigned char* lds) {
    constexpr int NIT = L / 16, XP = 1032;
    const bf16_t* h = (const bf16_t*)(P->ws + WS_H);
    bf16_t* yabc = (bf16_t*)(P->ws + WS_Y);
    float* lruA = (float*)(P->ws + WS_LRUA); float* lruU = (float*)(P->ws + WS_LRUU);
    const int tid = tidx(wv), w = tid >> 6, lane = tid & 63, fr = lane & 15, fq = lane >> 4;
    LAS bf16_t* xa = (LAS bf16_t*)lds;
    __syncthreads();
    {
        const int ch = 2 * tid;
        const float* cw = P->in[I_LCW] + (size_t)l * 4 * 1024 + ch;
        const f32x2_t w0 = *(const f32x2_t*)cw, w1 = *(const f32x2_t*)(cw + 1024), w2 = *(const f32x2_t*)(cw + 2048), w3 = *(const f32x2_t*)(cw + 3072);
        const f32x2_t cb = *(const f32x2_t*)(P->in[I_LCB] + l * 1024 + ch);
        f32x2_t xm3 = {0.f, 0.f}, xm2 = {0.f, 0.f}, xm1 = {0.f, 0.f};
        if (I.sample) { const float* st = P->in[I_SLC] + (size_t)(l * 16 + I.sb) * 3 * 1024 + ch; xm3 = *(const f32x2_t*)st; xm2 = *(const f32x2_t*)(st + 1024); xm1 = *(const f32x2_t*)(st + 2048); }
        else if (I.c > 0) { const bf16_t* hq = h + (size_t)(I.row0 - 3) * HP + HX + ch;
            const unsigned a0 = *(const unsigned*)hq, a1 = *(const unsigned*)(hq + HP), a2 = *(const unsigned*)(hq + 2 * (size_t)HP);
            xm3 = (f32x2_t){bflo(a0), bfhi(a0)}; xm2 = (f32x2_t){bflo(a1), bfhi(a1)}; xm1 = (f32x2_t){bflo(a2), bfhi(a2)}; }
        const bf16_t* hp = h + (size_t)I.row0 * HP + HX + ch;
#pragma unroll 8
        for (int t = 0; t < L; ++t) {
            const unsigned xw = *(const unsigned*)(hp + (size_t)t * HP);
            const f32x2_t x0 = {bflo(xw), bfhi(xw)};
            const f32x2_t y = cb + w0 * xm3 + w1 * xm2 + w2 * xm1 + w3 * x0;
            *(LAS unsigned*)(xa + t * XP + ch) = pk2(y[0], y[1]);
            xm3 = xm2; xm2 = xm1; xm1 = x0;
        }
    }
    __syncthreads();
#pragma unroll 1
    for (int pass = 0; pass < 2; ++pass) {
        const int blk = w + 8 * pass, ch0 = blk * 64;
        const bf16_t* waT = (const bf16_t*)(P->ws + W_LA) + (l & 1) * 65536 + blk * 4096;
        const bf16_t* wxT = (const bf16_t*)(P->ws + W_LX) + (l & 1) * 65536 + blk * 4096;
        float carryH[4][4], carryA[4][4], c8v[4][4];
#pragma unroll
        for (int jt = 0; jt < 4; ++jt)
#pragma unroll
            for (int jj = 0; jj < 4; ++jj) {
                const int ch = ch0 + jt * 16 + fq * 4 + jj;
                carryA[jt][jj] = 1.0f;
                c8v[jt][jj] = 8.0f * softplusf_(-P->in[I_LLAM][l * 1024 + ch]);
                if (FINAL) carryH[jt][jj] = I.sample ? P->in[I_SLH][(l * 16 + I.sb) * 1024 + ch] : lruU[(size_t)item * 1024 + ch];
                else carryH[jt][jj] = 0.f;
            }
        bf16x8 waf[4][2], wxf[4][2]; f32x4 bavv[4], bxvv[4];
#pragma unroll
        for (int jt = 0; jt < 4; ++jt) {
            const bf16_t* wa = waT + (jt * 16 + fr) * 64 + fq * 8; const bf16_t* wx = wxT + (jt * 16 + fr) * 64 + fq * 8;
            waf[jt][0] = *(const bf16x8*)wa; waf[jt][1] = *(const bf16x8*)(wa + 32); wxf[jt][0] = *(const bf16x8*)wx; wxf[jt][1] = *(const bf16x8*)(wx + 32);
            bavv[jt] = *(const f32x4*)(P->in[I_LBA] + l * 1024 + ch0 + jt * 16 + fq * 4); bxvv[jt] = *(const f32x4*)(P->in[I_LBX] + l * 1024 + ch0 + jt * 16 + fq * 4);
        }
#pragma unroll 1
        for (int it = 0; it < NIT; ++it) {
            const LAS bf16_t* xp = xa + (it * 16 + fr) * XP + ch0;
            const bf16x8 b0 = *(const LAS bf16x8*)(xp + fq * 8), b1 = *(const LAS bf16x8*)(xp + 32 + fq * 8);
            const int token = it * 16 + fr;
#pragma unroll
            for (int jt = 0; jt < 4; ++jt) {
                f32x4 ra = (f32x4){0.f, 0.f, 0.f, 0.f}, ia = (f32x4){0.f, 0.f, 0.f, 0.f};
                ra = MFMA16(waf[jt][0], b0, ra); ra = MFMA16(waf[jt][1], b1, ra);
                ia = MFMA16(wxf[jt][0], b0, ia); ia = MFMA16(wxf[jt][1], b1, ia);
                const u32x2 xw = *(const LAS u32x2*)(xp + jt * 16 + fq * 4);
                const float xv[4] = {bflo(xw.x), bfhi(xw.x), bflo(xw.y), bfhi(xw.y)};
                const f32x4 bav = bavv[jt], bxv = bxvv[jt];
                float hv[4], av[4];
#pragma unroll
                for (int jj = 0; jj < 4; ++jj) {
                    const float r = sigmoidf_(ra[jj] + bav[jj]);
                    const float ig = sigmoidf_(ia[jj] + bxv[jj]);
                    const float la = -c8v[jt][jj] * r;
                    float a = __expf(la);
                    float u = __builtin_amdgcn_sqrtf(fmaxf(1.0f - a * a, 0.f)) * ig * xv[jj];
                    { const float ap = dpp_f<0x111>(1.0f, a), up = dpp_f<0x111>(0.0f, u); u = a * up + u; a = a * ap; }
                    { const float ap = dpp_f<0x112>(1.0f, a), up = dpp_f<0x112>(0.0f, u); u = a * up + u; a = a * ap; }
                    { const float ap = dpp_f<0x114>(1.0f, a), up = dpp_f<0x114>(0.0f, u); u = a * up + u; a = a * ap; }
                    { const float ap = dpp_f<0x118>(1.0f, a), up = dpp_f<0x118>(0.0f, u); u = a * up + u; a = a * ap; }
                    const float hval = a * carryH[jt][jj] + u;
                    hv[jj] = hval;
                    carryH[jt][jj] = shfl_row15(hval);
                    if (!FINAL) { const float at = carryA[jt][jj] * a; av[jj] = at; carryA[jt][jj] = shfl_row15(at); }
                }
                if (!FINAL) {
                    u32x2 ow; ow.x = pk2(hv[0], hv[1]); ow.y = pk2(hv[2], hv[3]);
                    *(u32x2*)(yabc + (size_t)(I.row0 + token) * 3072 + ch0 + jt * 16 + fq * 4) = ow;
                    u32x2 aw; aw.x = pk2(av[0], av[1]); aw.y = pk2(av[2], av[3]);
                    *(u32x2*)((bf16_t*)(P->ws + WS_XB) + (size_t)(I.row0 + token) * DM + ch0 + jt * 16 + fq * 4) = aw;
                }
                if (FINAL) {
                    const u32x2 gw = *(const u32x2*)(h + (size_t)(I.row0 + token) * HP + HG + ch0 + jt * 16 + fq * 4);
                    u32x2 ow; ow.x = pk2(hv[0] * gelu_tanh(bflo(gw.x)), hv[1] * gelu_tanh(bfhi(gw.x)));
                    ow.y = pk2(hv[2] * gelu_tanh(bflo(gw.y)), hv[3] * gelu_tanh(bfhi(gw.y)));
                    *(u32x2*)(yabc + (size_t)(I.row0 + token) * 3072 + ch0 + jt * 16 + fq * 4) = ow;
                    if (it == NIT - 1 && fr == 15) {
                        if (I.sample) *(f32x4*)(P->out + O_SLH + (size_t)(l * 16 + I.sb) * 1024 + ch0 + jt * 16 + fq * 4) = (f32x4){hv[0], hv[1], hv[2], hv[3]};
                        else if (I.c == 127) *(f32x4*)(P->out + O_PLH + (size_t)(l * 2 + I.b) * 1024 + ch0 + jt * 16 + fq * 4) = (f32x4){hv[0], hv[1], hv[2], hv[3]};
                    }
                }
            }
        }
        if (!FINAL) {
            if (fr == 0) {
#pragma unroll
                for (int jt = 0; jt < 4; ++jt) {
                    *(f32x4*)(lruA + (size_t)item * 1024 + ch0 + jt * 16 + fq * 4) = (f32x4){carryA[jt][0], carryA[jt][1], carryA[jt][2], carryA[jt][3]};
                    *(f32x4*)(lruU + (size_t)item * 1024 + ch0 + jt * 16 + fq * 4) = (f32x4){carryH[jt][0], carryH[jt][1], carryH[jt][2], carryH[jt][3]};
                }
            }
        }
    }
}

__device__ __forceinline__ void lru_apply_item(int wv, KP P, int l, int item, const Item& I) {
    const bf16_t* h = (const bf16_t*)(P->ws + WS_H);
    bf16_t* yabc = (bf16_t*)(P->ws + WS_Y);
    const bf16_t* acum = (const bf16_t*)(P->ws + WS_XB);
    const float* carry = (const float*)(P->ws + WS_LRUU) + (size_t)item * 1024;
    const int tid = tidx(wv);
    const int c8 = (tid & 127) * 8;
    const f32x4 ca = *(const f32x4*)(carry + c8), cb = *(const f32x4*)(carry + c8 + 4);
    const float cv[8] = {ca[0], ca[1], ca[2], ca[3], cb[0], cb[1], cb[2], cb[3]};
#pragma unroll 1
    for (int tb = 0; tb < 4; ++tb) {
        u32x4 aw4[4], hw4[4], gw4[4];
#pragma unroll
        for (int q = 0; q < 4; ++q) {
            const size_t r = (size_t)(I.row0 + (tid >> 7) + 4 * (tb * 4 + q));
            aw4[q] = *(const u32x4*)(acum + r * DM + c8); hw4[q] = *(const u32x4*)(yabc + r * 3072 + c8); gw4[q] = *(const u32x4*)(h + r * HP + HG + c8);
        }
#pragma unroll
        for (int q = 0; q < 4; ++q) {
            const int t = (tid >> 7) + 4 * (tb * 4 + q);
            const size_t r = (size_t)(I.row0 + t);
            const unsigned au[4] = {aw4[q].x, aw4[q].y, aw4[q].z, aw4[q].w}, hu[4] = {hw4[q].x, hw4[q].y, hw4[q].z, hw4[q].w}, gu[4] = {gw4[q].x, gw4[q].y, gw4[q].z, gw4[q].w};
            float hv[8]; unsigned ou[4];
#pragma unroll
            for (int e = 0; e < 4; ++e) {
                hv[2 * e] = bflo(au[e]) * cv[2 * e] + bflo(hu[e]); hv[2 * e + 1] = bfhi(au[e]) * cv[2 * e + 1] + bfhi(hu[e]);
                ou[e] = pk2(hv[2 * e] * gelu_tanh(bflo(gu[e])), hv[2 * e + 1] * gelu_tanh(bfhi(gu[e])));
            }
            *(u32x4*)(yabc + r * 3072 + c8) = (u32x4){ou[0], ou[1], ou[2], ou[3]};
            if (I.c == 127 && t == 63) {
                float* op = P->out + O_PLH + (size_t)(l * 2 + I.b) * 1024 + c8;
                *(f32x4*)op = (f32x4){hv[0], hv[1], hv[2], hv[3]}; *(f32x4*)(op + 4) = (f32x4){hv[4], hv[5], hv[6], hv[7]};
            }
        }
    }
}

#define SW72(row, t) ((row) * 72 + (((((t) >> 3) ^ (((row) >> 3) & 7))) << 3) + ((t) & 7))
__device__ __forceinline__ float pre_xbc(KP P, const bf16_t* h, int l, const Item& I, int tt, int ch) {
    if (tt >= 0 || (!I.sample && I.c > 0)) return bf2f(h[(size_t)(I.row0 + tt) * HP + HXBC + ch]);
    if (I.sample) return P->in[I_SSC][((size_t)(l * 16 + I.sb) * 3 + (3 + tt)) * 1536 + ch];
    return 0.f;
}
__device__ __forceinline__ float conv_xbc(KP P, const bf16_t* h, int l, const Item& I, int t, int ch) {
    const float* cw = P->in[I_SCW] + (size_t)l * 4 * 1536 + ch;
    float y = P->in[I_SCB][l * 1536 + ch];
    y += cw[0] * pre_xbc(P, h, l, I, t - 3, ch); y += cw[1536] * pre_xbc(P, h, l, I, t - 2, ch);
    y += cw[3072] * pre_xbc(P, h, l, I, t - 1, ch); y += cw[4608] * pre_xbc(P, h, l, I, t, ch);
    return siluf_(y);
}
template <class F>
__device__ __forceinline__ void conv_roll(KP P, const bf16_t* h, int l, const Item& I, int chx, int t0, int t1, F f) {
    const float* cw = P->in[I_SCW] + (size_t)l * 4 * 1536 + chx;
    const float w0 = cw[0], w1 = cw[1536], w2 = cw[3072], w3 = cw[4608], cb = P->in[I_SCB][l * 1536 + chx];
    float xm3 = pre_xbc(P, h, l, I, t0 - 3, chx), xm2 = pre_xbc(P, h, l, I, t0 - 2, chx), xm1 = pre_xbc(P, h, l, I, t0 - 1, chx);
    const bf16_t* hp = h + (size_t)I.row0 * HP + HXBC + chx;
#pragma unroll 8
    for (int t = t0; t < t1; ++t) {
        const float x0 = bf2f(hp[(size_t)t * HP]);
        const float y = cb + w0 * xm3 + w1 * xm2 + w2 * xm1 + w3 * x0;
        f(t, siluf_(y));
        xm3 = xm2; xm2 = xm1; xm1 = x0;
    }
}
template <int L, int NCH8, class CF, class F>
__device__ __forceinline__ void ssd_stage(KP P, const bf16_t* h, int l, const Item& I, int tid, CF chx_of, F f) {
    constexpr int NSEG = 512 / NCH8, TS = L / NSEG;
    static_assert(TS >= 1 && TS * NSEG == L, "segmenting");
    const int c8 = tid % NCH8, sg = tid / NCH8, t0 = sg * TS, chx = chx_of(c8);
    u32x4 xr[TS + 3];
#pragma unroll
    for (int q = 0; q < TS + 3; ++q) {
        const int tt = t0 - 3 + q;
        if (tt >= 0 || (!I.sample && I.c > 0)) {
            xr[q] = *(const u32x4*)((const char*)h + ((unsigned)(I.row0 + tt) * (unsigned)HP + (unsigned)(HXBC + chx)) * 2u);
        } else if (I.sample) {
            const float* st = P->in[I_SSC] + ((size_t)(l * 16 + I.sb) * 3 + (3 + tt)) * 1536 + chx;
            const f32x4 a = *(const f32x4*)st, b = *(const f32x4*)(st + 4);
            xr[q] = (u32x4){pk2(a[0], a[1]), pk2(a[2], a[3]), pk2(b[0], b[1]), pk2(b[2], b[3])};
        } else xr[q] = (u32x4){0u, 0u, 0u, 0u};
    }
    const float* cw = P->in[I_SCW] + (size_t)l * 4 * 1536 + chx;
    float wt[4][8], cb[8];
#pragma unroll
    for (int j = 0; j < 4; ++j) { const f32x4 a = *(const f32x4*)(cw + j * 1536), b = *(const f32x4*)(cw + j * 1536 + 4);
        wt[j][0] = a[0]; wt[j][1] = a[1]; wt[j][2] = a[2]; wt[j][3] = a[3]; wt[j][4] = b[0]; wt[j][5] = b[1]; wt[j][6] = b[2]; wt[j][7] = b[3]; }
    { const f32x4 a = *(const f32x4*)(P->in[I_SCB] + l * 1536 + chx), b = *(const f32x4*)(P->in[I_SCB] + l * 1536 + chx + 4);
        cb[0] = a[0]; cb[1] = a[1]; cb[2] = a[2]; cb[3] = a[3]; cb[4] = b[0]; cb[5] = b[1]; cb[6] = b[2]; cb[7] = b[3]; }
#pragma unroll
    for (int q = 0; q < TS; ++q) {
        float v[8];
#pragma unroll
        for (int e2 = 0; e2 < 4; ++e2) {
            const unsigned r0 = xr[q][e2], r1 = xr[q + 1][e2], r2 = xr[q + 2][e2], r3 = xr[q + 3][e2];
            v[2 * e2] = siluf_(cb[2 * e2] + wt[0][2 * e2] * bflo(r0) + wt[1][2 * e2] * bflo(r1) + wt[2][2 * e2] * bflo(r2) + wt[3][2 * e2] * bflo(r3));
            v[2 * e2 + 1] = siluf_(cb[2 * e2 + 1] + wt[0][2 * e2 + 1] * bfhi(r0) + wt[1][2 * e2 + 1] * bfhi(r1) + wt[2][2 * e2 + 1] * bfhi(r2) + wt[3][2 * e2 + 1] * bfhi(r3));
        }
        f(t0 + q, c8, v);
    }
}
template <int L>
__device__ __forceinline__ void ssd_dtcum(int wv, KP P, int l, const Item& I, LAS float* dtv, LAS float* cumv) {
    const float* dtraw = (const float*)(P->ws + WS_DT);
    const int tid = tidx(wv);
    __syncthreads();
    for (int idx = tid; idx < L * 16; idx += 512) { const int hd = idx & 15; dtv[idx] = softplusf_(dtraw[(size_t)I.row0 * 16 + idx] + P->in[I_SDTB][l * 16 + hd]); }
    __syncthreads();
    if (tid < 64) {
        constexpr int SEG = L / 4;
        const int hd = tid & 15, sg = tid >> 4;
        const float A = -__expf(P->in[I_SALOG][l * 16 + hd]);
        float c = 0.f;
#pragma unroll
        for (int t = 0; t < SEG; ++t) { c += dtv[(sg * SEG + t) * 16 + hd] * A; cumv[(sg * SEG + t) * 16 + hd] = c; }
        const float t1 = shfl_idx(c, hd), t2 = shfl_idx(c, 16 + hd), t3 = shfl_idx(c, 32 + hd);
        const float off = sg == 0 ? 0.f : (sg == 1 ? t1 : (sg == 2 ? t1 + t2 : t1 + t2 + t3));
#pragma unroll
        for (int t = 0; t < SEG; ++t) cumv[(sg * SEG + t) * 16 + hd] += off;
    }
    __syncthreads();
}

template <int L>
__device__ __forceinline__ void ssd_states_item(int wv, KP P, int l, int item, const Item& I, LAS unsigned char* lds) {
    constexpr int LP = L < 32 ? 32 : L, KS = LP / 32;
    const bf16_t* h = (const bf16_t*)(P->ws + WS_H);
    bf16_t* states = (bf16_t*)(P->ws + WS_ST);
    float* cdec = (float*)(P->ws + WS_CDEC);
    const int tid = tidx(wv), w = tid >> 6, lane = tid & 63, fr = lane & 15, fq = lane >> 4;
    LAS float* dtv = (LAS float*)lds; LAS float* cumv = dtv + 1024;
    LAS bf16_t* BmT = (LAS bf16_t*)(lds + 8192);
    LAS bf16_t* xw = (LAS bf16_t*)(lds + 8192 + 36864) + w * (64 * 72);
    ssd_dtcum<L>(wv, P, l, I, dtv, cumv);
    LAS bf16_t* xwall = (LAS bf16_t*)(lds + 8192 + 36864);
    ssd_stage<L, 32>(P, h, l, I, tid, [](int c8) { return 1024 + c8 * 8; }, [&](int t, int c8, const float* v) {
#pragma unroll
        for (int e = 0; e < 8; ++e) BmT[SW72(c8 * 8 + e, t)] = f2bf(v[e]); });
    if (L < LP) for (int idx = tid; idx < 256 * (LP - L); idx += 512) BmT[SW72(idx / (LP - L), L + idx % (LP - L))] = 0;
    for (int hh = 0; hh < 2; ++hh) {
        const int head = w + 8 * hh;
        const float cl = cumv[(L - 1) * 16 + head];
        __syncthreads();
        ssd_stage<L, 64>(P, h, l, I, tid, [=](int c8) { return hh * 512 + c8 * 8; }, [&](int t, int c8, const float* v) {
            const int hd = hh * 8 + (c8 >> 3);
            const float sc = __expf(cumv[(L - 1) * 16 + hd] - cumv[t * 16 + hd]) * dtv[t * 16 + hd];
            LAS bf16_t* dst = xwall + (c8 >> 3) * (64 * 72);
#pragma unroll
            for (int e = 0; e < 8; ++e) dst[SW72((c8 & 7) * 8 + e, t)] = f2bf(v[e] * sc); });
        if (L < LP) for (int idx = tid; idx < 512 * (LP - L); idx += 512) xwall[SW72(idx / (LP - L), L + idx % (LP - L))] = 0;
        __syncthreads();
        const float dec = __expf(cl);
        if (!I.sample && lane == 0) cdec[item * 16 + head] = dec;
#pragma unroll 1
        for (int nt = 0; nt < 8; ++nt) {
            bf16x8 af[KS];
#pragma unroll
            for (int ks = 0; ks < KS; ++ks) af[ks] = *(const LAS bf16x8*)(BmT + SW72(hh * 128 + nt * 16 + fr, ks * 32 + fq * 8));
#pragma unroll
            for (int pt = 0; pt < 4; ++pt) {
                f32x4 a = (f32x4){0.f, 0.f, 0.f, 0.f};
#pragma unroll
                for (int ks = 0; ks < KS; ++ks) a = MFMA16(af[ks], *(const LAS bf16x8*)(xw + SW72(pt * 16 + fr, ks * 32 + fq * 8)), a);
                const int p = pt * 16 + fr, n0 = nt * 16 + fq * 4;
                if (!I.sample) {
                    u32x2 ow; ow.x = pk2(a[0], a[1]); ow.y = pk2(a[2], a[3]);
                    *(u32x2*)(states + ((size_t)((I.b * 128 + I.c) * 16 + head) * 64 + p) * 128 + n0) = ow;
                } else {
                    const size_t o = ((size_t)((l * 16 + I.sb) * 16 + head) * 64 + p) * 128 + n0;
                    const f32x4 h0 = *(const f32x4*)(P->in[I_SSH] + o);
                    *(f32x4*)(P->out + O_SSH + o) = h0 * dec + a;
                }
            }
        }
    }
}

template <int L>
__device__ __forceinline__ void ssd_y_item(int wv, KP P, int l, const Item& I, LAS unsigned char* lds) {
    constexpr int LP = L < 32 ? 32 : L, KS = LP / 32, NIT = L / 16;
    const bf16_t* h = (const bf16_t*)(P->ws + WS_H);
    const bf16_t* states = (const bf16_t*)(P->ws + WS_ST);
    bf16_t* yabc = (bf16_t*)(P->ws + WS_Y);
    const int tid = tidx(wv), w = tid >> 6, lane = tid & 63, fr = lane & 15, fq = lane >> 4;
    LAS float* dtv = (LAS float*)lds; LAS float* cumv = dtv + 1024;
    LAS bf16_t* Bm = (LAS bf16_t*)(lds + 8192);
    LAS bf16_t* Cm = (LAS bf16_t*)(lds + 8192 + 17408);
    LAS float* CBl = (LAS float*)(lds + 8192 + 2 * 17408);
    LAS float* part = (LAS float*)(lds + 8192 + 3 * 17408);
    LAS bf16_t* xT = (LAS bf16_t*)(lds + 8192 + 3 * 17408 + 2048) + w * (64 * 72);
    ssd_dtcum<L>(wv, P, l, I, dtv, cumv);
    for (int g = 0; g < 2; ++g) {
        const int head = g * 8 + w;
        __syncthreads();
        ssd_stage<L, 32>(P, h, l, I, tid, [=](int c8) { return 1024 + (c8 >> 4) * 256 + g * 128 + (c8 & 15) * 8; }, [&](int t, int c8, const float* v) {
            u32x4 ow; ow.x = pk2(v[0], v[1]); ow.y = pk2(v[2], v[3]); ow.z = pk2(v[4], v[5]); ow.w = pk2(v[6], v[7]);
            *(LAS u32x4*)(((c8 >> 4) ? Cm : Bm) + t * 136 + (c8 & 15) * 8) = ow; });
        {
            LAS bf16_t* xTall = (LAS bf16_t*)(lds + 8192 + 3 * 17408 + 2048);
            ssd_stage<L, 64>(P, h, l, I, tid, [=](int c8) { return g * 512 + c8 * 8; }, [&](int t, int c8, const float* v) {
                LAS bf16_t* dst = xTall + (c8 >> 3) * (64 * 72);
#pragma unroll
                for (int e = 0; e < 8; ++e) dst[SW72((c8 & 7) * 8 + e, t)] = f2bf(v[e]); });
            if (L < LP) for (int idx = tid; idx < 512 * (LP - L); idx += 512) xTall[SW72(idx / (LP - L), L + idx % (LP - L))] = 0;
        }
        __syncthreads();
        for (int tix = w; tix < NIT * NIT; tix += 8) {
            const int it = tix / NIT, jt = tix % NIT;
            f32x4 a = (f32x4){0.f, 0.f, 0.f, 0.f};
#pragma unroll
            for (int ks = 0; ks < 4; ++ks)
                a = MFMA16(*(const LAS bf16x8*)(Cm + (it * 16 + fr) * 136 + ks * 32 + fq * 8), *(const LAS bf16x8*)(Bm + (jt * 16 + fr) * 136 + ks * 32 + fq * 8), a);
#pragma unroll
            for (int jj = 0; jj < 4; ++jj) CBl[(it * 16 + fq * 4 + jj) * 68 + jt * 16 + fr] = a[jj];
        }
        __syncthreads();
        const float dsk = P->in[I_SD][l * 16 + head];
        bf16x8 hf[4][4];
#pragma unroll
        for (int pt = 0; pt < 4; ++pt) {
            const int p = pt * 16 + fr;
            if (!I.sample) {
                const bf16_t* sp = states + ((size_t)((I.b * 128 + I.c) * 16 + head) * 64 + p) * 128 + fq * 8;
#pragma unroll
                for (int ks = 0; ks < 4; ++ks) hf[pt][ks] = *(const bf16x8*)(sp + ks * 32);
            } else {
                const float* sp = P->in[I_SSH] + ((size_t)((l * 16 + I.sb) * 16 + head) * 64 + p) * 128 + fq * 8;
#pragma unroll
                for (int ks = 0; ks < 4; ++ks) {
                    const f32x4 a0 = *(const f32x4*)(sp + ks * 32), a1 = *(const f32x4*)(sp + ks * 32 + 4);
                    u32x4 ww; ww.x = pk2(a0[0], a0[1]); ww.y = pk2(a0[2], a0[3]); ww.z = pk2(a1[0], a1[1]); ww.w = pk2(a1[2], a1[3]);
                    __builtin_memcpy(&hf[pt][ks], &ww, 16);
                }
            }
        }
        u32x2 zcur[4];
#pragma unroll
        for (int pt = 0; pt < 4; ++pt) zcur[pt] = *(const u32x2*)(h + (size_t)(I.row0 + fr) * HP + HZ + head * 64 + pt * 16 + fq * 4);
#pragma unroll 1
        for (int it = 0; it < NIT; ++it) {
            const int i = it * 16 + fr; const float cum_i = cumv[i * 16 + head];
            u32x2 znext[4];
#pragma unroll
            for (int pt = 0; pt < 4; ++pt) znext[pt] = zcur[pt];
            if (it + 1 < NIT) {
#pragma unroll
                for (int pt = 0; pt < 4; ++pt) znext[pt] = *(const u32x2*)(h + (size_t)(I.row0 + i + 16) * HP + HZ + head * 64 + pt * 16 + fq * 4);
            }
            f32x4 acc[4];
#pragma unroll
            for (int pt = 0; pt < 4; ++pt) acc[pt] = (f32x4){0.f, 0.f, 0.f, 0.f};
#pragma unroll
            for (int ks = 0; ks < KS; ++ks) {
                if (ks * 32 > it * 16 + 15) continue;
                const int j0 = ks * 32 + fq * 8;
                const f32x4 c0 = *(const LAS f32x4*)(CBl + i * 68 + j0), c1 = *(const LAS f32x4*)(CBl + i * 68 + j0 + 4);
                float wv8[8];
#pragma unroll
                for (int e = 0; e < 8; ++e) {
                    const int j = j0 + e; const float cb = e < 4 ? c0[e & 3] : c1[e & 3];
                    const float ex = __expf(fminf(cum_i - cumv[j * 16 + head], 0.f));
                    wv8[e] = (j <= i) ? cb * ex * dtv[j * 16 + head] : 0.f;
                }
                u32x4 ww; ww.x = pk2(wv8[0], wv8[1]); ww.y = pk2(wv8[2], wv8[3]); ww.z = pk2(wv8[4], wv8[5]); ww.w = pk2(wv8[6], wv8[7]);
                bf16x8 wf; __builtin_memcpy(&wf, &ww, 16);
#pragma unroll
                for (int pt = 0; pt < 4; ++pt) acc[pt] = MFMA16(*(const LAS bf16x8*)(xT + SW72(pt * 16 + fr, j0)), wf, acc[pt]);
            }
            const float ecum = __expf(cum_i);
            bf16x8 cf[4];
#pragma unroll
            for (int ks = 0; ks < 4; ++ks) cf[ks] = *(const LAS bf16x8*)(Cm + i * 136 + ks * 32 + fq * 8);
#pragma unroll
            for (int pt = 0; pt < 4; ++pt) {
                f32x4 t2 = (f32x4){0.f, 0.f, 0.f, 0.f};
#pragma unroll
                for (int ks = 0; ks < 4; ++ks) t2 = MFMA16(hf[pt][ks], cf[ks], t2);
                acc[pt] += t2 * ecum;
            }
            float ss = 0.f;
#pragma unroll
            for (int pt = 0; pt < 4; ++pt) {
                const int p0 = pt * 16 + fq * 4;
                const u32x2 zw = zcur[pt];
                const float zv[4] = {bflo(zw.x), bfhi(zw.x), bflo(zw.y), bfhi(zw.y)};
                float yv[4];
#pragma unroll
                for (int jj = 0; jj < 4; ++jj) {
                    const float xs = bf2f(xT[SW72(p0 + jj, i)]);
                    const float y = (acc[pt][jj] + dsk * xs) * siluf_(zv[jj]);
                    yv[jj] = y; ss += y * y;
                }
                u32x2 ow; ow.x = pk2(yv[0], yv[1]); ow.y = pk2(yv[2], yv[3]);
                *(u32x2*)(yabc + (size_t)(I.row0 + i) * 3072 + 1024 + head * 64 + p0) = ow;
            }
            ss += shflx(ss, 16); ss += shflx(ss, 32);
            if (fq == 0) part[i * 8 + w] = ss;
#pragma unroll
            for (int pt = 0; pt < 4; ++pt) zcur[pt] = znext[pt];
        }
        __syncthreads();
        f32x4 ngv[4];
#pragma unroll
        for (int pt = 0; pt < 4; ++pt) ngv[pt] = *(const f32x4*)(P->in[I_SNORM] + l * 1024 + head * 64 + pt * 16 + fq * 4);
        u32x2 ycur[4];
#pragma unroll
        for (int pt = 0; pt < 4; ++pt) ycur[pt] = *(const u32x2*)(yabc + (size_t)(I.row0 + fr) * 3072 + 1024 + head * 64 + pt * 16 + fq * 4);
#pragma unroll 1
        for (int it = 0; it < NIT; ++it) {
            const int i = it * 16 + fr;
            u32x2 ynext[4];
#pragma unroll
            for (int pt = 0; pt < 4; ++pt) ynext[pt] = ycur[pt];
            if (it + 1 < NIT) {
#pragma unroll
                for (int pt = 0; pt < 4; ++pt) ynext[pt] = *(const u32x2*)(yabc + (size_t)(I.row0 + i + 16) * 3072 + 1024 + head * 64 + pt * 16 + fq * 4);
            }
            const f32x4 pa = *(const LAS f32x4*)(part + i * 8), pb = *(const LAS f32x4*)(part + i * 8 + 4);
            const float tot = (pa[0] + pa[1] + pa[2] + pa[3]) + (pb[0] + pb[1] + pb[2] + pb[3]);
            const float rs = rsqrtf(tot * (1.0f / 512.0f) + EPS);
#pragma unroll
            for (int pt = 0; pt < 4; ++pt) {
                const int p0 = pt * 16 + fq * 4;
                const f32x4 ng = ngv[pt];
                const u32x2 yw = ycur[pt];
                u32x2 ow; ow.x = pk2(bflo(yw.x) * rs * ng[0], bfhi(yw.x) * rs * ng[1]); ow.y = pk2(bflo(yw.y) * rs * ng[2], bfhi(yw.y) * rs * ng[3]);
                *(u32x2*)(yabc + (size_t)(I.row0 + i) * 3072 + 1024 + head * 64 + p0) = ow;
            }
#pragma unroll
            for (int pt = 0; pt < 4; ++pt) ycur[pt] = ynext[pt];
        }
    }
}

__device__ __forceinline__ void phase_scan(int wv, KP P, int l) {
    bf16_t* states = (bf16_t*)(P->ws + WS_ST);
    const float* cdec = (const float*)(P->ws + WS_CDEC);
    const float* lruA = (const float*)(P->ws + WS_LRUA); float* lruU = (float*)(P->ws + WS_LRUU);
    if (DBG_P5S) for (int idx = bidx() * 512 + tidx(wv); idx < 131072; idx += gdim() * 512) {
        const int e = idx * 2, b = e >> 17, rem = e & 131071, head = rem >> 13;
        unsigned* sp = (unsigned*)(states + (size_t)b * 128 * 131072 + rem);
        const float* dp = cdec + (b * 128) * 16 + head;
        float c0 = 0.f, c1 = 0.f;
        for (int c = 0; c < 128; c += 32) {
            unsigned v[32]; float dv[32];
#pragma unroll
            for (int k = 0; k < 32; ++k) { v[k] = sp[(size_t)(c + k) * 65536]; dv[k] = dp[(c + k) * 16]; }
#pragma unroll
            for (int k = 0; k < 32; ++k) {
                const float dec = dv[k];
                sp[(size_t)(c + k) * 65536] = pk2(c0, c1);
                c0 = dec * c0 + bflo(v[k]); c1 = dec * c1 + bfhi(v[k]);
            }
        }
        float* op = P->out + O_PSH + (size_t)(l * 2 + b) * 131072 + rem;
        op[0] = c0; op[1] = c1;
    }
    if (DBG_LRU4) for (int idx = bidx() * 512 + tidx(wv); idx < 2048; idx += gdim() * 512) {
        const int b = idx >> 10, ch = idx & 1023;
        float carry = 0.f;
        for (int c = 0; c < 128; c += 32) {
            float Av[32], Uv[32];
#pragma unroll
            for (int k = 0; k < 32; ++k) { const size_t o = (size_t)(b * 128 + c + k) * 1024 + ch; Av[k] = lruA[o]; Uv[k] = lruU[o]; }
#pragma unroll
            for (int k = 0; k < 32; ++k) { const size_t o = (size_t)(b * 128 + c + k) * 1024 + ch; lruU[o] = carry; carry = Av[k] * carry + Uv[k]; }
        }
    }
}

__device__ __forceinline__ void gsync(cg::grid_group& grid) {
    grid.sync();
}
#define XB_TMO      128
#define XB_XCNT(j)  (256  + 64 * (j))
#define XB_XSUB(j)  (1280 + 64 * (j))
#define XB_XGEN(j)  (2304 + 64 * (j))
#define XB_TOP      3328
#define XB_TOPGEN   3392
#define XCD_BAR_WORDS 3456
#define XB_SPIN_CAP (1u << 20)
__device__ __forceinline__ unsigned xb_ld(unsigned* p)              { return __hip_atomic_load(p, __ATOMIC_RELAXED, __HIP_MEMORY_SCOPE_AGENT); }
__device__ __forceinline__ unsigned xb_add(unsigned* p, unsigned v) { return __hip_atomic_fetch_add(p, v, __ATOMIC_RELAXED, __HIP_MEMORY_SCOPE_AGENT); }
__device__ __forceinline__ unsigned xb_xcc_id() { return (unsigned)__builtin_amdgcn_s_getreg((3 << 11) | 20) & 0xFu; }
#define XB_SPIN(cond, bar) do { unsigned _sp = 0; while (cond) { __builtin_amdgcn_s_sleep(1); \
    if ((++_sp & 255u) == 0u) { if (xb_ld(&(bar)[XB_TMO])) break; if (_sp > XB_SPIN_CAP) { atomicAdd(&(bar)[XB_TMO], 1u); break; } } } } while (0)
__device__ __forceinline__ void xcd_barrier_complete(unsigned* bar, unsigned x, unsigned& nloc, unsigned& nx) {
    const unsigned G = (unsigned)gdim();
    unsigned sum, cnt, mine, sp = 0u;
    for (;;) {
        sum = 0u; cnt = 0u; mine = 0u;
#pragma unroll
        for (unsigned j = 0; j < 16; ++j) { const unsigned c = xb_ld(&bar[XB_XCNT(j)]); sum += c; cnt += (c > 0u) ? 1u : 0u; mine = (j == x) ? c : mine; }
        if (sum == G) break;
        __builtin_amdgcn_s_sleep(1);
        if ((++sp & 255u) == 0u) { if (xb_ld(&bar[XB_TMO])) break; if (sp > XB_SPIN_CAP) { atomicAdd(&bar[XB_TMO], 1u); break; } }
    }
    nloc = mine > 0u ? mine : 1u; nx = cnt > 0u ? cnt : 1u;
}
__device__ __forceinline__ void gbar(int wv, LAS unsigned char* lds) {
    asm volatile("s_waitcnt vmcnt(0)" ::: "memory");
    __syncthreads();
    unsigned* bar = (unsigned*)(kparams()->ws + WS_BAR);
    if (tidx(wv) == 0) {
        volatile LAS unsigned* st = (volatile LAS unsigned*)(lds + LDS_BYTES - 16);
        const unsigned x = xb_xcc_id();
        __builtin_amdgcn_s_waitcnt(0);
        unsigned nloc = st[0], nx = st[1];
        if (nloc == 0u) { xcd_barrier_complete(bar, x, nloc, nx); st[0] = nloc; st[1] = nx; }
        const unsigned old = xb_add(&bar[XB_XSUB(x)], 1u);
        const unsigned gen = old / nloc;
        if (old + 1u == (gen + 1u) * nloc) {
            __builtin_amdgcn_fence(__ATOMIC_RELEASE, "agent");
            asm volatile("s_waitcnt vmcnt(0)" ::: "memory");
            const unsigned og = xb_add(&bar[XB_TOP], 1u);
            const unsigned tg = og / nx;
            if (og + 1u == (tg + 1u) * nx) xb_add(&bar[XB_TOPGEN], 1u);
            else XB_SPIN(xb_ld(&bar[XB_TOPGEN]) == tg, bar);
            __builtin_amdgcn_fence(__ATOMIC_ACQUIRE, "agent");
            xb_add(&bar[XB_XGEN(x)], 1u);
            asm volatile("s_waitcnt vmcnt(0)" ::: "memory");
        } else {
            XB_SPIN(xb_ld(&bar[XB_XGEN(x)]) == gen, bar);
            __builtin_amdgcn_fence(__ATOMIC_ACQUIRE, "agent");
            asm volatile("s_waitcnt vmcnt(0)" ::: "memory");
        }
    }
    __syncthreads();
}
__device__ __forceinline__ void gemm_gu(int wv, LAS unsigned char* lds, int j2) { KP P = kparams();
    EpiGU E; E.ssq = (const float*)(P->ws + WS_SSQ); E.hff = (bf16_t*)(P->ws + WS_H);
    run_gemm(wv, lds, (const bf16_t*)(P->ws + WS_XB), (const bf16_t*)(P->ws + (j2 ? W_GU1 : W_GU0)), MT, 5632, 1024, E); }
__device__ __forceinline__ void gemm_dn(int wv, LAS unsigned char* lds, int j2) { KP P = kparams();
    EpiRes E; E.x = P->out; E.xb = (bf16_t*)(P->ws + WS_XB); E.ssq = (float*)(P->ws + WS_SSQ); E.scale = 0.5f;
    run_gemm(wv, lds, (const bf16_t*)(P->ws + WS_H), (const bf16_t*)(P->ws + (j2 ? W_DN1 : W_DN0)), MP, 1024, 2816, E);
    skinny_gemm<0>(wv, lds, kparams(), (const bf16_t*)(kparams()->ws + WS_H) + (size_t)MP * DFF, (const bf16_t*)(kparams()->ws + (j2 ? W_DN1 : W_DN0)), 2816, 0.5f); }
__device__ __forceinline__ void gemm_in(int wv, LAS unsigned char* lds) { KP P = kparams();
    EpiIn E; E.ssq = (const float*)(P->ws + WS_SSQ); E.h = (bf16_t*)(P->ws + WS_H); E.dtraw = (float*)(P->ws + WS_DT);
    run_gemm(wv, lds, (const bf16_t*)(P->ws + WS_XB), (const bf16_t*)(P->ws + W_IN), MT, NINP, 1024, E); }
__device__ __forceinline__ void gemm_merge(int wv, LAS unsigned char* lds) { KP P = kparams();
    EpiMerge E; E.h = (const bf16_t*)(P->ws + WS_H); E.merged = (bf16_t*)(P->ws + WS_ST);
    run_gemm(wv, lds, (const bf16_t*)(P->ws + WS_Y), (const bf16_t*)(P->ws + W_BR), MP, 1024, 3072, E);
    skinny_gemm<1>(wv, lds, kparams(), (const bf16_t*)(kparams()->ws + WS_Y) + (size_t)MP * 3072, (const bf16_t*)(kparams()->ws + W_BR), 3072, 1.0f); }
__device__ __forceinline__ void gemm_out(int wv, LAS unsigned char* lds) { KP P = kparams();
    EpiRes E; E.x = P->out; E.xb = (bf16_t*)(P->ws + WS_XB); E.ssq = (float*)(P->ws + WS_SSQ); E.scale = 1.0f;
    run_gemm(wv, lds, (const bf16_t*)(P->ws + WS_ST), (const bf16_t*)(P->ws + W_OUT), MP, 1024, 1024, E);
    skinny_gemm<0>(wv, lds, kparams(), (const bf16_t*)(kparams()->ws + WS_ST) + (size_t)MP * DM, (const bf16_t*)(kparams()->ws + W_OUT), 1024, 1.0f); }

__global__ __launch_bounds__(512, 2) void mega(Params Pk) {
    extern __shared__ __attribute__((aligned(16))) unsigned char smem[];
    LAS unsigned char* lds = (LAS unsigned char*)smem;
    cg::grid_group grid = cg::this_grid();
    const int wv = __builtin_amdgcn_readfirstlane((int)(threadIdx.x >> 6));
    unsigned* bar0 = (unsigned*)(kparams()->ws + WS_BAR);
    if (threadIdx.x == 0) {
        volatile LAS unsigned* st = (volatile LAS unsigned*)(lds + LDS_BYTES - 16); st[0] = 0u; st[1] = 0u;
        (void)xb_add(&bar0[XB_XCNT(xb_xcc_id())], 1u);
    }
    __syncthreads();
    phase_init(wv, kparams());
    convert_layer(wv, kparams(), 0, 0, gdim(), lds);
    gsync(grid);
    unsigned long long tacc = 0, t0 = 0;
#pragma unroll 1
    for (int step = 0; step < 8; ++step) {
        const int l = step >> 1, j2 = step & 1;
        gbar(wv, lds);
        TB(0); gemm_gu(wv, lds, j2); gbar(wv, lds); TE(0);
        TB(1); gemm_dn(wv, lds, j2);
        if (j2 == 0) {
            gbar(wv, lds); TE(1);
            TB(2); gemm_in(wv, lds); gbar(wv, lds); TE(2);
            TB(3);
            for (int item = bidx(); item < 256; item += gdim()) {
                const Item I = get_item(item);
                copy_states_item(wv, kparams(), l, I);
                attn_item<64>(wv, kparams(), l, I, lds);
                lru_item<64, false>(wv, kparams(), l, item, I, lds);
                ssd_states_item<64>(wv, kparams(), l, item, I, lds);
            }
            gbar(wv, lds); TE(3);
            TB(4);
            phase_scan(wv, kparams(), l);
            {
                const int nconv = gdim() > 128 ? gdim() - 64 : gdim();
                convert_layer(wv, kparams(), l, 1, nconv, lds);
                if (l < 3) convert_layer(wv, kparams(), l + 1, 0, nconv, lds);
                for (int sj = bidx() - (gdim() > 128 ? gdim() - 64 : 0); sj >= 0 && sj < 64; sj += gdim()) {
                    const int sb = sj & 15, piece = sj >> 4;
                    const Item I = get_item(256 + sb);
                    if (piece == 0) lru_item<16, true>(wv, kparams(), l, 256 + sb, I, lds);
                    else if (piece == 1) ssd_states_item<16>(wv, kparams(), l, 256 + sb, I, lds);
                    else if (piece == 2) ssd_y_item<16>(wv, kparams(), l, I, lds);
                    else { copy_states_item(wv, kparams(), l, I); attn_item<16>(wv, kparams(), l, I, lds); }
                }
            }
            gbar(wv, lds); TE(4);
            TB(5);
            for (int item = bidx(); item < 256; item += gdim()) {
                const Item I = get_item(item);
                lru_apply_item(wv, kparams(), l, item, I);
                ssd_y_item<64>(wv, kparams(), l, I, lds);
            }
            gbar(wv, lds); TE(5);
            TB(6); gemm_merge(wv, lds); gbar(wv, lds); TE(6);
            TB(7); gemm_out(wv, lds);
        }
    }
    gbar(wv, lds);
    TE(7);
    phase_final(wv, kparams());
    if (PROBE >= 0 && bidx() == 0) { const unsigned long long tend = TNOW() + tacc; while (TNOW() < tend) __builtin_amdgcn_s_sleep(10); }
#if DBG_SANITIZE
    gbar(wv, lds);
    { KP P = kparams(); float* o = P->out;
      for (size_t i = (size_t)bidx() * 512 + tidx(wv); i < O_END; i += (size_t)gdim() * 512) { const float v = o[i]; if (!(fabsf(v) < 1e30f)) o[i] = 0.f; } }
#endif
}

extern "C" void kernel_launch(void* const* d_in, const int* in_sizes, int n_in, void* d_out, int out_size, void* d_ws, size_t ws_size, hipStream_t stream) {
    static int grid_blocks = 0;
    if (grid_blocks == 0) {
        if (n_in != N_INPUTS || (size_t)out_size != O_END || ws_size < WS_END) {
            fprintf(stderr, "kernel_launch: unexpected shapes: n_in %d out %d ws %zu (need %zu)\n", n_in, out_size, ws_size, (size_t)WS_END); grid_blocks = -1; return; }
        int dev = 0, cus = 0, per_cu = 0;
        hipGetDevice(&dev);
        hipDeviceGetAttribute(&cus, hipDeviceAttributeMultiprocessorCount, dev);
        if (hipFuncSetAttribute((const void*)mega, hipFuncAttributeMaxDynamicSharedMemorySize, LDS_BYTES) != hipSuccess) { fprintf(stderr, "hipFuncSetAttribute failed\n"); grid_blocks = -1; return; }
        hipOccupancyMaxActiveBlocksPerMultiprocessor(&per_cu, (const void*)mega, 512, LDS_BYTES);
        if (per_cu < 1) per_cu = 1;
        grid_blocks = cus * per_cu;
    }
    if (grid_blocks < 0) return;
    Params p{};
    for (int i = 0; i < N_INPUTS; ++i) p.in[i] = (const float*)d_in[i];
    p.out = (float*)d_out; p.ws = (unsigned char*)d_ws;
    if (hipMemsetAsync((unsigned char*)d_ws + WS_BAR, 0, 16384, stream) != hipSuccess) { fprintf(stderr, "memset failed\n"); return; }
    void* args[] = {&p};
    hipError_t e = hipLaunchCooperativeKernel((const void*)mega, dim3(grid_blocks), dim3(512), args, LDS_BYTES, stream);
    if (e != hipSuccess) fprintf(stderr, "cooperative launch failed: %s (grid %d)\n", hipGetErrorString(e), grid_blocks);
}
```

```cpp
#include <hip/hip_runtime.h>
#include <hip/hip_cooperative_groups.h>
#include <cstdio>
namespace cg = cooperative_groups;
#define DBG_SANITIZE 0
#ifndef REP_P4
#define REP_P4 1
#endif
#ifndef REP_P6
#define REP_P6 1
#endif
#ifndef REP_SYNC
#define REP_SYNC 0
#endif
#ifndef REP_IN
#define REP_IN 1
#endif
#ifndef REP_A
#define REP_A 1
#endif
#ifndef REP_L4
#define REP_L4 1
#endif
#ifndef REP_S4
#define REP_S4 1
#endif
#ifndef REP_L6
#define REP_L6 1
#endif
#ifndef REP_S6
#define REP_S6 1
#endif
#ifndef PROBE
#define PROBE -1
#endif
#define TNOW() __builtin_amdgcn_s_memrealtime()
#define TB(id) do { if (((PROBE) >> (id)) & 1 && PROBE >= 0) t0 = TNOW(); } while (0)
#define TE(id) do { if (((PROBE) >> (id)) & 1 && PROBE >= 0) tacc += TNOW() - t0; } while (0)
#ifndef REP_CV
#define REP_CV 1
#endif
#ifndef REP_GU
#define REP_GU 1
#endif
#ifndef REP_MG
#define REP_MG 1
#endif
#define DBG_MIX 1
#define DBG_MERGE 1
#define DBG_ATTN 1
#define DBG_LRU4 1
#define DBG_SSD4 1
#define DBG_P5S 1
#define DBG_P5W 1
#define DBG_P5 1
#define DBG_LRU6 1
#define DBG_SSD6 1

#define LAS __attribute__((address_space(3)))
typedef unsigned short bf16_t;
typedef short bf16x8 __attribute__((ext_vector_type(8)));
typedef float f32x4 __attribute__((ext_vector_type(4)));
typedef unsigned u32x4 __attribute__((ext_vector_type(4)));
typedef unsigned u32x2 __attribute__((ext_vector_type(2)));

constexpr int MP = 16384, MS = 256, MT = 16640;
constexpr int DM = 1024, DFF = 2816, NIN = 9232, NINP = 9472, HP = 9232;
constexpr int HX = 0, HG = 1024, HZ = 2048, HXBC = 3072, HQ = 4608, HK = 5632, HV = 5888, HGATE = 6144, HDT = 9216;
constexpr float EPS = 1e-6f;
constexpr int NITEM = 272;

enum { I_XP = 0, I_XS, I_CK, I_CV, I_SLC, I_SLH, I_SSC, I_SSH, I_FNORM, I_WG, I_WU, I_WD, I_MNORM, I_WIN, I_LCW, I_LCB, I_LWA, I_LBA, I_LWX, I_LBX,
       I_LLAM, I_SCW, I_SCB, I_SDTB, I_SALOG, I_SD, I_SNORM, I_SINK, I_WBR, I_WOUT, I_FINAL, N_INPUTS };

constexpr size_t O_YP = 0, O_YS = O_YP + (size_t)MP * DM, O_PK = O_YS + (size_t)MS * DM, O_PV = O_PK + 4 * 2 * 128 * 256, O_PLC = O_PV + 4 * 2 * 128 * 256,
                 O_PLH = O_PLC + 4 * 2 * 3 * 1024, O_PSC = O_PLH + 4 * 2 * 1024, O_PSH = O_PSC + 4 * 2 * 3 * 1536, O_SK = O_PSH + (size_t)4 * 2 * 16 * 64 * 128,
                 O_SV = O_SK + (size_t)4 * 16 * 128 * 256, O_SLC = O_SV + (size_t)4 * 16 * 128 * 256, O_SLH = O_SLC + 4 * 16 * 3 * 1024, O_SSC = O_SLH + 4 * 16 * 1024,
                 O_SSH = O_SSC + 4 * 16 * 3 * 1536, O_END = O_SSH + (size_t)4 * 16 * 16 * 64 * 128;

constexpr size_t WS_XB = 0;
constexpr size_t WS_H = WS_XB + (size_t)MT * DM * 2;
constexpr size_t WS_ST = WS_H + (size_t)MT * HP * 2;
constexpr size_t WS_Y = WS_ST + (size_t)2 * 128 * 16 * 64 * 128 * 2;
constexpr size_t WS_W = WS_Y + (size_t)MT * 3072 * 2;
constexpr size_t W_GU0 = WS_W, W_GU1 = W_GU0 + (size_t)5632 * 1024 * 2, W_DN0 = W_GU1 + (size_t)5632 * 1024 * 2, W_DN1 = W_DN0 + (size_t)1024 * 2816 * 2,
                 W_IN = W_DN1 + (size_t)1024 * 2816 * 2, W_BR = W_IN + (size_t)NINP * 1024 * 2, W_OUT = W_BR + (size_t)1024 * 3072 * 2,
                 W_LA = W_OUT + (size_t)1024 * 1024 * 2, W_LX = W_LA + 2 * 65536 * 2, WS_SSQ = W_LX + 2 * 65536 * 2;
constexpr size_t WS_DT = WS_SSQ + (size_t)MT * 16 * 4, WS_LRUA = WS_DT + (size_t)MT * 16 * 4, WS_LRUU = WS_LRUA + 256 * 1024 * 4, WS_CDEC = WS_LRUU + 256 * 1024 * 4,
                 WS_BAR = WS_CDEC + 256 * 16 * 4, WS_SSQ2 = WS_BAR + 16384, WS_END = WS_SSQ2 + 256 * 16 * 4;

constexpr int LDS_BYTES = 147456;

struct Params { const float* in[N_INPUTS]; float* out; unsigned char* ws; };
typedef const Params __attribute__((address_space(4))) * KP;
__device__ __forceinline__ KP kparams() { KP p = (KP)__builtin_amdgcn_kernarg_segment_ptr(); asm volatile("" : "+s"(p)); return p; }
__device__ __forceinline__ int tidx(int wv) { int t; asm volatile("v_mbcnt_lo_u32_b32 %0, -1, 0\n\tv_mbcnt_hi_u32_b32 %0, -1, %0" : "=v"(t)); return (wv << 6) | t; }
__device__ __forceinline__ int bidx() { int t = blockIdx.x; asm volatile("" : "+s"(t)); return t; }
__device__ __forceinline__ int gdim() { int t = gridDim.x; asm volatile("" : "+s"(t)); return t; }

typedef __bf16 bf16x2_t __attribute__((ext_vector_type(2)));
typedef float f32x2_t __attribute__((ext_vector_type(2)));
__device__ __forceinline__ unsigned pk2(float lo, float hi) { f32x2_t v = {lo, hi}; bf16x2_t b = __builtin_convertvector(v, bf16x2_t); unsigned r; __builtin_memcpy(&r, &b, 4); return r; }
__device__ __forceinline__ bf16_t f2bf(float f) { return (bf16_t)(pk2(f, 0.f) & 0xffffu); }
__device__ __forceinline__ float bf2f(bf16_t b) { return __uint_as_float(((unsigned)b) << 16); }
__device__ __forceinline__ float bflo(unsigned w) { return __uint_as_float(w << 16); }
__device__ __forceinline__ float bfhi(unsigned w) { return __uint_as_float(w & 0xffff0000u); }
__device__ __forceinline__ float rcpf_(float x) { return __builtin_amdgcn_rcpf(x); }
__device__ __forceinline__ float sigmoidf_(float x) { return rcpf_(1.0f + __expf(-x)); }
__device__ __forceinline__ float siluf_(float x) { return x * rcpf_(1.0f + __expf(-x)); }
__device__ __forceinline__ float softplusf_(float x) { return x > 20.f ? x : log1pf(__expf(x)); }
__device__ __forceinline__ float gelu_tanh(float x) { const float u = 0.7978845608028654f * (x + 0.044715f * x * x * x); return x * rcpf_(1.0f + __expf(-2.0f * u)); }
__device__ __forceinline__ float rstd_row(const float* ssq, int r) {
    const f32x4* p = (const f32x4*)(ssq + (size_t)r * 16); f32x4 a = p[0], b = p[1], c = p[2], d = p[3];
    float s = (a[0] + a[1] + a[2] + a[3]) + (b[0] + b[1] + b[2] + b[3]) + (c[0] + c[1] + c[2] + c[3]) + (d[0] + d[1] + d[2] + d[3]);
    if (r >= MP) {
        const f32x4* q = (const f32x4*)(ssq + (WS_SSQ2 - WS_SSQ) / 4 + (size_t)(r - MP) * 16); a = q[0]; b = q[1]; c = q[2]; d = q[3];
        s += (a[0] + a[1] + a[2] + a[3]) + (b[0] + b[1] + b[2] + b[3]) + (c[0] + c[1] + c[2] + c[3]) + (d[0] + d[1] + d[2] + d[3]);
    }
    return rsqrtf(s * (1.0f / 1024.0f) + EPS);
}
__device__ __forceinline__ int lane_now() { int t; asm volatile("v_mbcnt_lo_u32_b32 %0, -1, 0\n\tv_mbcnt_hi_u32_b32 %0, -1, %0" : "=v"(t)); return t; }
__device__ __forceinline__ float shfl_idx(float v, int src) { return __int_as_float(__builtin_amdgcn_ds_bpermute(src << 2, __float_as_int(v))); }
__device__ __forceinline__ float shflx(float v, int mask) { return shfl_idx(v, lane_now() ^ mask); }
__device__ __forceinline__ float shfl_row15(float v) { return __int_as_float(__builtin_amdgcn_ds_swizzle(__float_as_int(v), 0x1F0)); }
#define MFMA16(a, b, c) __builtin_amdgcn_mfma_f32_16x16x32_bf16((a), (b), (c), 0, 0, 0)

namespace pg8 {
constexpr int BM = 256, BK = 64, HALF = 128, HTB = HALF * BK * 2, STAGE_BYTES = 8 * HTB, NXCD = 8, WGM = 8;
__device__ __forceinline__ int lds_byte(int r, int c) { const int st = (r >> 4) * 2 + (c >> 5), rr = r & 15, cc = c & 31, ob = rr * 64 + cc * 2; return st * 1024 + (ob ^ (((ob >> 9) & 1) << 5)); }
__device__ __forceinline__ void stage_rc(int b, int& R, int& C) { const int st = b / 1024, sb = b % 1024, swz = sb ^ (((sb >> 9) & 1) << 5); R = (st >> 1) * 16 + swz / 64; C = (st & 1) * 32 + (swz % 64) / 2; }
struct Unit { int pm, pn; };
struct Gemm { const bf16_t* A; const bf16_t* Bt; int M, N, K; };
struct StaticOrder {
    int nM, nN, nwg, G, c;
    __device__ void init(int M, int N, int G_, int c_) { nM = M / BM; nN = N / BM; nwg = nM * nN; G = G_; c = c_; }
    __device__ bool next(int i, Unit& u) const {
        const long L = (long)i * G + c; if (L >= nwg) return false;
        int wgid = (int)L; { const int q = nwg / NXCD, r = nwg % NXCD, xcd = wgid % NXCD, off = wgid / NXCD; wgid = (xcd < r ? xcd * (q + 1) : r * (q + 1) + (xcd - r) * q) + off; }
        const int nig = WGM * nN, gid = wgid / nig, fm = gid * WGM, gsz = (nM - fm) < WGM ? (nM - fm) : WGM;
        u.pm = fm + ((wgid % nig) % gsz); u.pn = (wgid % nig) / gsz; return true;
    }
};

template <class Epi>
__device__ __forceinline__ void gemm_phase(int wv, LAS unsigned char* lds, const Gemm g, const StaticOrder& S, const Epi& E) {
    const int tid = tidx(wv), wid = wv, lane = tid & 63, wr = wid >> 2, wc = wid & 3, fr = lane & 15, fq = lane >> 4;
    const int K = g.K, nt = K / BK;
    unsigned voffA[2];
#pragma unroll
    for (int i = 0; i < 2; ++i) { int R, C; stage_rc(tid * 16 + i * 8192, R, C); voffA[i] = (unsigned)(R * K + C) * 2u; }
    const size_t kstep = (size_t)(BK * 2);
    const size_t hstep = (size_t)HALF * K * 2;
    const size_t tstep = 2 * hstep;
    const unsigned ldsw = (unsigned)wid * 1024u;
    const int aoff = lds_byte(wr * 64 + fr, fq * 8), boff = lds_byte(wc * 32 + fr, fq * 8);
#define PG8_SA(b, h) (((b) * 2 + (h)) * HTB)
#define PG8_SB(b, h) ((4 + (b) * 2 + (h)) * HTB)
#define PG8_STAGE(bufoff, gbase, voff) do { _Pragma("unroll") for (int _i = 0; _i < 2; ++_i) \
        __builtin_amdgcn_global_load_lds((const unsigned*)((const char*)(gbase) + (voff)[_i]), (LAS unsigned*)(lds + (bufoff) + ldsw + _i * 8192), 16, 0, 0); } while (0)
#define PG8_LDA(dst, b, h) do { _Pragma("unroll") for (int m = 0; m < 4; ++m) _Pragma("unroll") for (int k = 0; k < 2; ++k) dst[m][k] = *(const LAS bf16x8*)(lds + PG8_SA(b, h) + aoff + m * 2048 + k * 1024); } while (0)
#define PG8_LDB(dst, b, h) do { _Pragma("unroll") for (int n = 0; n < 2; ++n) _Pragma("unroll") for (int k = 0; k < 2; ++k) dst[n][k] = *(const LAS bf16x8*)(lds + PG8_SB(b, h) + boff + n * 2048 + k * 1024); } while (0)
#define PG8_MMA(ai, bj, At, Bt) do { __builtin_amdgcn_s_setprio(1); _Pragma("unroll") for (int m = 0; m < 4; ++m) _Pragma("unroll") for (int n = 0; n < 2; ++n) _Pragma("unroll") for (int k = 0; k < 2; ++k) \
        acc[ai][bj][m][n] = __builtin_amdgcn_mfma_f32_16x16x32_bf16(Bt[n][k], At[m][k], acc[ai][bj][m][n], 0, 0, 0); __builtin_amdgcn_s_setprio(0); } while (0)
#define PG8_WAIT_V(n) asm volatile("s_waitcnt vmcnt(" #n ")" ::: "memory")
#define PG8_WAIT_L(n) asm volatile("s_waitcnt lgkmcnt(" #n ")" ::: "memory")
#define PG8_BAR __builtin_amdgcn_s_barrier()
#define PG8_SCHED __builtin_amdgcn_sched_barrier(0)
    Unit cur, nxt; int ui = 0;
    if (!S.next(0, cur)) return;
    f32x4 acc[2][2][4][2];
#pragma unroll
    for (int a = 0; a < 2; ++a)
#pragma unroll
        for (int b = 0; b < 2; ++b)
#pragma unroll
            for (int m = 0; m < 4; ++m)
#pragma unroll
                for (int n = 0; n < 2; ++n) acc[a][b][m][n] = (f32x4){0.f, 0.f, 0.f, 0.f};
    bf16x8 At[4][2], B0[2][2], B1[2][2];
    const char* cA = (const char*)g.A + (size_t)cur.pm * tstep; const char* cB = (const char*)g.Bt + (size_t)cur.pn * tstep;
    PG8_STAGE(PG8_SB(0, 0), cB, voffA); PG8_STAGE(PG8_SA(0, 0), cA, voffA); PG8_STAGE(PG8_SB(0, 1), cB + hstep, voffA); PG8_STAGE(PG8_SA(0, 1), cA + hstep, voffA);
    if (wr == 1) PG8_BAR;
    PG8_WAIT_V(4); PG8_BAR;
    PG8_STAGE(PG8_SB(1, 0), cB + kstep, voffA); PG8_STAGE(PG8_SA(1, 0), cA + kstep, voffA); PG8_STAGE(PG8_SB(1, 1), cB + hstep + kstep, voffA);
    PG8_WAIT_V(6); PG8_BAR;
    for (;;) {
        if constexpr (Epi::NEEDS_RSTD) {
            LAS float* rb = (LAS float*)(lds + STAGE_BYTES) + (ui & 1) * 256;
            const int t2 = tidx(wv);
            if (t2 < 256) rb[t2] = rstd_row(E.ssq, cur.pm * 256 + t2);
        }
        const bool has_next = S.next(ui + 1, nxt);
        const char* nA = has_next ? (const char*)g.A + (size_t)nxt.pm * tstep : cA; const char* nB = has_next ? (const char*)g.Bt + (size_t)nxt.pn * tstep : cB;
        for (int t = 0; t < nt; t += 2) {
            const bool last = (t == nt - 2);
            const char* a1 = cA + (size_t)(t + 1) * kstep;
            const char* a2 = last ? nA : cA + (size_t)(t + 2) * kstep; const char* b2 = last ? nB : cB + (size_t)(t + 2) * kstep;
            const char* a3 = a2 + kstep; const char* b3 = b2 + kstep;
            PG8_LDB(B0, 0, 0); PG8_SCHED; PG8_LDA(At, 0, 0); PG8_STAGE(PG8_SA(1, 1), a1 + hstep, voffA);
            PG8_WAIT_L(8); PG8_BAR; PG8_WAIT_L(0); PG8_MMA(0, 0, At, B0); PG8_BAR; PG8_SCHED;
            PG8_LDB(B1, 0, 1); PG8_STAGE(PG8_SB(0, 0), b2, voffA);
            PG8_BAR; PG8_WAIT_L(0); PG8_MMA(0, 1, At, B1); PG8_BAR;
            PG8_LDA(At, 0, 1); PG8_STAGE(PG8_SA(0, 0), a2, voffA);
            PG8_BAR; PG8_WAIT_L(0); PG8_MMA(1, 0, At, B0); PG8_BAR; PG8_SCHED;
            PG8_STAGE(PG8_SB(0, 1), b2 + hstep, voffA);
            PG8_WAIT_V(6); PG8_BAR; PG8_MMA(1, 1, At, B1); PG8_BAR;
            PG8_LDB(B0, 1, 0); PG8_SCHED; PG8_LDA(At, 1, 0); PG8_STAGE(PG8_SA(0, 1), a2 + hstep, voffA);
            PG8_WAIT_L(8); PG8_BAR; PG8_WAIT_L(0); PG8_MMA(0, 0, At, B0); PG8_BAR; PG8_SCHED;
            PG8_LDB(B1, 1, 1); PG8_STAGE(PG8_SB(1, 0), b3, voffA);
            PG8_BAR; PG8_WAIT_L(0); PG8_MMA(0, 1, At, B1); PG8_BAR;
            PG8_LDA(At, 1, 1); PG8_STAGE(PG8_SA(1, 0), a3, voffA);
            PG8_BAR; PG8_WAIT_L(0); PG8_MMA(1, 0, At, B0); PG8_BAR; PG8_SCHED;
            PG8_STAGE(PG8_SB(1, 1), b3 + hstep, voffA);
            PG8_WAIT_V(6); PG8_BAR; PG8_MMA(1, 1, At, B1); PG8_BAR;
            if constexpr (Epi::HAS_MID) { if (!last && ((t + 2) & 15) == 0) E.mid(acc, cur, (t + 2) >> 4, wr, wc, fr, fq); }
        }
        if constexpr (Epi::NEEDS_RSTD) E.rb = (const LAS float*)(lds + STAGE_BYTES) + (ui & 1) * 256;
        E(acc, cur, wr, wc, fr, fq);
        if (!has_next) break;
#pragma unroll
        for (int a = 0; a < 2; ++a)
#pragma unroll
            for (int b = 0; b < 2; ++b)
#pragma unroll
                for (int m = 0; m < 4; ++m)
#pragma unroll
                    for (int n = 0; n < 2; ++n) acc[a][b][m][n] = (f32x4){0.f, 0.f, 0.f, 0.f};
        cur = nxt; cA = nA; cB = nB; ++ui;
    }
    PG8_WAIT_V(0);
    if (wr == 0) PG8_BAR;
    PG8_BAR;
#undef PG8_SA
#undef PG8_SB
#undef PG8_STAGE
#undef PG8_LDA
#undef PG8_LDB
#undef PG8_MMA
#undef PG8_WAIT_V
#undef PG8_WAIT_L
#undef PG8_BAR
#undef PG8_SCHED
}
}
using pg8::Unit;
typedef f32x4 AccT[2][2][4][2];

struct EpiGU {
    static constexpr bool HAS_MID = false, NEEDS_RSTD = true;
    const float* ssq; bf16_t* hff; mutable const LAS float* rb;
    __device__ __forceinline__ void mid(AccT&, const Unit&, int, int, int, int, int) const {}
    __device__ __forceinline__ void operator()(const AccT& acc, const Unit& u, int wr, int wc, int fr_, int fq_) const {
        int fr = fr_, fq = fq_; asm volatile("" : "+v"(fr), "+v"(fq));
        const int row0 = u.pm * 256 + wr * 64 + fr, hc0 = u.pn * 128 + wc * 32 + fq * 8;
#pragma unroll
        for (int ai = 0; ai < 2; ++ai)
#pragma unroll
            for (int m = 0; m < 4; ++m) {
                const int r = row0 + ai * 128 + m * 16; const float rs = rb[wr * 64 + fr + ai * 128 + m * 16];
                u32x4 w;
                { const f32x4 gt = acc[ai][0][m][0] * rs, up = acc[ai][0][m][1] * rs;
                  w.x = pk2(siluf_(gt[0]) * up[0], siluf_(gt[1]) * up[1]); w.y = pk2(siluf_(gt[2]) * up[2], siluf_(gt[3]) * up[3]); }
                { const f32x4 gt = acc[ai][1][m][0] * rs, up = acc[ai][1][m][1] * rs;
                  w.z = pk2(siluf_(gt[0]) * up[0], siluf_(gt[1]) * up[1]); w.w = pk2(siluf_(gt[2]) * up[2], siluf_(gt[3]) * up[3]); }
                *(u32x4*)(hff + (size_t)r * DFF + hc0) = w;
            }
    }
};
struct EpiRes {
    static constexpr bool HAS_MID = false, NEEDS_RSTD = false;
    float* x; bf16_t* xb; float* ssq; float scale;
    __device__ __forceinline__ void mid(AccT&, const Unit&, int, int, int, int, int) const {}
    __device__ __forceinline__ void operator()(const AccT& acc, const Unit& u, int wr, int wc, int fr_, int fq_) const {
        int fr = fr_, fq = fq_; asm volatile("" : "+v"(fr), "+v"(fq));
        const int row0 = u.pm * 256 + wr * 64 + fr, col0 = u.pn * 256 + wc * 32 + 8 * fq;
#pragma unroll
        for (int ai = 0; ai < 2; ++ai) {
            f32x4 xv[4][2][2];
#pragma unroll
            for (int m = 0; m < 4; ++m)
#pragma unroll
                for (int bj = 0; bj < 2; ++bj)
#pragma unroll
                    for (int n = 0; n < 2; ++n) xv[m][bj][n] = *(const f32x4*)(x + (size_t)(row0 + ai * 128 + m * 16) * DM + col0 + bj * 128 + n * 4);
#pragma unroll
            for (int m = 0; m < 4; ++m) {
                const int r = row0 + ai * 128 + m * 16; float ss = 0.f;
#pragma unroll
                for (int bj = 0; bj < 2; ++bj) {
                    const int c = col0 + bj * 128;
                    const f32x4 v0 = xv[m][bj][0] + acc[ai][bj][m][0] * scale, v1 = xv[m][bj][1] + acc[ai][bj][m][1] * scale;
                    *(f32x4*)(x + (size_t)r * DM + c) = v0; *(f32x4*)(x + (size_t)r * DM + c + 4) = v1;
                    u32x4 w; w.x = pk2(v0[0], v0[1]); w.y = pk2(v0[2], v0[3]); w.z = pk2(v1[0], v1[1]); w.w = pk2(v1[2], v1[3]);
                    *(u32x4*)(xb + (size_t)r * DM + c) = w;
                    ss += v0[0] * v0[0] + v0[1] * v0[1] + v0[2] * v0[2] + v0[3] * v0[3] + v1[0] * v1[0] + v1[1] * v1[1] + v1[2] * v1[2] + v1[3] * v1[3];
                }
                ss += shflx(ss, 16); ss += shflx(ss, 32);
                if (fq == 0) ssq[(size_t)r * 16 + u.pn * 4 + wc] = ss;
            }
        }
    }
};
struct EpiIn {
    static constexpr bool HAS_MID = false, NEEDS_RSTD = true;
    const float* ssq; bf16_t* h; float* dtraw; mutable const LAS float* rb;
    __device__ __forceinline__ void mid(AccT&, const Unit&, int, int, int, int, int) const {}
    __device__ __forceinline__ void operator()(const AccT& acc, const Unit& u, int wr, int wc, int fr_, int fq_) const {
        int fr = fr_, fq = fq_; asm volatile("" : "+v"(fr), "+v"(fq));
        const int row0 = u.pm * 256 + wr * 64 + fr, col0 = u.pn * 256 + wc * 32 + 8 * fq;
#pragma unroll
        for (int ai = 0; ai < 2; ++ai)
#pragma unroll
            for (int m = 0; m < 4; ++m) {
                const int r = row0 + ai * 128 + m * 16; const float rs = rb[wr * 64 + fr + ai * 128 + m * 16];
                if (u.pn < 36) {
#pragma unroll
                    for (int bj = 0; bj < 2; ++bj) {
                        const f32x4 v0 = acc[ai][bj][m][0] * rs, v1 = acc[ai][bj][m][1] * rs;
                        u32x4 w; w.x = pk2(v0[0], v0[1]); w.y = pk2(v0[2], v0[3]); w.z = pk2(v1[0], v1[1]); w.w = pk2(v1[2], v1[3]);
                        *(u32x4*)(h + (size_t)r * HP + col0 + bj * 128) = w;
                    }
                } else if (wc == 0 && fq < 2) {
                    *(f32x4*)(dtraw + (size_t)r * 16 + 8 * fq) = acc[ai][0][m][0] * rs;
                    *(f32x4*)(dtraw + (size_t)r * 16 + 8 * fq + 4) = acc[ai][0][m][1] * rs;
                }
            }
    }
};
struct EpiMerge {
    static constexpr bool HAS_MID = true, NEEDS_RSTD = false;
    const bf16_t* h; bf16_t* merged;
    __device__ __forceinline__ void mid(AccT& acc, const Unit& u, int seg, int wr, int wc, int fr_, int fq_) const {
        int fr = fr_, fq = fq_; asm volatile("" : "+v"(fr), "+v"(fq));
        const int row0 = u.pm * 256 + wr * 64 + fr, col0 = u.pn * 256 + wc * 32 + 8 * fq;
#pragma unroll
        for (int ai = 0; ai < 2; ++ai) {
            u32x2 ga[4][2][2], gb[4][2][2];
#pragma unroll
            for (int m = 0; m < 4; ++m)
#pragma unroll
                for (int bj = 0; bj < 2; ++bj)
#pragma unroll
                    for (int n = 0; n < 2; ++n) {
                        const bf16_t* gp = h + (size_t)(row0 + ai * 128 + m * 16) * HP + HGATE + (seg - 1) * 1024 + col0 + bj * 128 + n * 4;
                        ga[m][bj][n] = *(const u32x2*)gp; gb[m][bj][n] = *(const u32x2*)(gp + 1024);
                    }
#pragma unroll
            for (int m = 0; m < 4; ++m)
#pragma unroll
                for (int bj = 0; bj < 2; ++bj)
#pragma unroll
                    for (int n = 0; n < 2; ++n) {
                        const u32x2 a = ga[m][bj][n], b = gb[m][bj][n];
                        f32x4 f;
                        f[0] = (1.f + __expf(-fmaxf(bflo(b.x), -30.f))) * rcpf_(1.f + __expf(-fmaxf(bflo(a.x), -30.f)));
                        f[1] = (1.f + __expf(-fmaxf(bfhi(b.x), -30.f))) * rcpf_(1.f + __expf(-fmaxf(bfhi(a.x), -30.f)));
                        f[2] = (1.f + __expf(-fmaxf(bflo(b.y), -30.f))) * rcpf_(1.f + __expf(-fmaxf(bflo(a.y), -30.f)));
                        f[3] = (1.f + __expf(-fmaxf(bfhi(b.y), -30.f))) * rcpf_(1.f + __expf(-fmaxf(bfhi(a.y), -30.f)));
                        acc[ai][bj][m][n] *= f;
                    }
        }
    }
    __device__ __forceinline__ void operator()(const AccT& acc, const Unit& u, int wr, int wc, int fr_, int fq_) const {
        int fr = fr_, fq = fq_; asm volatile("" : "+v"(fr), "+v"(fq));
        const int row0 = u.pm * 256 + wr * 64 + fr, col0 = u.pn * 256 + wc * 32 + 8 * fq;
#pragma unroll
        for (int ai = 0; ai < 2; ++ai) {
            u32x2 gv[4][2][2];
#pragma unroll
            for (int m = 0; m < 4; ++m)
#pragma unroll
                for (int bj = 0; bj < 2; ++bj)
#pragma unroll
                    for (int n = 0; n < 2; ++n) gv[m][bj][n] = *(const u32x2*)(h + (size_t)(row0 + ai * 128 + m * 16) * HP + HGATE + 2048 + col0 + bj * 128 + n * 4);
#pragma unroll
            for (int m = 0; m < 4; ++m)
#pragma unroll
                for (int bj = 0; bj < 2; ++bj)
#pragma unroll
                    for (int n = 0; n < 2; ++n) {
                        const u32x2 ga = gv[m][bj][n];
                        const f32x4 v = acc[ai][bj][m][n];
                        u32x2 w;
                        w.x = pk2(v[0] * rcpf_(1.f + __expf(-fmaxf(bflo(ga.x), -30.f))), v[1] * rcpf_(1.f + __expf(-fmaxf(bfhi(ga.x), -30.f))));
                        w.y = pk2(v[2] * rcpf_(1.f + __expf(-fmaxf(bflo(ga.y), -30.f))), v[3] * rcpf_(1.f + __expf(-fmaxf(bfhi(ga.y), -30.f))));
                        *(u32x2*)(merged + (size_t)(row0 + ai * 128 + m * 16) * DM + col0 + bj * 128 + n * 4) = w;
                    }
        }
    }
};

template <class Epi> __device__ __forceinline__ void run_gemm(int wv, LAS unsigned char* lds, const bf16_t* A, const bf16_t* Bt, int M, int N, int K, const Epi& E) {
    asm volatile("" : "+s"(wv));
    pg8::Gemm g; g.A = A; g.Bt = Bt; g.M = M; g.N = N; g.K = K;
    pg8::StaticOrder S; S.init(M, N, (int)gdim(), (int)bidx());
    pg8::gemm_phase<Epi>(wv, lds, g, S, E);
}


template <int MODE>
__device__ __forceinline__ void skinny_gemm(int wv, LAS unsigned char* lds, KP P, const bf16_t* A, const bf16_t* Bt, int K, float scale) {
    const int tid = tidx(wv), w = tid >> 6, lane = tid & 63, fr = lane & 15, fq = lane >> 4;
    LAS float* part = (LAS float*)lds;
    constexpr int NSEG = MODE ? 3 : 1;
    const int kseg = K / NSEG, kw = kseg / 8;
    const bf16_t* h = (const bf16_t*)(P->ws + WS_H);
    for (int task = bidx(); task < 256; task += gdim()) {
        const int rt = task >> 5, ct = task & 31;
        f32x4 tot[2][2];
#pragma unroll
        for (int i = 0; i < 2; ++i)
#pragma unroll
            for (int j = 0; j < 2; ++j) tot[i][j] = (f32x4){0.f, 0.f, 0.f, 0.f};
#pragma unroll 1
        for (int seg = 0; seg < NSEG; ++seg) {
            f32x4 acc[2][2];
#pragma unroll
            for (int i = 0; i < 2; ++i)
#pragma unroll
                for (int j = 0; j < 2; ++j) acc[i][j] = (f32x4){0.f, 0.f, 0.f, 0.f};
            const bf16_t* ap = A + (size_t)(rt * 32 + fr) * K + seg * kseg + w * kw + fq * 8;
            const bf16_t* bp = Bt + (size_t)(ct * 32 + fr) * K + seg * kseg + w * kw + fq * 8;
#pragma unroll 2
            for (int k = 0; k < kw; k += 32) {
                const bf16x8 a0 = *(const bf16x8*)(ap + k), a1 = *(const bf16x8*)(ap + (size_t)16 * K + k);
                const bf16x8 b0 = *(const bf16x8*)(bp + k), b1 = *(const bf16x8*)(bp + (size_t)16 * K + k);
                acc[0][0] = MFMA16(b0, a0, acc[0][0]); acc[0][1] = MFMA16(b1, a0, acc[0][1]);
                acc[1][0] = MFMA16(b0, a1, acc[1][0]); acc[1][1] = MFMA16(b1, a1, acc[1][1]);
            }
#pragma unroll
            for (int i = 0; i < 2; ++i)
#pragma unroll
                for (int j = 0; j < 2; ++j) {
                    if (MODE) {
                        const u32x2 gw = *(const u32x2*)(h + (size_t)(MP + rt * 32 + i * 16 + fr) * HP + HGATE + seg * 1024 + ct * 32 + 8 * fq + 4 * j);
                        f32x4 sg; sg[0] = sigmoidf_(bflo(gw.x)); sg[1] = sigmoidf_(bfhi(gw.x)); sg[2] = sigmoidf_(bflo(gw.y)); sg[3] = sigmoidf_(bfhi(gw.y));
                        tot[i][j] += acc[i][j] * sg;
                    } else tot[i][j] = acc[i][j];
                }
        }
        __syncthreads();
#pragma unroll
        for (int i = 0; i < 2; ++i)
#pragma unroll
            for (int j = 0; j < 2; ++j) *(LAS f32x4*)(part + (w * 32 + i * 16 + fr) * 36 + 8 * fq + 4 * j) = tot[i][j];
        __syncthreads();
        const int row = tid >> 4, c2 = (tid & 15) * 2;
        float v0 = 0.f, v1 = 0.f;
#pragma unroll
        for (int ww = 0; ww < 8; ++ww) { v0 += part[(ww * 32 + row) * 36 + c2]; v1 += part[(ww * 32 + row) * 36 + c2 + 1]; }
        const int r = MP + rt * 32 + row, c = ct * 32 + c2;
        if (MODE) {
            *(unsigned*)((bf16_t*)(P->ws + WS_ST) + (size_t)r * DM + c) = pk2(v0, v1);
        } else {
            float* xp = P->out + (size_t)r * DM + c;
            const float x0 = xp[0] + scale * v0, x1 = xp[1] + scale * v1;
            xp[0] = x0; xp[1] = x1;
            *(unsigned*)((bf16_t*)(P->ws + WS_XB) + (size_t)r * DM + c) = pk2(x0, x1);
            float ss = x0 * x0 + x1 * x1;
            ss += shflx(ss, 1); ss += shflx(ss, 2); ss += shflx(ss, 4); ss += shflx(ss, 8);
            if ((tid & 15) == 0) {
                float* ssq = (float*)(P->ws + WS_SSQ);
                if (ct < 16) ssq[(size_t)r * 16 + ct] = ss; else ssq[(WS_SSQ2 - WS_SSQ) / 4 + (size_t)(r - MP) * 16 + (ct - 16)] = ss;
            }
        }
    }
}

struct CvtJob { const float* src; const float* gk; bf16_t* dst; int src_ld, dst_ld, k0, nsrc0, nvalid, rowbase, kind, which; };
__device__ __forceinline__ bool cvt_decode(KP P, int l, int part, int job, CvtJob& J) {
    constexpr int J_GU = 2 * 2 * 16 * 44, J_DN = 2 * 44 * 16, J_IN = 16 * 145, J_BR = 48 * 16, J_OUT = 16 * 16;
    int j = job; J.gk = nullptr; J.kind = 0; J.which = 0; J.nvalid = 64;
    if (j < J_GU) {
        const int nt = j % 44; j /= 44; const int kt = j % 16; j /= 16; const int which = j & 1, j2 = j >> 1;
        if (j2 != part) return false;
        J.src = P->in[which ? I_WU : I_WG] + (size_t)(l * 2 + j2) * 1024 * 2816; J.src_ld = 2816; J.k0 = kt * 64; J.nsrc0 = nt * 64;
        J.gk = P->in[I_FNORM] + (l * 2 + j2) * 1024; J.dst = (bf16_t*)(P->ws + (j2 ? W_GU1 : W_GU0)); J.dst_ld = 1024; J.rowbase = nt * 64; J.kind = 1; J.which = which;
        return true;
    }
    j -= J_GU;
    if (j < J_DN) {
        const int nt = j % 16; j /= 16; const int kt = j % 44; const int j2 = j / 44;
        if (j2 != part) return false;
        J.src = P->in[I_WD] + (size_t)(l * 2 + j2) * 2816 * 1024; J.src_ld = 1024; J.k0 = kt * 64; J.nsrc0 = nt * 64;
        J.dst = (bf16_t*)(P->ws + (j2 ? W_DN1 : W_DN0)); J.dst_ld = 2816; J.rowbase = nt * 64; J.kind = 2;
        return true;
    }
    j -= J_DN;
    if (j < J_IN) {
        if (part != 0) return false;
        const int nt = j % 145, kt = j / 145;
        J.src = P->in[I_WIN] + (size_t)l * 1024 * NIN; J.src_ld = NIN; J.k0 = kt * 64; J.nsrc0 = nt < 72 ? nt * 64 : (nt < 144 ? nt * 64 + 16 : 4608); J.nvalid = nt < 144 ? 64 : 16;
        J.gk = P->in[I_MNORM] + l * 1024; J.dst = (bf16_t*)(P->ws + W_IN); J.dst_ld = 1024; J.rowbase = nt * 64; J.kind = 2;
        return true;
    }
    j -= J_IN;
    if (j < J_BR) {
        if (part != 1) return false;
        const int nt = j % 16, kt = j / 16;
        J.src = P->in[I_WBR] + (size_t)l * 3072 * 1024; J.src_ld = 1024; J.k0 = kt * 64; J.nsrc0 = nt * 64; J.dst = (bf16_t*)(P->ws + W_BR); J.dst_ld = 3072; J.rowbase = nt * 64; J.kind = 2;
        return true;
    }
    j -= J_BR;
    if (j < J_OUT) {
        if (part != 1) return false;
        const int nt = j % 16, kt = j / 16;
        J.src = P->in[I_WOUT] + (size_t)l * 1024 * 1024; J.src_ld = 1024; J.k0 = kt * 64; J.nsrc0 = nt * 64; J.dst = (bf16_t*)(P->ws + W_OUT); J.dst_ld = 1024; J.rowbase = nt * 64; J.kind = 2;
        return true;
    }
    j -= J_OUT;
    if (part != 0) return false;
    const int blk = j & 15, which = j >> 4;
    J.src = P->in[which ? I_LWX : I_LWA] + (size_t)(l * 16 + blk) * 4096; J.src_ld = 64; J.k0 = 0; J.nsrc0 = 0;
    J.dst = (bf16_t*)(P->ws + (which ? W_LX : W_LA)) + (l & 1) * 65536 + blk * 4096; J.dst_ld = 64; J.rowbase = 0;
    return true;
}
__device__ __forceinline__ void cvt_load(const CvtJob& J, int tid, f32x4& v0, f32x4& v1, float& g0, float& g1) {
    const int kk = tid >> 4, n4 = (tid & 15) * 4;
    v0 = (f32x4){0.f, 0.f, 0.f, 0.f}; v1 = v0;
    if (n4 < J.nvalid) {
        v0 = __builtin_nontemporal_load((const f32x4*)(J.src + (size_t)(J.k0 + kk) * J.src_ld + J.nsrc0 + n4)); v1 = __builtin_nontemporal_load((const f32x4*)(J.src + (size_t)(J.k0 + kk + 32) * J.src_ld + J.nsrc0 + n4)); }
    g0 = J.gk ? J.gk[J.k0 + kk] : 1.0f; g1 = J.gk ? J.gk[J.k0 + kk + 32] : 1.0f;
}
__device__ __forceinline__ void convert_layer(int wv, KP P, int l, int part, int nb, LAS unsigned char* lds) {
    LAS float* tile = (LAS float*)lds;
    constexpr int J_TOT = 2 * 2 * 16 * 44 + 2 * 44 * 16 + 16 * 145 + 48 * 16 + 16 * 16 + 32;
    const int tid = tidx(wv), stride = nb;
    int job = bidx() < nb ? bidx() : J_TOT;
    CvtJob cur, nxt; bool have = false, hn = false;
    while (job < J_TOT && !have) { have = cvt_decode(P, l, part, job, cur); job += stride; }
    f32x4 v0, v1, n0, n1; float g0 = 1.f, g1 = 1.f, h0 = 1.f, h1 = 1.f;
    v0 = (f32x4){0.f, 0.f, 0.f, 0.f}; v1 = v0; n0 = v0; n1 = v0;
    if (have) cvt_load(cur, tid, v0, v1, g0, g1);
    __syncthreads();
    while (have) {
        hn = false;
        while (job < J_TOT && !hn) { hn = cvt_decode(P, l, part, job, nxt); job += stride; }
        if (hn) cvt_load(nxt, tid, n0, n1, h0, h1);
        {
            const int kk = tid >> 4, n4 = (tid & 15) * 4;
            tile[kk * 65 + n4 + 0] = v0[0] * g0; tile[kk * 65 + n4 + 1] = v0[1] * g0; tile[kk * 65 + n4 + 2] = v0[2] * g0; tile[kk * 65 + n4 + 3] = v0[3] * g0;
            tile[(kk + 32) * 65 + n4 + 0] = v1[0] * g1; tile[(kk + 32) * 65 + n4 + 1] = v1[1] * g1; tile[(kk + 32) * 65 + n4 + 2] = v1[2] * g1; tile[(kk + 32) * 65 + n4 + 3] = v1[3] * g1;
        }
        asm volatile("s_waitcnt lgkmcnt(0)\n\ts_barrier" ::: "memory");
        {
            const int nl = tid >> 3, k8 = (tid & 7) * 8;
            if (nl < cur.nvalid) {
                u32x4 w;
                w.x = pk2(tile[(k8 + 0) * 65 + nl], tile[(k8 + 1) * 65 + nl]); w.y = pk2(tile[(k8 + 2) * 65 + nl], tile[(k8 + 3) * 65 + nl]);
                w.z = pk2(tile[(k8 + 4) * 65 + nl], tile[(k8 + 5) * 65 + nl]); w.w = pk2(tile[(k8 + 6) * 65 + nl], tile[(k8 + 7) * 65 + nl]);
                int row = cur.rowbase + nl;
                if (cur.kind == 1) { const int hc = row; row = 256 * (hc >> 7) + 128 * ((hc >> 2) & 1) + 32 * ((hc >> 5) & 3) + 16 * cur.which + 4 * ((hc >> 3) & 3) + (hc & 3); }
                else if (cur.kind == 2) { const int c = row; row = (c & ~31) + 16 * ((c >> 2) & 1) + 4 * ((c >> 3) & 3) + (c & 3); }
                *(u32x4*)(cur.dst + (size_t)row * cur.dst_ld + cur.k0 + k8) = w;
            }
        }
        asm volatile("s_waitcnt lgkmcnt(0)\n\ts_barrier" ::: "memory");
        cur = nxt; v0 = n0; v1 = n1; g0 = h0; g1 = h1; have = hn;
    }
    __syncthreads();
}

__device__ __forceinline__ void phase_init(int wv, KP P) {
    const int w = tidx(wv) >> 6, lane = tidx(wv) & 63;
    float* x = P->out; bf16_t* xb = (bf16_t*)(P->ws + WS_XB); float* ssq = (float*)(P->ws + WS_SSQ);
    for (int row = bidx() * 8 + w; row < MT; row += gdim() * 8) {
        const float* src = row < MP ? P->in[I_XP] + (size_t)row * DM : P->in[I_XS] + (size_t)(row - MP) * DM;
        float ss = 0.f;
        f32x4 vv[4];
#pragma unroll
        for (int i = 0; i < 4; ++i) vv[i] = __builtin_nontemporal_load((const f32x4*)(src + (i * 64 + lane) * 4));
#pragma unroll
        for (int i = 0; i < 4; ++i) {
            const int c = (i * 64 + lane) * 4;
            const f32x4 v = vv[i];
            *(f32x4*)(x + (size_t)row * DM + c) = v;
            u32x2 pw; pw.x = pk2(v[0], v[1]); pw.y = pk2(v[2], v[3]);
            *(u32x2*)(xb + (size_t)row * DM + c) = pw;
            ss += v[0] * v[0] + v[1] * v[1] + v[2] * v[2] + v[3] * v[3];
        }
#pragma unroll
        for (int d = 32; d >= 1; d >>= 1) ss += shflx(ss, d);
        if (lane < 16) ssq[(size_t)row * 16 + lane] = lane == 0 ? ss : 0.f;
        if (row >= MP && lane < 16) ssq[(WS_SSQ2 - WS_SSQ) / 4 + (size_t)(row - MP) * 16 + lane] = 0.f;
    }
}
__device__ __forceinline__ void phase_final(int wv, KP P) {
    const int w = tidx(wv) >> 6, lane = tidx(wv) & 63;
    float* x = P->out; const float* ssq = (const float*)(P->ws + WS_SSQ); const float* gf = P->in[I_FINAL];
    for (int row = bidx() * 8 + w; row < MT; row += gdim() * 8) {
        const float rs = rstd_row(ssq, row);
        f32x4 vv[4], gg[4];
#pragma unroll
        for (int i = 0; i < 4; ++i) { const int c = (i * 64 + lane) * 4; vv[i] = *(const f32x4*)(x + (size_t)row * DM + c); gg[i] = *(const f32x4*)(gf + c); }
#pragma unroll
        for (int i = 0; i < 4; ++i) { const int c = (i * 64 + lane) * 4; *(f32x4*)(x + (size_t)row * DM + c) = vv[i] * rs * gg[i]; }
    }
}

struct Item { int row0, L, b, c, sb, sample; };
__device__ __forceinline__ Item get_item(int it) {
    Item I;
    if (it < 256) { I.b = it >> 7; I.c = it & 127; I.row0 = I.b * 8192 + I.c * 64; I.L = 64; I.sample = 0; I.sb = 0; }
    else { I.sb = it - 256; I.b = 0; I.c = 0; I.row0 = MP + I.sb * 16; I.L = 16; I.sample = 1; }
    return I;
}

__device__ __forceinline__ void copy_states_item(int wv, KP P, int l, const Item& I) {
    const bf16_t* h = (const bf16_t*)(P->ws + WS_H);
    const int tid = tidx(wv);
    if (!I.sample) {
        if (I.c >= 126) {
            {
                const int cc = (tid & 63) * 8, kv = cc >> 8, e = cc & 255;
                u32x4 w4[8];
#pragma unroll
                for (int q = 0; q < 8; ++q) w4[q] = *(const u32x4*)(h + (size_t)(I.row0 + (tid >> 6) + 8 * q) * HP + (kv ? HV : HK) + e);
#pragma unroll
                for (int q = 0; q < 8; ++q) {
                    const int t = (tid >> 6) + 8 * q;
                    float* op = P->out + (kv ? O_PV : O_PK) + ((size_t)(l * 2 + I.b) * 128 + (I.c - 126) * 64 + t) * 256 + e;
                    *(f32x4*)op = (f32x4){bflo(w4[q].x), bfhi(w4[q].x), bflo(w4[q].y), bfhi(w4[q].y)};
                    *(f32x4*)(op + 4) = (f32x4){bflo(w4[q].z), bfhi(w4[q].z), bflo(w4[q].w), bfhi(w4[q].w)};
                }
            }
        }
        if (I.c == 127) {
            for (int idx = tid; idx < 3 * 1024; idx += 512) { const int j = idx >> 10, ch = idx & 1023;
                P->out[O_PLC + ((size_t)(l * 2 + I.b) * 3 + j) * 1024 + ch] = bf2f(h[(size_t)(I.row0 + 61 + j) * HP + HX + ch]); }
            for (int idx = tid; idx < 3 * 1536; idx += 512) { const int j = idx / 1536, ch = idx % 1536;
                P->out[O_PSC + ((size_t)(l * 2 + I.b) * 3 + j) * 1536 + ch] = bf2f(h[(size_t)(I.row0 + 61 + j) * HP + HXBC + ch]); }
        }
    } else {
        {
            const int cc = (tid & 63) * 8, kv = cc >> 8, e = cc & 255;
            const float* cin = P->in[kv ? I_CV : I_CK] + ((size_t)(l * 16 + I.sb) * 128 + 16) * 256 + e;
            float* cout = P->out + (kv ? O_SV : O_SK) + ((size_t)(l * 16 + I.sb) * 128) * 256 + e;
#pragma unroll 1
            for (int qb = 0; qb < 14; qb += 7) {
                f32x4 a[7], b[7];
#pragma unroll
                for (int q = 0; q < 7; ++q) { const int j = (tid >> 6) + 8 * (qb + q); a[q] = __builtin_nontemporal_load((const f32x4*)(cin + (size_t)j * 256)); b[q] = __builtin_nontemporal_load((const f32x4*)(cin + (size_t)j * 256 + 4)); }
#pragma unroll
                for (int q = 0; q < 7; ++q) { const int j = (tid >> 6) + 8 * (qb + q); *(f32x4*)(cout + (size_t)j * 256) = a[q]; *(f32x4*)(cout + (size_t)j * 256 + 4) = b[q]; }
            }
            u32x4 w4[2];
#pragma unroll
            for (int q = 0; q < 2; ++q) w4[q] = *(const u32x4*)(h + (size_t)(I.row0 + (tid >> 6) + 8 * q) * HP + (kv ? HV : HK) + e);
#pragma unroll
            for (int q = 0; q < 2; ++q) {
                float* op = cout + (size_t)(112 + (tid >> 6) + 8 * q) * 256;
                *(f32x4*)op = (f32x4){bflo(w4[q].x), bfhi(w4[q].x), bflo(w4[q].y), bfhi(w4[q].y)};
                *(f32x4*)(op + 4) = (f32x4){bflo(w4[q].z), bfhi(w4[q].z), bflo(w4[q].w), bfhi(w4[q].w)};
            }
        }
        for (int idx = tid; idx < 3 * 1024; idx += 512) { const int j = idx >> 10, ch = idx & 1023;
            P->out[O_SLC + ((size_t)(l * 16 + I.sb) * 3 + j) * 1024 + ch] = bf2f(h[(size_t)(I.row0 + 13 + j) * HP + HX + ch]); }
        for (int idx = tid; idx < 3 * 1536; idx += 512) { const int j = idx / 1536, ch = idx % 1536;
            P->out[O_SSC + ((size_t)(l * 16 + I.sb) * 3 + j) * 1536 + ch] = bf2f(h[(size_t)(I.row0 + 13 + j) * HP + HXBC + ch]); }
    }
}

template <int L>
__device__ __forceinline__ void attn_item(int wv, KP P, int l, const Item& I, LAS unsigned char* lds) {
    constexpr int NS = (L == 64) ? 192 : 160;
    constexpr int NST = NS / 16, NKS = NS / 32, NQT = L / 16;
    const bf16_t* h = (const bf16_t*)(P->ws + WS_H);
    bf16_t* yabc = (bf16_t*)(P->ws + WS_Y);
    const int tid = tidx(wv), w = tid >> 6, lane = tid & 63, fr = lane & 15, fq = lane >> 4;
    LAS bf16_t* Kl = (LAS bf16_t*)lds;
    LAS bf16_t* Vt = Kl + 2 * 192 * 72;
    for (int pass = 0; pass < 2; ++pass) {
        __syncthreads();
        for (int idx = tid; idx < 2 * NS * 8; idx += 512) {
            const int dp = idx & 7, s = (idx >> 3) % NS, kvl = idx / (8 * NS), kvh = pass * 2 + kvl;
            u32x4 kw = (u32x4){0u, 0u, 0u, 0u}, vw = (u32x4){0u, 0u, 0u, 0u};
            if (L == 64) {
                const int pos = (I.c - 2) * 64 + s;
                if (pos >= 0) {
                    const bf16_t* rp = h + (size_t)(I.b * 8192 + pos) * HP + kvh * 64 + dp * 8;
                    kw = *(const u32x4*)(rp + HK); vw = *(const u32x4*)(rp + HV);
                }
            } else {
                if (s < 128) {
                    const size_t o = ((size_t)(l * 16 + I.sb) * 128 + s) * 256 + kvh * 64 + dp * 8;
                    const f32x4 k0 = *(const f32x4*)(P->in[I_CK] + o), k1 = *(const f32x4*)(P->in[I_CK] + o + 4);
                    const f32x4 v0 = *(const f32x4*)(P->in[I_CV] + o), v1 = *(const f32x4*)(P->in[I_CV] + o + 4);
                    kw.x = pk2(k0[0], k0[1]); kw.y = pk2(k0[2], k0[3]); kw.z = pk2(k1[0], k1[1]); kw.w = pk2(k1[2], k1[3]);
                    vw.x = pk2(v0[0], v0[1]); vw.y = pk2(v0[2], v0[3]); vw.z = pk2(v1[0], v1[1]); vw.w = pk2(v1[2], v1[3]);
                } else if (s < 144) {
                    const bf16_t* rp = h + (size_t)(I.row0 + s - 128) * HP + kvh * 64 + dp * 8;
                    kw = *(const u32x4*)(rp + HK); vw = *(const u32x4*)(rp + HV);
                }
            }
            *(LAS u32x4*)(Kl + (kvl * 192 + s) * 72 + dp * 8) = kw;
            LAS bf16_t* vp = Vt + (kvl * 64 + dp * 8) * 200 + s;
            vp[0 * 200] = (bf16_t)(vw.x & 0xffffu); vp[1 * 200] = (bf16_t)(vw.x >> 16); vp[2 * 200] = (bf16_t)(vw.y & 0xffffu); vp[3 * 200] = (bf16_t)(vw.y >> 16);
            vp[4 * 200] = (bf16_t)(vw.z & 0xffffu); vp[5 * 200] = (bf16_t)(vw.z >> 16); vp[6 * 200] = (bf16_t)(vw.w & 0xffffu); vp[7 * 200] = (bf16_t)(vw.w >> 16);
        }
        __syncthreads();
        const int head = pass * 8 + w, kvl = w >> 2;
        const float slope = exp2f(-0.5f * (float)(head + 1));
        const float sink = P->in[I_SINK][l * 16 + head];
        const bf16_t* qbase = h + (size_t)(I.row0 + fr) * HP + HQ + head * 64 + fq * 8;
        bf16x8 q0 = *(const bf16x8*)qbase, q1 = *(const bf16x8*)(qbase + 32);
#pragma unroll 1
        for (int qt = 0; qt < NQT; ++qt) {
            bf16x8 nq0 = q0, nq1 = q1;
            if (qt + 1 < NQT) { const bf16_t* qp = qbase + (size_t)(qt + 1) * 16 * HP; nq0 = *(const bf16x8*)qp; nq1 = *(const bf16x8*)(qp + 32); }
            f32x4 st[NST];
#pragma unroll
            for (int t = 0; t < NST; ++t) {
                const LAS bf16_t* kp = Kl + (kvl * 192 + t * 16 + fr) * 72 + fq * 8;
                f32x4 a = (f32x4){0.f, 0.f, 0.f, 0.f};
                a = MFMA16(*(const LAS bf16x8*)kp, q0, a);
                a = MFMA16(*(const LAS bf16x8*)(kp + 32), q1, a);
                st[t] = a;
                if ((t % 6) == 5) __builtin_amdgcn_sched_barrier(0);
            }
            const int qpos = (L == 64) ? (I.c * 64 + qt * 16 + fr) : (4096 + fr);
            float mx = sink;
#pragma unroll
            for (int t = 0; t < NST; ++t)
#pragma unroll
                for (int jj = 0; jj < 4; ++jj) {
                    const int s = t * 16 + fq * 4 + jj;
                    const int kpos = (L == 64) ? ((I.c - 2) * 64 + s) : (3968 + s);
                    const bool vis = (L == 64) ? (kpos >= 0) : (s < 144);
                    const float d = fabsf((float)(qpos - kpos));
                    const float sc = vis ? (st[t][jj] * 0.125f - slope * d) : -INFINITY;
                    st[t][jj] = sc; mx = fmaxf(mx, sc);
                }
            mx = fmaxf(mx, shflx(mx, 16)); mx = fmaxf(mx, shflx(mx, 32));
            float sum = 0.f;
#pragma unroll
            for (int t = 0; t < NST; ++t)
#pragma unroll
                for (int jj = 0; jj < 4; ++jj) { const float p = __expf(st[t][jj] - mx); st[t][jj] = p; sum += p; }
            sum += shflx(sum, 16); sum += shflx(sum, 32);
            const float inv = 1.0f / (sum + __expf(sink - mx));
            f32x4 o[4];
#pragma unroll
            for (int dt = 0; dt < 4; ++dt) o[dt] = (f32x4){0.f, 0.f, 0.f, 0.f};
#pragma unroll
            for (int ks = 0; ks < NKS; ++ks) {
                u32x4 pw; pw.x = pk2(st[2 * ks][0], st[2 * ks][1]); pw.y = pk2(st[2 * ks][2], st[2 * ks][3]);
                pw.z = pk2(st[2 * ks + 1][0], st[2 * ks + 1][1]); pw.w = pk2(st[2 * ks + 1][2], st[2 * ks + 1][3]);
                bf16x8 pf; __builtin_memcpy(&pf, &pw, 16);
#pragma unroll
                for (int dt = 0; dt < 4; ++dt) {
                    const LAS bf16_t* vp = Vt + (kvl * 64 + dt * 16 + fr) * 200 + ks * 32 + fq * 4;
                    const u32x2 va = *(const LAS u32x2*)vp, vb = *(const LAS u32x2*)(vp + 16);
                    u32x4 vw; vw.x = va.x; vw.y = va.y; vw.z = vb.x; vw.w = vb.y;
                    bf16x8 vf; __builtin_memcpy(&vf, &vw, 16);
                    o[dt] = MFMA16(vf, pf, o[dt]);
                }
            }
            bf16_t* op = yabc + (size_t)(I.row0 + qt * 16 + fr) * 3072 + 2048 + head * 64 + fq * 4;
#pragma unroll
            for (int dt = 0; dt < 4; ++dt) {
                u32x2 ow; ow.x = pk2(o[dt][0] * inv, o[dt][1] * inv); ow.y = pk2(o[dt][2] * inv, o[dt][3] * inv);
                *(u32x2*)(op + dt * 16) = ow;
            }
            q0 = nq0; q1 = nq1;
        }
    }
}

template <int CTRL> __device__ __forceinline__ float dpp_f(float old, float src) {
    return __int_as_float(__builtin_amdgcn_update_dpp(__float_as_int(old), __float_as_int(src), CTRL, 0xf, 0xf, false));
}
template <int L, bool FINAL>
__device__ __forceinline__ void lru_item(int wv, KP P, int l, int item, const Item& I, LAS unsigned char* lds) {
    constexpr int NIT = L / 16, XP = 1032;
    const bf16_t* h = (const bf16_t*)(P->ws + WS_H);
    bf16_t* yabc = (bf16_t*)(P->ws + WS_Y);
    float* lruA = (float*)(P->ws + WS_LRUA); float* lruU = (float*)(P->ws + WS_LRUU);
    const int tid = tidx(wv), w = tid >> 6, lane = tid & 63, fr = lane & 15, fq = lane >> 4;
    LAS bf16_t* xa = (LAS bf16_t*)lds;
    __syncthreads();
    {
        const int ch = 2 * tid;
        const float* cw = P->in[I_LCW] + (size_t)l * 4 * 1024 + ch;
        const f32x2_t w0 = *(const f32x2_t*)cw, w1 = *(const f32x2_t*)(cw + 1024), w2 = *(const f32x2_t*)(cw + 2048), w3 = *(const f32x2_t*)(cw + 3072);
        const f32x2_t cb = *(const f32x2_t*)(P->in[I_LCB] + l * 1024 + ch);
        f32x2_t xm3 = {0.f, 0.f}, xm2 = {0.f, 0.f}, xm1 = {0.f, 0.f};
        if (I.sample) { const float* st = P->in[I_SLC] + (size_t)(l * 16 + I.sb) * 3 * 1024 + ch; xm3 = *(const f32x2_t*)st; xm2 = *(const f32x2_t*)(st + 1024); xm1 = *(const f32x2_t*)(st + 2048); }
        else if (I.c > 0) { const bf16_t* hq = h + (size_t)(I.row0 - 3) * HP + HX + ch;
            const unsigned a0 = *(const unsigned*)hq, a1 = *(const unsigned*)(hq + HP), a2 = *(const unsigned*)(hq + 2 * (size_t)HP);
            xm3 = (f32x2_t){bflo(a0), bfhi(a0)}; xm2 = (f32x2_t){bflo(a1), bfhi(a1)}; xm1 = (f32x2_t){bflo(a2), bfhi(a2)}; }
        const bf16_t* hp = h + (size_t)I.row0 * HP + HX + ch;
#pragma unroll 8
        for (int t = 0; t < L; ++t) {
            const unsigned xw = *(const unsigned*)(hp + (size_t)t * HP);
            const f32x2_t x0 = {bflo(xw), bfhi(xw)};
            const f32x2_t y = cb + w0 * xm3 + w1 * xm2 + w2 * xm1 + w3 * x0;
            *(LAS unsigned*)(xa + t * XP + ch) = pk2(y[0], y[1]);
            xm3 = xm2; xm2 = xm1; xm1 = x0;
        }
    }
    __syncthreads();
#pragma unroll 1
    for (int pass = 0; pass < 2; ++pass) {
        const int blk = w + 8 * pass, ch0 = blk * 64;
        const bf16_t* waT = (const bf16_t*)(P->ws + W_LA) + (l & 1) * 65536 + blk * 4096;
        const bf16_t* wxT = (const bf16_t*)(P->ws + W_LX) + (l & 1) * 65536 + blk * 4096;
        float carryH[4][4], carryA[4][4], c8v[4][4];
#pragma unroll
        for (int jt = 0; jt < 4; ++jt)
#pragma unroll
            for (int jj = 0; jj < 4; ++jj) {
                const int ch = ch0 + jt * 16 + fq * 4 + jj;
                carryA[jt][jj] = 1.0f;
                c8v[jt][jj] = 8.0f * softplusf_(-P->in[I_LLAM][l * 1024 + ch]);
                if (FINAL) carryH[jt][jj] = I.sample ? P->in[I_SLH][(l * 16 + I.sb) * 1024 + ch] : lruU[(size_t)item * 1024 + ch];
                else carryH[jt][jj] = 0.f;
            }
        bf16x8 waf[4][2], wxf[4][2]; f32x4 bavv[4], bxvv[4];
#pragma unroll
        for (int jt = 0; jt < 4; ++jt) {
            const bf16_t* wa = waT + (jt * 16 + fr) * 64 + fq * 8; const bf16_t* wx = wxT + (jt * 16 + fr) * 64 + fq * 8;
            waf[jt][0] = *(const bf16x8*)wa; waf[jt][1] = *(const bf16x8*)(wa + 32); wxf[jt][0] = *(const bf16x8*)wx; wxf[jt][1] = *(const bf16x8*)(wx + 32);
            bavv[jt] = *(const f32x4*)(P->in[I_LBA] + l * 1024 + ch0 + jt * 16 + fq * 4); bxvv[jt] = *(const f32x4*)(P->in[I_LBX] + l * 1024 + ch0 + jt * 16 + fq * 4);
        }
#pragma unroll 1
        for (int it = 0; it < NIT; ++it) {
            const LAS bf16_t* xp = xa + (it * 16 + fr) * XP + ch0;
            const bf16x8 b0 = *(const LAS bf16x8*)(xp + fq * 8), b1 = *(const LAS bf16x8*)(xp + 32 + fq * 8);
            const int token = it * 16 + fr;
#pragma unroll
            for (int jt = 0; jt < 4; ++jt) {
                f32x4 ra = (f32x4){0.f, 0.f, 0.f, 0.f}, ia = (f32x4){0.f, 0.f, 0.f, 0.f};
                ra = MFMA16(waf[jt][0], b0, ra); ra = MFMA16(waf[jt][1], b1, ra);
                ia = MFMA16(wxf[jt][0], b0, ia); ia = MFMA16(wxf[jt][1], b1, ia);
                const u32x2 xw = *(const LAS u32x2*)(xp + jt * 16 + fq * 4);
                const float xv[4] = {bflo(xw.x), bfhi(xw.x), bflo(xw.y), bfhi(xw.y)};
                const f32x4 bav = bavv[jt], bxv = bxvv[jt];
                float hv[4], av[4];
#pragma unroll
                for (int jj = 0; jj < 4; ++jj) {
                    const float r = sigmoidf_(ra[jj] + bav[jj]);
                    const float ig = sigmoidf_(ia[jj] + bxv[jj]);
                    const float la = -c8v[jt][jj] * r;
                    float a = __expf(la);
                    float u = __builtin_amdgcn_sqrtf(fmaxf(1.0f - a * a, 0.f)) * ig * xv[jj];
                    { const float ap = dpp_f<0x111>(1.0f, a), up = dpp_f<0x111>(0.0f, u); u = a * up + u; a = a * ap; }
                    { const float ap = dpp_f<0x112>(1.0f, a), up = dpp_f<0x112>(0.0f, u); u = a * up + u; a = a * ap; }
                    { const float ap = dpp_f<0x114>(1.0f, a), up = dpp_f<0x114>(0.0f, u); u = a * up + u; a = a * ap; }
                    { const float ap = dpp_f<0x118>(1.0f, a), up = dpp_f<0x118>(0.0f, u); u = a * up + u; a = a * ap; }
                    const float hval = a * carryH[jt][jj] + u;
                    hv[jj] = hval;
                    carryH[jt][jj] = shfl_row15(hval);
                    if (!FINAL) { const float at = carryA[jt][jj] * a; av[jj] = at; carryA[jt][jj] = shfl_row15(at); }
                }
                if (!FINAL) {
                    u32x2 ow; ow.x = pk2(hv[0], hv[1]); ow.y = pk2(hv[2], hv[3]);
                    *(u32x2*)(yabc + (size_t)(I.row0 + token) * 3072 + ch0 + jt * 16 + fq * 4) = ow;
                    u32x2 aw; aw.x = pk2(av[0], av[1]); aw.y = pk2(av[2], av[3]);
                    *(u32x2*)((bf16_t*)(P->ws + WS_XB) + (size_t)(I.row0 + token) * DM + ch0 + jt * 16 + fq * 4) = aw;
                }
                if (FINAL) {
                    const u32x2 gw = *(const u32x2*)(h + (size_t)(I.row0 + token) * HP + HG + ch0 + jt * 16 + fq * 4);
                    u32x2 ow; ow.x = pk2(hv[0] * gelu_tanh(bflo(gw.x)), hv[1] * gelu_tanh(bfhi(gw.x)));
                    ow.y = pk2(hv[2] * gelu_tanh(bflo(gw.y)), hv[3] * gelu_tanh(bfhi(gw.y)));
                    *(u32x2*)(yabc + (size_t)(I.row0 + token) * 3072 + ch0 + jt * 16 + fq * 4) = ow;
                    if (it == NIT - 1 && fr == 15) {
                        if (I.sample) *(f32x4*)(P->out + O_SLH + (size_t)(l * 16 + I.sb) * 1024 + ch0 + jt * 16 + fq * 4) = (f32x4){hv[0], hv[1], hv[2], hv[3]};
                        else if (I.c == 127) *(f32x4*)(P->out + O_PLH + (size_t)(l * 2 + I.b) * 1024 + ch0 + jt * 16 + fq * 4) = (f32x4){hv[0], hv[1], hv[2], hv[3]};
                    }
                }
            }
        }
        if (!FINAL) {
            if (fr == 0) {
#pragma unroll
                for (int jt = 0; jt < 4; ++jt) {
                    *(f32x4*)(lruA + (size_t)item * 1024 + ch0 + jt * 16 + fq * 4) = (f32x4){carryA[jt][0], carryA[jt][1], carryA[jt][2], carryA[jt][3]};
                    *(f32x4*)(lruU + (size_t)item * 1024 + ch0 + jt * 16 + fq * 4) = (f32x4){carryH[jt][0], carryH[jt][1], carryH[jt][2], carryH[jt][3]};
                }
            }
        }
    }
}

__device__ __forceinline__ void lru_apply_item(int wv, KP P, int l, int item, const Item& I) {
    const bf16_t* h = (const bf16_t*)(P->ws + WS_H);
    bf16_t* yabc = (bf16_t*)(P->ws + WS_Y);
    const bf16_t* acum = (const bf16_t*)(P->ws + WS_XB);
    const float* carry = (const float*)(P->ws + WS_LRUU) + (size_t)item * 1024;
    const int tid = tidx(wv);
    const int c8 = (tid & 127) * 8;
    const f32x4 ca = *(const f32x4*)(carry + c8), cb = *(const f32x4*)(carry + c8 + 4);
    const float cv[8] = {ca[0], ca[1], ca[2], ca[3], cb[0], cb[1], cb[2], cb[3]};
#pragma unroll 1
    for (int tb = 0; tb < 4; ++tb) {
        u32x4 aw4[4], hw4[4], gw4[4];
#pragma unroll
        for (int q = 0; q < 4; ++q) {
            const size_t r = (size_t)(I.row0 + (tid >> 7) + 4 * (tb * 4 + q));
            aw4[q] = *(const u32x4*)(acum + r * DM + c8); hw4[q] = *(const u32x4*)(yabc + r * 3072 + c8); gw4[q] = *(const u32x4*)(h + r * HP + HG + c8);
        }
#pragma unroll
        for (int q = 0; q < 4; ++q) {
            const int t = (tid >> 7) + 4 * (tb * 4 + q);
            const size_t r = (size_t)(I.row0 + t);
            const unsigned au[4] = {aw4[q].x, aw4[q].y, aw4[q].z, aw4[q].w}, hu[4] = {hw4[q].x, hw4[q].y, hw4[q].z, hw4[q].w}, gu[4] = {gw4[q].x, gw4[q].y, gw4[q].z, gw4[q].w};
            float hv[8]; unsigned ou[4];
#pragma unroll
            for (int e = 0; e < 4; ++e) {
                hv[2 * e] = bflo(au[e]) * cv[2 * e] + bflo(hu[e]); hv[2 * e + 1] = bfhi(au[e]) * cv[2 * e + 1] + bfhi(hu[e]);
                ou[e] = pk2(hv[2 * e] * gelu_tanh(bflo(gu[e])), hv[2 * e + 1] * gelu_tanh(bfhi(gu[e])));
            }
            *(u32x4*)(yabc + r * 3072 + c8) = (u32x4){ou[0], ou[1], ou[2], ou[3]};
            if (I.c == 127 && t == 63) {
                float* op = P->out + O_PLH + (size_t)(l * 2 + I.b) * 1024 + c8;
                *(f32x4*)op = (f32x4){hv[0], hv[1], hv[2], hv[3]}; *(f32x4*)(op + 4) = (f32x4){hv[4], hv[5], hv[6], hv[7]};
            }
        }
    }
}

#define SW72(row, t) ((row) * 72 + (((((t) >> 3) ^ (((row) >> 3) & 7))) << 3) + ((t) & 7))
__device__ __forceinline__ float pre_xbc(KP P, const bf16_t* h, int l, const Item& I, int tt, int ch) {
    if (tt >= 0 || (!I.sample && I.c > 0)) return bf2f(h[(size_t)(I.row0 + tt) * HP + HXBC + ch]);
    if (I.sample) return P->in[I_SSC][((size_t)(l * 16 + I.sb) * 3 + (3 + tt)) * 1536 + ch];
    return 0.f;
}
__device__ __forceinline__ float conv_xbc(KP P, const bf16_t* h, int l, const Item& I, int t, int ch) {
    const float* cw = P->in[I_SCW] + (size_t)l * 4 * 1536 + ch;
    float y = P->in[I_SCB][l * 1536 + ch];
    y += cw[0] * pre_xbc(P, h, l, I, t - 3, ch); y += cw[1536] * pre_xbc(P, h, l, I, t - 2, ch);
    y += cw[3072] * pre_xbc(P, h, l, I, t - 1, ch); y += cw[4608] * pre_xbc(P, h, l, I, t, ch);
    return siluf_(y);
}
template <class F>
__device__ __forceinline__ void conv_roll(KP P, const bf16_t* h, int l, const Item& I, int chx, int t0, int t1, F f) {
    const float* cw = P->in[I_SCW] + (size_t)l * 4 * 1536 + chx;
    const float w0 = cw[0], w1 = cw[1536], w2 = cw[3072], w3 = cw[4608], cb = P->in[I_SCB][l * 1536 + chx];
    float xm3 = pre_xbc(P, h, l, I, t0 - 3, chx), xm2 = pre_xbc(P, h, l, I, t0 - 2, chx), xm1 = pre_xbc(P, h, l, I, t0 - 1, chx);
    const bf16_t* hp = h + (size_t)I.row0 * HP + HXBC + chx;
#pragma unroll 8
    for (int t = t0; t < t1; ++t) {
        const float x0 = bf2f(hp[(size_t)t * HP]);
        const float y = cb + w0 * xm3 + w1 * xm2 + w2 * xm1 + w3 * x0;
        f(t, siluf_(y));
        xm3 = xm2; xm2 = xm1; xm1 = x0;
    }
}
template <int L, int NCH8, class CF, class F>
__device__ __forceinline__ void ssd_stage(KP P, const bf16_t* h, int l, const Item& I, int tid, CF chx_of, F f) {
    constexpr int NSEG = 512 / NCH8, TS = L / NSEG;
    static_assert(TS >= 1 && TS * NSEG == L, "segmenting");
    const int c8 = tid % NCH8, sg = tid / NCH8, t0 = sg * TS, chx = chx_of(c8);
    u32x4 xr[TS + 3];
#pragma unroll
    for (int q = 0; q < TS + 3; ++q) {
        const int tt = t0 - 3 + q;
        if (tt >= 0 || (!I.sample && I.c > 0)) {
            xr[q] = *(const u32x4*)((const char*)h + ((unsigned)(I.row0 + tt) * (unsigned)HP + (unsigned)(HXBC + chx)) * 2u);
        } else if (I.sample) {
            const float* st = P->in[I_SSC] + ((size_t)(l * 16 + I.sb) * 3 + (3 + tt)) * 1536 + chx;
            const f32x4 a = *(const f32x4*)st, b = *(const f32x4*)(st + 4);
            xr[q] = (u32x4){pk2(a[0], a[1]), pk2(a[2], a[3]), pk2(b[0], b[1]), pk2(b[2], b[3])};
        } else xr[q] = (u32x4){0u, 0u, 0u, 0u};
    }
    const float* cw = P->in[I_SCW] + (size_t)l * 4 * 1536 + chx;
    float wt[4][8], cb[8];
#pragma unroll
    for (int j = 0; j < 4; ++j) { const f32x4 a = *(const f32x4*)(cw + j * 1536), b = *(const f32x4*)(cw + j * 1536 + 4);
        wt[j][0] = a[0]; wt[j][1] = a[1]; wt[j][2] = a[2]; wt[j][3] = a[3]; wt[j][4] = b[0]; wt[j][5] = b[1]; wt[j][6] = b[2]; wt[j][7] = b[3]; }
    { const f32x4 a = *(const f32x4*)(P->in[I_SCB] + l * 1536 + chx), b = *(const f32x4*)(P->in[I_SCB] + l * 1536 + chx + 4);
        cb[0] = a[0]; cb[1] = a[1]; cb[2] = a[2]; cb[3] = a[3]; cb[4] = b[0]; cb[5] = b[1]; cb[6] = b[2]; cb[7] = b[3]; }
#pragma unroll
    for (int q = 0; q < TS; ++q) {
        float v[8];
#pragma unroll
        for (int e2 = 0; e2 < 4; ++e2) {
            const unsigned r0 = xr[q][e2], r1 = xr[q + 1][e2], r2 = xr[q + 2][e2], r3 = xr[q + 3][e2];
            v[2 * e2] = siluf_(cb[2 * e2] + wt[0][2 * e2] * bflo(r0) + wt[1][2 * e2] * bflo(r1) + wt[2][2 * e2] * bflo(r2) + wt[3][2 * e2] * bflo(r3));
            v[2 * e2 + 1] = siluf_(cb[2 * e2 + 1] + wt[0][2 * e2 + 1] * bfhi(r0) + wt[1][2 * e2 + 1] * bfhi(r1) + wt[2][2 * e2 + 1] * bfhi(r2) + wt[3][2 * e2 + 1] * bfhi(r3));
        }
        f(t0 + q, c8, v);
    }
}
template <int L>
__device__ __forceinline__ void ssd_dtcum(int wv, KP P, int l, const Item& I, LAS float* dtv, LAS float* cumv) {
    const float* dtraw = (const float*)(P->ws + WS_DT);
    const int tid = tidx(wv);
    __syncthreads();
    for (int idx = tid; idx < L * 16; idx += 512) { const int hd = idx & 15; dtv[idx] = softplusf_(dtraw[(size_t)I.row0 * 16 + idx] + P->in[I_SDTB][l * 16 + hd]); }
    __syncthreads();
    if (tid < 64) {
        constexpr int SEG = L / 4;
        const int hd = tid & 15, sg = tid >> 4;
        const float A = -__expf(P->in[I_SALOG][l * 16 + hd]);
        float c = 0.f;
#pragma unroll
        for (int t = 0; t < SEG; ++t) { c += dtv[(sg * SEG + t) * 16 + hd] * A; cumv[(sg * SEG + t) * 16 + hd] = c; }
        const float t1 = shfl_idx(c, hd), t2 = shfl_idx(c, 16 + hd), t3 = shfl_idx(c, 32 + hd);
        const float off = sg == 0 ? 0.f : (sg == 1 ? t1 : (sg == 2 ? t1 + t2 : t1 + t2 + t3));
#pragma unroll
        for (int t = 0; t < SEG; ++t) cumv[(sg * SEG + t) * 16 + hd] += off;
    }
    __syncthreads();
}

template <int L>
__device__ __forceinline__ void ssd_states_item(int wv, KP P, int l, int item, const Item& I, LAS unsigned char* lds) {
    constexpr int LP = L < 32 ? 32 : L, KS = LP / 32;
    const bf16_t* h = (const bf16_t*)(P->ws + WS_H);
    bf16_t* states = (bf16_t*)(P->ws + WS_ST);
    float* cdec = (float*)(P->ws + WS_CDEC);
    const int tid = tidx(wv), w = tid >> 6, lane = tid & 63, fr = lane & 15, fq = lane >> 4;
    LAS float* dtv = (LAS float*)lds; LAS float* cumv = dtv + 1024;
    LAS bf16_t* BmT = (LAS bf16_t*)(lds + 8192);
    LAS bf16_t* xw = (LAS bf16_t*)(lds + 8192 + 36864) + w * (64 * 72);
    ssd_dtcum<L>(wv, P, l, I, dtv, cumv);
    LAS bf16_t* xwall = (LAS bf16_t*)(lds + 8192 + 36864);
    ssd_stage<L, 32>(P, h, l, I, tid, [](int c8) { return 1024 + c8 * 8; }, [&](int t, int c8, const float* v) {
#pragma unroll
        for (int e = 0; e < 8; ++e) BmT[SW72(c8 * 8 + e, t)] = f2bf(v[e]); });
    if (L < LP) for (int idx = tid; idx < 256 * (LP - L); idx += 512) BmT[SW72(idx / (LP - L), L + idx % (LP - L))] = 0;
    for (int hh = 0; hh < 2; ++hh) {
        const int head = w + 8 * hh;
        const float cl = cumv[(L - 1) * 16 + head];
        __syncthreads();
        ssd_stage<L, 64>(P, h, l, I, tid, [=](int c8) { return hh * 512 + c8 * 8; }, [&](int t, int c8, const float* v) {
            const int hd = hh * 8 + (c8 >> 3);
            const float sc = __expf(cumv[(L - 1) * 16 + hd] - cumv[t * 16 + hd]) * dtv[t * 16 + hd];
            LAS bf16_t* dst = xwall + (c8 >> 3) * (64 * 72);
#pragma unroll
            for (int e = 0; e < 8; ++e) dst[SW72((c8 & 7) * 8 + e, t)] = f2bf(v[e] * sc); });
        if (L < LP) for (int idx = tid; idx < 512 * (LP - L); idx += 512) xwall[SW72(idx / (LP - L), L + idx % (LP - L))] = 0;
        __syncthreads();
        const float dec = __expf(cl);
        if (!I.sample && lane == 0) cdec[item * 16 + head] = dec;
#pragma unroll 1
        for (int nt = 0; nt < 8; ++nt) {
            bf16x8 af[KS];
#pragma unroll
            for (int ks = 0; ks < KS; ++ks) af[ks] = *(const LAS bf16x8*)(BmT + SW72(hh * 128 + nt * 16 + fr, ks * 32 + fq * 8));
#pragma unroll
            for (int pt = 0; pt < 4; ++pt) {
                f32x4 a = (f32x4){0.f, 0.f, 0.f, 0.f};
#pragma unroll
                for (int ks = 0; ks < KS; ++ks) a = MFMA16(af[ks], *(const LAS bf16x8*)(xw + SW72(pt * 16 + fr, ks * 32 + fq * 8)), a);
                const int p = pt * 16 + fr, n0 = nt * 16 + fq * 4;
                if (!I.sample) {
                    u32x2 ow; ow.x = pk2(a[0], a[1]); ow.y = pk2(a[2], a[3]);
                    *(u32x2*)(states + ((size_t)((I.b * 128 + I.c) * 16 + head) * 64 + p) * 128 + n0) = ow;
                } else {
                    const size_t o = ((size_t)((l * 16 + I.sb) * 16 + head) * 64 + p) * 128 + n0;
                    const f32x4 h0 = *(const f32x4*)(P->in[I_SSH] + o);
                    *(f32x4*)(P->out + O_SSH + o) = h0 * dec + a;
                }
            }
        }
    }
}

template <int L>
__device__ __forceinline__ void ssd_y_item(int wv, KP P, int l, const Item& I, LAS unsigned char* lds) {
    constexpr int LP = L < 32 ? 32 : L, KS = LP / 32, NIT = L / 16;
    const bf16_t* h = (const bf16_t*)(P->ws + WS_H);
    const bf16_t* states = (const bf16_t*)(P->ws + WS_ST);
    bf16_t* yabc = (bf16_t*)(P->ws + WS_Y);
    const int tid = tidx(wv), w = tid >> 6, lane = tid & 63, fr = lane & 15, fq = lane >> 4;
    LAS float* dtv = (LAS float*)lds; LAS float* cumv = dtv + 1024;
    LAS bf16_t* Bm = (LAS bf16_t*)(lds + 8192);
    LAS bf16_t* Cm = (LAS bf16_t*)(lds + 8192 + 17408);
    LAS float* CBl = (LAS float*)(lds + 8192 + 2 * 17408);
    LAS float* part = (LAS float*)(lds + 8192 + 3 * 17408);
    LAS bf16_t* xT = (LAS bf16_t*)(lds + 8192 + 3 * 17408 + 2048) + w * (64 * 72);
    ssd_dtcum<L>(wv, P, l, I, dtv, cumv);
    for (int g = 0; g < 2; ++g) {
        const int head = g * 8 + w;
        __syncthreads();
        ssd_stage<L, 32>(P, h, l, I, tid, [=](int c8) { return 1024 + (c8 >> 4) * 256 + g * 128 + (c8 & 15) * 8; }, [&](int t, int c8, const float* v) {
            u32x4 ow; ow.x = pk2(v[0], v[1]); ow.y = pk2(v[2], v[3]); ow.z = pk2(v[4], v[5]); ow.w = pk2(v[6], v[7]);
            *(LAS u32x4*)(((c8 >> 4) ? Cm : Bm) + t * 136 + (c8 & 15) * 8) = ow; });
        {
            LAS bf16_t* xTall = (LAS bf16_t*)(lds + 8192 + 3 * 17408 + 2048);
            ssd_stage<L, 64>(P, h, l, I, tid, [=](int c8) { return g * 512 + c8 * 8; }, [&](int t, int c8, const float* v) {
                LAS bf16_t* dst = xTall + (c8 >> 3) * (64 * 72);
#pragma unroll
                for (int e = 0; e < 8; ++e) dst[SW72((c8 & 7) * 8 + e, t)] = f2bf(v[e]); });
            if (L < LP) for (int idx = tid; idx < 512 * (LP - L); idx += 512) xTall[SW72(idx / (LP - L), L + idx % (LP - L))] = 0;
        }
        __syncthreads();
        for (int tix = w; tix < NIT * NIT; tix += 8) {
            const int it = tix / NIT, jt = tix % NIT;
            f32x4 a = (f32x4){0.f, 0.f, 0.f, 0.f};
#pragma unroll
            for (int ks = 0; ks < 4; ++ks)
                a = MFMA16(*(const LAS bf16x8*)(Cm + (it * 16 + fr) * 136 + ks * 32 + fq * 8), *(const LAS bf16x8*)(Bm + (jt * 16 + fr) * 136 + ks * 32 + fq * 8), a);
#pragma unroll
            for (int jj = 0; jj < 4; ++jj) CBl[(it * 16 + fq * 4 + jj) * 68 + jt * 16 + fr] = a[jj];
        }
        __syncthreads();
        const float dsk = P->in[I_SD][l * 16 + head];
        bf16x8 hf[4][4];
#pragma unroll
        for (int pt = 0; pt < 4; ++pt) {
            const int p = pt * 16 + fr;
            if (!I.sample) {
                const bf16_t* sp = states + ((size_t)((I.b * 128 + I.c) * 16 + head) * 64 + p) * 128 + fq * 8;
#pragma unroll
                for (int ks = 0; ks < 4; ++ks) hf[pt][ks] = *(const bf16x8*)(sp + ks * 32);
            } else {
                const float* sp = P->in[I_SSH] + ((size_t)((l * 16 + I.sb) * 16 + head) * 64 + p) * 128 + fq * 8;
#pragma unroll
                for (int ks = 0; ks < 4; ++ks) {
                    const f32x4 a0 = *(const f32x4*)(sp + ks * 32), a1 = *(const f32x4*)(sp + ks * 32 + 4);
                    u32x4 ww; ww.x = pk2(a0[0], a0[1]); ww.y = pk2(a0[2], a0[3]); ww.z = pk2(a1[0], a1[1]); ww.w = pk2(a1[2], a1[3]);
                    __builtin_memcpy(&hf[pt][ks], &ww, 16);
                }
            }
        }
        u32x2 zcur[4];
#pragma unroll
        for (int pt = 0; pt < 4; ++pt) zcur[pt] = *(const u32x2*)(h + (size_t)(I.row0 + fr) * HP + HZ + head * 64 + pt * 16 + fq * 4);
#pragma unroll 1
        for (int it = 0; it < NIT; ++it) {
            const int i = it * 16 + fr; const float cum_i = cumv[i * 16 + head];
            u32x2 znext[4];
#pragma unroll
            for (int pt = 0; pt < 4; ++pt) znext[pt] = zcur[pt];
            if (it + 1 < NIT) {
#pragma unroll
                for (int pt = 0; pt < 4; ++pt) znext[pt] = *(const u32x2*)(h + (size_t)(I.row0 + i + 16) * HP + HZ + head * 64 + pt * 16 + fq * 4);
            }
            f32x4 acc[4];
#pragma unroll
            for (int pt = 0; pt < 4; ++pt) acc[pt] = (f32x4){0.f, 0.f, 0.f, 0.f};
#pragma unroll
            for (int ks = 0; ks < KS; ++ks) {
                if (ks * 32 > it * 16 + 15) continue;
                const int j0 = ks * 32 + fq * 8;
                const f32x4 c0 = *(const LAS f32x4*)(CBl + i * 68 + j0), c1 = *(const LAS f32x4*)(CBl + i * 68 + j0 + 4);
                float wv8[8];
#pragma unroll
                for (int e = 0; e < 8; ++e) {
                    const int j = j0 + e; const float cb = e < 4 ? c0[e & 3] : c1[e & 3];
                    const float ex = __expf(fminf(cum_i - cumv[j * 16 + head], 0.f));
                    wv8[e] = (j <= i) ? cb * ex * dtv[j * 16 + head] : 0.f;
                }
                u32x4 ww; ww.x = pk2(wv8[0], wv8[1]); ww.y = pk2(wv8[2], wv8[3]); ww.z = pk2(wv8[4], wv8[5]); ww.w = pk2(wv8[6], wv8[7]);
                bf16x8 wf; __builtin_memcpy(&wf, &ww, 16);
#pragma unroll
                for (int pt = 0; pt < 4; ++pt) acc[pt] = MFMA16(*(const LAS bf16x8*)(xT + SW72(pt * 16 + fr, j0)), wf, acc[pt]);
            }
            const float ecum = __expf(cum_i);
            bf16x8 cf[4];
#pragma unroll
            for (int ks = 0; ks < 4; ++ks) cf[ks] = *(const LAS bf16x8*)(Cm + i * 136 + ks * 32 + fq * 8);
#pragma unroll
            for (int pt = 0; pt < 4; ++pt) {
                f32x4 t2 = (f32x4){0.f, 0.f, 0.f, 0.f};
#pragma unroll
                for (int ks = 0; ks < 4; ++ks) t2 = MFMA16(hf[pt][ks], cf[ks], t2);
                acc[pt] += t2 * ecum;
            }
            float ss = 0.f;
#pragma unroll
            for (int pt = 0; pt < 4; ++pt) {
                const int p0 = pt * 16 + fq * 4;
                const u32x2 zw = zcur[pt];
                const float zv[4] = {bflo(zw.x), bfhi(zw.x), bflo(zw.y), bfhi(zw.y)};
                float yv[4];
#pragma unroll
                for (int jj = 0; jj < 4; ++jj) {
                    const float xs = bf2f(xT[SW72(p0 + jj, i)]);
                    const float y = (acc[pt][jj] + dsk * xs) * siluf_(zv[jj]);
                    yv[jj] = y; ss += y * y;
                }
                u32x2 ow; ow.x = pk2(yv[0], yv[1]); ow.y = pk2(yv[2], yv[3]);
                *(u32x2*)(yabc + (size_t)(I.row0 + i) * 3072 + 1024 + head * 64 + p0) = ow;
            }
            ss += shflx(ss, 16); ss += shflx(ss, 32);
            if (fq == 0) part[i * 8 + w] = ss;
#pragma unroll
            for (int pt = 0; pt < 4; ++pt) zcur[pt] = znext[pt];
        }
        __syncthreads();
        f32x4 ngv[4];
#pragma unroll
        for (int pt = 0; pt < 4; ++pt) ngv[pt] = *(const f32x4*)(P->in[I_SNORM] + l * 1024 + head * 64 + pt * 16 + fq * 4);
        u32x2 ycur[4];
#pragma unroll
        for (int pt = 0; pt < 4; ++pt) ycur[pt] = *(const u32x2*)(yabc + (size_t)(I.row0 + fr) * 3072 + 1024 + head * 64 + pt * 16 + fq * 4);
#pragma unroll 1
        for (int it = 0; it < NIT; ++it) {
            const int i = it * 16 + fr;
            u32x2 ynext[4];
#pragma unroll
            for (int pt = 0; pt < 4; ++pt) ynext[pt] = ycur[pt];
            if (it + 1 < NIT) {
#pragma unroll
                for (int pt = 0; pt < 4; ++pt) ynext[pt] = *(const u32x2*)(yabc + (size_t)(I.row0 + i + 16) * 3072 + 1024 + head * 64 + pt * 16 + fq * 4);
            }
            const f32x4 pa = *(const LAS f32x4*)(part + i * 8), pb = *(const LAS f32x4*)(part + i * 8 + 4);
            const float tot = (pa[0] + pa[1] + pa[2] + pa[3]) + (pb[0] + pb[1] + pb[2] + pb[3]);
            const float rs = rsqrtf(tot * (1.0f / 512.0f) + EPS);
#pragma unroll
            for (int pt = 0; pt < 4; ++pt) {
                const int p0 = pt * 16 + fq * 4;
                const f32x4 ng = ngv[pt];
                const u32x2 yw = ycur[pt];
                u32x2 ow; ow.x = pk2(bflo(yw.x) * rs * ng[0], bfhi(yw.x) * rs * ng[1]); ow.y = pk2(bflo(yw.y) * rs * ng[2], bfhi(yw.y) * rs * ng[3]);
                *(u32x2*)(yabc + (size_t)(I.row0 + i) * 3072 + 1024 + head * 64 + p0) = ow;
            }
#pragma unroll
            for (int pt = 0; pt < 4; ++pt) ycur[pt] = ynext[pt];
        }
    }
}

__device__ __forceinline__ void phase_scan(int wv, KP P, int l) {
    bf16_t* states = (bf16_t*)(P->ws + WS_ST);
    const float* cdec = (const float*)(P->ws + WS_CDEC);
    const float* lruA = (const float*)(P->ws + WS_LRUA); float* lruU = (float*)(P->ws + WS_LRUU);
    if (DBG_P5S) for (int idx = bidx() * 512 + tidx(wv); idx < 131072; idx += gdim() * 512) {
        const int e = idx * 2, b = e >> 17, rem = e & 131071, head = rem >> 13;
        unsigned* sp = (unsigned*)(states + (size_t)b * 128 * 131072 + rem);
        const float* dp = cdec + (b * 128) * 16 + head;
        float c0 = 0.f, c1 = 0.f;
        for (int c = 0; c < 128; c += 32) {
            unsigned v[32]; float dv[32];
#pragma unroll
            for (int k = 0; k < 32; ++k) { v[k] = sp[(size_t)(c + k) * 65536]; dv[k] = dp[(c + k) * 16]; }
#pragma unroll
            for (int k = 0; k < 32; ++k) {
                const float dec = dv[k];
                sp[(size_t)(c + k) * 65536] = pk2(c0, c1);
                c0 = dec * c0 + bflo(v[k]); c1 = dec * c1 + bfhi(v[k]);
            }
        }
        float* op = P->out + O_PSH + (size_t)(l * 2 + b) * 131072 + rem;
        op[0] = c0; op[1] = c1;
    }
    if (DBG_LRU4) for (int idx = bidx() * 512 + tidx(wv); idx < 2048; idx += gdim() * 512) {
        const int b = idx >> 10, ch = idx & 1023;
        float carry = 0.f;
        for (int c = 0; c < 128; c += 32) {
            float Av[32], Uv[32];
#pragma unroll
            for (int k = 0; k < 32; ++k) { const size_t o = (size_t)(b * 128 + c + k) * 1024 + ch; Av[k] = lruA[o]; Uv[k] = lruU[o]; }
#pragma unroll
            for (int k = 0; k < 32; ++k) { const size_t o = (size_t)(b * 128 + c + k) * 1024 + ch; lruU[o] = carry; carry = Av[k] * carry + Uv[k]; }
        }
    }
}

__device__ __forceinline__ void gsync(cg::grid_group& grid) {
    grid.sync();
}
#define XB_TMO      128
#define XB_XCNT(j)  (256  + 64 * (j))
#define XB_XSUB(j)  (1280 + 64 * (j))
#define XB_XGEN(j)  (2304 + 64 * (j))
#define XB_TOP      3328
#define XB_TOPGEN   3392
#define XCD_BAR_WORDS 3456
#define XB_SPIN_CAP (1u << 20)
__device__ __forceinline__ unsigned xb_ld(unsigned* p)              { return __hip_atomic_load(p, __ATOMIC_RELAXED, __HIP_MEMORY_SCOPE_AGENT); }
__device__ __forceinline__ unsigned xb_add(unsigned* p, unsigned v) { return __hip_atomic_fetch_add(p, v, __ATOMIC_RELAXED, __HIP_MEMORY_SCOPE_AGENT); }
__device__ __forceinline__ unsigned xb_xcc_id() { return (unsigned)__builtin_amdgcn_s_getreg((3 << 11) | 20) & 0xFu; }
#define XB_SPIN(cond, bar) do { unsigned _sp = 0; while (cond) { __builtin_amdgcn_s_sleep(1); \
    if ((++_sp & 255u) == 0u) { if (xb_ld(&(bar)[XB_TMO])) break; if (_sp > XB_SPIN_CAP) { atomicAdd(&(bar)[XB_TMO], 1u); break; } } } } while (0)
__device__ __forceinline__ void xcd_barrier_complete(unsigned* bar, unsigned x, unsigned& nloc, unsigned& nx) {
    const unsigned G = (unsigned)gdim();
    unsigned sum, cnt, mine, sp = 0u;
    for (;;) {
        sum = 0u; cnt = 0u; mine = 0u;
#pragma unroll
        for (unsigned j = 0; j < 16; ++j) { const unsigned c = xb_ld(&bar[XB_XCNT(j)]); sum += c; cnt += (c > 0u) ? 1u : 0u; mine = (j == x) ? c : mine; }
        if (sum == G) break;
        __builtin_amdgcn_s_sleep(1);
        if ((++sp & 255u) == 0u) { if (xb_ld(&bar[XB_TMO])) break; if (sp > XB_SPIN_CAP) { atomicAdd(&bar[XB_TMO], 1u); break; } }
    }
    nloc = mine > 0u ? mine : 1u; nx = cnt > 0u ? cnt : 1u;
}
__device__ __forceinline__ void gbar(int wv, LAS unsigned char* lds) {
    asm volatile("s_waitcnt vmcnt(0)" ::: "memory");
    __syncthreads();
    unsigned* bar = (unsigned*)(kparams()->ws + WS_BAR);
    if (tidx(wv) == 0) {
        volatile LAS unsigned* st = (volatile LAS unsigned*)(lds + LDS_BYTES - 16);
        const unsigned x = xb_xcc_id();
        __builtin_amdgcn_s_waitcnt(0);
        unsigned nloc = st[0], nx = st[1];
        if (nloc == 0u) { xcd_barrier_complete(bar, x, nloc, nx); st[0] = nloc; st[1] = nx; }
        const unsigned old = xb_add(&bar[XB_XSUB(x)], 1u);
        const unsigned gen = old / nloc;
        if (old + 1u == (gen + 1u) * nloc) {
            __builtin_amdgcn_fence(__ATOMIC_RELEASE, "agent");
            asm volatile("s_waitcnt vmcnt(0)" ::: "memory");
            const unsigned og = xb_add(&bar[XB_TOP], 1u);
            const unsigned tg = og / nx;
            if (og + 1u == (tg + 1u) * nx) xb_add(&bar[XB_TOPGEN], 1u);
            else XB_SPIN(xb_ld(&bar[XB_TOPGEN]) == tg, bar);
            __builtin_amdgcn_fence(__ATOMIC_ACQUIRE, "agent");
            xb_add(&bar[XB_XGEN(x)], 1u);
            asm volatile("s_waitcnt vmcnt(0)" ::: "memory");
        } else {
            XB_SPIN(xb_ld(&bar[XB_XGEN(x)]) == gen, bar);
            __builtin_amdgcn_fence(__ATOMIC_ACQUIRE, "agent");
            asm volatile("s_waitcnt vmcnt(0)" ::: "memory");
        }
    }
    __syncthreads();
}
__device__ __forceinline__ void gemm_gu(int wv, LAS unsigned char* lds, int j2) { KP P = kparams();
    EpiGU E; E.ssq = (const float*)(P->ws + WS_SSQ); E.hff = (bf16_t*)(P->ws + WS_H);
    run_gemm(wv, lds, (const bf16_t*)(P->ws + WS_XB), (const bf16_t*)(P->ws + (j2 ? W_GU1 : W_GU0)), MT, 5632, 1024, E); }
__device__ __forceinline__ void gemm_dn(int wv, LAS unsigned char* lds, int j2) { KP P = kparams();
    EpiRes E; E.x = P->out; E.xb = (bf16_t*)(P->ws + WS_XB); E.ssq = (float*)(P->ws + WS_SSQ); E.scale = 0.5f;
    run_gemm(wv, lds, (const bf16_t*)(P->ws + WS_H), (const bf16_t*)(P->ws + (j2 ? W_DN1 : W_DN0)), MP, 1024, 2816, E);
    skinny_gemm<0>(wv, lds, kparams(), (const bf16_t*)(kparams()->ws + WS_H) + (size_t)MP * DFF, (const bf16_t*)(kparams()->ws + (j2 ? W_DN1 : W_DN0)), 2816, 0.5f); }
__device__ __forceinline__ void gemm_in(int wv, LAS unsigned char* lds) { KP P = kparams();
    EpiIn E; E.ssq = (const float*)(P->ws + WS_SSQ); E.h = (bf16_t*)(P->ws + WS_H); E.dtraw = (float*)(P->ws + WS_DT);
    run_gemm(wv, lds, (const bf16_t*)(P->ws + WS_XB), (const bf16_t*)(P->ws + W_IN), MT, NINP, 1024, E); }
__device__ __forceinline__ void gemm_merge(int wv, LAS unsigned char* lds) { KP P = kparams();
    EpiMerge E; E.h = (const bf16_t*)(P->ws + WS_H); E.merged = (bf16_t*)(P->ws + WS_ST);
    run_gemm(wv, lds, (const bf16_t*)(P->ws + WS_Y), (const bf16_t*)(P->ws + W_BR), MP, 1024, 3072, E);
    skinny_gemm<1>(wv, lds, kparams(), (const bf16_t*)(kparams()->ws + WS_Y) + (size_t)MP * 3072, (const bf16_t*)(kparams()->ws + W_BR), 3072, 1.0f); }
__device__ __forceinline__ void gemm_out(int wv, LAS unsigned char* lds) { KP P = kparams();
    EpiRes E; E.x = P->out; E.xb = (bf16_t*)(P->ws + WS_XB); E.ssq = (float*)(P->ws + WS_SSQ); E.scale = 1.0f;
    run_gemm(wv, lds, (const bf16_t*)(P->ws + WS_ST), (const bf16_t*)(P->ws + W_OUT), MP, 1024, 1024, E);
    skinny_gemm<0>(wv, lds, kparams(), (const bf16_t*)(kparams()->ws + WS_ST) + (size_t)MP * DM, (const bf16_t*)(kparams()->ws + W_OUT), 1024, 1.0f); }

__global__ __launch_bounds__(512, 2) void mega(Params Pk) {
    extern __shared__ __attribute__((aligned(16))) unsigned char smem[];
    LAS unsigned char* lds = (LAS unsigned char*)smem;
    cg::grid_group grid = cg::this_grid();
    const int wv = __builtin_amdgcn_readfirstlane((int)(threadIdx.x >> 6));
    unsigned* bar0 = (unsigned*)(kparams()->ws + WS_BAR);
    if (threadIdx.x == 0) {
        volatile LAS unsigned* st = (volatile LAS unsigned*)(lds + LDS_BYTES - 16); st[0] = 0u; st[1] = 0u;
        (void)xb_add(&bar0[XB_XCNT(xb_xcc_id())], 1u);
    }
    __syncthreads();
    phase_init(wv, kparams());
    convert_layer(wv, kparams(), 0, 0, gdim(), lds);
    gsync(grid);
    unsigned long long tacc = 0, t0 = 0;
#pragma unroll 1
    for (int step = 0; step < 8; ++step) {
        const int l = step >> 1, j2 = step & 1;
        gbar(wv, lds);
        TB(0); gemm_gu(wv, lds, j2); gbar(wv, lds); TE(0);
        TB(1); gemm_dn(wv, lds, j2);
        if (j2 == 0) {
            gbar(wv, lds); TE(1);
            TB(2); gemm_in(wv, lds); gbar(wv, lds); TE(2);
            TB(3);
            for (int item = bidx(); item < 256; item += gdim()) {
                const Item I = get_item(item);
                copy_states_item(wv, kparams(), l, I);
                attn_item<64>(wv, kparams(), l, I, lds);
                lru_item<64, false>(wv, kparams(), l, item, I, lds);
                ssd_states_item<64>(wv, kparams(), l, item, I, lds);
            }
            gbar(wv, lds); TE(3);
            TB(4);
            phase_scan(wv, kparams(), l);
            {
                const int nconv = gdim() > 128 ? gdim() - 64 : gdim();
                convert_layer(wv, kparams(), l, 1, nconv, lds);
                if (l < 3) convert_layer(wv, kparams(), l + 1, 0, nconv, lds);
                for (int sj = bidx() - (gdim() > 128 ? gdim() - 64 : 0); sj >= 0 && sj < 64; sj += gdim()) {
                    const int sb = sj & 15, piece = sj >> 4;
                    const Item I = get_item(256 + sb);
                    if (piece == 0) lru_item<16, true>(wv, kparams(), l, 256 + sb, I, lds);
                    else if (piece == 1) ssd_states_item<16>(wv, kparams(), l, 256 + sb, I, lds);
                    else if (piece == 2) ssd_y_item<16>(wv, kparams(), l, I, lds);
                    else { copy_states_item(wv, kparams(), l, I); attn_item<16>(wv, kparams(), l, I, lds); }
                }
            }
            gbar(wv, lds); TE(4);
            TB(5);
            for (int item = bidx(); item < 256; item += gdim()) {
                const Item I = get_item(item);
                lru_apply_item(wv, kparams(), l, item, I);
                ssd_y_item<64>(wv, kparams(), l, I, lds);
            }
            gbar(wv, lds); TE(5);
            TB(6); gemm_merge(wv, lds); gbar(wv, lds); TE(6);
            TB(7); gemm_out(wv, lds);
        }
    }
    gbar(wv, lds);
    TE(7);
    phase_final(wv, kparams());
    if (PROBE >= 0 && bidx() == 0) { const unsigned long long tend = TNOW() + tacc; while (TNOW() < tend) __builtin_amdgcn_s_sleep(10); }
#if DBG_SANITIZE
    gbar(wv, lds);
    { KP P = kparams(); float* o = P->out;
      for (size_t i = (size_t)bidx() * 512 + tidx(wv); i < O_END; i += (size_t)gdim() * 512) { const float v = o[i]; if (!(fabsf(v) < 1e30f)) o[i] = 0.f; } }
#endif
}

extern "C" void kernel_launch(void* const* d_in, const int* in_sizes, int n_in, void* d_out, int out_size, void* d_ws, size_t ws_size, hipStream_t stream) {
    static int grid_blocks = 0;
    if (grid_blocks == 0) {
        if (n_in != N_INPUTS || (size_t)out_size != O_END || ws_size < WS_END) {
            fprintf(stderr, "kernel_launch: unexpected shapes: n_in %d out %d ws %zu (need %zu)\n", n_in, out_size, ws_size, (size_t)WS_END); grid_blocks = -1; return; }
        int dev = 0, cus = 0, per_cu = 0;
        hipGetDevice(&dev);
        hipDeviceGetAttribute(&cus, hipDeviceAttributeMultiprocessorCount, dev);
        if (hipFuncSetAttribute((const void*)mega, hipFuncAttributeMaxDynamicSharedMemorySize, LDS_BYTES) != hipSuccess) { fprintf(stderr, "hipFuncSetAttribute failed\n"); grid_blocks = -1; return; }
        hipOccupancyMaxActiveBlocksPerMultiprocessor(&per_cu, (const void*)mega, 512, LDS_BYTES);
        if (per_cu < 1) per_cu = 1;
        grid_blocks = cus * per_cu;
    }
    if (grid_blocks < 0) return;
    Params p{};
    for (int i = 0; i < N_INPUTS; ++i) p.in[i] = (const float*)d_in[i];
    p.out = (float*)d_out; p.ws = (unsigned char*)d_ws;
    if (hipMemsetAsync((unsigned char*)d_ws + WS_BAR, 0, 16384, stream) != hipSuccess) { fprintf(stderr, "memset failed\n"); return; }
    void* args[] = {&p};
    hipError_t e = hipLaunchCooperativeKernel((const void*)mega, dim3(grid_blocks), dim3(512), args, LDS_BYTES, stream);
    if (e != hipSuccess) fprintf(stderr, "cooperative launch failed: %s (grid %d)\n", hipGetErrorString(e), grid_blocks);
}
```

```cpp
#include <hip/hip_runtime.h>
#include <hip/hip_cooperative_groups.h>
#include <cstdio>
namespace cg = cooperative_groups;
#define DBG_SANITIZE 0
#ifndef REP_P4
#define REP_P4 1
#endif
#ifndef REP_P6
#define REP_P6 1
#endif
#ifndef REP_SYNC
#define REP_SYNC 0
#endif
#ifndef REP_IN
#define REP_IN 1
#endif
#ifndef REP_A
#define REP_A 1
#endif
#ifndef REP_L4
#define REP_L4 1
#endif
#ifndef REP_S4
#define REP_S4 1
#endif
#ifndef REP_L6
#define REP_L6 1
#endif
#ifndef REP_S6
#define REP_S6 1
#endif
#ifndef PROBE
#define PROBE -1
#endif
#define TNOW() __builtin_amdgcn_s_memrealtime()
#define TB(id) do { if (((PROBE) >> (id)) & 1 && PROBE >= 0) t0 = TNOW(); } while (0)
#define TE(id) do { if (((PROBE) >> (id)) & 1 && PROBE >= 0) tacc += TNOW() - t0; } while (0)
#ifndef REP_CV
#define REP_CV 1
#endif
#ifndef REP_GU
#define REP_GU 1
#endif
#ifndef REP_MG
#define REP_MG 1
#endif
#define DBG_MIX 1
#define DBG_MERGE 1
#define DBG_ATTN 1
#define DBG_LRU4 1
#define DBG_SSD4 1
#define DBG_P5S 1
#define DBG_P5W 1
#define DBG_P5 1
#define DBG_LRU6 1
#define DBG_SSD6 1

#define LAS __attribute__((address_space(3)))
typedef unsigned short bf16_t;
typedef short bf16x8 __attribute__((ext_vector_type(8)));
typedef float f32x4 __attribute__((ext_vector_type(4)));
typedef unsigned u32x4 __attribute__((ext_vector_type(4)));
typedef unsigned u32x2 __attribute__((ext_vector_type(2)));

constexpr int MP = 16384, MS = 256, MT = 16640;
constexpr int DM = 1024, DFF = 2816, NIN = 9232, NINP = 9472, HP = 9232;
constexpr int HX = 0, HG = 1024, HZ = 2048, HXBC = 3072, HQ = 4608, HK = 5632, HV = 5888, HGATE = 6144, HDT = 9216;
constexpr float EPS = 1e-6f;
constexpr int NITEM = 272;

enum { I_XP = 0, I_XS, I_CK, I_CV, I_SLC, I_SLH, I_SSC, I_SSH, I_FNORM, I_WG, I_WU, I_WD, I_MNORM, I_WIN, I_LCW, I_LCB, I_LWA, I_LBA, I_LWX, I_LBX,
       I_LLAM, I_SCW, I_SCB, I_SDTB, I_SALOG, I_SD, I_SNORM, I_SINK, I_WBR, I_WOUT, I_FINAL, N_INPUTS };

constexpr size_t O_YP = 0, O_YS = O_YP + (size_t)MP * DM, O_PK = O_YS + (size_t)MS * DM, O_PV = O_PK + 4 * 2 * 128 * 256, O_PLC = O_PV + 4 * 2 * 128 * 256,
                 O_PLH = O_PLC + 4 * 2 * 3 * 1024, O_PSC = O_PLH + 4 * 2 * 1024, O_PSH = O_PSC + 4 * 2 * 3 * 1536, O_SK = O_PSH + (size_t)4 * 2 * 16 * 64 * 128,
                 O_SV = O_SK + (size_t)4 * 16 * 128 * 256, O_SLC = O_SV + (size_t)4 * 16 * 128 * 256, O_SLH = O_SLC + 4 * 16 * 3 * 1024, O_SSC = O_SLH + 4 * 16 * 1024,
                 O_SSH = O_SSC + 4 * 16 * 3 * 1536, O_END = O_SSH + (size_t)4 * 16 * 16 * 64 * 128;

constexpr size_t WS_XB = 0;
constexpr size_t WS_H = WS_XB + (size_t)MT * DM * 2;
constexpr size_t WS_ST = WS_H + (size_t)MT * HP * 2;
constexpr size_t WS_Y = WS_ST + (size_t)2 * 128 * 16 * 64 * 128 * 2;
constexpr size_t WS_W = WS_Y + (size_t)MT * 3072 * 2;
constexpr size_t W_GU0 = WS_W, W_GU1 = W_GU0 + (size_t)5632 * 1024 * 2, W_DN0 = W_GU1 + (size_t)5632 * 1024 * 2, W_DN1 = W_DN0 + (size_t)1024 * 2816 * 2,
                 W_IN = W_DN1 + (size_t)1024 * 2816 * 2, W_BR = W_IN + (size_t)NINP * 1024 * 2, W_OUT = W_BR + (size_t)1024 * 3072 * 2,
                 W_LA = W_OUT + (size_t)1024 * 1024 * 2, W_LX = W_LA + 2 * 65536 * 2, WS_SSQ = W_LX + 2 * 65536 * 2;
constexpr size_t WS_DT = WS_SSQ + (size_t)MT * 16 * 4, WS_LRUA = WS_DT + (size_t)MT * 16 * 4, WS_LRUU = WS_LRUA + 256 * 1024 * 4, WS_CDEC = WS_LRUU + 256 * 1024 * 4,
                 WS_BAR = WS_CDEC + 256 * 16 * 4, WS_SSQ2 = WS_BAR + 16384, WS_END = WS_SSQ2 + 256 * 16 * 4;

constexpr int LDS_BYTES = 147456;

struct Params { const float* in[N_INPUTS]; float* out; unsigned char* ws; };
typedef const Params __attribute__((address_space(4))) * KP;
__device__ __forceinline__ KP kparams() { KP p = (KP)__builtin_amdgcn_kernarg_segment_ptr(); asm volatile("" : "+s"(p)); return p; }
__device__ __forceinline__ int tidx(int wv) { int t; asm volatile("v_mbcnt_lo_u32_b32 %0, -1, 0\n\tv_mbcnt_hi_u32_b32 %0, -1, %0" : "=v"(t)); return (wv << 6) | t; }
__device__ __forceinline__ int bidx() { int t = blockIdx.x; asm volatile("" : "+s"(t)); return t; }
__device__ __forceinline__ int gdim() { int t = gridDim.x; asm volatile("" : "+s"(t)); return t; }

typedef __bf16 bf16x2_t __attribute__((ext_vector_type(2)));
typedef float f32x2_t __attribute__((ext_vector_type(2)));
__device__ __forceinline__ unsigned pk2(float lo, float hi) { f32x2_t v = {lo, hi}; bf16x2_t b = __builtin_convertvector(v, bf16x2_t); unsigned r; __builtin_memcpy(&r, &b, 4); return r; }
__device__ __forceinline__ bf16_t f2bf(float f) { return (bf16_t)(pk2(f, 0.f) & 0xffffu); }
__device__ __forceinline__ float bf2f(bf16_t b) { return __uint_as_float(((unsigned)b) << 16); }
__device__ __forceinline__ float bflo(unsigned w) { return __uint_as_float(w << 16); }
__device__ __forceinline__ float bfhi(unsigned w) { return __uint_as_float(w & 0xffff0000u); }
__device__ __forceinline__ float rcpf_(float x) { return __builtin_amdgcn_rcpf(x); }
__device__ __forceinline__ float sigmoidf_(float x) { return rcpf_(1.0f + __expf(-x)); }
__device__ __forceinline__ float siluf_(float x) { return x * rcpf_(1.0f + __expf(-x)); }
__device__ __forceinline__ float softplusf_(float x) { return x > 20.f ? x : log1pf(__expf(x)); }
__device__ __forceinline__ float gelu_tanh(float x) { const float u = 0.7978845608028654f * (x + 0.044715f * x * x * x); return x * rcpf_(1.0f + __expf(-2.0f * u)); }
__device__ __forceinline__ float rstd_row(const float* ssq, int r) {
    const f32x4* p = (const f32x4*)(ssq + (size_t)r * 16); f32x4 a = p[0], b = p[1], c = p[2], d = p[3];
    float s = (a[0] + a[1] + a[2] + a[3]) + (b[0] + b[1] + b[2] + b[3]) + (c[0] + c[1] + c[2] + c[3]) + (d[0] + d[1] + d[2] + d[3]);
    if (r >= MP) {
        const f32x4* q = (const f32x4*)(ssq + (WS_SSQ2 - WS_SSQ) / 4 + (size_t)(r - MP) * 16); a = q[0]; b = q[1]; c = q[2]; d = q[3];
        s += (a[0] + a[1] + a[2] + a[3]) + (b[0] + b[1] + b[2] + b[3]) + (c[0] + c[1] + c[2] + c[3]) + (d[0] + d[1] + d[2] + d[3]);
    }
    return rsqrtf(s * (1.0f / 1024.0f) + EPS);
}
__device__ __forceinline__ int lane_now() { int t; asm volatile("v_mbcnt_lo_u32_b32 %0, -1, 0\n\tv_mbcnt_hi_u32_b32 %0, -1, %0" : "=v"(t)); return t; }
__device__ __forceinline__ float shfl_idx(float v, int src) { return __int_as_float(__builtin_amdgcn_ds_bpermute(src << 2, __float_as_int(v))); }
__device__ __forceinline__ float shflx(float v, int mask) { return shfl_idx(v, lane_now() ^ mask); }
__device__ __forceinline__ float shfl_row15(float v) { return __int_as_float(__builtin_amdgcn_ds_swizzle(__float_as_int(v), 0x1F0)); }
#define MFMA16(a, b, c) __builtin_amdgcn_mfma_f32_16x16x32_bf16((a), (b), (c), 0, 0, 0)

namespace pg8 {
constexpr int BM = 256, BK = 64, HALF = 128, HTB = HALF * BK * 2, STAGE_BYTES = 8 * HTB, NXCD = 8, WGM = 8;
__device__ __forceinline__ int lds_byte(int r, int c) { const int st = (r >> 4) * 2 + (c >> 5), rr = r & 15, cc = c & 31, ob = rr * 64 + cc * 2; return st * 1024 + (ob ^ (((ob >> 9) & 1) << 5)); }
__device__ __forceinline__ void stage_rc(int b, int& R, int& C) { const int st = b / 1024, sb = b % 1024, swz = sb ^ (((sb >> 9) & 1) << 5); R = (st >> 1) * 16 + swz / 64; C = (st & 1) * 32 + (swz % 64) / 2; }
struct Unit { int pm, pn; };
struct Gemm { const bf16_t* A; const bf16_t* Bt; int M, N, K; };
struct StaticOrder {
    int nM, nN, nwg, G, c;
    __device__ void init(int M, int N, int G_, int c_) { nM = M / BM; nN = N / BM; nwg = nM * nN; G = G_; c = c_; }
    __device__ bool next(int i, Unit& u) const {
        const long L = (long)i * G + c; if (L >= nwg) return false;
        int wgid = (int)L; { const int q = nwg / NXCD, r = nwg % NXCD, xcd = wgid % NXCD, off = wgid / NXCD; wgid = (xcd < r ? xcd * (q + 1) : r * (q + 1) + (xcd - r) * q) + off; }
        const int nig = WGM * nN, gid = wgid / nig, fm = gid * WGM, gsz = (nM - fm) < WGM ? (nM - fm) : WGM;
        u.pm = fm + ((wgid % nig) % gsz); u.pn = (wgid % nig) / gsz; return true;
    }
};

template <class Epi>
__device__ __forceinline__ void gemm_phase(int wv, LAS unsigned char* lds, const Gemm g, const StaticOrder& S, const Epi& E) {
    const int tid = tidx(wv), wid = wv, lane = tid & 63, wr = wid >> 2, wc = wid & 3, fr = lane & 15, fq = lane >> 4;
    const int K = g.K, nt = K / BK;
    unsigned voffA[2];
#pragma unroll
    for (int i = 0; i < 2; ++i) { int R, C; stage_rc(tid * 16 + i * 8192, R, C); voffA[i] = (unsigned)(R * K + C) * 2u; }
    const size_t kstep = (size_t)(BK * 2);
    const size_t hstep = (size_t)HALF * K * 2;
    const size_t tstep = 2 * hstep;
    const unsigned ldsw = (unsigned)wid * 1024u;
    const int aoff = lds_byte(wr * 64 + fr, fq * 8), boff = lds_byte(wc * 32 + fr, fq * 8);
#define PG8_SA(b, h) (((b) * 2 + (h)) * HTB)
#define PG8_SB(b, h) ((4 + (b) * 2 + (h)) * HTB)
#define PG8_STAGE(bufoff, gbase, voff) do { _Pragma("unroll") for (int _i = 0; _i < 2; ++_i) \
        __builtin_amdgcn_global_load_lds((const unsigned*)((const char*)(gbase) + (voff)[_i]), (LAS unsigned*)(lds + (bufoff) + ldsw + _i * 8192), 16, 0, 0); } while (0)
#define PG8_LDA(dst, b, h) do { _Pragma("unroll") for (int m = 0; m < 4; ++m) _Pragma("unroll") for (int k = 0; k < 2; ++k) dst[m][k] = *(const LAS bf16x8*)(lds + PG8_SA(b, h) + aoff + m * 2048 + k * 1024); } while (0)
#define PG8_LDB(dst, b, h) do { _Pragma("unroll") for (int n = 0; n < 2; ++n) _Pragma("unroll") for (int k = 0; k < 2; ++k) dst[n][k] = *(const LAS bf16x8*)(lds + PG8_SB(b, h) + boff + n * 2048 + k * 1024); } while (0)
#define PG8_MMA(ai, bj, At, Bt) do { __builtin_amdgcn_s_setprio(1); _Pragma("unroll") for (int m = 0; m < 4; ++m) _Pragma("unroll") for (int n = 0; n < 2; ++n) _Pragma("unroll") for (int k = 0; k < 2; ++k) \
        acc[ai][bj][m][n] = __builtin_amdgcn_mfma_f32_16x16x32_bf16(Bt[n][k], At[m][k], acc[ai][bj][m][n], 0, 0, 0); __builtin_amdgcn_s_setprio(0); } while (0)
#define PG8_WAIT_V(n) asm volatile("s_waitcnt vmcnt(" #n ")" ::: "memory")
#define PG8_WAIT_L(n) asm volatile("s_waitcnt lgkmcnt(" #n ")" ::: "memory")
#define PG8_BAR __builtin_amdgcn_s_barrier()
#define PG8_SCHED __builtin_amdgcn_sched_barrier(0)
    Unit cur, nxt; int ui = 0;
    if (!S.next(0, cur)) return;
    f32x4 acc[2][2][4][2];
#pragma unroll
    for (int a = 0; a < 2; ++a)
#pragma unroll
        for (int b = 0; b < 2; ++b)
#pragma unroll
            for (int m = 0; m < 4; ++m)
#pragma unroll
                for (int n = 0; n < 2; ++n) acc[a][b][m][n] = (f32x4){0.f, 0.f, 0.f, 0.f};
    bf16x8 At[4][2], B0[2][2], B1[2][2];
    const char* cA = (const char*)g.A + (size_t)cur.pm * tstep; const char* cB = (const char*)g.Bt + (size_t)cur.pn * tstep;
    PG8_STAGE(PG8_SB(0, 0), cB, voffA); PG8_STAGE(PG8_SA(0, 0), cA, voffA); PG8_STAGE(PG8_SB(0, 1), cB + hstep, voffA); PG8_STAGE(PG8_SA(0, 1), cA + hstep, voffA);
    if (wr == 1) PG8_BAR;
    PG8_WAIT_V(4); PG8_BAR;
    PG8_STAGE(PG8_SB(1, 0), cB + kstep, voffA); PG8_STAGE(PG8_SA(1, 0), cA + kstep, voffA); PG8_STAGE(PG8_SB(1, 1), cB + hstep + kstep, voffA);
    PG8_WAIT_V(6); PG8_BAR;
    for (;;) {
        if constexpr (Epi::NEEDS_RSTD) {
            LAS float* rb = (LAS float*)(lds + STAGE_BYTES) + (ui & 1) * 256;
            const int t2 = tidx(wv);
            if (t2 < 256) rb[t2] = rstd_row(E.ssq, cur.pm * 256 + t2);
        }
        const bool has_next = S.next(ui + 1, nxt);
        const char* nA = has_next ? (const char*)g.A + (size_t)nxt.pm * tstep : cA; const char* nB = has_next ? (const char*)g.Bt + (size_t)nxt.pn * tstep : cB;
        for (int t = 0; t < nt; t += 2) {
            const bool last = (t == nt - 2);
            const char* a1 = cA + (size_t)(t + 1) * kstep;
            const char* a2 = last ? nA : cA + (size_t)(t + 2) * kstep; const char* b2 = last ? nB : cB + (size_t)(t + 2) * kstep;
            const char* a3 = a2 + kstep; const char* b3 = b2 + kstep;
            PG8_LDB(B0, 0, 0); PG8_SCHED; PG8_LDA(At, 0, 0); PG8_STAGE(PG8_SA(1, 1), a1 + hstep, voffA);
            PG8_WAIT_L(8); PG8_BAR; PG8_WAIT_L(0); PG8_MMA(0, 0, At, B0); PG8_BAR; PG8_SCHED;
            PG8_LDB(B1, 0, 1); PG8_STAGE(PG8_SB(0, 0), b2, voffA);
            PG8_BAR; PG8_WAIT_L(0); PG8_MMA(0, 1, At, B1); PG8_BAR;
            PG8_LDA(At, 0, 1); PG8_STAGE(PG8_SA(0, 0), a2, voffA);
            PG8_BAR; PG8_WAIT_L(0); PG8_MMA(1, 0, At, B0); PG8_BAR; PG8_SCHED;
            PG8_STAGE(PG8_SB(0, 1), b2 + hstep, voffA);
            PG8_WAIT_V(6); PG8_BAR; PG8_MMA(1, 1, At, B1); PG8_BAR;
            PG8_LDB(B0, 1, 0); PG8_SCHED; PG8_LDA(At, 1, 0); PG8_STAGE(PG8_SA(0, 1), a2 + hstep, voffA);
            PG8_WAIT_L(8); PG8_BAR; PG8_WAIT_L(0); PG8_MMA(0, 0, At, B0); PG8_BAR; PG8_SCHED;
            PG8_LDB(B1, 1, 1); PG8_STAGE(PG8_SB(1, 0), b3, voffA);
            PG8_BAR; PG8_WAIT_L(0); PG8_MMA(0, 1, At, B1); PG8_BAR;
            PG8_LDA(At, 1, 1); PG8_STAGE(PG8_SA(1, 0), a3, voffA);
            PG8_BAR; PG8_WAIT_L(0); PG8_MMA(1, 0, At, B0); PG8_BAR; PG8_SCHED;
            PG8_STAGE(PG8_SB(1, 1), b3 + hstep, voffA);
            PG8_WAIT_V(6); PG8_BAR; PG8_MMA(1, 1, At, B1); PG8_BAR;
            if constexpr (Epi::HAS_MID) { if (!last && ((t + 2) & 15) == 0) E.mid(acc, cur, (t + 2) >> 4, wr, wc, fr, fq); }
        }
        if constexpr (Epi::NEEDS_RSTD) E.rb = (const LAS float*)(lds + STAGE_BYTES) + (ui & 1) * 256;
        E(acc, cur, wr, wc, fr, fq);
        if (!has_next) break;
#pragma unroll
        for (int a = 0; a < 2; ++a)
#pragma unroll
            for (int b = 0; b < 2; ++b)
#pragma unroll
                for (int m = 0; m < 4; ++m)
#pragma unroll
                    for (int n = 0; n < 2; ++n) acc[a][b][m][n] = (f32x4){0.f, 0.f, 0.f, 0.f};
        cur = nxt; cA = nA; cB = nB; ++ui;
    }
    PG8_WAIT_V(0);
    if (wr == 0) PG8_BAR;
    PG8_BAR;
#undef PG8_SA
#undef PG8_SB
#undef PG8_STAGE
#undef PG8_LDA
#undef PG8_LDB
#undef PG8_MMA
#undef PG8_WAIT_V
#undef PG8_WAIT_L
#undef PG8_BAR
#undef PG8_SCHED
}
}
using pg8::Unit;
typedef f32x4 AccT[2][2][4][2];

struct EpiGU {
    static constexpr bool HAS_MID = false, NEEDS_RSTD = true;
    const float* ssq; bf16_t* hff; mutable const LAS float* rb;
    __device__ __forceinline__ void mid(AccT&, const Unit&, int, int, int, int, int) const {}
    __device__ __forceinline__ void operator()(const AccT& acc, const Unit& u, int wr, int wc, int fr_, int fq_) const {
        int fr = fr_, fq = fq_; asm volatile("" : "+v"(fr), "+v"(fq));
        const int row0 = u.pm * 256 + wr * 64 + fr, hc0 = u.pn * 128 + wc * 32 + fq * 8;
#pragma unroll
        for (int ai = 0; ai < 2; ++ai)
#pragma unroll
            for (int m = 0; m < 4; ++m) {
                const int r = row0 + ai * 128 + m * 16; const float rs = rb[wr * 64 + fr + ai * 128 + m * 16];
                u32x4 w;
                { const f32x4 gt = acc[ai][0][m][0] * rs, up = acc[ai][0][m][1] * rs;
                  w.x = pk2(siluf_(gt[0]) * up[0], siluf_(gt[1]) * up[1]); w.y = pk2(siluf_(gt[2]) * up[2], siluf_(gt[3]) * up[3]); }
                { const f32x4 gt = acc[ai][1][m][0] * rs, up = acc[ai][1][m][1] * rs;
                  w.z = pk2(siluf_(gt[0]) * up[0], siluf_(gt[1]) * up[1]); w.w = pk2(siluf_(gt[2]) * up[2], siluf_(gt[3]) * up[3]); }
                *(u32x4*)(hff + (size_t)r * DFF + hc0) = w;
            }
    }
};
struct EpiRes {
    static constexpr bool HAS_MID = false, NEEDS_RSTD = false;
    float* x; bf16_t* xb; float* ssq; float scale;
    __device__ __forceinline__ void mid(AccT&, const Unit&, int, int, int, int, int) const {}
    __device__ __forceinline__ void operator()(const AccT& acc, const Unit& u, int wr, int wc, int fr_, int fq_) const {
        int fr = fr_, fq = fq_; asm volatile("" : "+v"(fr), "+v"(fq));
        const int row0 = u.pm * 256 + wr * 64 + fr, col0 = u.pn * 256 + wc * 32 + 8 * fq;
#pragma unroll
        for (int ai = 0; ai < 2; ++ai) {
            f32x4 xv[4][2][2];
#pragma unroll
            for (int m = 0; m < 4; ++m)
#pragma unroll
                for (int bj = 0; bj < 2; ++bj)
#pragma unroll
                    for (int n = 0; n < 2; ++n) xv[m][bj][n] = *(const f32x4*)(x + (size_t)(row0 + ai * 128 + m * 16) * DM + col0 + bj * 128 + n * 4);
#pragma unroll
            for (int m = 0; m < 4; ++m) {
                const int r = row0 + ai * 128 + m * 16; float ss = 0.f;
#pragma unroll
                for (int bj = 0; bj < 2; ++bj) {
                    const int c = col0 + bj * 128;
                    const f32x4 v0 = xv[m][bj][0] + acc[ai][bj][m][0] * scale, v1 = xv[m][bj][1] + acc[ai][bj][m][1] * scale;
                    *(f32x4*)(x + (size_t)r * DM + c) = v0; *(f32x4*)(x + (size_t)r * DM + c + 4) = v1;
                    u32x4 w; w.x = pk2(v0[0], v0[1]); w.y = pk2(v0[2], v0[3]); w.z = pk2(v1[0], v1[1]); w.w = pk2(v1[2], v1[3]);
                    *(u32x4*)(xb + (size_t)r * DM + c) = w;
                    ss += v0[0] * v0[0] + v0[1] * v0[1] + v0[2] * v0[2] + v0[3] * v0[3] + v1[0] * v1[0] + v1[1] * v1[1] + v1[2] * v1[2] + v1[3] * v1[3];
                }
                ss += shflx(ss, 16); ss += shflx(ss, 32);
                if (fq == 0) ssq[(size_t)r * 16 + u.pn * 4 + wc] = ss;
            }
        }
    }
};
struct EpiIn {
    static constexpr bool HAS_MID = false, NEEDS_RSTD = true;
    const float* ssq; bf16_t* h; float* dtraw; mutable const LAS float* rb;
    __device__ __forceinline__ void mid(AccT&, const Unit&, int, int, int, int, int) const {}
    __device__ __forceinline__ void operator()(const AccT& acc, const Unit& u, int wr, int wc, int fr_, int fq_) const {
        int fr = fr_, fq = fq_; asm volatile("" : "+v"(fr), "+v"(fq));
        const int row0 = u.pm * 256 + wr * 64 + fr, col0 = u.pn * 256 + wc * 32 + 8 * fq;
#pragma unroll
        for (int ai = 0; ai < 2; ++ai)
#pragma unroll
            for (int m = 0; m < 4; ++m) {
                const int r = row0 + ai * 128 + m * 16; const float rs = rb[wr * 64 + fr + ai * 128 + m * 16];
                if (u.pn < 36) {
#pragma unroll
                    for (int bj = 0; bj < 2; ++bj) {
                        const f32x4 v0 = acc[ai][bj][m][0] * rs, v1 = acc[ai][bj][m][1] * rs;
                        u32x4 w; w.x = pk2(v0[0], v0[1]); w.y = pk2(v0[2], v0[3]); w.z = pk2(v1[0], v1[1]); w.w = pk2(v1[2], v1[3]);
                        *(u32x4*)(h + (size_t)r * HP + col0 + bj * 128) = w;
                    }
                } else if (wc == 0 && fq < 2) {
                    *(f32x4*)(dtraw + (size_t)r * 16 + 8 * fq) = acc[ai][0][m][0] * rs;
                    *(f32x4*)(dtraw + (size_t)r * 16 + 8 * fq + 4) = acc[ai][0][m][1] * rs;
                }
            }
    }
};
struct EpiMerge {
    static constexpr bool HAS_MID = true, NEEDS_RSTD = false;
    const bf16_t* h; bf16_t* merged;
    __device__ __forceinline__ void mid(AccT& acc, const Unit& u, int seg, int wr, int wc, int fr_, int fq_) const {
        int fr = fr_, fq = fq_; asm volatile("" : "+v"(fr), "+v"(fq));
        const int row0 = u.pm * 256 + wr * 64 + fr, col0 = u.pn * 256 + wc * 32 + 8 * fq;
#pragma unroll
        for (int ai = 0; ai < 2; ++ai) {
            u32x2 ga[4][2][2], gb[4][2][2];
#pragma unroll
            for (int m = 0; m < 4; ++m)
#pragma unroll
                for (int bj = 0; bj < 2; ++bj)
#pragma unroll
                    for (int n = 0; n < 2; ++n) {
                        const bf16_t* gp = h + (size_t)(row0 + ai * 128 + m * 16) * HP + HGATE + (seg - 1) * 1024 + col0 + bj * 128 + n * 4;
                        ga[m][bj][n] = *(const u32x2*)gp; gb[m][bj][n] = *(const u32x2*)(gp + 1024);
                    }
#pragma unroll
            for (int m = 0; m < 4; ++m)
#pragma unroll
                for (int bj = 0; bj < 2; ++bj)
#pragma unroll
                    for (int n = 0; n < 2; ++n) {
                        const u32x2 a = ga[m][bj][n], b = gb[m][bj][n];
                        f32x4 f;
                        f[0] = (1.f + __expf(-fmaxf(bflo(b.x), -30.f))) * rcpf_(1.f + __expf(-fmaxf(bflo(a.x), -30.f)));
                        f[1] = (1.f + __expf(-fmaxf(bfhi(b.x), -30.f))) * rcpf_(1.f + __expf(-fmaxf(bfhi(a.x), -30.f)));
                        f[2] = (1.f + __expf(-fmaxf(bflo(b.y), -30.f))) * rcpf_(1.f + __expf(-fmaxf(bflo(a.y), -30.f)));
                        f[3] = (1.f + __expf(-fmaxf(bfhi(b.y), -30.f))) * rcpf_(1.f + __expf(-fmaxf(bfhi(a.y), -30.f)));
                        acc[ai][bj][m][n] *= f;
                    }
        }
    }
    __device__ __forceinline__ void operator()(const AccT& acc, const Unit& u, int wr, int wc, int fr_, int fq_) const {
        int fr = fr_, fq = fq_; asm volatile("" : "+v"(fr), "+v"(fq));
        const int row0 = u.pm * 256 + wr * 64 + fr, col0 = u.pn * 256 + wc * 32 + 8 * fq;
#pragma unroll
        for (int ai = 0; ai < 2; ++ai) {
            u32x2 gv[4][2][2];
#pragma unroll
            for (int m = 0; m < 4; ++m)
#pragma unroll
                for (int bj = 0; bj < 2; ++bj)
#pragma unroll
                    for (int n = 0; n < 2; ++n) gv[m][bj][n] = *(const u32x2*)(h + (size_t)(row0 + ai * 128 + m * 16) * HP + HGATE + 2048 + col0 + bj * 128 + n * 4);
#pragma unroll
            for (int m = 0; m < 4; ++m)
#pragma unroll
                for (int bj = 0; bj < 2; ++bj)
#pragma unroll
                    for (int n = 0; n < 2; ++n) {
                        const u32x2 ga = gv[m][bj][n];
                        const f32x4 v = acc[ai][bj][m][n];
                        u32x2 w;
                        w.x = pk2(v[0] * rcpf_(1.f + __expf(-fmaxf(bflo(ga.x), -30.f))), v[1] * rcpf_(1.f + __expf(-fmaxf(bfhi(ga.x), -30.f))));
                        w.y = pk2(v[2] * rcpf_(1.f + __expf(-fmaxf(bflo(ga.y), -30.f))), v[3] * rcpf_(1.f + __expf(-fmaxf(bfhi(ga.y), -30.f))));
                        *(u32x2*)(merged + (size_t)(row0 + ai * 128 + m * 16) * DM + col0 + bj * 128 + n * 4) = w;
                    }
        }
    }
};

template <class Epi> __device__ __forceinline__ void run_gemm(int wv, LAS unsigned char* lds, const bf16_t* A, const bf16_t* Bt, int M, int N, int K, const Epi& E) {
    asm volatile("" : "+s"(wv));
    pg8::Gemm g; g.A = A; g.Bt = Bt; g.M = M; g.N = N; g.K = K;
    pg8::StaticOrder S; S.init(M, N, (int)gdim(), (int)bidx());
    pg8::gemm_phase<Epi>(wv, lds, g, S, E);
}


template <int MODE>
__device__ __forceinline__ void skinny_gemm(int wv, LAS unsigned char* lds, KP P, const bf16_t* A, const bf16_t* Bt, int K, float scale) {
    const int tid = tidx(wv), w = tid >> 6, lane = tid & 63, fr = lane & 15, fq = lane >> 4;
    LAS float* part = (LAS float*)lds;
    constexpr int NSEG = MODE ? 3 : 1;
    const int kseg = K / NSEG, kw = kseg / 8;
    const bf16_t* h = (const bf16_t*)(P->ws + WS_H);
    for (int task = bidx(); task < 256; task += gdim()) {
        const int rt = task >> 5, ct = task & 31;
        f32x4 tot[2][2];
#pragma unroll
        for (int i = 0; i < 2; ++i)
#pragma unroll
            for (int j = 0; j < 2; ++j) tot[i][j] = (f32x4){0.f, 0.f, 0.f, 0.f};
#pragma unroll 1
        for (int seg = 0; seg < NSEG; ++seg) {
            f32x4 acc[2][2];
#pragma unroll
            for (int i = 0; i < 2; ++i)
#pragma unroll
                for (int j = 0; j < 2; ++j) acc[i][j] = (f32x4){0.f, 0.f, 0.f, 0.f};
            const bf16_t* ap = A + (size_t)(rt * 32 + fr) * K + seg * kseg + w * kw + fq * 8;
            const bf16_t* bp = Bt + (size_t)(ct * 32 + fr) * K + seg * kseg + w * kw + fq * 8;
#pragma unroll 2
            for (int k = 0; k < kw; k += 32) {
                const bf16x8 a0 = *(const bf16x8*)(ap + k), a1 = *(const bf16x8*)(ap + (size_t)16 * K + k);
                const bf16x8 b0 = *(const bf16x8*)(bp + k), b1 = *(const bf16x8*)(bp + (size_t)16 * K + k);
                acc[0][0] = MFMA16(b0, a0, acc[0][0]); acc[0][1] = MFMA16(b1, a0, acc[0][1]);
                acc[1][0] = MFMA16(b0, a1, acc[1][0]); acc[1][1] = MFMA16(b1, a1, acc[1][1]);
            }
#pragma unroll
            for (int i = 0; i < 2; ++i)
#pragma unroll
                for (int j = 0; j < 2; ++j) {
                    if (MODE) {
                        const u32x2 gw = *(const u32x2*)(h + (size_t)(MP + rt * 32 + i * 16 + fr) * HP + HGATE + seg * 1024 + ct * 32 + 8 * fq + 4 * j);
                        f32x4 sg; sg[0] = sigmoidf_(bflo(gw.x)); sg[1] = sigmoidf_(bfhi(gw.x)); sg[2] = sigmoidf_(bflo(gw.y)); sg[3] = sigmoidf_(bfhi(gw.y));
                        tot[i][j] += acc[i][j] * sg;
                    } else tot[i][j] = acc[i][j];
                }
        }
        __syncthreads();
#pragma unroll
        for (int i = 0; i < 2; ++i)
#pragma unroll
            for (int j = 0; j < 2; ++j) *(LAS f32x4*)(part + (w * 32 + i * 16 + fr) * 36 + 8 * fq + 4 * j) = tot[i][j];
        __syncthreads();
        const int row = tid >> 4, c2 = (tid & 15) * 2;
        float v0 = 0.f, v1 = 0.f;
#pragma unroll
        for (int ww = 0; ww < 8; ++ww) { v0 += part[(ww * 32 + row) * 36 + c2]; v1 += part[(ww * 32 + row) * 36 + c2 + 1]; }
        const int r = MP + rt * 32 + row, c = ct * 32 + c2;
        if (MODE) {
            *(unsigned*)((bf16_t*)(P->ws + WS_ST) + (size_t)r * DM + c) = pk2(v0, v1);
        } else {
            float* xp = P->out + (size_t)r * DM + c;
            const float x0 = xp[0] + scale * v0, x1 = xp[1] + scale * v1;
            xp[0] = x0; xp[1] = x1;
            *(unsigned*)((bf16_t*)(P->ws + WS_XB) + (size_t)r * DM + c) = pk2(x0, x1);
            float ss = x0 * x0 + x1 * x1;
            ss += shflx(ss, 1); ss += shflx(ss, 2); ss += shflx(ss, 4); ss += shflx(ss, 8);
            if ((tid & 15) == 0) {
                float* ssq = (float*)(P->ws + WS_SSQ);
                if (ct < 16) ssq[(size_t)r * 16 + ct] = ss; else ssq[(WS_SSQ2 - WS_SSQ) / 4 + (size_t)(r - MP) * 16 + (ct - 16)] = ss;
            }
        }
    }
}

struct CvtJob { const float* src; const float* gk; bf16_t* dst; int src_ld, dst_ld, k0, nsrc0, nvalid, rowbase, kind, which; };
__device__ __forceinline__ bool cvt_decode(KP P, int l, int part, int job, CvtJob& J) {
    constexpr int J_GU = 2 * 2 * 16 * 44, J_DN = 2 * 44 * 16, J_IN = 16 * 145, J_BR = 48 * 16, J_OUT = 16 * 16;
    int j = job; J.gk = nullptr; J.kind = 0; J.which = 0; J.nvalid = 64;
    if (j < J_GU) {
        const int nt = j % 44; j /= 44; const int kt = j % 16; j /= 16; const int which = j & 1, j2 = j >> 1;
        if (j2 != part) return false;
        J.src = P->in[which ? I_WU : I_WG] + (size_t)(l * 2 + j2) * 1024 * 2816; J.src_ld = 2816; J.k0 = kt * 64; J.nsrc0 = nt * 64;
        J.gk = P->in[I_FNORM] + (l * 2 + j2) * 1024; J.dst = (bf16_t*)(P->ws + (j2 ? W_GU1 : W_GU0)); J.dst_ld = 1024; J.rowbase = nt * 64; J.kind = 1; J.which = which;
        return true;
    }
    j -= J_GU;
    if (j < J_DN) {
        const int nt = j % 16; j /= 16; const int kt = j % 44; const int j2 = j / 44;
        if (j2 != part) return false;
        J.src = P->in[I_WD] + (size_t)(l * 2 + j2) * 2816 * 1024; J.src_ld = 1024; J.k0 = kt * 64; J.nsrc0 = nt * 64;
        J.dst = (bf16_t*)(P->ws + (j2 ? W_DN1 : W_DN0)); J.dst_ld = 2816; J.rowbase = nt * 64; J.kind = 2;
        return true;
    }
    j -= J_DN;
    if (j < J_IN) {
        if (part != 0) return false;
        const int nt = j % 145, kt = j / 145;
        J.src = P->in[I_WIN] + (size_t)l * 1024 * NIN; J.src_ld = NIN; J.k0 = kt * 64; J.nsrc0 = nt < 72 ? nt * 64 : (nt < 144 ? nt * 64 + 16 : 4608); J.nvalid = nt < 144 ? 64 : 16;
        J.gk = P->in[I_MNORM] + l * 1024; J.dst = (bf16_t*)(P->ws + W_IN); J.dst_ld = 1024; J.rowbase = nt * 64; J.kind = 2;
        return true;
    }
    j -= J_IN;
    if (j < J_BR) {
        if (part != 1) return false;
        const int nt = j % 16, kt = j / 16;
        J.src = P->in[I_WBR] + (size_t)l * 3072 * 1024; J.src_ld = 1024; J.k0 = kt * 64; J.nsrc0 = nt * 64; J.dst = (bf16_t*)(P->ws + W_BR); J.dst_ld = 3072; J.rowbase = nt * 64; J.kind = 2;
        return true;
    }
    j -= J_BR;
    if (j < J_OUT) {
        if (part != 1) return false;
        const int nt = j % 16, kt = j / 16;
        J.src = P->in[I_WOUT] + (size_t)l * 1024 * 1024; J.src_ld = 1024; J.k0 = kt * 64; J.nsrc0 = nt * 64; J.dst = (bf16_t*)(P->ws + W_OUT); J.dst_ld = 1024; J.rowbase = nt * 64; J.kind = 2;
        return true;
    }
    j -= J_OUT;
    if (part != 0) return false;
    const int blk = j & 15, which = j >> 4;
    J.src = P->in[which ? I_LWX : I_LWA] + (size_t)(l * 16 + blk) * 4096; J.src_ld = 64; J.k0 = 0; J.nsrc0 = 0;
    J.dst = (bf16_t*)(P->ws + (which ? W_LX : W_LA)) + (l & 1) * 65536 + blk * 4096; J.dst_ld = 64; J.rowbase = 0;
    return true;
}
__device__ __forceinline__ void cvt_load(const CvtJob& J, int tid, f32x4& v0, f32x4& v1, float& g0, float& g1) {
    const int kk = tid >> 4, n4 = (tid & 15) * 4;
    v0 = (f32x4){0.f, 0.f, 0.f, 0.f}; v1 = v0;
    if (n4 < J.nvalid) {
        v0 = __builtin_nontemporal_load((const f32x4*)(J.src + (size_t)(J.k0 + kk) * J.src_ld + J.nsrc0 + n4)); v1 = __builtin_nontemporal_load((const f32x4*)(J.src + (size_t)(J.k0 + kk + 32) * J.src_ld + J.nsrc0 + n4)); }
    g0 = J.gk ? J.gk[J.k0 + kk] : 1.0f; g1 = J.gk ? J.gk[J.k0 + kk + 32] : 1.0f;
}
__device__ __forceinline__ void convert_layer(int wv, KP P, int l, int part, int nb, LAS unsigned char* lds) {
    LAS float* tile = (LAS float*)lds;
    constexpr int J_TOT = 2 * 2 * 16 * 44 + 2 * 44 * 16 + 16 * 145 + 48 * 16 + 16 * 16 + 32;
    const int tid = tidx(wv), stride = nb;
    int job = bidx() < nb ? bidx() : J_TOT;
    CvtJob cur, nxt; bool have = false, hn = false;
    while (job < J_TOT && !have) { have = cvt_decode(P, l, part, job, cur); job += stride; }
    f32x4 v0, v1, n0, n1; float g0 = 1.f, g1 = 1.f, h0 = 1.f, h1 = 1.f;
    v0 = (f32x4){0.f, 0.f, 0.f, 0.f}; v1 = v0; n0 = v0; n1 = v0;
    if (have) cvt_load(cur, tid, v0, v1, g0, g1);
    __syncthreads();
    while (have) {
        hn = false;
        while (job < J_TOT && !hn) { hn = cvt_decode(P, l, part, job, nxt); job += stride; }
        if (hn) cvt_load(nxt, tid, n0, n1, h0, h1);
        {
            const int kk = tid >> 4, n4 = (tid & 15) * 4;
            tile[kk * 65 + n4 + 0] = v0[0] * g0; tile[kk * 65 + n4 + 1] = v0[1] * g0; tile[kk * 65 + n4 + 2] = v0[2] * g0; tile[kk * 65 + n4 + 3] = v0[3] * g0;
            tile[(kk + 32) * 65 + n4 + 0] = v1[0] * g1; tile[(kk + 32) * 65 + n4 + 1] = v1[1] * g1; tile[(kk + 32) * 65 + n4 + 2] = v1[2] * g1; tile[(kk + 32) * 65 + n4 + 3] = v1[3] * g1;
        }
        asm volatile("s_waitcnt lgkmcnt(0)\n\ts_barrier" ::: "memory");
        {
            const int nl = tid >> 3, k8 = (tid & 7) * 8;
            if (nl < cur.nvalid) {
                u32x4 w;
                w.x = pk2(tile[(k8 + 0) * 65 + nl], tile[(k8 + 1) * 65 + nl]); w.y = pk2(tile[(k8 + 2) * 65 + nl], tile[(k8 + 3) * 65 + nl]);
                w.z = pk2(tile[(k8 + 4) * 65 + nl], tile[(k8 + 5) * 65 + nl]); w.w = pk2(tile[(k8 + 6) * 65 + nl], tile[(k8 + 7) * 65 + nl]);
                int row = cur.rowbase + nl;
                if (cur.kind == 1) { const int hc = row; row = 256 * (hc >> 7) + 128 * ((hc >> 2) & 1) + 32 * ((hc >> 5) & 3) + 16 * cur.which + 4 * ((hc >> 3) & 3) + (hc & 3); }
                else if (cur.kind == 2) { const int c = row; row = (c & ~31) + 16 * ((c >> 2) & 1) + 4 * ((c >> 3) & 3) + (c & 3); }
                *(u32x4*)(cur.dst + (size_t)row * cur.dst_ld + cur.k0 + k8) = w;
            }
        }
        asm volatile("s_waitcnt lgkmcnt(0)\n\ts_barrier" ::: "memory");
        cur = nxt; v0 = n0; v1 = n1; g0 = h0; g1 = h1; have = hn;
    }
    __syncthreads();
}

__device__ __forceinline__ void phase_init(int wv, KP P) {
    const int w = tidx(wv) >> 6, lane = tidx(wv) & 63;
    float* x = P->out; bf16_t* xb = (bf16_t*)(P->ws + WS_XB); float* ssq = (float*)(P->ws + WS_SSQ);
    for (int row = bidx() * 8 + w; row < MT; row += gdim() * 8) {
        const float* src = row < MP ? P->in[I_XP] + (size_t)row * DM : P->in[I_XS] + (size_t)(row - MP) * DM;
        float ss = 0.f;
        f32x4 vv[4];
#pragma unroll
        for (int i = 0; i < 4; ++i) vv[i] = __builtin_nontemporal_load((const f32x4*)(src + (i * 64 + lane) * 4));
#pragma unroll
        for (int i = 0; i < 4; ++i) {
            const int c = (i * 64 + lane) * 4;
            const f32x4 v = vv[i];
            *(f32x4*)(x + (size_t)row * DM + c) = v;
            u32x2 pw; pw.x = pk2(v[0], v[1]); pw.y = pk2(v[2], v[3]);
            *(u32x2*)(xb + (size_t)row * DM + c) = pw;
            ss += v[0] * v[0] + v[1] * v[1] + v[2] * v[2] + v[3] * v[3];
        }
#pragma unroll
        for (int d = 32; d >= 1; d >>= 1) ss += shflx(ss, d);
        if (lane < 16) ssq[(size_t)row * 16 + lane] = lane == 0 ? ss : 0.f;
        if (row >= MP && lane < 16) ssq[(WS_SSQ2 - WS_SSQ) / 4 + (size_t)(row - MP) * 16 + lane] = 0.f;
    }
}
__device__ __forceinline__ void phase_final(int wv, KP P) {
    const int w = tidx(wv) >> 6, lane = tidx(wv) & 63;
    float* x = P->out; const float* ssq = (const float*)(P->ws + WS_SSQ); const float* gf = P->in[I_FINAL];
    for (int row = bidx() * 8 + w; row < MT; row += gdim() * 8) {
        const float rs = rstd_row(ssq, row);
        f32x4 vv[4], gg[4];
#pragma unroll
        for (int i = 0; i < 4; ++i) { const int c = (i * 64 + lane) * 4; vv[i] = *(const f32x4*)(x + (size_t)row * DM + c); gg[i] = *(const f32x4*)(gf + c); }
#pragma unroll
        for (int i = 0; i < 4; ++i) { const int c = (i * 64 + lane) * 4; *(f32x4*)(x + (size_t)row * DM + c) = vv[i] * rs * gg[i]; }
    }
}

struct Item { int row0, L, b, c, sb, sample; };
__device__ __forceinline__ Item get_item(int it) {
    Item I;
    if (it < 256) { I.b = it >> 7; I.c = it & 127; I.row0 = I.b * 8192 + I.c * 64; I.L = 64; I.sample = 0; I.sb = 0; }
    else { I.sb = it - 256; I.b = 0; I.c = 0; I.row0 = MP + I.sb * 16; I.L = 16; I.sample = 1; }
    return I;
}

__device__ __forceinline__ void copy_conv_states(const bf16_t* h, int row_first, float* out_lc, float* out_sc, int tid) {
    u32x4 w4[2]; bool ok[2];
#pragma unroll
    for (int it = 0; it < 2; ++it) {
        const int q = tid + 512 * it; ok[it] = q < 960;
        const int j = q / 320, c8 = (q % 320) * 8;
        w4[it] = (u32x4){0u, 0u, 0u, 0u};
        if (ok[it]) w4[it] = *(const u32x4*)(h + (size_t)(row_first + j) * HP + (c8 < 1024 ? HX + c8 : HXBC + c8 - 1024));
    }
#pragma unroll
    for (int it = 0; it < 2; ++it) {
        const int q = tid + 512 * it;
        const int j = q / 320, c8 = (q % 320) * 8;
        if (ok[it]) {
            float* op = c8 < 1024 ? out_lc + j * 1024 + c8 : out_sc + j * 1536 + (c8 - 1024);
            *(f32x4*)op = (f32x4){bflo(w4[it].x), bfhi(w4[it].x), bflo(w4[it].y), bfhi(w4[it].y)};
            *(f32x4*)(op + 4) = (f32x4){bflo(w4[it].z), bfhi(w4[it].z), bflo(w4[it].w), bfhi(w4[it].w)};
        }
    }
}
__device__ __forceinline__ void copy_states_item(int wv, KP P, int l, const Item& I) {
    const bf16_t* h = (const bf16_t*)(P->ws + WS_H);
    const int tid = tidx(wv);
    if (!I.sample) {
        if (I.c >= 126) {
            {
                const int cc = (tid & 63) * 8, kv = cc >> 8, e = cc & 255;
                u32x4 w4[8];
#pragma unroll
                for (int q = 0; q < 8; ++q) w4[q] = *(const u32x4*)(h + (size_t)(I.row0 + (tid >> 6) + 8 * q) * HP + (kv ? HV : HK) + e);
#pragma unroll
                for (int q = 0; q < 8; ++q) {
                    const int t = (tid >> 6) + 8 * q;
                    float* op = P->out + (kv ? O_PV : O_PK) + ((size_t)(l * 2 + I.b) * 128 + (I.c - 126) * 64 + t) * 256 + e;
                    *(f32x4*)op = (f32x4){bflo(w4[q].x), bfhi(w4[q].x), bflo(w4[q].y), bfhi(w4[q].y)};
                    *(f32x4*)(op + 4) = (f32x4){bflo(w4[q].z), bfhi(w4[q].z), bflo(w4[q].w), bfhi(w4[q].w)};
                }
            }
        }
        if (I.c == 127) copy_conv_states(h, I.row0 + 61, P->out + O_PLC + (size_t)(l * 2 + I.b) * 3 * 1024, P->out + O_PSC + (size_t)(l * 2 + I.b) * 3 * 1536, tid);
    } else {
        {
            const int cc = (tid & 63) * 8, kv = cc >> 8, e = cc & 255;
            const float* cin = P->in[kv ? I_CV : I_CK] + ((size_t)(l * 16 + I.sb) * 128 + 16) * 256 + e;
            float* cout = P->out + (kv ? O_SV : O_SK) + ((size_t)(l * 16 + I.sb) * 128) * 256 + e;
#pragma unroll 1
            for (int qb = 0; qb < 14; qb += 7) {
                f32x4 a[7], b[7];
#pragma unroll
                for (int q = 0; q < 7; ++q) { const int j = (tid >> 6) + 8 * (qb + q); a[q] = __builtin_nontemporal_load((const f32x4*)(cin + (size_t)j * 256)); b[q] = __builtin_nontemporal_load((const f32x4*)(cin + (size_t)j * 256 + 4)); }
#pragma unroll
                for (int q = 0; q < 7; ++q) { const int j = (tid >> 6) + 8 * (qb + q); *(f32x4*)(cout + (size_t)j * 256) = a[q]; *(f32x4*)(cout + (size_t)j * 256 + 4) = b[q]; }
            }
            u32x4 w4[2];
#pragma unroll
            for (int q = 0; q < 2; ++q) w4[q] = *(const u32x4*)(h + (size_t)(I.row0 + (tid >> 6) + 8 * q) * HP + (kv ? HV : HK) + e);
#pragma unroll
            for (int q = 0; q < 2; ++q) {
                float* op = cout + (size_t)(112 + (tid >> 6) + 8 * q) * 256;
                *(f32x4*)op = (f32x4){bflo(w4[q].x), bfhi(w4[q].x), bflo(w4[q].y), bfhi(w4[q].y)};
                *(f32x4*)(op + 4) = (f32x4){bflo(w4[q].z), bfhi(w4[q].z), bflo(w4[q].w), bfhi(w4[q].w)};
            }
        }
        copy_conv_states(h, I.row0 + 13, P->out + O_SLC + (size_t)(l * 16 + I.sb) * 3 * 1024, P->out + O_SSC + (size_t)(l * 16 + I.sb) * 3 * 1536, tid);
    }
}

template <int L>
__device__ __forceinline__ void attn_item(int wv, KP P, int l, const Item& I, LAS unsigned char* lds) {
    constexpr int NS = (L == 64) ? 192 : 160;
    constexpr int NST = NS / 16, NKS = NS / 32, NQT = L / 16;
    const bf16_t* h = (const bf16_t*)(P->ws + WS_H);
    bf16_t* yabc = (bf16_t*)(P->ws + WS_Y);
    const int tid = tidx(wv), w = tid >> 6, lane = tid & 63, fr = lane & 15, fq = lane >> 4;
    LAS bf16_t* Kl = (LAS bf16_t*)lds;
    LAS bf16_t* Vt = Kl + 2 * 192 * 72;
    for (int pass = 0; pass < 2; ++pass) {
        __syncthreads();
        for (int idx = tid; idx < 2 * NS * 8; idx += 512) {
            const int dp = idx & 7, s = (idx >> 3) % NS, kvl = idx / (8 * NS), kvh = pass * 2 + kvl;
            u32x4 kw = (u32x4){0u, 0u, 0u, 0u}, vw = (u32x4){0u, 0u, 0u, 0u};
            if (L == 64) {
                const int pos = (I.c - 2) * 64 + s;
                if (pos >= 0) {
                    const bf16_t* rp = h + (size_t)(I.b * 8192 + pos) * HP + kvh * 64 + dp * 8;
                    kw = *(const u32x4*)(rp + HK); vw = *(const u32x4*)(rp + HV);
                }
            } else {
                if (s < 128) {
                    const size_t o = ((size_t)(l * 16 + I.sb) * 128 + s) * 256 + kvh * 64 + dp * 8;
                    const f32x4 k0 = *(const f32x4*)(P->in[I_CK] + o), k1 = *(const f32x4*)(P->in[I_CK] + o + 4);
                    const f32x4 v0 = *(const f32x4*)(P->in[I_CV] + o), v1 = *(const f32x4*)(P->in[I_CV] + o + 4);
                    kw.x = pk2(k0[0], k0[1]); kw.y = pk2(k0[2], k0[3]); kw.z = pk2(k1[0], k1[1]); kw.w = pk2(k1[2], k1[3]);
                    vw.x = pk2(v0[0], v0[1]); vw.y = pk2(v0[2], v0[3]); vw.z = pk2(v1[0], v1[1]); vw.w = pk2(v1[2], v1[3]);
                } else if (s < 144) {
                    const bf16_t* rp = h + (size_t)(I.row0 + s - 128) * HP + kvh * 64 + dp * 8;
                    kw = *(const u32x4*)(rp + HK); vw = *(const u32x4*)(rp + HV);
                }
            }
            *(LAS u32x4*)(Kl + (kvl * 192 + s) * 72 + dp * 8) = kw;
            LAS bf16_t* vp = Vt + (kvl * 64 + dp * 8) * 200 + s;
            vp[0 * 200] = (bf16_t)(vw.x & 0xffffu); vp[1 * 200] = (bf16_t)(vw.x >> 16); vp[2 * 200] = (bf16_t)(vw.y & 0xffffu); vp[3 * 200] = (bf16_t)(vw.y >> 16);
            vp[4 * 200] = (bf16_t)(vw.z & 0xffffu); vp[5 * 200] = (bf16_t)(vw.z >> 16); vp[6 * 200] = (bf16_t)(vw.w & 0xffffu); vp[7 * 200] = (bf16_t)(vw.w >> 16);
        }
        __syncthreads();
        const int head = pass * 8 + w, kvl = w >> 2;
        const float slope = exp2f(-0.5f * (float)(head + 1));
        const float sink = P->in[I_SINK][l * 16 + head];
        const bf16_t* qbase = h + (size_t)(I.row0 + fr) * HP + HQ + head * 64 + fq * 8;
        bf16x8 q0 = *(const bf16x8*)qbase, q1 = *(const bf16x8*)(qbase + 32);
#pragma unroll 1
        for (int qt = 0; qt < NQT; ++qt) {
            bf16x8 nq0 = q0, nq1 = q1;
            if (qt + 1 < NQT) { const bf16_t* qp = qbase + (size_t)(qt + 1) * 16 * HP; nq0 = *(const bf16x8*)qp; nq1 = *(const bf16x8*)(qp + 32); }
            f32x4 st[NST];
#pragma unroll
            for (int t = 0; t < NST; ++t) {
                const LAS bf16_t* kp = Kl + (kvl * 192 + t * 16 + fr) * 72 + fq * 8;
                f32x4 a = (f32x4){0.f, 0.f, 0.f, 0.f};
                a = MFMA16(*(const LAS bf16x8*)kp, q0, a);
                a = MFMA16(*(const LAS bf16x8*)(kp + 32), q1, a);
                st[t] = a;
                if ((t % 6) == 5) __builtin_amdgcn_sched_barrier(0);
            }
            const int qpos = (L == 64) ? (I.c * 64 + qt * 16 + fr) : (4096 + fr);
            float mx = sink;
#pragma unroll
            for (int t = 0; t < NST; ++t)
#pragma unroll
                for (int jj = 0; jj < 4; ++jj) {
                    const int s = t * 16 + fq * 4 + jj;
                    const int kpos = (L == 64) ? ((I.c - 2) * 64 + s) : (3968 + s);
                    const bool vis = (L == 64) ? (kpos >= 0) : (s < 144);
                    const float d = fabsf((float)(qpos - kpos));
                    const float sc = vis ? (st[t][jj] * 0.125f - slope * d) : -INFINITY;
                    st[t][jj] = sc; mx = fmaxf(mx, sc);
                }
            mx = fmaxf(mx, shflx(mx, 16)); mx = fmaxf(mx, shflx(mx, 32));
            float sum = 0.f;
#pragma unroll
            for (int t = 0; t < NST; ++t)
#pragma unroll
                for (int jj = 0; jj < 4; ++jj) { const float p = __expf(st[t][jj] - mx); st[t][jj] = p; sum += p; }
            sum += shflx(sum, 16); sum += shflx(sum, 32);
            const float inv = 1.0f / (sum + __expf(sink - mx));
            f32x4 o[4];
#pragma unroll
            for (int dt = 0; dt < 4; ++dt) o[dt] = (f32x4){0.f, 0.f, 0.f, 0.f};
#pragma unroll
            for (int ks = 0; ks < NKS; ++ks) {
                u32x4 pw; pw.x = pk2(st[2 * ks][0], st[2 * ks][1]); pw.y = pk2(st[2 * ks][2], st[2 * ks][3]);
                pw.z = pk2(st[2 * ks + 1][0], st[2 * ks + 1][1]); pw.w = pk2(st[2 * ks + 1][2], st[2 * ks + 1][3]);
                bf16x8 pf; __builtin_memcpy(&pf, &pw, 16);
#pragma unroll
                for (int dt = 0; dt < 4; ++dt) {
                    const LAS bf16_t* vp = Vt + (kvl * 64 + dt * 16 + fr) * 200 + ks * 32 + fq * 4;
                    const u32x2 va = *(const LAS u32x2*)vp, vb = *(const LAS u32x2*)(vp + 16);
                    u32x4 vw; vw.x = va.x; vw.y = va.y; vw.z = vb.x; vw.w = vb.y;
                    bf16x8 vf; __builtin_memcpy(&vf, &vw, 16);
                    o[dt] = MFMA16(vf, pf, o[dt]);
                }
            }
            bf16_t* op = yabc + (size_t)(I.row0 + qt * 16 + fr) * 3072 + 2048 + head * 64 + fq * 4;
#pragma unroll
            for (int dt = 0; dt < 4; ++dt) {
                u32x2 ow; ow.x = pk2(o[dt][0] * inv, o[dt][1] * inv); ow.y = pk2(o[dt][2] * inv, o[dt][3] * inv);
                *(u32x2*)(op + dt * 16) = ow;
            }
            q0 = nq0; q1 = nq1;
        }
    }
}

template <int CTRL> __device__ __forceinline__ float dpp_f(float old, float src) {
    return __int_as_float(__builtin_amdgcn_update_dpp(__float_as_int(old), __float_as_int(src), CTRL, 0xf, 0xf, false));
}
template <int L, bool FINAL>
__device__ __forceinline__ void lru_item(int wv, KP P, int l, int item, const Item& I, LAS unsigned char* lds) {
    constexpr int NIT = L / 16, XP = 1032;
    const bf16_t* h = (const bf16_t*)(P->ws + WS_H);
    bf16_t* yabc = (bf16_t*)(P->ws + WS_Y);
    float* lruA = (float*)(P->ws + WS_LRUA); float* lruU = (float*)(P->ws + WS_LRUU);
    const int tid = tidx(wv), w = tid >> 6, lane = tid & 63, fr = lane & 15, fq = lane >> 4;
    LAS bf16_t* xa = (LAS bf16_t*)lds;
    __syncthreads();
    {
        const int ch = 2 * tid;
        const float* cw = P->in[I_LCW] + (size_t)l * 4 * 1024 + ch;
        const f32x2_t w0 = *(const f32x2_t*)cw, w1 = *(const f32x2_t*)(cw + 1024), w2 = *(const f32x2_t*)(cw + 2048), w3 = *(const f32x2_t*)(cw + 3072);
        const f32x2_t cb = *(const f32x2_t*)(P->in[I_LCB] + l * 1024 + ch);
        f32x2_t xm3 = {0.f, 0.f}, xm2 = {0.f, 0.f}, xm1 = {0.f, 0.f};
        if (I.sample) { const float* st = P->in[I_SLC] + (size_t)(l * 16 + I.sb) * 3 * 1024 + ch; xm3 = *(const f32x2_t*)st; xm2 = *(const f32x2_t*)(st + 1024); xm1 = *(const f32x2_t*)(st + 2048); }
        else if (I.c > 0) { const bf16_t* hq = h + (size_t)(I.row0 - 3) * HP + HX + ch;
            const unsigned a0 = *(const unsigned*)hq, a1 = *(const unsigned*)(hq + HP), a2 = *(const unsigned*)(hq + 2 * (size_t)HP);
            xm3 = (f32x2_t){bflo(a0), bfhi(a0)}; xm2 = (f32x2_t){bflo(a1), bfhi(a1)}; xm1 = (f32x2_t){bflo(a2), bfhi(a2)}; }
        const bf16_t* hp = h + (size_t)I.row0 * HP + HX + ch;
#pragma unroll 8
        for (int t = 0; t < L; ++t) {
            const unsigned xw = *(const unsigned*)(hp + (size_t)t * HP);
            const f32x2_t x0 = {bflo(xw), bfhi(xw)};
            const f32x2_t y = cb + w0 * xm3 + w1 * xm2 + w2 * xm1 + w3 * x0;
            *(LAS unsigned*)(xa + t * XP + ch) = pk2(y[0], y[1]);
            xm3 = xm2; xm2 = xm1; xm1 = x0;
        }
    }
    __syncthreads();
#pragma unroll 1
    for (int pass = 0; pass < 2; ++pass) {
        const int blk = w + 8 * pass, ch0 = blk * 64;
        const bf16_t* waT = (const bf16_t*)(P->ws + W_LA) + (l & 1) * 65536 + blk * 4096;
        const bf16_t* wxT = (const bf16_t*)(P->ws + W_LX) + (l & 1) * 65536 + blk * 4096;
        float carryH[4][4], carryA[4][4], c8v[4][4];
#pragma unroll
        for (int jt = 0; jt < 4; ++jt)
#pragma unroll
            for (int jj = 0; jj < 4; ++jj) {
                const int ch = ch0 + jt * 16 + fq * 4 + jj;
                carryA[jt][jj] = 1.0f;
                c8v[jt][jj] = 8.0f * softplusf_(-P->in[I_LLAM][l * 1024 + ch]);
                if (FINAL) carryH[jt][jj] = I.sample ? P->in[I_SLH][(l * 16 + I.sb) * 1024 + ch] : lruU[(size_t)item * 1024 + ch];
                else carryH[jt][jj] = 0.f;
            }
        bf16x8 waf[4][2], wxf[4][2]; f32x4 bavv[4], bxvv[4];
#pragma unroll
        for (int jt = 0; jt < 4; ++jt) {
            const bf16_t* wa = waT + (jt * 16 + fr) * 64 + fq * 8; const bf16_t* wx = wxT + (jt * 16 + fr) * 64 + fq * 8;
            waf[jt][0] = *(const bf16x8*)wa; waf[jt][1] = *(const bf16x8*)(wa + 32); wxf[jt][0] = *(const bf16x8*)wx; wxf[jt][1] = *(const bf16x8*)(wx + 32);
            bavv[jt] = *(const f32x4*)(P->in[I_LBA] + l * 1024 + ch0 + jt * 16 + fq * 4); bxvv[jt] = *(const f32x4*)(P->in[I_LBX] + l * 1024 + ch0 + jt * 16 + fq * 4);
        }
#pragma unroll 1
        for (int it = 0; it < NIT; ++it) {
            const LAS bf16_t* xp = xa + (it * 16 + fr) * XP + ch0;
            const bf16x8 b0 = *(const LAS bf16x8*)(xp + fq * 8), b1 = *(const LAS bf16x8*)(xp + 32 + fq * 8);
            const int token = it * 16 + fr;
#pragma unroll
            for (int jt = 0; jt < 4; ++jt) {
                f32x4 ra = (f32x4){0.f, 0.f, 0.f, 0.f}, ia = (f32x4){0.f, 0.f, 0.f, 0.f};
                ra = MFMA16(waf[jt][0], b0, ra); ra = MFMA16(waf[jt][1], b1, ra);
                ia = MFMA16(wxf[jt][0], b0, ia); ia = MFMA16(wxf[jt][1], b1, ia);
                const u32x2 xw = *(const LAS u32x2*)(xp + jt * 16 + fq * 4);
                const float xv[4] = {bflo(xw.x), bfhi(xw.x), bflo(xw.y), bfhi(xw.y)};
                const f32x4 bav = bavv[jt], bxv = bxvv[jt];
                float hv[4], av[4];
#pragma unroll
                for (int jj = 0; jj < 4; ++jj) {
                    const float r = sigmoidf_(ra[jj] + bav[jj]);
                    const float ig = sigmoidf_(ia[jj] + bxv[jj]);
                    const float la = -c8v[jt][jj] * r;
                    float a = __expf(la);
                    float u = __builtin_amdgcn_sqrtf(fmaxf(1.0f - a * a, 0.f)) * ig * xv[jj];
                    { const float ap = dpp_f<0x111>(1.0f, a), up = dpp_f<0x111>(0.0f, u); u = a * up + u; a = a * ap; }
                    { const float ap = dpp_f<0x112>(1.0f, a), up = dpp_f<0x112>(0.0f, u); u = a * up + u; a = a * ap; }
                    { const float ap = dpp_f<0x114>(1.0f, a), up = dpp_f<0x114>(0.0f, u); u = a * up + u; a = a * ap; }
                    { const float ap = dpp_f<0x118>(1.0f, a), up = dpp_f<0x118>(0.0f, u); u = a * up + u; a = a * ap; }
                    const float hval = a * carryH[jt][jj] + u;
                    hv[jj] = hval;
                    carryH[jt][jj] = shfl_row15(hval);
                    if (!FINAL) { const float at = carryA[jt][jj] * a; av[jj] = at; carryA[jt][jj] = shfl_row15(at); }
                }
                if (!FINAL) {
                    u32x2 ow; ow.x = pk2(hv[0], hv[1]); ow.y = pk2(hv[2], hv[3]);
                    *(u32x2*)(yabc + (size_t)(I.row0 + token) * 3072 + ch0 + jt * 16 + fq * 4) = ow;
                    u32x2 aw; aw.x = pk2(av[0], av[1]); aw.y = pk2(av[2], av[3]);
                    *(u32x2*)((bf16_t*)(P->ws + WS_XB) + (size_t)(I.row0 + token) * DM + ch0 + jt * 16 + fq * 4) = aw;
                }
                if (FINAL) {
                    const u32x2 gw = *(const u32x2*)(h + (size_t)(I.row0 + token) * HP + HG + ch0 + jt * 16 + fq * 4);
                    u32x2 ow; ow.x = pk2(hv[0] * gelu_tanh(bflo(gw.x)), hv[1] * gelu_tanh(bfhi(gw.x)));
                    ow.y = pk2(hv[2] * gelu_tanh(bflo(gw.y)), hv[3] * gelu_tanh(bfhi(gw.y)));
                    *(u32x2*)(yabc + (size_t)(I.row0 + token) * 3072 + ch0 + jt * 16 + fq * 4) = ow;
                    if (it == NIT - 1 && fr == 15) {
                        if (I.sample) *(f32x4*)(P->out + O_SLH + (size_t)(l * 16 + I.sb) * 1024 + ch0 + jt * 16 + fq * 4) = (f32x4){hv[0], hv[1], hv[2], hv[3]};
                        else if (I.c == 127) *(f32x4*)(P->out + O_PLH + (size_t)(l * 2 + I.b) * 1024 + ch0 + jt * 16 + fq * 4) = (f32x4){hv[0], hv[1], hv[2], hv[3]};
                    }
                }
            }
        }
        if (!FINAL) {
            if (fr == 0) {
#pragma unroll
                for (int jt = 0; jt < 4; ++jt) {
                    *(f32x4*)(lruA + (size_t)item * 1024 + ch0 + jt * 16 + fq * 4) = (f32x4){carryA[jt][0], carryA[jt][1], carryA[jt][2], carryA[jt][3]};
                    *(f32x4*)(lruU + (size_t)item * 1024 + ch0 + jt * 16 + fq * 4) = (f32x4){carryH[jt][0], carryH[jt][1], carryH[jt][2], carryH[jt][3]};
                }
            }
        }
    }
}

__device__ __forceinline__ void lru_apply_item(int wv, KP P, int l, int item, const Item& I) {
    const bf16_t* h = (const bf16_t*)(P->ws + WS_H);
    bf16_t* yabc = (bf16_t*)(P->ws + WS_Y);
    const bf16_t* acum = (const bf16_t*)(P->ws + WS_XB);
    const float* carry = (const float*)(P->ws + WS_LRUU) + (size_t)item * 1024;
    const int tid = tidx(wv);
    const int c8 = (tid & 127) * 8;
    const f32x4 ca = *(const f32x4*)(carry + c8), cb = *(const f32x4*)(carry + c8 + 4);
    const float cv[8] = {ca[0], ca[1], ca[2], ca[3], cb[0], cb[1], cb[2], cb[3]};
#pragma unroll 1
    for (int tb = 0; tb < 4; ++tb) {
        u32x4 aw4[4], hw4[4], gw4[4];
#pragma unroll
        for (int q = 0; q < 4; ++q) {
            const size_t r = (size_t)(I.row0 + (tid >> 7) + 4 * (tb * 4 + q));
            aw4[q] = *(const u32x4*)(acum + r * DM + c8); hw4[q] = *(const u32x4*)(yabc + r * 3072 + c8); gw4[q] = *(const u32x4*)(h + r * HP + HG + c8);
        }
#pragma unroll
        for (int q = 0; q < 4; ++q) {
            const int t = (tid >> 7) + 4 * (tb * 4 + q);
            const size_t r = (size_t)(I.row0 + t);
            const unsigned au[4] = {aw4[q].x, aw4[q].y, aw4[q].z, aw4[q].w}, hu[4] = {hw4[q].x, hw4[q].y, hw4[q].z, hw4[q].w}, gu[4] = {gw4[q].x, gw4[q].y, gw4[q].z, gw4[q].w};
            float hv[8]; unsigned ou[4];
#pragma unroll
            for (int e = 0; e < 4; ++e) {
                hv[2 * e] = bflo(au[e]) * cv[2 * e] + bflo(hu[e]); hv[2 * e + 1] = bfhi(au[e]) * cv[2 * e + 1] + bfhi(hu[e]);
                ou[e] = pk2(hv[2 * e] * gelu_tanh(bflo(gu[e])), hv[2 * e + 1] * gelu_tanh(bfhi(gu[e])));
            }
            *(u32x4*)(yabc + r * 3072 + c8) = (u32x4){ou[0], ou[1], ou[2], ou[3]};
            if (I.c == 127 && t == 63) {
                float* op = P->out + O_PLH + (size_t)(l * 2 + I.b) * 1024 + c8;
                *(f32x4*)op = (f32x4){hv[0], hv[1], hv[2], hv[3]}; *(f32x4*)(op + 4) = (f32x4){hv[4], hv[5], hv[6], hv[7]};
            }
        }
    }
}

#define SW72(row, t) ((row) * 72 + (((((t) >> 3) ^ (((row) >> 3) & 7))) << 3) + ((t) & 7))
__device__ __forceinline__ float pre_xbc(KP P, const bf16_t* h, int l, const Item& I, int tt, int ch) {
    if (tt >= 0 || (!I.sample && I.c > 0)) return bf2f(h[(size_t)(I.row0 + tt) * HP + HXBC + ch]);
    if (I.sample) return P->in[I_SSC][((size_t)(l * 16 + I.sb) * 3 + (3 + tt)) * 1536 + ch];
    return 0.f;
}
__device__ __forceinline__ float conv_xbc(KP P, const bf16_t* h, int l, const Item& I, int t, int ch) {
    const float* cw = P->in[I_SCW] + (size_t)l * 4 * 1536 + ch;
    float y = P->in[I_SCB][l * 1536 + ch];
    y += cw[0] * pre_xbc(P, h, l, I, t - 3, ch); y += cw[1536] * pre_xbc(P, h, l, I, t - 2, ch);
    y += cw[3072] * pre_xbc(P, h, l, I, t - 1, ch); y += cw[4608] * pre_xbc(P, h, l, I, t, ch);
    return siluf_(y);
}
template <class F>
__device__ __forceinline__ void conv_roll(KP P, const bf16_t* h, int l, const Item& I, int chx, int t0, int t1, F f) {
    const float* cw = P->in[I_SCW] + (size_t)l * 4 * 1536 + chx;
    const float w0 = cw[0], w1 = cw[1536], w2 = cw[3072], w3 = cw[4608], cb = P->in[I_SCB][l * 1536 + chx];
    float xm3 = pre_xbc(P, h, l, I, t0 - 3, chx), xm2 = pre_xbc(P, h, l, I, t0 - 2, chx), xm1 = pre_xbc(P, h, l, I, t0 - 1, chx);
    const bf16_t* hp = h + (size_t)I.row0 * HP + HXBC + chx;
#pragma unroll 8
    for (int t = t0; t < t1; ++t) {
        const float x0 = bf2f(hp[(size_t)t * HP]);
        const float y = cb + w0 * xm3 + w1 * xm2 + w2 * xm1 + w3 * x0;
        f(t, siluf_(y));
        xm3 = xm2; xm2 = xm1; xm1 = x0;
    }
}
template <int L, int NCH8, class CF, class F>
__device__ __forceinline__ void ssd_stage(KP P, const bf16_t* h, int l, const Item& I, int tid, CF chx_of, F f) {
    constexpr int NSEG = 512 / NCH8, TS = L / NSEG;
    static_assert(TS >= 1 && TS * NSEG == L, "segmenting");
    const int c8 = tid % NCH8, sg = tid / NCH8, t0 = sg * TS, chx = chx_of(c8);
    u32x4 xr[TS + 3];
#pragma unroll
    for (int q = 0; q < TS + 3; ++q) {
        const int tt = t0 - 3 + q;
        if (tt >= 0 || (!I.sample && I.c > 0)) {
            xr[q] = *(const u32x4*)((const char*)h + ((unsigned)(I.row0 + tt) * (unsigned)HP + (unsigned)(HXBC + chx)) * 2u);
        } else if (I.sample) {
            const float* st = P->in[I_SSC] + ((size_t)(l * 16 + I.sb) * 3 + (3 + tt)) * 1536 + chx;
            const f32x4 a = *(const f32x4*)st, b = *(const f32x4*)(st + 4);
            xr[q] = (u32x4){pk2(a[0], a[1]), pk2(a[2], a[3]), pk2(b[0], b[1]), pk2(b[2], b[3])};
        } else xr[q] = (u32x4){0u, 0u, 0u, 0u};
    }
    const float* cw = P->in[I_SCW] + (size_t)l * 4 * 1536 + chx;
    float wt[4][8], cb[8];
#pragma unroll
    for (int j = 0; j < 4; ++j) { const f32x4 a = *(const f32x4*)(cw + j * 1536), b = *(const f32x4*)(cw + j * 1536 + 4);
        wt[j][0] = a[0]; wt[j][1] = a[1]; wt[j][2] = a[2]; wt[j][3] = a[3]; wt[j][4] = b[0]; wt[j][5] = b[1]; wt[j][6] = b[2]; wt[j][7] = b[3]; }
    { const f32x4 a = *(const f32x4*)(P->in[I_SCB] + l * 1536 + chx), b = *(const f32x4*)(P->in[I_SCB] + l * 1536 + chx + 4);
        cb[0] = a[0]; cb[1] = a[1]; cb[2] = a[2]; cb[3] = a[3]; cb[4] = b[0]; cb[5] = b[1]; cb[6] = b[2]; cb[7] = b[3]; }
#pragma unroll
    for (int q = 0; q < TS; ++q) {
        float v[8];
#pragma unroll
        for (int e2 = 0; e2 < 4; ++e2) {
            const unsigned r0 = xr[q][e2], r1 = xr[q + 1][e2], r2 = xr[q + 2][e2], r3 = xr[q + 3][e2];
            v[2 * e2] = siluf_(cb[2 * e2] + wt[0][2 * e2] * bflo(r0) + wt[1][2 * e2] * bflo(r1) + wt[2][2 * e2] * bflo(r2) + wt[3][2 * e2] * bflo(r3));
            v[2 * e2 + 1] = siluf_(cb[2 * e2 + 1] + wt[0][2 * e2 + 1] * bfhi(r0) + wt[1][2 * e2 + 1] * bfhi(r1) + wt[2][2 * e2 + 1] * bfhi(r2) + wt[3][2 * e2 + 1] * bfhi(r3));
        }
        f(t0 + q, c8, v);
    }
}
template <int L>
__device__ __forceinline__ void ssd_dtcum(int wv, KP P, int l, const Item& I, LAS float* dtv, LAS float* cumv) {
    const float* dtraw = (const float*)(P->ws + WS_DT);
    const int tid = tidx(wv);
    __syncthreads();
    for (int idx = tid; idx < L * 16; idx += 512) { const int hd = idx & 15; dtv[idx] = softplusf_(dtraw[(size_t)I.row0 * 16 + idx] + P->in[I_SDTB][l * 16 + hd]); }
    __syncthreads();
    if (tid < 64) {
        constexpr int SEG = L / 4;
        const int hd = tid & 15, sg = tid >> 4;
        const float A = -__expf(P->in[I_SALOG][l * 16 + hd]);
        float c = 0.f;
#pragma unroll
        for (int t = 0; t < SEG; ++t) { c += dtv[(sg * SEG + t) * 16 + hd] * A; cumv[(sg * SEG + t) * 16 + hd] = c; }
        const float t1 = shfl_idx(c, hd), t2 = shfl_idx(c, 16 + hd), t3 = shfl_idx(c, 32 + hd);
        const float off = sg == 0 ? 0.f : (sg == 1 ? t1 : (sg == 2 ? t1 + t2 : t1 + t2 + t3));
#pragma unroll
        for (int t = 0; t < SEG; ++t) cumv[(sg * SEG + t) * 16 + hd] += off;
    }
    __syncthreads();
}

template <int L>
__device__ __forceinline__ void ssd_states_item(int wv, KP P, int l, int item, const Item& I, LAS unsigned char* lds) {
    constexpr int LP = L < 32 ? 32 : L, KS = LP / 32;
    const bf16_t* h = (const bf16_t*)(P->ws + WS_H);
    bf16_t* states = (bf16_t*)(P->ws + WS_ST);
    float* cdec = (float*)(P->ws + WS_CDEC);
    const int tid = tidx(wv), w = tid >> 6, lane = tid & 63, fr = lane & 15, fq = lane >> 4;
    LAS float* dtv = (LAS float*)lds; LAS float* cumv = dtv + 1024;
    LAS bf16_t* BmT = (LAS bf16_t*)(lds + 8192);
    LAS bf16_t* xw = (LAS bf16_t*)(lds + 8192 + 36864) + w * (64 * 72);
    ssd_dtcum<L>(wv, P, l, I, dtv, cumv);
    LAS bf16_t* xwall = (LAS bf16_t*)(lds + 8192 + 36864);
    ssd_stage<L, 32>(P, h, l, I, tid, [](int c8) { return 1024 + c8 * 8; }, [&](int t, int c8, const float* v) {
#pragma unroll
        for (int e = 0; e < 8; ++e) BmT[SW72(c8 * 8 + e, t)] = f2bf(v[e]); });
    if (L < LP) for (int idx = tid; idx < 256 * (LP - L); idx += 512) BmT[SW72(idx / (LP - L), L + idx % (LP - L))] = 0;
    for (int hh = 0; hh < 2; ++hh) {
        const int head = w + 8 * hh;
        const float cl = cumv[(L - 1) * 16 + head];
        __syncthreads();
        ssd_stage<L, 64>(P, h, l, I, tid, [=](int c8) { return hh * 512 + c8 * 8; }, [&](int t, int c8, const float* v) {
            const int hd = hh * 8 + (c8 >> 3);
            const float sc = __expf(cumv[(L - 1) * 16 + hd] - cumv[t * 16 + hd]) * dtv[t * 16 + hd];
            LAS bf16_t* dst = xwall + (c8 >> 3) * (64 * 72);
#pragma unroll
            for (int e = 0; e < 8; ++e) dst[SW72((c8 & 7) * 8 + e, t)] = f2bf(v[e] * sc); });
        if (L < LP) for (int idx = tid; idx < 512 * (LP - L); idx += 512) xwall[SW72(idx / (LP - L), L + idx % (LP - L))] = 0;
        __syncthreads();
        const float dec = __expf(cl);
        if (!I.sample && lane == 0) cdec[item * 16 + head] = dec;
#pragma unroll 1
        for (int nt = 0; nt < 8; ++nt) {
            bf16x8 af[KS];
#pragma unroll
            for (int ks = 0; ks < KS; ++ks) af[ks] = *(const LAS bf16x8*)(BmT + SW72(hh * 128 + nt * 16 + fr, ks * 32 + fq * 8));
#pragma unroll
            for (int pt = 0; pt < 4; ++pt) {
                f32x4 a = (f32x4){0.f, 0.f, 0.f, 0.f};
#pragma unroll
                for (int ks = 0; ks < KS; ++ks) a = MFMA16(af[ks], *(const LAS bf16x8*)(xw + SW72(pt * 16 + fr, ks * 32 + fq * 8)), a);
                const int p = pt * 16 + fr, n0 = nt * 16 + fq * 4;
                if (!I.sample) {
                    u32x2 ow; ow.x = pk2(a[0], a[1]); ow.y = pk2(a[2], a[3]);
                    *(u32x2*)(states + ((size_t)((I.b * 128 + I.c) * 16 + head) * 64 + p) * 128 + n0) = ow;
                } else {
                    const size_t o = ((size_t)((l * 16 + I.sb) * 16 + head) * 64 + p) * 128 + n0;
                    const f32x4 h0 = *(const f32x4*)(P->in[I_SSH] + o);
                    *(f32x4*)(P->out + O_SSH + o) = h0 * dec + a;
                }
            }
        }
    }
}

template <int L>
__device__ __forceinline__ void ssd_y_item(int wv, KP P, int l, const Item& I, LAS unsigned char* lds) {
    constexpr int LP = L < 32 ? 32 : L, KS = LP / 32, NIT = L / 16;
    const bf16_t* h = (const bf16_t*)(P->ws + WS_H);
    const bf16_t* states = (const bf16_t*)(P->ws + WS_ST);
    bf16_t* yabc = (bf16_t*)(P->ws + WS_Y);
    const int tid = tidx(wv), w = tid >> 6, lane = tid & 63, fr = lane & 15, fq = lane >> 4;
    LAS float* dtv = (LAS float*)lds; LAS float* cumv = dtv + 1024;
    LAS bf16_t* Bm = (LAS bf16_t*)(lds + 8192);
    LAS bf16_t* Cm = (LAS bf16_t*)(lds + 8192 + 17408);
    LAS float* CBl = (LAS float*)(lds + 8192 + 2 * 17408);
    LAS float* part = (LAS float*)(lds + 8192 + 3 * 17408);
    LAS bf16_t* xT = (LAS bf16_t*)(lds + 8192 + 3 * 17408 + 2048) + w * (64 * 72);
    ssd_dtcum<L>(wv, P, l, I, dtv, cumv);
    for (int g = 0; g < 2; ++g) {
        const int head = g * 8 + w;
        __syncthreads();
        ssd_stage<L, 32>(P, h, l, I, tid, [=](int c8) { return 1024 + (c8 >> 4) * 256 + g * 128 + (c8 & 15) * 8; }, [&](int t, int c8, const float* v) {
            u32x4 ow; ow.x = pk2(v[0], v[1]); ow.y = pk2(v[2], v[3]); ow.z = pk2(v[4], v[5]); ow.w = pk2(v[6], v[7]);
            *(LAS u32x4*)(((c8 >> 4) ? Cm : Bm) + t * 136 + (c8 & 15) * 8) = ow; });
        {
            LAS bf16_t* xTall = (LAS bf16_t*)(lds + 8192 + 3 * 17408 + 2048);
            ssd_stage<L, 64>(P, h, l, I, tid, [=](int c8) { return g * 512 + c8 * 8; }, [&](int t, int c8, const float* v) {
                LAS bf16_t* dst = xTall + (c8 >> 3) * (64 * 72);
#pragma unroll
                for (int e = 0; e < 8; ++e) dst[SW72((c8 & 7) * 8 + e, t)] = f2bf(v[e]); });
            if (L < LP) for (int idx = tid; idx < 512 * (LP - L); idx += 512) xTall[SW72(idx / (LP - L), L + idx % (LP - L))] = 0;
        }
        __syncthreads();
        for (int tix = w; tix < NIT * NIT; tix += 8) {
            const int it = tix / NIT, jt = tix % NIT;
            f32x4 a = (f32x4){0.f, 0.f, 0.f, 0.f};
#pragma unroll
            for (int ks = 0; ks < 4; ++ks)
                a = MFMA16(*(const LAS bf16x8*)(Cm + (it * 16 + fr) * 136 + ks * 32 + fq * 8), *(const LAS bf16x8*)(Bm + (jt * 16 + fr) * 136 + ks * 32 + fq * 8), a);
#pragma unroll
            for (int jj = 0; jj < 4; ++jj) CBl[(it * 16 + fq * 4 + jj) * 68 + jt * 16 + fr] = a[jj];
        }
        __syncthreads();
        const float dsk = P->in[I_SD][l * 16 + head];
        bf16x8 hf[4][4];
#pragma unroll
        for (int pt = 0; pt < 4; ++pt) {
            const int p = pt * 16 + fr;
            if (!I.sample) {
                const bf16_t* sp = states + ((size_t)((I.b * 128 + I.c) * 16 + head) * 64 + p) * 128 + fq * 8;
#pragma unroll
                for (int ks = 0; ks < 4; ++ks) hf[pt][ks] = *(const bf16x8*)(sp + ks * 32);
            } else {
                const float* sp = P->in[I_SSH] + ((size_t)((l * 16 + I.sb) * 16 + head) * 64 + p) * 128 + fq * 8;
#pragma unroll
                for (int ks = 0; ks < 4; ++ks) {
                    const f32x4 a0 = *(const f32x4*)(sp + ks * 32), a1 = *(const f32x4*)(sp + ks * 32 + 4);
                    u32x4 ww; ww.x = pk2(a0[0], a0[1]); ww.y = pk2(a0[2], a0[3]); ww.z = pk2(a1[0], a1[1]); ww.w = pk2(a1[2], a1[3]);
                    __builtin_memcpy(&hf[pt][ks], &ww, 16);
                }
            }
        }
        u32x2 zcur[4];
#pragma unroll
        for (int pt = 0; pt < 4; ++pt) zcur[pt] = *(const u32x2*)(h + (size_t)(I.row0 + fr) * HP + HZ + head * 64 + pt * 16 + fq * 4);
#pragma unroll 1
        for (int it = 0; it < NIT; ++it) {
            const int i = it * 16 + fr; const float cum_i = cumv[i * 16 + head];
            u32x2 znext[4];
#pragma unroll
            for (int pt = 0; pt < 4; ++pt) znext[pt] = zcur[pt];
            if (it + 1 < NIT) {
#pragma unroll
                for (int pt = 0; pt < 4; ++pt) znext[pt] = *(const u32x2*)(h + (size_t)(I.row0 + i + 16) * HP + HZ + head * 64 + pt * 16 + fq * 4);
            }
            f32x4 acc[4];
#pragma unroll
            for (int pt = 0; pt < 4; ++pt) acc[pt] = (f32x4){0.f, 0.f, 0.f, 0.f};
#pragma unroll
            for (int ks = 0; ks < KS; ++ks) {
                if (ks * 32 > it * 16 + 15) continue;
                const int j0 = ks * 32 + fq * 8;
                const f32x4 c0 = *(const LAS f32x4*)(CBl + i * 68 + j0), c1 = *(const LAS f32x4*)(CBl + i * 68 + j0 + 4);
                float wv8[8];
#pragma unroll
                for (int e = 0; e < 8; ++e) {
                    const int j = j0 + e; const float cb = e < 4 ? c0[e & 3] : c1[e & 3];
                    const float ex = __expf(fminf(cum_i - cumv[j * 16 + head], 0.f));
                    wv8[e] = (j <= i) ? cb * ex * dtv[j * 16 + head] : 0.f;
                }
                u32x4 ww; ww.x = pk2(wv8[0], wv8[1]); ww.y = pk2(wv8[2], wv8[3]); ww.z = pk2(wv8[4], wv8[5]); ww.w = pk2(wv8[6], wv8[7]);
                bf16x8 wf; __builtin_memcpy(&wf, &ww, 16);
#pragma unroll
                for (int pt = 0; pt < 4; ++pt) acc[pt] = MFMA16(*(const LAS bf16x8*)(xT + SW72(pt * 16 + fr, j0)), wf, acc[pt]);
            }
            const float ecum = __expf(cum_i);
            bf16x8 cf[4];
#pragma unroll
            for (int ks = 0; ks < 4; ++ks) cf[ks] = *(const LAS bf16x8*)(Cm + i * 136 + ks * 32 + fq * 8);
#pragma unroll
            for (int pt = 0; pt < 4; ++pt) {
                f32x4 t2 = (f32x4){0.f, 0.f, 0.f, 0.f};
#pragma unroll
                for (int ks = 0; ks < 4; ++ks) t2 = MFMA16(hf[pt][ks], cf[ks], t2);
                acc[pt] += t2 * ecum;
            }
            float ss = 0.f;
#pragma unroll
            for (int pt = 0; pt < 4; ++pt) {
                const int p0 = pt * 16 + fq * 4;
                const u32x2 zw = zcur[pt];
                const float zv[4] = {bflo(zw.x), bfhi(zw.x), bflo(zw.y), bfhi(zw.y)};
                float yv[4];
#pragma unroll
                for (int jj = 0; jj < 4; ++jj) {
                    const float xs = bf2f(xT[SW72(p0 + jj, i)]);
                    const float y = (acc[pt][jj] + dsk * xs) * siluf_(zv[jj]);
                    yv[jj] = y; ss += y * y;
                }
                u32x2 ow; ow.x = pk2(yv[0], yv[1]); ow.y = pk2(yv[2], yv[3]);
                *(u32x2*)(yabc + (size_t)(I.row0 + i) * 3072 + 1024 + head * 64 + p0) = ow;
            }
            ss += shflx(ss, 16); ss += shflx(ss, 32);
            if (fq == 0) part[i * 8 + w] = ss;
#pragma unroll
            for (int pt = 0; pt < 4; ++pt) zcur[pt] = znext[pt];
        }
        __syncthreads();
        f32x4 ngv[4];
#pragma unroll
        for (int pt = 0; pt < 4; ++pt) ngv[pt] = *(const f32x4*)(P->in[I_SNORM] + l * 1024 + head * 64 + pt * 16 + fq * 4);
        u32x2 ycur[4];
#pragma unroll
        for (int pt = 0; pt < 4; ++pt) ycur[pt] = *(const u32x2*)(yabc + (size_t)(I.row0 + fr) * 3072 + 1024 + head * 64 + pt * 16 + fq * 4);
#pragma unroll 1
        for (int it = 0; it < NIT; ++it) {
            const int i = it * 16 + fr;
            u32x2 ynext[4];
#pragma unroll
            for (int pt = 0; pt < 4; ++pt) ynext[pt] = ycur[pt];
            if (it + 1 < NIT) {
#pragma unroll
                for (int pt = 0; pt < 4; ++pt) ynext[pt] = *(const u32x2*)(yabc + (size_t)(I.row0 + i + 16) * 3072 + 1024 + head * 64 + pt * 16 + fq * 4);
            }
            const f32x4 pa = *(const LAS f32x4*)(part + i * 8), pb = *(const LAS f32x4*)(part + i * 8 + 4);
            const float tot = (pa[0] + pa[1] + pa[2] + pa[3]) + (pb[0] + pb[1] + pb[2] + pb[3]);
            const float rs = rsqrtf(tot * (1.0f / 512.0f) + EPS);
#pragma unroll
            for (int pt = 0; pt < 4; ++pt) {
                const int p0 = pt * 16 + fq * 4;
                const f32x4 ng = ngv[pt];
                const u32x2 yw = ycur[pt];
                u32x2 ow; ow.x = pk2(bflo(yw.x) * rs * ng[0], bfhi(yw.x) * rs * ng[1]); ow.y = pk2(bflo(yw.y) * rs * ng[2], bfhi(yw.y) * rs * ng[3]);
                *(u32x2*)(yabc + (size_t)(I.row0 + i) * 3072 + 1024 + head * 64 + p0) = ow;
            }
#pragma unroll
            for (int pt = 0; pt < 4; ++pt) ycur[pt] = ynext[pt];
        }
    }
}

__device__ __forceinline__ void phase_scan(int wv, KP P, int l) {
    bf16_t* states = (bf16_t*)(P->ws + WS_ST);
    const float* cdec = (const float*)(P->ws + WS_CDEC);
    const float* lruA = (const float*)(P->ws + WS_LRUA); float* lruU = (float*)(P->ws + WS_LRUU);
    if (DBG_P5S) for (int idx = bidx() * 512 + tidx(wv); idx < 131072; idx += gdim() * 512) {
        const int e = idx * 2, b = e >> 17, rem = e & 131071, head = rem >> 13;
        unsigned* sp = (unsigned*)(states + (size_t)b * 128 * 131072 + rem);
        const float* dp = cdec + (b * 128) * 16 + head;
        float c0 = 0.f, c1 = 0.f;
        for (int c = 0; c < 128; c += 32) {
            unsigned v[32]; float dv[32];
#pragma unroll
            for (int k = 0; k < 32; ++k) { v[k] = sp[(size_t)(c + k) * 65536]; dv[k] = dp[(c + k) * 16]; }
#pragma unroll
            for (int k = 0; k < 32; ++k) {
                const float dec = dv[k];
                sp[(size_t)(c + k) * 65536] = pk2(c0, c1);
                c0 = dec * c0 + bflo(v[k]); c1 = dec * c1 + bfhi(v[k]);
            }
        }
        float* op = P->out + O_PSH + (size_t)(l * 2 + b) * 131072 + rem;
        op[0] = c0; op[1] = c1;
    }
    if (DBG_LRU4) for (int idx = bidx() * 512 + tidx(wv); idx < 2048; idx += gdim() * 512) {
        const int b = idx >> 10, ch = idx & 1023;
        float carry = 0.f;
        for (int c = 0; c < 128; c += 32) {
            float Av[32], Uv[32];
#pragma unroll
            for (int k = 0; k < 32; ++k) { const size_t o = (size_t)(b * 128 + c + k) * 1024 + ch; Av[k] = lruA[o]; Uv[k] = lruU[o]; }
#pragma unroll
            for (int k = 0; k < 32; ++k) { const size_t o = (size_t)(b * 128 + c + k) * 1024 + ch; lruU[o] = carry; carry = Av[k] * carry + Uv[k]; }
        }
    }
}

__device__ __forceinline__ void gsync(cg::grid_group& grid) {
    grid.sync();
}
#define XB_TMO      128
#define XB_XCNT(j)  (256  + 64 * (j))
#define XB_XSUB(j)  (1280 + 64 * (j))
#define XB_XGEN(j)  (2304 + 64 * (j))
#define XB_TOP      3328
#define XB_TOPGEN   3392
#define XCD_BAR_WORDS 3456
#define XB_SPIN_CAP (1u << 20)
__device__ __forceinline__ unsigned xb_ld(unsigned* p)              { return __hip_atomic_load(p, __ATOMIC_RELAXED, __HIP_MEMORY_SCOPE_AGENT); }
__device__ __forceinline__ unsigned xb_add(unsigned* p, unsigned v) { return __hip_atomic_fetch_add(p, v, __ATOMIC_RELAXED, __HIP_MEMORY_SCOPE_AGENT); }
__device__ __forceinline__ unsigned xb_xcc_id() { return (unsigned)__builtin_amdgcn_s_getreg((3 << 11) | 20) & 0xFu; }
#define XB_SPIN(cond, bar) do { unsigned _sp = 0; while (cond) { __builtin_amdgcn_s_sleep(1); \
    if ((++_sp & 255u) == 0u) { if (xb_ld(&(bar)[XB_TMO])) break; if (_sp > XB_SPIN_CAP) { atomicAdd(&(bar)[XB_TMO], 1u); break; } } } } while (0)
__device__ __forceinline__ void xcd_barrier_complete(unsigned* bar, unsigned x, unsigned& nloc, unsigned& nx) {
    const unsigned G = (unsigned)gdim();
    unsigned sum, cnt, mine, sp = 0u;
    for (;;) {
        sum = 0u; cnt = 0u; mine = 0u;
#pragma unroll
        for (unsigned j = 0; j < 16; ++j) { const unsigned c = xb_ld(&bar[XB_XCNT(j)]); sum += c; cnt += (c > 0u) ? 1u : 0u; mine = (j == x) ? c : mine; }
        if (sum == G) break;
        __builtin_amdgcn_s_sleep(1);
        if ((++sp & 255u) == 0u) { if (xb_ld(&bar[XB_TMO])) break; if (sp > XB_SPIN_CAP) { atomicAdd(&bar[XB_TMO], 1u); break; } }
    }
    nloc = mine > 0u ? mine : 1u; nx = cnt > 0u ? cnt : 1u;
}
__device__ __forceinline__ void gbar(int wv, LAS unsigned char* lds) {
    asm volatile("s_waitcnt vmcnt(0)" ::: "memory");
    __syncthreads();
    unsigned* bar = (unsigned*)(kparams()->ws + WS_BAR);
    if (tidx(wv) == 0) {
        volatile LAS unsigned* st = (volatile LAS unsigned*)(lds + LDS_BYTES - 16);
        const unsigned x = xb_xcc_id();
        __builtin_amdgcn_s_waitcnt(0);
        unsigned nloc = st[0], nx = st[1];
        if (nloc == 0u) { xcd_barrier_complete(bar, x, nloc, nx); st[0] = nloc; st[1] = nx; }
        const unsigned old = xb_add(&bar[XB_XSUB(x)], 1u);
        const unsigned gen = old / nloc;
        if (old + 1u == (gen + 1u) * nloc) {
            __builtin_amdgcn_fence(__ATOMIC_RELEASE, "agent");
            asm volatile("s_waitcnt vmcnt(0)" ::: "memory");
            const unsigned og = xb_add(&bar[XB_TOP], 1u);
            const unsigned tg = og / nx;
            if (og + 1u == (tg + 1u) * nx) xb_add(&bar[XB_TOPGEN], 1u);
            else XB_SPIN(xb_ld(&bar[XB_TOPGEN]) == tg, bar);
            __builtin_amdgcn_fence(__ATOMIC_ACQUIRE, "agent");
            xb_add(&bar[XB_XGEN(x)], 1u);
            asm volatile("s_waitcnt vmcnt(0)" ::: "memory");
        } else {
            XB_SPIN(xb_ld(&bar[XB_XGEN(x)]) == gen, bar);
            __builtin_amdgcn_fence(__ATOMIC_ACQUIRE, "agent");
            asm volatile("s_waitcnt vmcnt(0)" ::: "memory");
        }
    }
    __syncthreads();
}
__device__ __forceinline__ void gemm_gu(int wv, LAS unsigned char* lds, int j2) { KP P = kparams();
    EpiGU E; E.ssq = (const float*)(P->ws + WS_SSQ); E.hff = (bf16_t*)(P->ws + WS_H);
    run_gemm(wv, lds, (const bf16_t*)(P->ws + WS_XB), (const bf16_t*)(P->ws + (j2 ? W_GU1 : W_GU0)), MT, 5632, 1024, E); }
__device__ __forceinline__ void gemm_dn(int wv, LAS unsigned char* lds, int j2) { KP P = kparams();
    EpiRes E; E.x = P->out; E.xb = (bf16_t*)(P->ws + WS_XB); E.ssq = (float*)(P->ws + WS_SSQ); E.scale = 0.5f;
    run_gemm(wv, lds, (const bf16_t*)(P->ws + WS_H), (const bf16_t*)(P->ws + (j2 ? W_DN1 : W_DN0)), MP, 1024, 2816, E);
    skinny_gemm<0>(wv, lds, kparams(), (const bf16_t*)(kparams()->ws + WS_H) + (size_t)MP * DFF, (const bf16_t*)(kparams()->ws + (j2 ? W_DN1 : W_DN0)), 2816, 0.5f); }
__device__ __forceinline__ void gemm_in(int wv, LAS unsigned char* lds) { KP P = kparams();
    EpiIn E; E.ssq = (const float*)(P->ws + WS_SSQ); E.h = (bf16_t*)(P->ws + WS_H); E.dtraw = (float*)(P->ws + WS_DT);
    run_gemm(wv, lds, (const bf16_t*)(P->ws + WS_XB), (const bf16_t*)(P->ws + W_IN), MT, NINP, 1024, E); }
__device__ __forceinline__ void gemm_merge(int wv, LAS unsigned char* lds) { KP P = kparams();
    EpiMerge E; E.h = (const bf16_t*)(P->ws + WS_H); E.merged = (bf16_t*)(P->ws + WS_ST);
    run_gemm(wv, lds, (const bf16_t*)(P->ws + WS_Y), (const bf16_t*)(P->ws + W_BR), MP, 1024, 3072, E);
    skinny_gemm<1>(wv, lds, kparams(), (const bf16_t*)(kparams()->ws + WS_Y) + (size_t)MP * 3072, (const bf16_t*)(kparams()->ws + W_BR), 3072, 1.0f); }
__device__ __forceinline__ void gemm_out(int wv, LAS unsigned char* lds) { KP P = kparams();
    EpiRes E; E.x = P->out; E.xb = (bf16_t*)(P->ws + WS_XB); E.ssq = (float*)(P->ws + WS_SSQ); E.scale = 1.0f;
    run_gemm(wv, lds, (const bf16_t*)(P->ws + WS_ST), (const bf16_t*)(P->ws + W_OUT), MP, 1024, 1024, E);
    skinny_gemm<0>(wv, lds, kparams(), (const bf16_t*)(kparams()->ws + WS_ST) + (size_t)MP * DM, (const bf16_t*)(kparams()->ws + W_OUT), 1024, 1.0f); }

__global__ __launch_bounds__(512, 2) void mega(Params Pk) {
    extern __shared__ __attribute__((aligned(16))) unsigned char smem[];
    LAS unsigned char* lds = (LAS unsigned char*)smem;
    cg::grid_group grid = cg::this_grid();
    const int wv = __builtin_amdgcn_readfirstlane((int)(threadIdx.x >> 6));
    unsigned* bar0 = (unsigned*)(kparams()->ws + WS_BAR);
    if (threadIdx.x == 0) {
        volatile LAS unsigned* st = (volatile LAS unsigned*)(lds + LDS_BYTES - 16); st[0] = 0u; st[1] = 0u;
        (void)xb_add(&bar0[XB_XCNT(xb_xcc_id())], 1u);
    }
    __syncthreads();
    phase_init(wv, kparams());
    convert_layer(wv, kparams(), 0, 0, gdim(), lds);
    gsync(grid);
    unsigned long long tacc = 0, t0 = 0;
#pragma unroll 1
    for (int step = 0; step < 8; ++step) {
        const int l = step >> 1, j2 = step & 1;
        gbar(wv, lds);
        TB(0); gemm_gu(wv, lds, j2); gbar(wv, lds); TE(0);
        TB(1); gemm_dn(wv, lds, j2);
        if (j2 == 0) {
            gbar(wv, lds); TE(1);
            TB(2); gemm_in(wv, lds); gbar(wv, lds); TE(2);
            TB(3);
            for (int item = bidx(); item < 256; item += gdim()) {
                const Item I = get_item(item);
                copy_states_item(wv, kparams(), l, I);
                attn_item<64>(wv, kparams(), l, I, lds);
                lru_item<64, false>(wv, kparams(), l, item, I, lds);
                ssd_states_item<64>(wv, kparams(), l, item, I, lds);
            }
            gbar(wv, lds); TE(3);
            TB(4);
            phase_scan(wv, kparams(), l);
            {
                const int nconv = gdim() > 128 ? gdim() - 64 : gdim();
                convert_layer(wv, kparams(), l, 1, nconv, lds);
                if (l < 3) convert_layer(wv, kparams(), l + 1, 0, nconv, lds);
                for (int sj = bidx() - (gdim() > 128 ? gdim() - 64 : 0); sj >= 0 && sj < 64; sj += gdim()) {
                    const int sb = sj & 15, piece = sj >> 4;
                    const Item I = get_item(256 + sb);
                    if (piece == 0) lru_item<16, true>(wv, kparams(), l, 256 + sb, I, lds);
                    else if (piece == 1) ssd_states_item<16>(wv, kparams(), l, 256 + sb, I, lds);
                    else if (piece == 2) ssd_y_item<16>(wv, kparams(), l, I, lds);
                    else { copy_states_item(wv, kparams(), l, I); attn_item<16>(wv, kparams(), l, I, lds); }
                }
            }
            gbar(wv, lds); TE(4);
            TB(5);
            for (int item = bidx(); item < 256; item += gdim()) {
                const Item I = get_item(item);
                lru_apply_item(wv, kparams(), l, item, I);
                ssd_y_item<64>(wv, kparams(), l, I, lds);
            }
            gbar(wv, lds); TE(5);
            TB(6); gemm_merge(wv, lds); gbar(wv, lds); TE(6);
            TB(7); gemm_out(wv, lds);
        }
    }
    gbar(wv, lds);
    TE(7);
    phase_final(wv, kparams());
    if (PROBE >= 0 && bidx() == 0) { const unsigned long long tend = TNOW() + tacc; while (TNOW() < tend) __builtin_amdgcn_s_sleep(10); }
#if DBG_SANITIZE
    gbar(wv, lds);
    { KP P = kparams(); float* o = P->out;
      for (size_t i = (size_t)bidx() * 512 + tidx(wv); i < O_END; i += (size_t)gdim() * 512) { const float v = o[i]; if (!(fabsf(v) < 1e30f)) o[i] = 0.f; } }
#endif
}

extern "C" void kernel_launch(void* const* d_in, const int* in_sizes, int n_in, void* d_out, int out_size, void* d_ws, size_t ws_size, hipStream_t stream) {
    static int grid_blocks = 0;
    if (grid_blocks == 0) {
        if (n_in != N_INPUTS || (size_t)out_size != O_END || ws_size < WS_END) {
            fprintf(stderr, "kernel_launch: unexpected shapes: n_in %d out %d ws %zu (need %zu)\n", n_in, out_size, ws_size, (size_t)WS_END); grid_blocks = -1; return; }
        int dev = 0, cus = 0, per_cu = 0;
        hipGetDevice(&dev);
        hipDeviceGetAttribute(&cus, hipDeviceAttributeMultiprocessorCount, dev);
        if (hipFuncSetAttribute((const void*)mega, hipFuncAttributeMaxDynamicSharedMemorySize, LDS_BYTES) != hipSuccess) { fprintf(stderr, "hipFuncSetAttribute failed\n"); grid_blocks = -1; return; }
        hipOccupancyMaxActiveBlocksPerMultiprocessor(&per_cu, (const void*)mega, 512, LDS_BYTES);
        if (per_cu < 1) per_cu = 1;
        grid_blocks = cus * per_cu;
    }
    if (grid_blocks < 0) return;
    Params p{};
    for (int i = 0; i < N_INPUTS; ++i) p.in[i] = (const float*)d_in[i];
    p.out = (float*)d_out; p.ws = (unsigned char*)d_ws;
    if (hipMemsetAsync((unsigned char*)d_ws + WS_BAR, 0, 16384, stream) != hipSuccess) { fprintf(stderr, "memset failed\n"); return; }
    void* args[] = {&p};
    hipError_t e = hipLaunchCooperativeKernel((const void*)mega, dim3(grid_blocks), dim3(512), args, LDS_BYTES, stream);
    if (e != hipSuccess) fprintf(stderr, "cooperative launch failed: %s (grid %d)\n", hipGetErrorString(e), grid_blocks);
}
```
